# Optimizing an MI355X kernel written in HIP

```python
import math
import jax, jax.numpy as jnp
from jax import lax
import numpy as np


D_MODEL = 1024
BATCH = 4
SEQ = 8192
DEPTH = 2

GRID_W = 64
CTX_LEN = 256
D_SSM = 512
SSM_GROUP = 16
N_SSM_GROUPS = D_SSM // SSM_GROUP
SSM_STATE = 64
N_HEADS = 8
QK_NOPE = 64
QK_ROPE = 32
V_HEAD = 64
Q_LORA = 256
KV_LORA = 128
D_QK = QK_NOPE + QK_ROPE
D_ATT = N_HEADS * V_HEAD
D_MIX = D_SSM + D_ATT
D_IN = D_SSM + Q_LORA + KV_LORA + QK_ROPE
AXIS_ROPE = QK_ROPE // 2
ROPE_FREQS = AXIS_ROPE // 2
ROPE_BASE = 10000.0
ATT_SCALE = 1.0 / math.sqrt(D_QK)
Q_BLOCK = 128
D_FF = 2816
N_EXPERTS = 8
TOP_K = 2
D_FF_EXPERT = 1408
N_DENSE = (DEPTH + 1) // 2
N_MOE = DEPTH // 2
EPS = 1e-6

kernel_name = 'hymba_s5_mla_moe_dit_prefix'


def rmsnorm(x, g):
    xf = x.astype(jnp.float32)
    y = xf * lax.rsqrt(jnp.mean(xf * xf, axis=-1, keepdims=True) + EPS)
    return (y * g.astype(jnp.float32)).astype(x.dtype)


def modulate(h, shift, scale):
    return h * (1 + scale) + shift


def axial_rope_tables(L):
    rows = L // GRID_W
    t = jnp.arange(L)
    row = jnp.repeat(jnp.arange(rows), GRID_W, total_repeat_length=L).astype(jnp.float32)
    col = (t % GRID_W).astype(jnp.float32)
    inv_freq = ROPE_BASE ** (-2.0 * jnp.arange(ROPE_FREQS, dtype=jnp.float32) / AXIS_ROPE)
    ang = jnp.stack([row[:, None] * inv_freq, col[:, None] * inv_freq], axis=1)
    return jnp.cos(ang), jnp.sin(ang)


def axial_rope(x, cos, sin):
    xs = x.reshape(x.shape[:-1] + (2, 2, ROPE_FREQS))
    x1, x2 = xs[..., 0, :], xs[..., 1, :]
    shape = (1, cos.shape[0]) + (1,) * (x.ndim - 3) + (2, ROPE_FREQS)
    cs, sn = cos.reshape(shape), sin.reshape(shape)
    out = jnp.stack([x1 * cs - x2 * sn, x2 * cs + x1 * sn], axis=-2)
    return out.reshape(x.shape)


def s5_discretize(a_re, a_im, log_dt, b_re, b_im):
    a_re, a_im = a_re.astype(jnp.float32), a_im.astype(jnp.float32)
    dt = jnp.exp(log_dt.astype(jnp.float32))[..., None]
    mag = jnp.exp(dt * a_re)
    ab_re, ab_im = mag * jnp.cos(dt * a_im), mag * jnp.sin(dt * a_im)
    den = a_re * a_re + a_im * a_im
    num_re = ab_re - 1.0
    f_re = (num_re * a_re + ab_im * a_im) / den
    f_im = (ab_im * a_re - num_re * a_im) / den
    b_re, b_im = b_re.astype(jnp.float32), b_im.astype(jnp.float32)
    bb_re = f_re[..., None] * b_re - f_im[..., None] * b_im
    bb_im = f_re[..., None] * b_im + f_im[..., None] * b_re
    return ab_re, ab_im, bb_re, bb_im


def s5_scan(ab_re, ab_im, bb_re, bb_im, ug, h0_re, h0_im, reverse):
    L = ug.shape[1]
    bu_re = jnp.einsum('blgc,gpc->lbgp', ug, bb_re)
    bu_im = jnp.einsum('blgc,gpc->lbgp', ug, bb_im)
    a_re = jnp.broadcast_to(ab_re, (L, 1) + ab_re.shape)
    a_im = jnp.broadcast_to(ab_im, (L, 1) + ab_im.shape)

    def combine(e1, e2):
        a1r, a1i, b1r, b1i = e1
        a2r, a2i, b2r, b2i = e2
        return (a2r * a1r - a2i * a1i, a2r * a1i + a2i * a1r,
                a2r * b1r - a2i * b1i + b2r, a2r * b1i + a2i * b1r + b2i)

    pa_re, pa_im, h_re, h_im = lax.associative_scan(combine, (a_re, a_im, bu_re, bu_im),
                                                    reverse=reverse, axis=0)
    h_re = h_re + pa_re * h0_re[None] - pa_im * h0_im[None]
    h_im = h_im + pa_re * h0_im[None] + pa_im * h0_re[None]
    return h_re, h_im


def s5_readout(h_re, h_im, c_re, c_im):
    return (jnp.einsum('lbgp,gcp->blgc', h_re, c_re)
            - jnp.einsum('lbgp,gcp->blgc', h_im, c_im))


def s5_glu(y, w_glu, b_glu):
    z = jax.nn.gelu(y)
    return z * jax.nn.sigmoid(z @ w_glu.astype(jnp.float32) + b_glu.astype(jnp.float32))


def s5_mixer(u, uc, a_re, a_im, log_dt, b_re, b_im, c_re, c_im, d_skip, w_glu, b_glu, need_ctx):
    B, L, _ = u.shape
    Lc = uc.shape[1]
    ab_re, ab_im, bb_re, bb_im = s5_discretize(a_re, a_im, log_dt, b_re, b_im)
    c_re, c_im = c_re.astype(jnp.float32), c_im.astype(jnp.float32)
    ug = u.astype(jnp.float32).reshape(B, L, N_SSM_GROUPS, SSM_GROUP)
    ucg = uc.astype(jnp.float32).reshape(B, Lc, N_SSM_GROUPS, SSM_GROUP)
    zero = jnp.zeros((B, N_SSM_GROUPS, SSM_STATE), jnp.float32)
    d = d_skip.astype(jnp.float32).reshape(N_SSM_GROUPS, SSM_GROUP)
    y = d * ug
    yc = d * ucg if need_ctx else None
    for dr, rev in enumerate((False, True)):
        hc_re, hc_im = s5_scan(ab_re[dr], ab_im[dr], bb_re[dr], bb_im[dr], ucg, zero, zero, rev)
        last = 0 if rev else Lc - 1
        h_re, h_im = s5_scan(ab_re[dr], ab_im[dr], bb_re[dr], bb_im[dr], ug,
                             hc_re[last], hc_im[last], rev)
        y = y + s5_readout(h_re, h_im, c_re[dr], c_im[dr])
        if need_ctx:
            yc = yc + s5_readout(hc_re, hc_im, c_re[dr], c_im[dr])
    out = s5_glu(y.reshape(B, L, D_SSM), w_glu, b_glu).astype(u.dtype)
    out_c = s5_glu(yc.reshape(B, Lc, D_SSM), w_glu, b_glu).astype(u.dtype) if need_ctx else None
    return out, out_c


def mla_queries(cq, q_norm, w_uq):
    B, L, _ = cq.shape
    return (rmsnorm(cq, q_norm) @ w_uq).reshape(B, L, N_HEADS, D_QK)


def mla_keys_values(ckv, kr, kv_norm, w_ukv):
    B, L, _ = ckv.shape
    kv = (rmsnorm(ckv, kv_norm) @ w_ukv).reshape(B, L, N_HEADS, QK_NOPE + V_HEAD)
    k_rope = jnp.broadcast_to(kr[:, :, None, :], (B, L, N_HEADS, QK_ROPE))
    k = jnp.concatenate([kv[..., :QK_NOPE], k_rope], axis=-1)
    return k, kv[..., QK_NOPE:]


def softmax_attend(q, k, v):
    s = jnp.einsum('bqhd,bkhd->bhqk', q, k).astype(jnp.float32) * ATT_SCALE
    p = jax.nn.softmax(s, axis=-1).astype(v.dtype)
    return jnp.einsum('bhqk,bkhd->bqhd', p, v)


def mla_mixer(cq, ckv, kr, cq_c, ckv_c, kr_c, q_norm, kv_norm, w_uq, w_ukv, cos, sin, need_ctx):
    B, L, _ = cq.shape
    Lc = ckv_c.shape[1]
    q = mla_queries(cq, q_norm, w_uq)
    q = jnp.concatenate([q[..., :QK_NOPE], axial_rope(q[..., QK_NOPE:], cos, sin)], axis=-1)
    k, v = mla_keys_values(ckv, axial_rope(kr, cos, sin), kv_norm, w_ukv)
    k_c, v_c = mla_keys_values(ckv_c, kr_c, kv_norm, w_ukv)
    k_all = jnp.concatenate([k, k_c], axis=1)
    v_all = jnp.concatenate([v, v_c], axis=1)
    nb = L // Q_BLOCK
    q_blocks = q.reshape(B, nb, Q_BLOCK, N_HEADS, D_QK).swapaxes(0, 1)
    out = lax.map(lambda qb: softmax_attend(qb, k_all, v_all), q_blocks)
    out = out.swapaxes(0, 1).reshape(B, L, D_ATT)
    out_c = None
    if need_ctx:
        q_c = mla_queries(cq_c, q_norm, w_uq)
        out_c = softmax_attend(q_c, k_c, v_c).reshape(B, Lc, D_ATT)
    return out, out_c


def swiglu(h, w1, w3, w2):
    return (jax.nn.silu(h @ w1) * (h @ w3)) @ w2


def moe_swiglu(h, router, w1, w3, w2):
    logits = (h @ router).astype(jnp.float32)
    top_val, top_idx = lax.top_k(logits, TOP_K)
    weights = jax.nn.softmax(top_val, axis=-1)
    gate = jnp.einsum('blk,blke->ble', weights,
                      jax.nn.one_hot(top_idx, N_EXPERTS, dtype=jnp.float32)).astype(h.dtype)
    y = jnp.zeros_like(h)
    for e in range(N_EXPERTS):
        y = y + gate[..., e:e + 1] * swiglu(h, w1[e], w3[e], w2[e])
    return y


def setup_inputs(seed: int = 0) -> dict:
    key = jax.random.key(seed)
    keys = iter(jax.random.split(key, 40))

    def nrm(shape, scale):
        return scale * jax.random.normal(next(keys), shape, jnp.float32)

    def gain(shape):
        return 1.0 + nrm(shape, 0.02)

    G, P, Hc = N_SSM_GROUPS, SSM_STATE, SSM_GROUP
    n_idx = jnp.arange(P, dtype=jnp.float32)
    return {
        'x': nrm((BATCH, SEQ, D_MODEL), 1.0),
        'c': nrm((BATCH, D_MODEL), 1.0),
        'ctx': nrm((BATCH, CTX_LEN, D_MODEL), 1.0),
        'c_ctx': nrm((D_MODEL,), 1.0),
        'w_ada': nrm((DEPTH, D_MODEL, 6 * D_MODEL), 0.5 * D_MODEL ** -0.5),
        'b_ada': nrm((DEPTH, 6 * D_MODEL), 0.02),
        'norm_mix': gain((DEPTH, D_MODEL)),
        'norm_ffn': gain((DEPTH, D_MODEL)),
        'w_in': nrm((DEPTH, D_MODEL, D_IN), D_MODEL ** -0.5),
        'q_norm': gain((DEPTH, Q_LORA)),
        'kv_norm': gain((DEPTH, KV_LORA)),
        'w_uq': nrm((DEPTH, Q_LORA, N_HEADS * D_QK), Q_LORA ** -0.5),
        'w_ukv': nrm((DEPTH, KV_LORA, N_HEADS * (QK_NOPE + V_HEAD)), KV_LORA ** -0.5),
        'ssm_a_re': -0.5 + nrm((DEPTH, 2, G, P), 0.01),
        'ssm_a_im': math.pi * n_idx + nrm((DEPTH, 2, G, P), 0.01),
        'ssm_log_dt': jax.random.uniform(next(keys), (DEPTH, 2, G), jnp.float32,
                                         math.log(1e-3), math.log(1e-1)),
        'ssm_b_re': nrm((DEPTH, 2, G, P, Hc), (2 * Hc) ** -0.5),
        'ssm_b_im': nrm((DEPTH, 2, G, P, Hc), (2 * Hc) ** -0.5),
        'ssm_c_re': nrm((DEPTH, 2, G, Hc, P), P ** -0.5),
        'ssm_c_im': nrm((DEPTH, 2, G, Hc, P), P ** -0.5),
        'ssm_d': nrm((DEPTH, D_SSM), 1.0),
        'w_glu': nrm((DEPTH, D_SSM, D_SSM), D_SSM ** -0.5),
        'b_glu': nrm((DEPTH, D_SSM), 0.02),
        'w_out': nrm((DEPTH, D_MIX, D_MODEL), D_MIX ** -0.5),
        'ffn_w1': nrm((N_DENSE, D_MODEL, D_FF), D_MODEL ** -0.5),
        'ffn_w3': nrm((N_DENSE, D_MODEL, D_FF), D_MODEL ** -0.5),
        'ffn_w2': nrm((N_DENSE, D_FF, D_MODEL), D_FF ** -0.5),
        'moe_router': nrm((N_MOE, D_MODEL, N_EXPERTS), D_MODEL ** -0.5),
        'moe_w1': nrm((N_MOE, N_EXPERTS, D_MODEL, D_FF_EXPERT), D_MODEL ** -0.5),
        'moe_w3': nrm((N_MOE, N_EXPERTS, D_MODEL, D_FF_EXPERT), D_MODEL ** -0.5),
        'moe_w2': nrm((N_MOE, N_EXPERTS, D_FF_EXPERT, D_MODEL), D_FF_EXPERT ** -0.5),
        'final_norm': gain((D_MODEL,)),
    }


def reference(x, c, ctx, c_ctx, w_ada, b_ada, norm_mix, norm_ffn, w_in, q_norm, kv_norm,
              w_uq, w_ukv, ssm_a_re, ssm_a_im, ssm_log_dt, ssm_b_re, ssm_b_im, ssm_c_re,
              ssm_c_im, ssm_d, w_glu, b_glu, w_out, ffn_w1, ffn_w3, ffn_w2, moe_router,
              moe_w1, moe_w3, moe_w2, final_norm):
    L = x.shape[1]
    cos, sin = axial_rope_tables(L)
    cos, sin = cos.astype(x.dtype), sin.astype(x.dtype)
    silu_c = jax.nn.silu(c)
    silu_cc = jax.nn.silu(c_ctx)
    splits = (D_SSM, D_SSM + Q_LORA, D_SSM + Q_LORA + KV_LORA)
    xc = ctx
    for i in range(DEPTH):
        need_ctx = i < DEPTH - 1
        mod = (silu_c @ w_ada[i] + b_ada[i])[:, None, :]
        mod_c = silu_cc @ w_ada[i] + b_ada[i]
        sh1, sc1, g1, sh2, sc2, g2 = jnp.split(mod, 6, axis=-1)
        sh1c, sc1c, g1c, sh2c, sc2c, g2c = jnp.split(mod_c, 6, axis=-1)
        z = modulate(rmsnorm(x, norm_mix[i]), sh1, sc1) @ w_in[i]
        zc = modulate(rmsnorm(xc, norm_mix[i]), sh1c, sc1c) @ w_in[i]
        u, cq, ckv, kr = jnp.split(z, splits, axis=-1)
        uc, cq_c, ckv_c, kr_c = jnp.split(zc, splits, axis=-1)
        y_ssm, yc_ssm = s5_mixer(u, uc, ssm_a_re[i], ssm_a_im[i], ssm_log_dt[i], ssm_b_re[i],
                                 ssm_b_im[i], ssm_c_re[i], ssm_c_im[i], ssm_d[i], w_glu[i],
                                 b_glu[i], need_ctx)
        y_att, yc_att = mla_mixer(cq, ckv, kr, cq_c, ckv_c, kr_c, q_norm[i], kv_norm[i],
                                  w_uq[i], w_ukv[i], cos, sin, need_ctx)
        x = x + g1 * (jnp.concatenate([y_ssm, y_att], axis=-1) @ w_out[i])
        if need_ctx:
            xc = xc + g1c * (jnp.concatenate([yc_ssm, yc_att], axis=-1) @ w_out[i])
        j = i // 2
        if i % 2 == 0:
            ffn = lambda t: swiglu(t, ffn_w1[j], ffn_w3[j], ffn_w2[j])
        else:
            ffn = lambda t: moe_swiglu(t, moe_router[j], moe_w1[j], moe_w3[j], moe_w2[j])
        x = x + g2 * ffn(modulate(rmsnorm(x, norm_ffn[i]), sh2, sc2))
        if need_ctx:
            xc = xc + g2c * ffn(modulate(rmsnorm(xc, norm_ffn[i]), sh2c, sc2c))
    return rmsnorm(x, final_norm)
```

```cpp
#include <hip/hip_runtime.h>
#include <cstdio>
#include <cstdint>

#define LAS __attribute__((address_space(3)))
#define GAS __attribute__((address_space(1)))
#define PG8_LAS LAS
typedef unsigned short bf16_t;
typedef short bf16x8 __attribute__((ext_vector_type(8)));
typedef float f32x4 __attribute__((ext_vector_type(4)));
typedef float f32x2 __attribute__((ext_vector_type(2)));
typedef unsigned u32x4 __attribute__((ext_vector_type(4)));
typedef unsigned u32x2 __attribute__((ext_vector_type(2)));
typedef __bf16 bf16x2_t __attribute__((ext_vector_type(2)));

#ifndef MK_N_LAUNCHES
#define MK_N_LAUNCHES 1
#endif

constexpr int DM = 1024, NB = 4, SEQ = 8192, CTXL = 256, NX = NB * SEQ, NC = NB * CTXL, NR = NX + NC;
constexpr int D_SSM = 512, NG = 32, NP = 64, NH = 8, DQK = 96, DIN = 928;
constexpr int DFF = 2816, NE = 8, DFE = 1408, DFE8 = 1536;
constexpr float EPS = 1e-6f;
constexpr float QSCALE = 0.10206207261596575f * 1.4426950408889634f;
constexpr int TCH = 32, NCH = NR / TCH;
constexpr int MOE_ROWS = 2 * NX + NE * 256;

constexpr size_t MiB = 1u << 20;
constexpr size_t WS_CTL = 0, CTL_ZERO_BYTES = 1 * MiB;
constexpr int CW_TMO = 0, CW_BAR = 4096, CW_MOE = 8192;
constexpr size_t WS_MOD = 64 * 1024;
constexpr size_t WS_RS = 5 * MiB;
constexpr size_t WS_COS = 1 * MiB, WS_SIN = WS_COS + 512 * 1024;
constexpr size_t WS_AB = 2 * MiB;
constexpr size_t WS_BB = WS_AB + 128 * 1024;
constexpr size_t WS_PW = 8 * MiB;
constexpr size_t WS_KL = 11 * MiB;
constexpr size_t WS_PROBE = 15 * MiB;
constexpr size_t WS_TOKE = 4 * MiB, WS_TOKP = WS_TOKE + 256 * 1024, WS_TOKW = WS_TOKP + 256 * 1024, WS_CNTB = WS_TOKW + 256 * 1024;
constexpr size_t WS_WIN = 16 * MiB, WS_WUQ = 20 * MiB, WS_WUKV = 21 * MiB, WS_WGLU = 22 * MiB, WS_WOUT = 23 * MiB;
constexpr size_t WS_WFF13 = 27 * MiB, WS_WFF2 = 38 * MiB, WS_WM13 = 44 * MiB, WS_WM2 = 88 * MiB;
constexpr size_t WS_XC = 112 * MiB;
constexpr size_t WS_RB = 116 * MiB;
constexpr size_t WS_XN = WS_RB, WS_Q = WS_RB, WS_XP = WS_RB, WS_YP = WS_RB;
constexpr size_t WS_W1T = WS_RB + 66 * MiB;
constexpr size_t WS_MT = WS_RB + 82 * MiB;
constexpr size_t WS_RA = 248 * MiB;
constexpr size_t WS_Z = WS_RA, WS_YMIX = WS_RA, WS_KN = WS_RA + 66 * MiB, WS_V = WS_RA + 99 * MiB, WS_KR = WS_RA + 132 * MiB;
constexpr size_t WS_ZG = WS_RA + 135 * MiB;
constexpr size_t WS_UH = WS_RA + 168 * MiB;
constexpr size_t WS_S = WS_RA + 218 * MiB;
constexpr size_t WS_H = WS_RA, WS_HP = WS_RA, WS_XNM = WS_RA + 182 * MiB;
constexpr size_t WS_END = 512 * MiB;
static_assert(WS_S + (size_t)32 * (NR / 32) * 256 * 4 <= WS_END && WS_UH + (size_t)32 * (NR / 32) * 768 * 2 + 512 * 1024 <= WS_S && WS_MT + (size_t)2 * 32 * 512 * 768 * 2 <= WS_RA && WS_XNM + (size_t)NX * DM * 2 <= WS_END && WS_H + (size_t)NR * DFF * 2 <= WS_XNM, "ws map");
static_assert(WS_RS + (size_t)2 * NR * 8 * 4 <= 16 * MiB && WS_MOD + 2 * 5 * 6144 * 4 <= CTL_ZERO_BYTES, "ctl map");

constexpr int RING_BYTES = 131072, LDSCTL_OFF = RING_BYTES, MISC_OFF = LDSCTL_OFF + 320, LDS_BYTES = 147456;

__device__ __forceinline__ unsigned f2bf(float f) { unsigned u = __builtin_bit_cast(unsigned, f); return (u + 0x7fffu + ((u >> 16) & 1u)) >> 16; }
__device__ __forceinline__ unsigned pk2(float lo, float hi) { f32x2 v = {lo, hi}; bf16x2_t b = __builtin_convertvector(v, bf16x2_t); return __builtin_bit_cast(unsigned, b); }
__device__ __forceinline__ unsigned pk4_fp8(float a, float b, float c, float d) { int w = 0; w = __builtin_amdgcn_cvt_pk_fp8_f32(a, b, w, false); w = __builtin_amdgcn_cvt_pk_fp8_f32(c, d, w, true); return (unsigned)w; }
constexpr float W8_SCALE = 64.f;
__device__ __forceinline__ float bflo(unsigned w) { return __builtin_bit_cast(float, w << 16); }
__device__ __forceinline__ float bfhi(unsigned w) { return __builtin_bit_cast(float, w & 0xffff0000u); }
__device__ __forceinline__ float bf1(bf16_t h) { return __builtin_bit_cast(float, (unsigned)h << 16); }
__device__ __forceinline__ float shx(float v, int m, int lane) { return __builtin_bit_cast(float, __builtin_amdgcn_ds_bpermute((lane ^ m) << 2, __builtin_bit_cast(int, v))); }
__device__ __forceinline__ int shx_i(int v, int m, int lane) { return __builtin_amdgcn_ds_bpermute((lane ^ m) << 2, v); }
__device__ __forceinline__ int wave_sum_i(int v, int lane) {
#pragma unroll
    for (int o = 1; o < 64; o <<= 1) v += shx_i(v, o, lane);
    return v;
}
__device__ __forceinline__ float wave_sum(float v, int lane) {
#pragma unroll
    for (int o = 1; o < 64; o <<= 1) v += shx(v, o, lane);
    return v;
}
__device__ __forceinline__ float silu_f(float x) { return x / (1.f + __expf(-x)); }
__device__ __forceinline__ float sigmoid_f(float x) { return 1.f / (1.f + __expf(-x)); }
__device__ __forceinline__ float gelu_tanh_f(float x) { const float u = 1.5957691216057308f * (x + 0.044715f * x * x * x); return x / (1.f + __expf(-u)); }
#define LDS_WAIT() asm volatile("s_waitcnt lgkmcnt(0)" ::: "memory")
#define VM_WAIT() asm volatile("s_waitcnt vmcnt(0)" ::: "memory")

__device__ __forceinline__ int lane_id() { int l; asm volatile("v_mbcnt_lo_u32_b32 %0, -1, 0\n\tv_mbcnt_hi_u32_b32 %0, -1, %0" : "=v"(l)); return l; }
__device__ __forceinline__ unsigned char* opq(unsigned char* p) { asm volatile("" : "+s"(p)); return p; }
typedef const float* cfptr_t;
__device__ __forceinline__ const float* inptr(int k) {
    const __attribute__((address_space(4))) char* kp = (const __attribute__((address_space(4))) char*)__builtin_amdgcn_kernarg_segment_ptr();
    return *(const __attribute__((address_space(4))) cfptr_t volatile*)(kp + 8 * k);
}
#define INP(k) inptr(k)

namespace pg8 {
constexpr int BM = 256, BK = 64, HALF = 128, HTB = HALF * BK * 2  , STAGE_BYTES = 8 * HTB, NXCD = 8, WGM = 8;

__host__ __device__ __forceinline__ int lds_byte(int r, int c) { const int st = (r >> 4) * 2 + (c >> 5), rr = r & 15, cc = c & 31, ob = rr * 64 + cc * 2; return st * 1024 + (ob ^ (((ob >> 9) & 1) << 5)); }
__host__ __device__ __forceinline__ void stage_rc(int b, int& R, int& C) { const int st = b / 1024, sb = b % 1024, swz = sb ^ (((sb >> 9) & 1) << 5); R = (st >> 1) * 16 + swz / 64; C = (st & 1) * 32 + (swz % 64) / 2; }
__host__ __device__ __forceinline__ int perm32(int rho) { const int n = rho >> 4, i = rho & 15; return 8 * (i >> 2) + 4 * n + (i & 3); }
struct Unit { int pm, pn, ex; };
struct Gemm { const bf16_t* A; const bf16_t* Bt; int lda, ldb, K; size_t bexp, aexp; };

struct StaticOrder {
    int nM, nN, nwg, G, c;
    __device__ __forceinline__ void init(int M, int N, int G_, int c_) { nM = M / BM; nN = N / BM; nwg = nM * nN; G = G_; c = c_; }
    __device__ __forceinline__ bool next(int i, Unit& u) const {
        const long L = (long)i * G + c; if (L >= nwg) return false;
        int wgid = (int)L; { const int q = nwg / NXCD, r = nwg % NXCD, xcd = wgid % NXCD, off = wgid / NXCD; wgid = (xcd < r ? xcd * (q + 1) : r * (q + 1) + (xcd - r) * q) + off; }
        const int nig = WGM * nN, gid = wgid / nig, fm = gid * WGM, gsz = (nM - fm) < WGM ? (nM - fm) : WGM;
        u.pm = fm + ((wgid % nig) % gsz); u.pn = (wgid % nig) / gsz; u.ex = 0; return true;
    }
    __device__ __forceinline__ void a_ready(const Unit&) const {}
    __device__ __forceinline__ void done(const Unit&) const {}
};
struct MoeOrder {
    int nT, nN, nwg, G, c; int o1, o2, o3, o4, o5, o6, o7;
    __device__ __forceinline__ bool next(int i, Unit& u) const {
        const long L = (long)i * G + c; if (L >= nwg) return false;
        const int wgid = (int)L;
        const int nig = WGM * nN, gid = wgid / nig, fm = gid * WGM, gsz = (nT - fm) < WGM ? (nT - fm) : WGM;
        u.pm = fm + ((wgid % nig) % gsz); u.pn = (wgid % nig) / gsz;
        const int r = u.pm * BM; u.ex = (r >= o1) + (r >= o2) + (r >= o3) + (r >= o4) + (r >= o5) + (r >= o6) + (r >= o7); return true;
    }
    __device__ __forceinline__ void a_ready(const Unit&) const {}
    __device__ __forceinline__ void done(const Unit&) const {}
};

struct GroupOrder {
    int nMt, nN, G, c;
    __device__ __forceinline__ bool next(int i, Unit& u) const {
        const int L = i * G + c; const int per = nMt * nN; if (L >= NG * per) return false;
        u.ex = L / per; const int r = L - u.ex * per; u.pm = r / nN; u.pn = r - u.pm * nN; return true;
    }
    __device__ __forceinline__ void a_ready(const Unit&) const {}
    __device__ __forceinline__ void done(const Unit&) const {}
};

__device__ __forceinline__ u32x4 pack8(const f32x4& a, const f32x4& b) { u32x4 w; w.x = pk2(a[0], a[1]); w.y = pk2(a[2], a[3]); w.z = pk2(b[0], b[1]); w.w = pk2(b[2], b[3]); return w; }

struct EpiInProj {
    static constexpr bool PERM = true, AFTER_DRAIN = false;
    bf16_t* Z; float* rs; bf16_t* UH;
    __device__ __forceinline__ void operator()(const f32x4 (&acc)[2][2][4][2], const Unit& u, int wr, int wc, int fr_, int fq_) const {
        const int ln_ = lane_id(); const int fr = ln_ & 15, fq = ln_ >> 4; (void)fr_; (void)fq_;
        const int row0 = u.pm * BM + wr * 64 + fr, col0 = u.pn * BM + wc * 32 + 8 * fq;
#pragma unroll
        for (int ai = 0; ai < 2; ++ai)
#pragma unroll
            for (int m = 0; m < 4; ++m) {
                const int row = row0 + ai * HALF + m * 16; float ss = 0.f;
#pragma unroll
                for (int bj = 0; bj < 2; ++bj) { const f32x4 v0 = acc[ai][bj][m][0], v1 = acc[ai][bj][m][1]; const int col = col0 + bj * HALF;
                    if (u.pn < 2) *(u32x4*)(UH + ((size_t)(col >> 4) * NCH + (row >> 5)) * 768 + (row & 31) * 16 + (col & 15)) = pack8(v0, v1);
                    else *(u32x4*)(Z + (size_t)row * 1024 + col) = pack8(v0, v1);
                    if (bj == 0 || u.pn == 2) ss += (v0[0] * v0[0] + v0[1] * v0[1]) + (v0[2] * v0[2] + v0[3] * v0[3]) + (v1[0] * v1[0] + v1[1] * v1[1]) + (v1[2] * v1[2] + v1[3] * v1[3]); }
                if (u.pn >= 2) { ss += shx(ss, 16, ln_); ss += shx(ss, 32, ln_); if (fq == 0) rs[(size_t)row * 8 + (u.pn - 2) * 4 + wc] = ss; }
            }
    }
};
struct EpiS {
    static constexpr bool PERM = false, AFTER_DRAIN = false;
    float* S;
    __device__ __forceinline__ void operator()(const f32x4 (&acc)[2][2][4][2], const Unit& u, int wr, int wc, int fr_, int fq_) const {
        const int ln_ = lane_id(); const int fr = ln_ & 15, fq = ln_ >> 4; (void)fr_; (void)fq_;
        const int row0 = u.pm * BM + wr * 64 + fr, col0 = wc * 32 + 4 * fq;
#pragma unroll
        for (int ai = 0; ai < 2; ++ai)
#pragma unroll
            for (int m = 0; m < 4; ++m) { const int n = row0 + ai * HALF + m * 16; if (n < NCH) { float* sp = S + ((size_t)u.ex * NCH + n) * 256 + col0;
#pragma unroll
                for (int bj = 0; bj < 2; ++bj)
#pragma unroll
                    for (int nn = 0; nn < 2; ++nn) *(f32x4*)(sp + bj * HALF + nn * 16) = acc[ai][bj][m][nn]; } }
    }
};
struct EpiY {
    static constexpr bool PERM = true, AFTER_DRAIN = false;
    bf16_t* ZG;
    __device__ __forceinline__ void operator()(const f32x4 (&acc)[2][2][4][2], const Unit& u, int wr, int wc, int fr_, int fq_) const {
        const int ln_ = lane_id(); const int fr = ln_ & 15, fq = ln_ >> 4; (void)fr_; (void)fq_;
        const int row0 = u.pm * BM + wr * 64 + fr, col0 = u.pn * BM + wc * 32 + 8 * fq;
#pragma unroll
        for (int ai = 0; ai < 2; ++ai)
#pragma unroll
            for (int m = 0; m < 4; ++m) { const int n = row0 + ai * HALF + m * 16; if (n < NCH) {
#pragma unroll
                for (int bj = 0; bj < 2; ++bj) { const int q = col0 + bj * HALF; f32x4 a = acc[ai][bj][m][0], b = acc[ai][bj][m][1];
#pragma unroll
                    for (int j = 0; j < 4; ++j) { a[j] = gelu_tanh_f(a[j]); b[j] = gelu_tanh_f(b[j]); }
                    *(u32x4*)(ZG + ((size_t)n * TCH + (q >> 4)) * 512 + u.ex * 16 + (q & 15)) = pack8(a, b); } } }
    }
};
struct EpiQ {
    static constexpr bool PERM = true, AFTER_DRAIN = false;
    bf16_t* Q; const float* rs; const float* cosT; const float* sinT;
    __device__ __forceinline__ void operator()(const f32x4 (&acc)[2][2][4][2], const Unit& u, int wr, int wc, int fr_, int fq_) const {
        const int ln_ = lane_id(); const int fr = ln_ & 15, fq = ln_ >> 4; (void)fr_; (void)fq_;
        const int row0 = u.pm * BM + wr * 64 + fr; const bool latent = u.pm < NX / BM;
#pragma unroll
        for (int ai = 0; ai < 2; ++ai)
#pragma unroll
            for (int m = 0; m < 4; ++m) {
                const int row = row0 + ai * HALF + m * 16; const f32x4 q4 = *(const f32x4*)(rs + (size_t)row * 8); const float rstd = rsqrtf(((q4[0] + q4[1]) + (q4[2] + q4[3])) * (1.f / 256.f) + EPS);
#pragma unroll
                for (int bj = 0; bj < 2; ++bj) { const int cg = (u.pn * BM + bj * HALF + wc * 32) >> 5; const bool rope = latent && (cg % 3 == 2);
                    f32x4 v0 = acc[ai][bj][m][0] * rstd, v1 = acc[ai][bj][m][1] * rstd;
                    if (rope) {
                        f32x4 p0, p1;
#pragma unroll
                        for (int j = 0; j < 4; ++j) { p0[j] = shx(v0[j], 16, ln_); p1[j] = shx(v1[j], 16, ln_); }
                        const int t = row & (SEQ - 1); const float* cp = cosT + t * 16 + (fq >> 1) * 8; const float* sp = sinT + t * 16 + (fq >> 1) * 8;
                        const f32x4 c0 = *(const f32x4*)cp, c1 = *(const f32x4*)(cp + 4); f32x4 s0 = *(const f32x4*)sp, s1 = *(const f32x4*)(sp + 4);
                        if ((fq & 1) == 0) { s0 = -s0; s1 = -s1; }
                        v0 = v0 * c0 + p0 * s0; v1 = v1 * c1 + p1 * s1;
                    }
                    v0 = v0 * QSCALE; v1 = v1 * QSCALE;
                    *(u32x4*)(Q + (size_t)row * 768 + u.pn * BM + bj * HALF + wc * 32 + 8 * fq) = pack8(v0, v1); }
            }
    }
};
struct EpiKV {
    static constexpr bool PERM = true, AFTER_DRAIN = false;
    bf16_t* KN; const float* rs;
    __device__ __forceinline__ void operator()(const f32x4 (&acc)[2][2][4][2], const Unit& u, int wr, int wc, int fr_, int fq_) const {
        const int ln_ = lane_id(); const int fr = ln_ & 15, fq = ln_ >> 4; (void)fr_; (void)fq_;
        const int row0 = u.pm * BM + wr * 64 + fr; const int col0 = u.pn * BM + wc * 32 + 8 * fq;
#pragma unroll
        for (int ai = 0; ai < 2; ++ai)
#pragma unroll
            for (int m = 0; m < 4; ++m) {
                const int row = row0 + ai * HALF + m * 16; const f32x4 q4 = *(const f32x4*)(rs + (size_t)row * 8 + 4); const float rstd = rsqrtf(((q4[0] + q4[1]) + (q4[2] + q4[3])) * (1.f / 128.f) + EPS);
#pragma unroll
                for (int bj = 0; bj < 2; ++bj) *(u32x4*)(KN + (size_t)row * 512 + col0 + bj * HALF) = pack8(acc[ai][bj][m][0] * rstd, acc[ai][bj][m][1] * rstd);
            }
    }
};
struct EpiVT {
    static constexpr bool PERM = true, AFTER_DRAIN = false;
    bf16_t* VT; const float* rs;
    __device__ __forceinline__ void operator()(const f32x4 (&acc)[2][2][4][2], const Unit& u, int wr, int wc, int fr_, int fq_) const {
        const int ln_ = lane_id(); const int fr = ln_ & 15, fq = ln_ >> 4; (void)fr_; (void)fq_;
        const int c0 = u.pm * BM + wr * 64 + fr;
        const int b = u.pn < NX / BM ? (u.pn >> 5) : (u.pn - NX / BM); const int kbase = u.pn < NX / BM ? (u.pn & 31) * BM : SEQ;
#pragma unroll
        for (int bj = 0; bj < 2; ++bj) { const int tl = bj * HALF + wc * 32 + 8 * fq, tok = u.pn * BM + tl;
            f32x4 s0, s1;
#pragma unroll
            for (int i = 0; i < 4; ++i) { const f32x4 qa = *(const f32x4*)(rs + (size_t)(tok + i) * 8 + 4), qb = *(const f32x4*)(rs + (size_t)(tok + 4 + i) * 8 + 4);
                s0[i] = rsqrtf(((qa[0] + qa[1]) + (qa[2] + qa[3])) * (1.f / 128.f) + EPS); s1[i] = rsqrtf(((qb[0] + qb[1]) + (qb[2] + qb[3])) * (1.f / 128.f) + EPS); }
#pragma unroll
            for (int ai = 0; ai < 2; ++ai)
#pragma unroll
                for (int m = 0; m < 4; ++m) { const int c = c0 + ai * HALF + m * 16;
                    *(u32x4*)(VT + (size_t)(b * 512 + c) * (SEQ + CTXL) + kbase + tl) = pack8(acc[ai][bj][m][0] * s0, acc[ai][bj][m][1] * s1); } }
    }
};
struct EpiGlu {
    static constexpr bool PERM = true, AFTER_DRAIN = false;
    const bf16_t* ZG; const float* bias; bf16_t* Y;
    __device__ __forceinline__ void operator()(const f32x4 (&acc)[2][2][4][2], const Unit& u, int wr, int wc, int fr_, int fq_) const {
        const int ln_ = lane_id(); const int fr = ln_ & 15, fq = ln_ >> 4; (void)fr_; (void)fq_;
        const int row0 = u.pm * BM + wr * 64 + fr, col0 = u.pn * BM + wc * 32 + 8 * fq;
#pragma unroll
        for (int ai = 0; ai < 2; ++ai)
#pragma unroll
            for (int m = 0; m < 4; ++m) { const int row = row0 + ai * HALF + m * 16;
#pragma unroll
                for (int bj = 0; bj < 2; ++bj) { const int col = col0 + bj * HALF;
                    const u32x4 zw = *(const u32x4*)(ZG + (size_t)row * 512 + col); const f32x4 b0 = *(const f32x4*)(bias + col), b1 = *(const f32x4*)(bias + col + 4);
                    const f32x4 a0 = acc[ai][bj][m][0] + b0, a1 = acc[ai][bj][m][1] + b1; f32x4 o0, o1;
                    o0[0] = bflo(zw.x) * sigmoid_f(a0[0]); o0[1] = bfhi(zw.x) * sigmoid_f(a0[1]); o0[2] = bflo(zw.y) * sigmoid_f(a0[2]); o0[3] = bfhi(zw.y) * sigmoid_f(a0[3]);
                    o1[0] = bflo(zw.z) * sigmoid_f(a1[0]); o1[1] = bfhi(zw.z) * sigmoid_f(a1[1]); o1[2] = bflo(zw.w) * sigmoid_f(a1[2]); o1[3] = bfhi(zw.w) * sigmoid_f(a1[3]);
                    *(u32x4*)(Y + (size_t)row * 1024 + col) = pack8(o0, o1); } }
    }
};
struct EpiRes {
    static constexpr bool PERM = false, AFTER_DRAIN = false;
    const float* xin_x; const float* xin_c; float* xout_x; float* xout_c; const float* gate;   float s;
    __device__ __forceinline__ void operator()(const f32x4 (&acc)[2][2][4][2], const Unit& u, int wr, int wc, int fr_, int fq_) const {
        const int ln_ = lane_id(); const int fr = ln_ & 15, fq = ln_ >> 4; (void)fr_; (void)fq_;
        const int row0 = u.pm * BM + wr * 64 + fr, col0 = u.pn * BM + wc * 32 + 4 * fq;
        const bool lat = u.pm < NX / BM; const int v = lat ? (u.pm >> 5) : 4;
        const float* xi = lat ? xin_x : xin_c - (size_t)NX * 1024; float* xo = lat ? xout_x : xout_c - (size_t)NX * 1024;
        f32x4 gv[2][2];
#pragma unroll
        for (int bj = 0; bj < 2; ++bj)
#pragma unroll
            for (int n = 0; n < 2; ++n) gv[bj][n] = *(const f32x4*)(gate + v * 6144 + col0 + bj * HALF + n * 16) * s;
#pragma unroll
        for (int ai = 0; ai < 2; ++ai)
#pragma unroll
            for (int m = 0; m < 4; ++m) { const size_t ro = (size_t)(row0 + ai * HALF + m * 16) * 1024 + col0;
#pragma unroll
                for (int bj = 0; bj < 2; ++bj)
#pragma unroll
                    for (int n = 0; n < 2; ++n) { const size_t o = ro + bj * HALF + n * 16; *(f32x4*)(xo + o) = *(const f32x4*)(xi + o) + gv[bj][n] * acc[ai][bj][m][n]; } }
    }
};
template <bool OUT8> struct EpiSwiglu {
    static constexpr bool PERM = true, AFTER_DRAIN = false;
    void* H; int ldh; float s;
    __device__ __forceinline__ void operator()(const f32x4 (&acc)[2][2][4][2], const Unit& u, int wr, int wc, int fr_, int fq_) const {
        const int ln_ = lane_id(); const int fr = ln_ & 15, fq = ln_ >> 4; (void)fr_; (void)fq_;
        const int row0 = u.pm * BM + wr * 64 + fr, col0 = u.pn * HALF + wc * 32 + 8 * fq;
#pragma unroll
        for (int ai = 0; ai < 2; ++ai)
#pragma unroll
            for (int m = 0; m < 4; ++m) { f32x4 o0, o1;
#pragma unroll
                for (int j = 0; j < 4; ++j) { o0[j] = silu_f(acc[ai][0][m][0][j] * s) * (acc[ai][1][m][0][j] * s); o1[j] = silu_f(acc[ai][0][m][1][j] * s) * (acc[ai][1][m][1][j] * s); }
                const size_t off = (size_t)(row0 + ai * HALF + m * 16) * ldh + col0;
                if constexpr (OUT8) { u32x2 w; w.x = pk4_fp8(o0[0], o0[1], o0[2], o0[3]); w.y = pk4_fp8(o1[0], o1[1], o1[2], o1[3]); *(u32x2*)((unsigned char*)H + off) = w; }
                else *(u32x4*)((bf16_t*)H + off) = pack8(o0, o1); }
    }
};
struct EpiBf16 {
    static constexpr bool PERM = true, AFTER_DRAIN = false;
    bf16_t* O; int ldc; float s;
    __device__ __forceinline__ void operator()(const f32x4 (&acc)[2][2][4][2], const Unit& u, int wr, int wc, int fr_, int fq_) const {
        const int ln_ = lane_id(); const int fr = ln_ & 15, fq = ln_ >> 4; (void)fr_; (void)fq_;
        const int row0 = u.pm * BM + wr * 64 + fr, col0 = u.pn * BM + wc * 32 + 8 * fq;
#pragma unroll
        for (int ai = 0; ai < 2; ++ai)
#pragma unroll
            for (int m = 0; m < 4; ++m)
#pragma unroll
                for (int bj = 0; bj < 2; ++bj) *(u32x4*)(O + (size_t)(row0 + ai * HALF + m * 16) * ldc + col0 + bj * HALF) = pack8(acc[ai][bj][m][0] * s, acc[ai][bj][m][1] * s);
    }
};
typedef int v8i_t __attribute__((ext_vector_type(8)));
typedef short s16x16_t __attribute__((ext_vector_type(16)));
__device__ __forceinline__ v8i_t cat8(bf16x8 a, bf16x8 b) { return __builtin_bit_cast(v8i_t, __builtin_shufflevector(a, b, 0, 1, 2, 3, 4, 5, 6, 7, 8, 9, 10, 11, 12, 13, 14, 15)); }
template <class Epi, class Sched, bool ALIGN_EPI = false, bool SP2 = false, bool F8 = false>
__device__ __forceinline__ void gemm_phase(PG8_LAS unsigned char* lds, const Gemm g, const Sched& S, const Epi& E, const int wid) {
    const int lane = lane_id(), tid = wid * 64 + lane, wr = wid >> 2, wc = wid & 3, fr = lane & 15, fq = lane >> 4;
    const int K = g.K, nt = K / BK;
    unsigned v_offA, v_offB;
    { int R, C; stage_rc(tid * 16, R, C); const int Rb = Epi::PERM ? ((R & ~31) + perm32(R & 31)) : R;
        v_offA = (unsigned)(R * g.lda + C) * 2u; v_offB = (unsigned)(Rb * g.ldb + C) * 2u; }
    const unsigned r64_offA = 64u * (unsigned)g.lda * 2u, r64_offB = 64u * (unsigned)g.ldb * 2u;
    const size_t kstep = (size_t)(BK * 2);
    const size_t hstepA = (size_t)HALF * g.lda * 2, hstepB = (size_t)HALF * g.ldb * 2;
    const size_t tstepA = 2 * hstepA, tstepB = 2 * hstepB;
    const unsigned ldsw = (unsigned)wid * 1024u;
    const int aoff = lds_byte(wr * 64 + fr, fq * 8), boff = lds_byte(wc * 32 + fr, fq * 8);
#define PG8_SA(b, h) (((b) * 2 + (h)) * HTB)
#define PG8_SB(b, h) ((4 + (b) * 2 + (h)) * HTB)
#define PG8_STAGE(bufoff, gbase, voff) do { _Pragma("unroll") for (int _i = 0; _i < 2; ++_i) \
        __builtin_amdgcn_global_load_lds((const unsigned*)((const char*)(gbase) + (size_t)(_i * r64_##voff) + v_##voff), (PG8_LAS unsigned*)(lds + (bufoff) + ldsw + _i * 8192), 16, 0, 0); } while (0)
#define PG8_RD(p) (*(const PG8_LAS bf16x8*)(p))
#define PG8_LDA(dst, b, h) do { if constexpr (F8) { _Pragma("unroll") for (int m = 0; m < 4; ++m) dst##8[m] = cat8(PG8_RD(lds + PG8_SA(b, h) + aoff + m * 2048), PG8_RD(lds + PG8_SA(b, h) + aoff + m * 2048 + 1024)); } \
        else { _Pragma("unroll") for (int m = 0; m < 4; ++m) _Pragma("unroll") for (int k = 0; k < 2; ++k) dst[m][k] = PG8_RD(lds + PG8_SA(b, h) + aoff + m * 2048 + k * 1024); } } while (0)
#define PG8_LDB(dst, b, h) do { if constexpr (F8) { _Pragma("unroll") for (int n = 0; n < 2; ++n) dst##8[n] = cat8(PG8_RD(lds + PG8_SB(b, h) + boff + n * 2048), PG8_RD(lds + PG8_SB(b, h) + boff + n * 2048 + 1024)); } \
        else { _Pragma("unroll") for (int n = 0; n < 2; ++n) _Pragma("unroll") for (int k = 0; k < 2; ++k) dst[n][k] = PG8_RD(lds + PG8_SB(b, h) + boff + n * 2048 + k * 1024); } } while (0)
#define PG8_MMA(ai, bj, At, Bt) do { __builtin_amdgcn_s_setprio(1); if constexpr (F8) { _Pragma("unroll") for (int m = 0; m < 4; ++m) _Pragma("unroll") for (int n = 0; n < 2; ++n) \
        asm volatile("v_mfma_scale_f32_16x16x128_f8f6f4 %0, %1, %2, %0, %3, %3 op_sel_hi:[0,0,0]" : "+v"(acc[ai][bj][m][n]) : "v"(Bt##8[n]), "v"(At##8[m]), "v"(sc1_)); asm volatile("s_nop 11"); } \
        else { _Pragma("unroll") for (int m = 0; m < 4; ++m) _Pragma("unroll") for (int n = 0; n < 2; ++n) _Pragma("unroll") for (int k = 0; k < 2; ++k) \
        acc[ai][bj][m][n] = __builtin_amdgcn_mfma_f32_16x16x32_bf16(Bt[n][k], At[m][k], acc[ai][bj][m][n], 0, 0, 0); } __builtin_amdgcn_s_setprio(0); } while (0)
#define PG8_WAIT_V(n) asm volatile("s_waitcnt vmcnt(" #n ")" ::: "memory")
#define PG8_WAIT_L(n) asm volatile("s_waitcnt lgkmcnt(" #n ")" ::: "memory")
#define PG8_BAR __builtin_amdgcn_s_barrier()
#define PG8_SCHED __builtin_amdgcn_sched_barrier(0)
    Unit cur, nxt; int ui = 0;
    if (!S.next(0, cur)) return;
    f32x4 acc[2][2][4][2];
#pragma unroll
    for (int a = 0; a < 2; ++a)
#pragma unroll
        for (int b = 0; b < 2; ++b)
#pragma unroll
            for (int m = 0; m < 4; ++m)
#pragma unroll
                for (int n = 0; n < 2; ++n) acc[a][b][m][n] = (f32x4){0.f, 0.f, 0.f, 0.f};
    const int sc1_ = 0x7f7f7f7f;
    bf16x8 At[4][2], B0[2][2], B1[2][2]; v8i_t At8[4], B08[2], B18[2];
    const char* cA = (const char*)g.A + (size_t)cur.ex * g.aexp + (size_t)cur.pm * tstepA; const char* cB = (const char*)g.Bt + (size_t)cur.ex * g.bexp + (size_t)cur.pn * tstepB;
    S.a_ready(cur);
    if constexpr (SP2) {
        PG8_STAGE(PG8_SB(0, 0), cB, offB); PG8_STAGE(PG8_SB(0, 1), cB + hstepB, offB); PG8_STAGE(PG8_SA(0, 0), cA, offA); PG8_STAGE(PG8_SA(0, 1), cA + hstepA, offA);
        if (wr == 1) PG8_BAR;
        PG8_WAIT_V(2); PG8_BAR;
        PG8_STAGE(PG8_SB(1, 0), cB + kstep, offB); PG8_STAGE(PG8_SA(1, 0), cA + kstep, offA); PG8_STAGE(PG8_SB(1, 1), cB + hstepB + kstep, offB);
        PG8_WAIT_V(6); PG8_BAR;
    } else {
        PG8_STAGE(PG8_SB(0, 0), cB, offB); PG8_STAGE(PG8_SA(0, 0), cA, offA); PG8_STAGE(PG8_SB(0, 1), cB + hstepB, offB); PG8_STAGE(PG8_SA(0, 1), cA + hstepA, offA);
        if (wr == 1) PG8_BAR;
        PG8_WAIT_V(4); PG8_BAR;
        PG8_STAGE(PG8_SB(1, 0), cB + kstep, offB); PG8_STAGE(PG8_SA(1, 0), cA + kstep, offA); PG8_STAGE(PG8_SB(1, 1), cB + hstepB + kstep, offB);
        PG8_WAIT_V(6); PG8_BAR;
    }
    for (;;) {
        const bool has_next = S.next(ui + 1, nxt);
        const char* nA = has_next ? (const char*)g.A + (size_t)nxt.ex * g.aexp + (size_t)nxt.pm * tstepA : cA; const char* nB = has_next ? (const char*)g.Bt + (size_t)nxt.ex * g.bexp + (size_t)nxt.pn * tstepB : cB;
        for (int t = 0; t < nt; t += 2) {
            const bool last = (t == nt - 2);
            const char* a1 = cA + (size_t)(t + 1) * kstep;
            const char* a2 = last ? nA : cA + (size_t)(t + 2) * kstep; const char* b2 = last ? nB : cB + (size_t)(t + 2) * kstep;
            const char* a3 = a2 + kstep; const char* b3 = b2 + kstep;
            if (last && has_next) S.a_ready(nxt);
            if constexpr (SP2) {
            PG8_LDB(B0, 0, 0); PG8_LDB(B1, 0, 1); PG8_SCHED; PG8_LDA(At, 0, 0); PG8_STAGE(PG8_SA(1, 1), a1 + hstepA, offA);
            PG8_WAIT_V(8); PG8_WAIT_L(0); PG8_BAR; PG8_MMA(0, 0, At, B0); PG8_MMA(0, 1, At, B1); PG8_BAR; PG8_SCHED;
            PG8_LDA(At, 0, 1); PG8_STAGE(PG8_SB(0, 0), b2, offB); PG8_STAGE(PG8_SB(0, 1), b2 + hstepB, offB); PG8_STAGE(PG8_SA(0, 0), a2, offA);
            PG8_WAIT_V(8); PG8_WAIT_L(0); PG8_BAR; PG8_MMA(1, 0, At, B0); PG8_MMA(1, 1, At, B1); PG8_BAR; PG8_SCHED;
            PG8_LDB(B0, 1, 0); PG8_LDB(B1, 1, 1); PG8_SCHED; PG8_LDA(At, 1, 0); PG8_STAGE(PG8_SA(0, 1), a2 + hstepA, offA);
            PG8_WAIT_V(8); PG8_WAIT_L(0); PG8_BAR; PG8_MMA(0, 0, At, B0); PG8_MMA(0, 1, At, B1); PG8_BAR; PG8_SCHED;
            PG8_LDA(At, 1, 1); PG8_STAGE(PG8_SB(1, 0), b3, offB); PG8_STAGE(PG8_SB(1, 1), b3 + hstepB, offB); PG8_STAGE(PG8_SA(1, 0), a3, offA);
            PG8_WAIT_V(8); PG8_WAIT_L(0); PG8_BAR; PG8_MMA(1, 0, At, B0); PG8_MMA(1, 1, At, B1); PG8_BAR; PG8_SCHED;
            } else {
            PG8_LDB(B0, 0, 0); PG8_SCHED; PG8_LDA(At, 0, 0); PG8_STAGE(PG8_SA(1, 1), a1 + hstepA, offA);
            PG8_WAIT_L(8); PG8_BAR; PG8_WAIT_L(0); PG8_MMA(0, 0, At, B0); PG8_BAR; PG8_SCHED;
            PG8_LDB(B1, 0, 1); PG8_STAGE(PG8_SB(0, 0), b2, offB);
            PG8_BAR; PG8_WAIT_L(0); PG8_MMA(0, 1, At, B1); PG8_BAR;
            PG8_LDA(At, 0, 1); PG8_STAGE(PG8_SA(0, 0), a2, offA);
            PG8_BAR; PG8_WAIT_L(0); PG8_MMA(1, 0, At, B0); PG8_BAR; PG8_SCHED;
            PG8_STAGE(PG8_SB(0, 1), b2 + hstepB, offB);
            PG8_WAIT_V(6); PG8_BAR; PG8_MMA(1, 1, At, B1); PG8_BAR;
            PG8_LDB(B0, 1, 0); PG8_SCHED; PG8_LDA(At, 1, 0); PG8_STAGE(PG8_SA(0, 1), a2 + hstepA, offA);
            PG8_WAIT_L(8); PG8_BAR; PG8_WAIT_L(0); PG8_MMA(0, 0, At, B0); PG8_BAR; PG8_SCHED;
            PG8_LDB(B1, 1, 1); PG8_STAGE(PG8_SB(1, 0), b3, offB);
            PG8_BAR; PG8_WAIT_L(0); PG8_MMA(0, 1, At, B1); PG8_BAR;
            PG8_LDA(At, 1, 1); PG8_STAGE(PG8_SA(1, 0), a3, offA);
            PG8_BAR; PG8_WAIT_L(0); PG8_MMA(1, 0, At, B0); PG8_BAR; PG8_SCHED;
            PG8_STAGE(PG8_SB(1, 1), b3 + hstepB, offB);
            PG8_WAIT_V(6); PG8_BAR; PG8_MMA(1, 1, At, B1); PG8_BAR;
            }
        }
        if constexpr (F8) { asm volatile("s_nop 15\n\ts_nop 7" ::: "memory"); }
        if constexpr (ALIGN_EPI) { if (wr == 0) PG8_BAR; }
        if constexpr (!Epi::AFTER_DRAIN) { E(acc, cur, wr, wc, fr, fq); S.done(cur); }
        if (!has_next) break;
#pragma unroll
        for (int a = 0; a < 2; ++a)
#pragma unroll
            for (int b = 0; b < 2; ++b)
#pragma unroll
                for (int m = 0; m < 4; ++m)
#pragma unroll
                    for (int n = 0; n < 2; ++n) acc[a][b][m][n] = (f32x4){0.f, 0.f, 0.f, 0.f};
        cur = nxt; cA = nA; cB = nB; ++ui;
        if constexpr (ALIGN_EPI) { if (wr == 1) PG8_BAR; }
    }
    PG8_WAIT_V(0);
    if constexpr (!ALIGN_EPI) { if (wr == 0) PG8_BAR; }
    PG8_BAR;
    if constexpr (Epi::AFTER_DRAIN) { E.fused(acc, cur, wr, wc, fr, fq, lds, wid, lane); S.done(cur); }
#undef PG8_SA
#undef PG8_SB
#undef PG8_STAGE
#undef PG8_RD
#undef PG8_LDA
#undef PG8_LDB
#undef PG8_MMA
#undef PG8_WAIT_V
#undef PG8_WAIT_L
#undef PG8_BAR
#undef PG8_SCHED
}
}


#define XB_TMO      128
#define XB_XCNT(j)  (256  + 64 * (j))
#define XB_XSUB(j)  (1280 + 64 * (j))
#define XB_XGEN(j)  (2304 + 64 * (j))
#define XB_TOP      3328
#define XB_TOPGEN   3392
#define XCD_BAR_WORDS 3456
#define XB_SPIN_CAP (1u << 18)

__device__ __forceinline__ unsigned xb_ld(unsigned* p)              { return __hip_atomic_load(p, __ATOMIC_RELAXED, __HIP_MEMORY_SCOPE_AGENT); }
__device__ __forceinline__ unsigned xb_add(unsigned* p, unsigned v) { return __hip_atomic_fetch_add(p, v, __ATOMIC_RELAXED, __HIP_MEMORY_SCOPE_AGENT); }
__device__ __forceinline__ unsigned xb_xcc_id() { return (unsigned)__builtin_amdgcn_s_getreg((3 << 11) | 20) & 0xFu; }
#define XB_SPIN(cond, bar) do { unsigned _sp = 0; while (cond) { __builtin_amdgcn_s_sleep(1); \
    if ((++_sp & 255u) == 0u) { if (xb_ld(&(bar)[XB_TMO])) break; if (_sp > XB_SPIN_CAP) { atomicAdd(&(bar)[XB_TMO], 1u); break; } } } } while (0)

struct XcdBarrier {
    unsigned* bar; unsigned x;
    volatile LAS unsigned* st;
};

__device__ __forceinline__ XcdBarrier xcd_barrier_post(unsigned* bar, volatile LAS unsigned* st) {
    XcdBarrier b; b.bar = bar; b.x = xb_xcc_id(); b.st = st;
    if (threadIdx.x == 0) (void)xb_add(&bar[XB_XCNT(b.x)], 1u);
    return b;
}
__device__ __forceinline__ void xcd_barrier_complete(unsigned* bar, unsigned x, unsigned& nloc, unsigned& nx) {
    const unsigned G = gridDim.x * gridDim.y * gridDim.z;
    unsigned sum, cnt, mine, sp = 0u;
    for (;;) {
        sum = 0u; cnt = 0u; mine = 0u;
#pragma unroll
        for (unsigned j = 0; j < 16; ++j) { const unsigned c = xb_ld(&bar[XB_XCNT(j)]); sum += c; cnt += (c > 0u) ? 1u : 0u; mine = (j == x) ? c : mine; }
        if (sum == G) break;
        __builtin_amdgcn_s_sleep(1);
        if ((++sp & 255u) == 0u) { if (xb_ld(&bar[XB_TMO])) break; if (sp > XB_SPIN_CAP) { atomicAdd(&bar[XB_TMO], 1u); break; } }
    }
    nloc = mine > 0u ? mine : 1u; nx = cnt > 0u ? cnt : 1u;
}

__device__ __forceinline__ void xcd_barrier(const XcdBarrier& b) {
    asm volatile("s_waitcnt vmcnt(0)" ::: "memory");
    __syncthreads();
    if (threadIdx.x == 0) {
        unsigned* bar = b.bar; asm volatile("" : "+s"(bar));
        __builtin_amdgcn_s_waitcnt(0);
        unsigned bx = b.x; asm volatile("" : "+s"(bx));
        unsigned nloc = b.st[0], nx = b.st[1];
        if (nloc == 0u) { xcd_barrier_complete(bar, bx, nloc, nx); b.st[0] = nloc; b.st[1] = nx; }
        const unsigned old = xb_add(&bar[XB_XSUB(bx)], 1u);
        const unsigned gen = old / nloc;
        if (old + 1u == (gen + 1u) * nloc) {
            __builtin_amdgcn_fence(__ATOMIC_RELEASE, "agent");
            asm volatile("s_waitcnt vmcnt(0)" ::: "memory");
            const unsigned og = xb_add(&bar[XB_TOP], 1u);
            const unsigned tg = og / nx;
            if (og + 1u == (tg + 1u) * nx) xb_add(&bar[XB_TOPGEN], 1u);
            else XB_SPIN(xb_ld(&bar[XB_TOPGEN]) == tg, bar);
            __builtin_amdgcn_fence(__ATOMIC_ACQUIRE, "agent");
            xb_add(&bar[XB_XGEN(bx)], 1u);
            asm volatile("s_waitcnt vmcnt(0)" ::: "memory");
        } else {
            XB_SPIN(xb_ld(&bar[XB_XGEN(bx)]) == gen, bar);
            __builtin_amdgcn_fence(__ATOMIC_ACQUIRE, "agent");
            asm volatile("s_waitcnt vmcnt(0)" ::: "memory");
        }
    }
    __syncthreads();
}

struct Args { const float* in[32]; float* out; unsigned char* ws; int ph_lo, ph_hi, li, pad; };
struct Frame {
    LAS unsigned char* lds; volatile LAS unsigned* MISC; unsigned* ctl;
    int wave, G, bid, gw, NGW;
    float* out; unsigned char* ws;
};
constexpr int NWAVES = 8, NTHR = NWAVES * 64;

#define TR_LOAD(wv, W, N, k0, n0) do { _Pragma("unroll") for (int i_ = 0; i_ < 32; ++i_) wv[i_] = __builtin_nontemporal_load((W) + (size_t)((k0) + 2 * i_ + (lane >> 5)) * (N) + (n0) + (lane & 31)); } while (0)
template <bool F8>
__device__ __forceinline__ void tr_store(const float (&wv)[32], void* WTv, int K  , int k0, int drow0, const float* ksc, LAS float* scr, int lane) {
#pragma unroll
    for (int i = 0; i < 32; ++i) { const int kk = 2 * i + (lane >> 5); float w = wv[i]; if (ksc) w *= ksc[k0 + kk]; if (F8) w *= W8_SCALE; scr[kk * 33 + (lane & 31)] = w; }
    LDS_WAIT(); asm volatile("" ::: "memory");
    const int c = lane & 7;
#pragma unroll
    for (int j = 0; j < 4; ++j) { const int n = (lane >> 3) + 8 * j; const LAS float* s = scr + (8 * c) * 33 + n;
        if (F8) { u32x2 o; o.x = pk4_fp8(s[0 * 33], s[1 * 33], s[2 * 33], s[3 * 33]); o.y = pk4_fp8(s[4 * 33], s[5 * 33], s[6 * 33], s[7 * 33]); *(u32x2*)((unsigned char*)WTv + (size_t)(drow0 + n) * K + k0 + 8 * c) = o; }
        else { u32x4 o; o.x = pk2(s[0 * 33], s[1 * 33]); o.y = pk2(s[2 * 33], s[3 * 33]); o.z = pk2(s[4 * 33], s[5 * 33]); o.w = pk2(s[6 * 33], s[7 * 33]); *(u32x4*)((bf16_t*)WTv + (size_t)(drow0 + n) * K + k0 + 8 * c) = o; } }
    LDS_WAIT(); asm volatile("" ::: "memory");
}
__device__ __forceinline__ int drow_map(int mode, int n0) {
    if (mode == 1) { const int h = n0 >> 7, j0 = n0 & 127; return j0 < 64 ? h * 64 + j0 : 512 + h * 64 + (j0 - 64); }
    if (mode == 2) return (n0 >> 7) * 256 + (n0 & 127);
    if (mode == 3) return (n0 >> 7) * 256 + 128 + (n0 & 127);
    return n0;
}
template <bool F8>
__device__ __forceinline__ void conv_mat(const Frame& F, const float* W, int K, int N, void* WT, int mode, const float* ksc, int ldk = 0) {
    if (ldk == 0) ldk = K;
    const int lane = lane_id();
    LAS float* scr = (LAS float*)(F.lds + F.wave * 16384);
    const int nblk = N / 32, items = (K / 64) * nblk;
    for (int it = F.gw; it < items; it += F.NGW) { const int k0 = 64 * (it / nblk), n0 = 32 * (it % nblk); float wv[32];
        TR_LOAD(wv, W, N, k0, n0); tr_store<F8>(wv, WT, ldk, k0, drow_map(mode, n0), ksc, scr, lane); }
}
__device__ __forceinline__ void p0_weights(const Frame& F, const Args& A) { unsigned char* const wsq_ = opq(F.ws);
    const int lane = lane_id(), tid = F.wave * 64 + lane; (void)tid; (void)lane;
    unsigned char* ws = wsq_;
    for (int l = 0; l < 2; ++l) {
        conv_mat<false>(F, INP(8) + (size_t)l * DM * DIN, DM, DIN, (bf16_t*)(ws + WS_WIN) + (size_t)l * 1024 * 1024, 0, nullptr);
        conv_mat<false>(F, INP(11) + (size_t)l * 256 * 768, 256, 768, (bf16_t*)(ws + WS_WUQ) + (size_t)l * 768 * 256, 0, INP(9) + l * 256);
        conv_mat<false>(F, INP(12) + (size_t)l * 128 * 1024, 128, 1024, (bf16_t*)(ws + WS_WUKV) + (size_t)l * 1024 * 128, 1, INP(10) + l * 128);
        conv_mat<false>(F, INP(21) + (size_t)l * 512 * 512, 512, 512, (bf16_t*)(ws + WS_WGLU) + (size_t)l * 512 * 512, 0, nullptr);
        conv_mat<false>(F, INP(23) + (size_t)l * 1024 * 1024, 1024, 1024, (bf16_t*)(ws + WS_WOUT) + (size_t)l * 1024 * 1024, 0, nullptr);
        { u32x4* z = (u32x4*)((bf16_t*)(ws + WS_WIN) + (size_t)l * 1024 * 1024 + (size_t)DIN * 1024); const int n16 = (1024 - DIN) * 1024 * 2 / 16;
          u32x4 z4 = {0u, 0u, 0u, 0u}; asm volatile("" : "+v"(z4));
          for (int i = F.gw * 64 + lane; i < n16; i += F.NGW * 64) z[i] = z4; }
    }
    conv_mat<false>(F, INP(24), DM, DFF, ws + WS_WFF13, 2, nullptr);
    conv_mat<false>(F, INP(25), DM, DFF, ws + WS_WFF13, 3, nullptr);
    conv_mat<false>(F, INP(26), DFF, DM, ws + WS_WFF2, 0, nullptr);
    for (int e = 0; e < NE; ++e) {
        conv_mat<true>(F, INP(28) + (size_t)e * DM * DFE, DM, DFE, ws + WS_WM13 + (size_t)e * 2 * DFE * DM, 2, nullptr);
        conv_mat<true>(F, INP(29) + (size_t)e * DM * DFE, DM, DFE, ws + WS_WM13 + (size_t)e * 2 * DFE * DM, 3, nullptr);
        conv_mat<true>(F, INP(30) + (size_t)e * DFE * DM, DFE, DM, ws + WS_WM2 + (size_t)e * DM * DFE8, 0, nullptr, DFE8);
    }
    { const int lane = lane_id(); u32x4 z4 = {0u, 0u, 0u, 0u}; asm volatile("" : "+v"(z4));
      for (int i = F.gw * 64 + lane; i < NE * DM * 8; i += F.NGW * 64) *(u32x4*)(wsq_ + WS_WM2 + (size_t)(i >> 3) * DFE8 + DFE + (i & 7) * 16) = z4; }
}
__device__ __forceinline__ void p0_prologue(const Frame& F, const Args& A) { unsigned char* const wsq_ = opq(F.ws);
    const int lane = lane_id(), tid = F.wave * 64 + lane; (void)tid; (void)lane;
    unsigned char* ws = wsq_;
    { float* cosT = (float*)(ws + WS_COS); float* sinT = (float*)(ws + WS_SIN);
      for (int idx = F.gw * 64 + lane; idx < SEQ * 16; idx += F.NGW * 64) { const int t = idx >> 4, a = (idx >> 3) & 1, i = idx & 7; const float pos = (float)(a == 0 ? (t >> 6) : (t & 63));
          const float inv = exp2f(-(float)i * (13.287712379549449f / 8.0f)); const float ang = pos * inv; cosT[idx] = cosf(ang); sinT[idx] = sinf(ang); } }
    { float* AB = (float*)(ws + WS_AB); float* BB = (float*)(ws + WS_BB);
      for (int idx = F.gw * 64 + lane; idx < 2 * 2 * NG * NP; idx += F.NGW * 64) {
          const float ar = INP(13)[idx], ai = INP(14)[idx], dt = expf(INP(15)[idx >> 6]);
          const float mag = expf(dt * ar), abr = mag * cosf(dt * ai), abi = mag * sinf(dt * ai), den = ar * ar + ai * ai, nre = abr - 1.0f;
          const float fre = (nre * ar + abi * ai) / den, fim = (abi * ar - nre * ai) / den;
          AB[idx * 2] = abr; AB[idx * 2 + 1] = abi;
          { float* PW = (float*)(ws + WS_PW) + (size_t)idx * 66; const float dar = dt * ar, dai = dt * ai;
            for (int e = 0; e <= TCH; ++e) { const float mg = expf((float)e * dar), an = (float)e * dai; PW[2 * e] = mg * cosf(an); PW[2 * e + 1] = mg * sinf(an); } }
#pragma unroll 4
          for (int c = 0; c < 16; ++c) { const float br = INP(16)[idx * 16 + c], bi = INP(17)[idx * 16 + c]; BB[(idx * 16 + c) * 2] = fre * br - fim * bi; BB[(idx * 16 + c) * 2 + 1] = fre * bi + fim * br; } } }
    { LAS float* sv = (LAS float*)F.lds; LAS float* red = sv + 5 * 1024; float* MOD = (float*)(ws + WS_MOD);
      __syncthreads();
      for (int i = tid; i < 5 * 1024; i += NTHR) { const int v = i >> 10, k = i & 1023; const float cv = v < 4 ? INP(1)[v * 1024 + k] : INP(3)[k]; sv[i] = silu_f(cv); }
      __syncthreads();
      for (int it = F.bid; it < 2 * 96; it += F.G) { const int l = it / 96, jb = it % 96, kg = tid >> 6, jj = tid & 63, j = jb * 64 + jj;
          float a0 = 0.f, a1 = 0.f, a2 = 0.f, a3 = 0.f, a4 = 0.f; const float* wp = INP(4) + ((size_t)l * 1024 + kg * 128) * 6144 + j;
#pragma unroll 8
          for (int kk = 0; kk < 128; ++kk) { const float w = wp[(size_t)kk * 6144]; const int k = kg * 128 + kk; a0 += sv[k] * w; a1 += sv[1024 + k] * w; a2 += sv[2048 + k] * w; a3 += sv[3072 + k] * w; a4 += sv[4096 + k] * w; }
          red[(kg * 5 + 0) * 64 + jj] = a0; red[(kg * 5 + 1) * 64 + jj] = a1; red[(kg * 5 + 2) * 64 + jj] = a2; red[(kg * 5 + 3) * 64 + jj] = a3; red[(kg * 5 + 4) * 64 + jj] = a4;
          __syncthreads();
          if (tid < 320) { const int v = tid >> 6, q = tid & 63; float s = INP(5)[l * 6144 + jb * 64 + q];
#pragma unroll
              for (int g = 0; g < 8; ++g) s += red[(g * 5 + v) * 64 + q];
              MOD[((size_t)l * 5 + v) * 6144 + jb * 64 + q] = s; }
          __syncthreads(); }
    }
}

template <bool OUT8>
__device__ __forceinline__ void norm_rows(const Frame& F, const float* xs_x, const float* xs_c, int nrows, const float* gain, const float* mod, int shoff, int scoff, void* XNv) {
    const int lane = lane_id();
    for (int v = 0; v < 5; ++v) {
        const int r0 = v < 4 ? v * SEQ : NX, r1 = v < 4 ? r0 + SEQ : NR; if (r0 >= nrows) break;
        f32x4 ca[4], cb[4];
#pragma unroll
        for (int j = 0; j < 4; ++j) { const int c = 4 * lane + 256 * j; const f32x4 g = *(const f32x4*)(gain + c), sc = *(const f32x4*)(mod + v * 6144 + scoff + c); ca[j] = g * (sc + 1.0f); cb[j] = *(const f32x4*)(mod + v * 6144 + shoff + c); }
        for (int r = r0 + F.gw; r < r1; r += F.NGW) {
            const float* src = r < NX ? xs_x + (size_t)r * 1024 : xs_c + (size_t)(r - NX) * 1024;
            f32x4 x[4]; float ss = 0.f;
#pragma unroll
            for (int j = 0; j < 4; ++j) { x[j] = *(const f32x4*)(src + 4 * lane + 256 * j); ss += (x[j][0] * x[j][0] + x[j][1] * x[j][1]) + (x[j][2] * x[j][2] + x[j][3] * x[j][3]); }
            const float rstd = rsqrtf(wave_sum(ss, lane) * (1.f / 1024.f) + EPS);
#pragma unroll
            for (int j = 0; j < 4; ++j) { x[j] = x[j] * rstd * ca[j] + cb[j];
                if (OUT8) *(unsigned*)((unsigned char*)XNv + (size_t)r * 1024 + 4 * lane + 256 * j) = pk4_fp8(x[j][0], x[j][1], x[j][2], x[j][3]);
                else { u32x2 o; o.x = pk2(x[j][0], x[j][1]); o.y = pk2(x[j][2], x[j][3]); *(u32x2*)((bf16_t*)XNv + (size_t)r * 1024 + 4 * lane + 256 * j) = o; } }
        }
    }
}
__device__ __forceinline__ void norm_router(const Frame& F, const float* xs, const float* gain, const float* mod, int shoff, int scoff, unsigned char* XNM) { unsigned char* const wsq_ = opq(F.ws);
    const int lane = lane_id(), tid = F.wave * 64 + lane;
    LAS float* RT = (LAS float*)F.lds; LAS int* lcnt = (LAS int*)(F.lds + 32768);
    __syncthreads();
    for (int i = tid; i < 1024 * 8 / 4; i += NTHR) ((LAS f32x4*)RT)[i] = ((const f32x4*)INP(27))[i];
    if (tid < 8) lcnt[tid] = 0;
    __syncthreads();
    for (int ch = F.bid; ch < NX / 128; ch += F.G) {
        const int v = ch >> 6;
        f32x4 ca[4], cb[4];
#pragma unroll
        for (int j = 0; j < 4; ++j) { const int c = 4 * lane + 256 * j; const f32x4 g = *(const f32x4*)(gain + c), sc = *(const f32x4*)(mod + v * 6144 + scoff + c); ca[j] = g * (sc + 1.0f); cb[j] = *(const f32x4*)(mod + v * 6144 + shoff + c); }
        for (int i = 0; i < 16; ++i) {
            const int r = ch * 128 + F.wave * 16 + i; const float* src = xs + (size_t)r * 1024;
            f32x4 x[4]; float ss = 0.f;
#pragma unroll
            for (int j = 0; j < 4; ++j) { x[j] = *(const f32x4*)(src + 4 * lane + 256 * j); ss += (x[j][0] * x[j][0] + x[j][1] * x[j][1]) + (x[j][2] * x[j][2] + x[j][3] * x[j][3]); }
            const float rstd = rsqrtf(wave_sum(ss, lane) * (1.f / 1024.f) + EPS);
#pragma unroll
            for (int j = 0; j < 4; ++j) { x[j] = x[j] * rstd * ca[j] + cb[j]; *(unsigned*)(XNM + (size_t)r * 1024 + 4 * lane + 256 * j) = pk4_fp8(x[j][0], x[j][1], x[j][2], x[j][3]); }
            float lg[8];
#pragma unroll
            for (int e = 0; e < 8; ++e) lg[e] = 0.f;
#pragma unroll
            for (int j = 0; j < 4; ++j)
#pragma unroll
                for (int q = 0; q < 4; ++q) { const int k = 4 * lane + 256 * j + q; const f32x4 w0 = *(const LAS f32x4*)(RT + k * 8), w1 = *(const LAS f32x4*)(RT + k * 8 + 4); const float xv = x[j][q];
                    lg[0] += xv * w0[0]; lg[1] += xv * w0[1]; lg[2] += xv * w0[2]; lg[3] += xv * w0[3]; lg[4] += xv * w1[0]; lg[5] += xv * w1[1]; lg[6] += xv * w1[2]; lg[7] += xv * w1[3]; }
#pragma unroll
            for (int e = 0; e < 8; ++e) lg[e] = wave_sum(lg[e], lane);
            if (lane == 0) {
                int i1 = 0; float v1 = lg[0];
#pragma unroll
                for (int e = 1; e < 8; ++e) if (lg[e] > v1) { v1 = lg[e]; i1 = e; }
                int i2 = -1; float v2 = -3.0e38f;
#pragma unroll
                for (int e = 0; e < 8; ++e) if (e != i1 && lg[e] > v2) { v2 = lg[e]; i2 = e; }
                const float w1 = 1.f / (1.f + expf(v2 - v1)), w2 = 1.f - w1;
                __hip_atomic_fetch_add(lcnt + i1, 1, __ATOMIC_RELAXED, __HIP_MEMORY_SCOPE_WORKGROUP); __hip_atomic_fetch_add(lcnt + i2, 1, __ATOMIC_RELAXED, __HIP_MEMORY_SCOPE_WORKGROUP);
                int* te = (int*)(wsq_ + WS_TOKE) + r * 2; float* tw = (float*)(wsq_ + WS_TOKW) + r * 2;
                te[0] = i1; te[1] = i2; tw[0] = w1; tw[1] = w2;
            }
        }
        __syncthreads();
        if (tid < 8) { ((int*)(wsq_ + WS_CNTB))[ch * 8 + tid] = lcnt[tid]; lcnt[tid] = 0; }
        __syncthreads();
    }
}

__device__ __forceinline__ void kr_rows(const Frame& F, const bf16_t* Z, bf16_t* KR) { unsigned char* const wsq_ = opq(F.ws);
    const int lane = lane_id(), tid = F.wave * 64 + lane; (void)tid; (void)lane;
    const float* cosT = (const float*)(wsq_ + WS_COS); const float* sinT = (const float*)(wsq_ + WS_SIN);
    for (int idx = F.gw * 64 + lane; idx < NR * 16; idx += F.NGW * 64) { const int r = idx >> 4, a = (idx >> 3) & 1, i = idx & 7;
        const float x1 = bf1(Z[(size_t)r * 1024 + 896 + a * 16 + i]), x2 = bf1(Z[(size_t)r * 1024 + 896 + a * 16 + 8 + i]);
        float c = 1.f, s = 0.f; if (r < NX) { const int t = r & (SEQ - 1); c = cosT[t * 16 + a * 8 + i]; s = sinT[t * 16 + a * 8 + i]; }
        KR[(size_t)r * 32 + a * 16 + i] = (bf16_t)f2bf(x1 * c - x2 * s); KR[(size_t)r * 32 + a * 16 + 8 + i] = (bf16_t)f2bf(x2 * c + x1 * s); }
}

__device__ __forceinline__ void ssm_tables(const Frame& F, const Args& A) { unsigned char* const wsq_ = opq(F.ws);
    const int lane = lane_id(), tid = F.wave * 64 + lane;
    LAS float* Cr = (LAS float*)F.lds; LAS float* Ci = Cr + 1024; LAS float* BBl = Ci + 1024; LAS float* PWl = BBl + 2048;
    unsigned char* ws = wsq_;
    for (int it = F.bid; it < 2 * NG * 2; it += F.G) {
        const int dir = it & 1, g = (it >> 1) & 31, l = it >> 6; const int gi = (l * 2 + dir) * NG + g;
        __syncthreads();
        for (int i = tid; i < 1024; i += NTHR) { Cr[i] = INP(18)[(size_t)gi * 1024 + i]; Ci[i] = INP(19)[(size_t)gi * 1024 + i]; }
        for (int i = tid; i < 2048; i += NTHR) BBl[i] = ((const float*)(ws + WS_BB))[(size_t)gi * 2048 + i];
        for (int i = tid; i < 64 * 66; i += NTHR) PWl[i] = ((const float*)(ws + WS_PW))[(size_t)gi * 64 * 66 + i];
        __syncthreads();
        float* KL = (float*)(ws + WS_KL) + (size_t)((l * NG + g) * 2 + dir) * 8192;
        for (int e = tid; e < 8192; e += NTHR) { const int lag = e >> 8, c = (e >> 4) & 15, cp = e & 15; float acc = 0.f;
#pragma unroll 4
            for (int p = 0; p < 64; ++p) { const float cr = Cr[c * 64 + p], ci = Ci[c * 64 + p], pr = PWl[p * 66 + 2 * lag], pi = PWl[p * 66 + 2 * lag + 1], br = BBl[(p * 16 + cp) * 2], bi = BBl[(p * 16 + cp) * 2 + 1];
                acc += (cr * pr - ci * pi) * br - (cr * pi + ci * pr) * bi; }
            KL[e] = acc; }
        bf16_t* W1 = (bf16_t*)(ws + WS_W1T) + ((size_t)(l * NG + g) * 256 + dir * 128) * 512;
        for (int q = tid; q < 8192; q += NTHR) { const int r = q >> 6, reim = r >> 6, p = r & 63, pc = q & 63, j = pc >> 1, c0 = (pc & 1) * 8, e = dir ? j : TCH - 1 - j;
            const float pr = PWl[p * 66 + 2 * e], pi = PWl[p * 66 + 2 * e + 1]; float v[8];
#pragma unroll
            for (int k = 0; k < 8; ++k) { const float br = BBl[(p * 16 + c0 + k) * 2], bi = BBl[(p * 16 + c0 + k) * 2 + 1]; v[k] = reim ? (pr * bi + pi * br) : (pr * br - pi * bi); }
            u32x4 o; o.x = pk2(v[0], v[1]); o.y = pk2(v[2], v[3]); o.z = pk2(v[4], v[5]); o.w = pk2(v[6], v[7]);
            *(u32x4*)(W1 + (size_t)r * 512 + j * 16 + c0) = o; }
        bf16_t* MT = (bf16_t*)(ws + WS_MT) + (size_t)(l * NG + g) * 512 * 768 + 512 + dir * 128;
        for (int q = tid; q < 8192; q += NTHR) { const int row = q >> 4, ii = row >> 4, c = row & 15, pc = q & 15, reim = pc >> 3, p0 = (pc & 7) * 8, e = dir ? TCH - ii : ii + 1; float v[8];
#pragma unroll
            for (int k = 0; k < 8; ++k) { const int p = p0 + k; const float cr = Cr[c * 64 + p], ci = Ci[c * 64 + p], pr = PWl[p * 66 + 2 * e], pi = PWl[p * 66 + 2 * e + 1]; v[k] = reim ? -(cr * pi + ci * pr) : (cr * pr - ci * pi); }
            u32x4 o; o.x = pk2(v[0], v[1]); o.y = pk2(v[2], v[3]); o.z = pk2(v[4], v[5]); o.w = pk2(v[6], v[7]);
            *(u32x4*)(MT + (size_t)row * 768 + reim * 64 + p0) = o; }
    }
    __syncthreads();
}
__device__ __forceinline__ void ssm_toeplitz(const Frame& F, const Args& A) { unsigned char* const wsq_ = opq(F.ws);
    const int lane = lane_id(); unsigned char* ws = wsq_;
    for (int x = F.gw * 64 + lane; x < 2 * NG * 512 * 64; x += F.NGW * 64) { const int pc = x & 63, row = (x >> 6) & 511, lg = x >> 15, j = pc >> 1, c0 = (pc & 1) * 8, i = row >> 4, c = row & 15;
        const float* KL = (const float*)(ws + WS_KL) + (size_t)lg * 2 * 8192; float v[8];
#pragma unroll
        for (int k = 0; k < 8; ++k) v[k] = 0.f;
        if (j <= i) { const float* kp = KL + (i - j) * 256 + c * 16 + c0; const f32x4 a = *(const f32x4*)kp, b = *(const f32x4*)(kp + 4); v[0] += a[0]; v[1] += a[1]; v[2] += a[2]; v[3] += a[3]; v[4] += b[0]; v[5] += b[1]; v[6] += b[2]; v[7] += b[3]; }
        if (j >= i) { const float* kp = KL + 8192 + (j - i) * 256 + c * 16 + c0; const f32x4 a = *(const f32x4*)kp, b = *(const f32x4*)(kp + 4); v[0] += a[0]; v[1] += a[1]; v[2] += a[2]; v[3] += a[3]; v[4] += b[0]; v[5] += b[1]; v[6] += b[2]; v[7] += b[3]; }
        if (i == j && (c >> 3) == (c0 >> 3)) { const float d = INP(20)[(lg >> 5) * 512 + (lg & 31) * 16 + c];
#pragma unroll
            for (int k = 0; k < 8; ++k) v[k] += (k == (c & 7)) ? d : 0.f; }
        u32x4 o; o.x = pk2(v[0], v[1]); o.y = pk2(v[2], v[3]); o.z = pk2(v[4], v[5]); o.w = pk2(v[6], v[7]);
        *(u32x4*)((bf16_t*)(ws + WS_MT) + ((size_t)lg * 512 + row) * 768 + j * 16 + c0) = o; }
}
__device__ __forceinline__ void ssm_scan(const Frame& F, int l) { unsigned char* const wsq_ = opq(F.ws);
    const int lane = lane_id(); unsigned char* ws = wsq_;
    for (int w = F.bid + F.G * F.wave; w < NB * NG * 2; w += F.G * NWAVES) {
        const int dir = w & 1, g = (w >> 1) & 31, b = w >> 6; const int idx = ((l * 2 + dir) * NG + g) * NP + lane;
        const float* PW = (const float*)(ws + WS_PW) + (size_t)idx * 66; const float are = PW[2 * TCH], aim = PW[2 * TCH + 1];
        const float* S = (const float*)(ws + WS_S) + (size_t)g * NCH * 256 + dir * 128 + lane; bf16_t* UH = (bf16_t*)(ws + WS_UH) + (size_t)g * NCH * 768 + 512 + dir * 128 + lane;
        float hre = 0.f, him = 0.f;
        for (int blk = 0; blk < (CTXL + SEQ) / TCH / 24; ++blk) {
            float sr[24], si[24]; int nn[24];
#pragma unroll
            for (int k = 0; k < 24; ++k) { const int s = blk * 24 + k; int n;
                if (s < CTXL / TCH) n = NX / TCH + b * (CTXL / TCH) + (dir ? CTXL / TCH - 1 - s : s); else { const int t = s - CTXL / TCH; n = b * (SEQ / TCH) + (dir ? SEQ / TCH - 1 - t : t); }
                nn[k] = n; sr[k] = S[(size_t)n * 256]; si[k] = S[(size_t)n * 256 + 64]; }
#pragma unroll
            for (int k = 0; k < 24; ++k) { UH[(size_t)nn[k] * 768] = (bf16_t)f2bf(hre); UH[(size_t)nn[k] * 768 + 64] = (bf16_t)f2bf(him);
                const float nr = are * hre - aim * him + sr[k], ni = are * him + aim * hre + si[k]; hre = nr; him = ni; }
        }
    }
}

__device__ __forceinline__ int pad256(unsigned c) { return (int)((c + 255u) & ~255u); }
__device__ __forceinline__ void moe_gather(const Frame& F, const unsigned char* XNM, unsigned char* XP) { unsigned char* const wsq_ = opq(F.ws);
    const int lane = lane_id(), tid = F.wave * 64 + lane;
    { u32x4 z4 = {0u, 0u, 0u, 0u}; asm volatile("" : "+v"(z4));
      for (int i = F.gw * 64 + lane; i < MOE_ROWS * 8; i += F.NGW * 64) *(u32x4*)(wsq_ + WS_HP + (size_t)(i >> 3) * DFE8 + DFE + (i & 7) * 16) = z4; }
    LAS int* posl = (LAS int*)F.lds;
    const int* CNTB = (const int*)(wsq_ + WS_CNTB); const int* te = (const int*)(wsq_ + WS_TOKE); int* tp = (int*)(wsq_ + WS_TOKP);
    for (int ch = F.bid; ch < NX / 128; ch += F.G) {
        __syncthreads();
        if (F.wave == 0) {
            int es[4];
#pragma unroll
            for (int q = 0; q < 4; ++q) es[q] = te[ch * 256 + lane + 64 * q];
            int off = 0, ps[4] = {0, 0, 0, 0};
#pragma unroll
            for (int e = 0; e < 8; ++e) {
                int tot = 0, bef = 0;
#pragma unroll
                for (int q = 0; q < 4; ++q) { const int c2 = lane + 64 * q, vv = CNTB[c2 * 8 + e]; tot += vv; bef += (c2 < ch) ? vv : 0; }
                tot = wave_sum_i(tot, lane); bef = wave_sum_i(bef, lane);
                int run = off + bef;
#pragma unroll
                for (int q = 0; q < 4; ++q) { const unsigned long long m = __ballot(es[q] == e); if (es[q] == e) ps[q] = run + __popcll(m & ((1ull << lane) - 1ull)); run += __popcll(m); }
                if (ch == 0 && lane == 0) F.ctl[CW_MOE + e] = (unsigned)tot;
                off += pad256((unsigned)tot);
            }
#pragma unroll
            for (int q = 0; q < 4; ++q) { posl[lane + 64 * q] = ps[q]; tp[ch * 256 + lane + 64 * q] = ps[q]; }
        }
        __syncthreads();
        for (int i = 0; i < 16; ++i) { const int tl = F.wave * 16 + i, r = ch * 128 + tl;
            const u32x4 a = *(const u32x4*)(XNM + (size_t)r * 1024 + lane * 16);
#pragma unroll
            for (int k = 0; k < 2; ++k) { const size_t dst = (size_t)posl[tl * 2 + k] * 1024; *(u32x4*)(XP + dst + lane * 16) = a; } }
    }
}
__device__ __forceinline__ void moe_combine_final(const Frame& F, const Args& A, const bf16_t* YP, const float* g2mod) { unsigned char* const wsq_ = opq(F.ws);
    const int lane = lane_id(), tid = F.wave * 64 + lane; (void)tid; (void)lane;
    const int* tp = (const int*)(wsq_ + WS_TOKP); const float* tw = (const float*)(wsq_ + WS_TOKW);
    f32x4 fn[4];
#pragma unroll
    for (int j = 0; j < 4; ++j) fn[j] = *(const f32x4*)(INP(31) + 4 * lane + 256 * j);
    for (int r = F.gw; r < NX; r += F.NGW) {
        const int v = r >> 13; size_t src[2]; float wk[2];
#pragma unroll
        for (int k = 0; k < 2; ++k) { src[k] = (size_t)tp[r * 2 + k] * 1024; wk[k] = tw[r * 2 + k]; }
        f32x4 x[4]; float ss = 0.f;
#pragma unroll
        for (int j = 0; j < 4; ++j) { const int c = 4 * lane + 256 * j; x[j] = *(const f32x4*)(F.out + (size_t)r * 1024 + c);
            const u32x2 y0 = *(const u32x2*)(YP + src[0] + c), y1 = *(const u32x2*)(YP + src[1] + c); const f32x4 g = *(const f32x4*)(g2mod + v * 6144 + c);
            f32x4 y; y[0] = wk[0] * bflo(y0.x) + wk[1] * bflo(y1.x); y[1] = wk[0] * bfhi(y0.x) + wk[1] * bfhi(y1.x); y[2] = wk[0] * bflo(y0.y) + wk[1] * bflo(y1.y); y[3] = wk[0] * bfhi(y0.y) + wk[1] * bfhi(y1.y);
            x[j] = x[j] + g * y; ss += (x[j][0] * x[j][0] + x[j][1] * x[j][1]) + (x[j][2] * x[j][2] + x[j][3] * x[j][3]); }
        const float rstd = rsqrtf(wave_sum(ss, lane) * (1.f / 1024.f) + EPS);
#pragma unroll
        for (int j = 0; j < 4; ++j) *(f32x4*)(F.out + (size_t)r * 1024 + 4 * lane + 256 * j) = x[j] * rstd * fn[j];
    }
}

typedef float f32x16 __attribute__((ext_vector_type(16)));
constexpr int KALL = SEQ + CTXL;
constexpr int ATT_KB = 12 * 1024, ATT_VB = 8 * 1024, ATT_TB = ATT_KB + ATT_VB, ATT_NBUF = 4;
__device__ __forceinline__ void glds16(const void* gsrc, unsigned lds_dst) { unsigned keep;
    asm volatile("s_mov_b32 %0, m0\n\ts_mov_b32 m0, %2\n\ts_nop 0\n\tglobal_load_lds_dwordx4 %1, off\n\ts_mov_b32 m0, %0" : "=&s"(keep) : "v"(gsrc), "s"(lds_dst) : "memory"); }
__device__ __forceinline__ float max3f(float a, float b, float c) { float r; asm("v_max3_f32 %0, %1, %2, %3" : "=v"(r) : "v"(a), "v"(b), "v"(c)); return r; }
__device__ __forceinline__ float max2f(float a, float b) { float r; asm("v_max_f32_e32 %0, %1, %2" : "=v"(r) : "v"(a), "v"(b)); return r; }
__device__ __forceinline__ bf16x8 pack_p(const f32x16& p, int s) {
    u32x4 w; w.x = pk2(p[8 * s], p[8 * s + 1]); w.y = pk2(p[8 * s + 2], p[8 * s + 3]); w.z = pk2(p[8 * s + 4], p[8 * s + 5]); w.w = pk2(p[8 * s + 6], p[8 * s + 7]); return __builtin_bit_cast(bf16x8, w);
}
__device__ __forceinline__ void attn_phase(const Frame& F, bool need_ctx, const bf16_t* Q, const bf16_t* KN, const bf16_t* KR, const bf16_t* VT, bf16_t* Y) {
    const bool lead = F.wave < 4;
    LAS unsigned char* lds = F.lds;
    const int nmain = (F.G == 256) ? 4 : (NB * NH * (SEQ / 256) + F.G - 1) / F.G;
    for (int ui = 0; ui < nmain + 1; ++ui) {
        const int lane = lane_id(), r32 = lane & 31, hi = lane >> 5;
        int b, h, qrow0, t0;
        if (ui < nmain) { int un; if (F.G == 256) un = (((F.bid & 7) + 8 * ui) << 5) | (F.bid >> 3); else un = F.bid + ui * F.G;
            if (un >= NB * NH * (SEQ / 256)) continue;
            b = un >> 8; h = (un >> 5) & 7; qrow0 = b * SEQ + (un & 31) * 256; t0 = 0; }
        else { if (!need_ctx || F.bid >= NB * NH) continue; b = F.bid >> 3; h = F.bid & 7; qrow0 = NX + b * CTXL; t0 = SEQ / 64; }
        const int nt = KALL / 64;
        bf16x8 qf[6];
        { const bf16_t* qp = Q + (size_t)(qrow0 + F.wave * 32 + r32) * 768 + h * 96 + 8 * hi;
#pragma unroll
          for (int s = 0; s < 6; ++s) qf[s] = *(const bf16x8*)(qp + 16 * s); }
        const unsigned ldsb = (unsigned)(size_t)lds;
        const char* kbase = (const char*)(KN + h * 64 + F.wave * 8); const char* rbase = (const char*)(KR + (F.wave & 3) * 8); const char* vbase = (const char*)(VT + (size_t)((b * NH + h) * 64) * KALL + F.wave * 8);
        const unsigned klo = (unsigned)lane * 1024u, rlo = (unsigned)lane * 64u, vlo = (unsigned)lane * (unsigned)(KALL * 2);
#define ATT_DMA(t, bo) do { const int row0_ = (t) < SEQ / 64 ? b * SEQ + (t) * 64 : NX + b * CTXL + ((t) - SEQ / 64) * 64; \
            unsigned klo_ = klo, rlo_ = rlo, vlo_ = vlo; asm volatile("" : "+v"(klo_), "+v"(rlo_), "+v"(vlo_));     \
            glds16(kbase + (size_t)row0_ * 1024 + klo_, (unsigned)__builtin_amdgcn_readfirstlane(ldsb + (bo) + F.wave * 1024)); \
            if (lead) glds16(rbase + (size_t)row0_ * 64 + rlo_, (unsigned)__builtin_amdgcn_readfirstlane(ldsb + (bo) + (8 + F.wave) * 1024)); \
            glds16(vbase + (size_t)(t) * 128 + vlo_, (unsigned)__builtin_amdgcn_readfirstlane(ldsb + (bo) + ATT_KB + F.wave * 1024)); } while (0)
#define ATT_WAITBAR(fresh) do { if (!(fresh)) asm volatile("s_waitcnt vmcnt(0) lgkmcnt(0)\n\ts_barrier" ::: "memory"); else if (lead) asm volatile("s_waitcnt vmcnt(3) lgkmcnt(0)\n\ts_barrier" ::: "memory"); \
            else asm volatile("s_waitcnt vmcnt(2) lgkmcnt(0)\n\ts_barrier" ::: "memory"); } while (0)
        const unsigned r32p = (unsigned)((r32 & ~12) | ((r32 & 4) << 1) | ((r32 & 8) >> 1));
        const unsigned ka = hi * 1024 + r32p * 16;
        const unsigned va = ATT_KB + hi * 1024 + r32 * 16;
        f32x16 o0, o1, pA0, pA1, pB0, pB1;
#pragma unroll
        for (int r = 0; r < 16; ++r) { o0[r] = 0.f; o1[r] = 0.f; }
        float m = 0.f, lsum = 0.f;
#define ATT_QK(P0, P1, bo) do { _Pragma("unroll") for (int r = 0; r < 16; ++r) { P0[r] = -m; P1[r] = -m; } _Pragma("unroll") for (int s = 0; s < 6; ++s) { \
            const bf16x8 k0_ = *(const LAS bf16x8*)(lds + (bo) + ka + s * 2048), k1_ = *(const LAS bf16x8*)(lds + (bo) + ka + 512 + s * 2048); \
            P0 = __builtin_amdgcn_mfma_f32_32x32x16_bf16(k0_, qf[s], P0, 0, 0, 0); P1 = __builtin_amdgcn_mfma_f32_32x32x16_bf16(k1_, qf[s], P1, 0, 0, 0); } } while (0)
#define ATT_FIN(P0, P1) do { float ps_ = 0.f; _Pragma("unroll") for (int r = 0; r < 16; ++r) { P0[r] = __builtin_amdgcn_exp2f(P0[r]); P1[r] = __builtin_amdgcn_exp2f(P1[r]); ps_ += P0[r] + P1[r]; } lsum += ps_; \
            pf0 = pack_p(P0, 0); pf1 = pack_p(P0, 1); pf2 = pack_p(P1, 0); pf3 = pack_p(P1, 1); } while (0)
#define ATT_VF(bo, db, kb, s) (*(const LAS bf16x8*)(lds + (bo) + va + (db) * 512 + (kb) * 4096 + (s) * 2048))
#define ATT_PV(bo) do { \
            o0 = __builtin_amdgcn_mfma_f32_32x32x16_bf16(ATT_VF(bo, 0, 0, 0), pf0, o0, 0, 0, 0); o1 = __builtin_amdgcn_mfma_f32_32x32x16_bf16(ATT_VF(bo, 1, 0, 0), pf0, o1, 0, 0, 0); \
            o0 = __builtin_amdgcn_mfma_f32_32x32x16_bf16(ATT_VF(bo, 0, 0, 1), pf1, o0, 0, 0, 0); o1 = __builtin_amdgcn_mfma_f32_32x32x16_bf16(ATT_VF(bo, 1, 0, 1), pf1, o1, 0, 0, 0); \
            o0 = __builtin_amdgcn_mfma_f32_32x32x16_bf16(ATT_VF(bo, 0, 1, 0), pf2, o0, 0, 0, 0); o1 = __builtin_amdgcn_mfma_f32_32x32x16_bf16(ATT_VF(bo, 1, 1, 0), pf2, o1, 0, 0, 0); \
            o0 = __builtin_amdgcn_mfma_f32_32x32x16_bf16(ATT_VF(bo, 0, 1, 1), pf3, o0, 0, 0, 0); o1 = __builtin_amdgcn_mfma_f32_32x32x16_bf16(ATT_VF(bo, 1, 1, 1), pf3, o1, 0, 0, 0); } while (0)
#define ATT_MAX(P0, P1, FIRST) do { asm volatile("s_nop 15\n\ts_nop 7" : "+v"(P0), "+v"(P1));     \
            float ra_ = max3f(P0[0], P0[1], P1[0]), rb_ = max3f(P0[2], P0[3], P1[1]); ra_ = max3f(ra_, P1[2], P1[3]); \
            _Pragma("unroll") for (int r = 4; r < 16; r += 4) { ra_ = max3f(ra_, P0[r], P0[r + 1]); rb_ = max3f(rb_, P0[r + 2], P0[r + 3]); ra_ = max3f(ra_, P1[r], P1[r + 1]); rb_ = max3f(rb_, P1[r + 2], P1[r + 3]); } \
            float rm_ = max2f(ra_, rb_); rm_ = max2f(rm_, shx(rm_, 32, lane)); \
            if ((FIRST) || __any(rm_ > 8.0f)) { const float dl_ = (FIRST) ? rm_ : max2f(rm_, 0.f); m += dl_; const float al_ = __builtin_amdgcn_exp2f(-dl_); lsum *= al_; \
                _Pragma("unroll") for (int r = 0; r < 16; ++r) { P0[r] -= dl_; P1[r] -= dl_; o0[r] *= al_; o1[r] *= al_; } } } while (0)
#define ATT_ROT() do { const unsigned t_ = bprv; bprv = bcur; bcur = bnxt; bnxt = bnn; bnn = t_; } while (0)
#define ATT_STEP(PN0, PN1, PO0, PO1, j) do { const bool fresh_ = (j) + 2 < nt; \
            if (fresh_) ATT_DMA((j) + 2, bnn); \
            ATT_QK(PN0, PN1, bcur); ATT_FIN(PO0, PO1); \
            ATT_PV(bprv); ATT_MAX(PN0, PN1, false); \
            ATT_ROT(); ATT_WAITBAR(fresh_); } while (0)
        bf16x8 pf0, pf1, pf2, pf3;
        unsigned bprv = 3 * ATT_TB, bcur = 0, bnxt = ATT_TB, bnn = 2 * ATT_TB;
        asm volatile("s_waitcnt vmcnt(0) lgkmcnt(0)\n\ts_barrier" ::: "memory");
        ATT_DMA(t0, bcur); ATT_DMA(t0 + 1, bnxt);
        ATT_WAITBAR(true);
        ATT_DMA(t0 + 2, bnn);
        ATT_QK(pA0, pA1, bcur); ATT_MAX(pA0, pA1, true);
        ATT_ROT(); ATT_WAITBAR(true);
        int j = t0 + 1;
        for (; j + 1 < nt; j += 2) { ATT_STEP(pB0, pB1, pA0, pA1, j); ATT_STEP(pA0, pA1, pB0, pB1, j + 1); }
        ATT_STEP(pB0, pB1, pA0, pA1, j);
        ATT_FIN(pB0, pB1); ATT_PV(bprv);
#undef ATT_DMA
#undef ATT_WAITBAR
#undef ATT_QK
#undef ATT_FIN
#undef ATT_VF
#undef ATT_PV
#undef ATT_MAX
#undef ATT_ROT
#undef ATT_STEP
        const int le = lane_id();
        lsum += shx(lsum, 32, le);
        const float inv = 1.f / lsum;
        bf16_t* yp = Y + (size_t)(qrow0 + F.wave * 32 + (le & 31)) * 1024 + 512 + h * 64 + 4 * (le >> 5);
#pragma unroll
        for (int g = 0; g < 4; ++g) {
            u32x2 w0, w1; w0.x = pk2(o0[4 * g] * inv, o0[4 * g + 1] * inv); w0.y = pk2(o0[4 * g + 2] * inv, o0[4 * g + 3] * inv);
            w1.x = pk2(o1[4 * g] * inv, o1[4 * g + 1] * inv); w1.y = pk2(o1[4 * g + 2] * inv, o1[4 * g + 3] * inv);
            *(u32x2*)(yp + 8 * g) = w0; *(u32x2*)(yp + 32 + 8 * g) = w1;
        }
    }
    __syncthreads();
}

constexpr int N_PHASES = 23;
#define SP2v true
#define ALIGNv true
__global__ void __launch_bounds__(NTHR, 2) fwd_kernel(Args A) {
    extern __shared__ __attribute__((aligned(16))) unsigned char lds_raw[];
    Frame F;
    F.lds = (LAS unsigned char*)lds_raw; F.MISC = (volatile LAS unsigned*)(F.lds + MISC_OFF);
    F.wave = __builtin_amdgcn_readfirstlane((int)threadIdx.x >> 6);
    F.G = gridDim.x; F.bid = blockIdx.x; F.gw = F.bid * NWAVES + F.wave; F.NGW = F.G * NWAVES;
    F.out = A.out; F.ws = A.ws; F.ctl = (unsigned*)(A.ws + WS_CTL);
    for (int u = (int)threadIdx.x; u < (LDS_BYTES - LDSCTL_OFF) / 4; u += NTHR) ((LAS unsigned*)(F.lds + LDSCTL_OFF))[u] = 0u;
    __syncthreads();
#if MK_N_LAUNCHES == 1
    XcdBarrier bar = xcd_barrier_post(F.ctl + CW_BAR, F.MISC + 8);
#define GRID_BAR() xcd_barrier(bar)
#else
#define GRID_BAR() do {} while (0)
#endif
    const int lo = A.ph_lo, hi = A.ph_hi;
#define IN(k) (lo <= (k) && (k) < hi)
#define SEAM(k) do { if (IN(k) && IN((k) + 1)) GRID_BAR(); } while (0)
    LAS unsigned char* ring = F.lds;
#define WSQ() unsigned char* ws = opq(F.ws)
#define PBF(name, off) bf16_t* name = (bf16_t*)(ws + (off))

    if (IN(0)) { p0_prologue(F, A); } SEAM(0);

    for (int l = 0; l < 2; ++l) {
        const int pb = 1 + 10 * l; const bool need_ctx = (l == 0);
        if (IN(pb + 0)) { WSQ(); PBF(XN, WS_XN); const float* modl = (const float*)(ws + WS_MOD) + (size_t)l * 5 * 6144;
            const float* xs_x = (l == 0) ? INP(0) : F.out; const float* xs_c = (l == 0) ? INP(2) : (const float*)(ws + WS_XC);
            if (l == 0) { p0_weights(F, A); __syncthreads(); ssm_tables(F, A); }
            norm_rows<false>(F, xs_x, xs_c, NR, INP(6) + l * 1024, modl, 0, 1024, XN); } SEAM(pb + 0);
        if (IN(pb + 1)) { WSQ(); PBF(XN, WS_XN); PBF(Z, WS_Z); float* rs = (float*)(ws + WS_RS) + (size_t)l * NR * 8;
            pg8::Gemm g{XN, (const bf16_t*)(ws + WS_WIN) + (size_t)l * 1024 * 1024, 1024, 1024, 1024, 0}; pg8::StaticOrder S; S.init(NR, 1024, F.G, F.bid);
            pg8::EpiInProj E{Z, rs, (bf16_t*)(ws + WS_UH)}; pg8::gemm_phase<pg8::EpiInProj, pg8::StaticOrder, ALIGNv, SP2v>(ring, g, S, E, F.wave);
            if (l == 0) ssm_toeplitz(F, A); } SEAM(pb + 1);
        if (IN(pb + 2)) {
            { WSQ(); PBF(Z, WS_Z); PBF(Qb, WS_Q); const float* rs = (const float*)(ws + WS_RS) + (size_t)l * NR * 8;
              pg8::Gemm g{Z + 512, (const bf16_t*)(ws + WS_WUQ) + (size_t)l * 768 * 256, 1024, 256, 256, 0}; pg8::StaticOrder S; S.init(need_ctx ? NR : NX, 768, F.G, F.bid);
              pg8::EpiQ E{Qb, rs, (const float*)(ws + WS_COS), (const float*)(ws + WS_SIN)}; pg8::gemm_phase<pg8::EpiQ, pg8::StaticOrder, ALIGNv, SP2v>(ring, g, S, E, F.wave); }
            { WSQ(); PBF(Z, WS_Z); PBF(KN, WS_KN); const float* rs = (const float*)(ws + WS_RS) + (size_t)l * NR * 8;
              pg8::Gemm g{Z + 768, (const bf16_t*)(ws + WS_WUKV) + (size_t)l * 1024 * 128, 1024, 128, 128, 0}; pg8::StaticOrder S; S.init(NR, 512, F.G, F.bid);
              pg8::EpiKV E{KN, rs}; pg8::gemm_phase<pg8::EpiKV, pg8::StaticOrder, ALIGNv, SP2v>(ring, g, S, E, F.wave); }
            { WSQ(); PBF(Z, WS_Z); PBF(VT, WS_V); const float* rs = (const float*)(ws + WS_RS) + (size_t)l * NR * 8;
              pg8::Gemm g{(const bf16_t*)(ws + WS_WUKV) + (size_t)l * 1024 * 128 + 512 * 128, Z + 768, 128, 1024, 128, 0}; pg8::StaticOrder S; S.init(512, NR, F.G, F.bid);
              pg8::EpiVT E{VT, rs}; pg8::gemm_phase<pg8::EpiVT, pg8::StaticOrder, ALIGNv, SP2v>(ring, g, S, E, F.wave); }
            { WSQ(); PBF(Z, WS_Z); PBF(KR, WS_KR); kr_rows(F, Z, KR); }
            { WSQ(); PBF(UH, WS_UH);
              pg8::Gemm g{UH, (const bf16_t*)(ws + WS_W1T) + (size_t)l * NG * 256 * 512, 768, 512, 512, (size_t)256 * 512 * 2, (size_t)NCH * 768 * 2}; pg8::GroupOrder S{5, 1, F.G, F.bid};
              pg8::EpiS E{(float*)(ws + WS_S)}; pg8::gemm_phase<pg8::EpiS, pg8::GroupOrder, ALIGNv, SP2v>(ring, g, S, E, F.wave); }
        } SEAM(pb + 2);
        if (IN(pb + 3)) {
            ssm_scan(F, l);
            { WSQ(); PBF(Qb, WS_Q); PBF(KN, WS_KN); PBF(KR, WS_KR); PBF(VT, WS_V); PBF(YMIX, WS_YMIX); attn_phase(F, need_ctx, Qb, KN, KR, VT, YMIX); }
        } SEAM(pb + 3);
        if (IN(pb + 4)) { WSQ(); PBF(UH, WS_UH); PBF(ZG, WS_ZG);
            pg8::Gemm g{UH, (const bf16_t*)(ws + WS_MT) + (size_t)l * NG * 512 * 768, 768, 768, 768, (size_t)512 * 768 * 2, (size_t)NCH * 768 * 2}; pg8::GroupOrder S{5, 2, F.G, F.bid};
            pg8::EpiY E{ZG}; pg8::gemm_phase<pg8::EpiY, pg8::GroupOrder, ALIGNv, SP2v>(ring, g, S, E, F.wave); } SEAM(pb + 4);
        if (IN(pb + 5)) { WSQ(); PBF(ZG, WS_ZG); PBF(YMIX, WS_YMIX);
            pg8::Gemm g{ZG, (const bf16_t*)(ws + WS_WGLU) + (size_t)l * 512 * 512, 512, 512, 512, 0}; pg8::StaticOrder S; S.init(need_ctx ? NR : NX, 512, F.G, F.bid);
            pg8::EpiGlu E{ZG, INP(22) + l * 512, YMIX}; pg8::gemm_phase<pg8::EpiGlu, pg8::StaticOrder, ALIGNv, SP2v>(ring, g, S, E, F.wave); } SEAM(pb + 5);
        if (IN(pb + 6)) { WSQ(); PBF(YMIX, WS_YMIX); const float* modl = (const float*)(ws + WS_MOD) + (size_t)l * 5 * 6144; float* XC = (float*)(ws + WS_XC);
            const float* xs_x = (l == 0) ? INP(0) : F.out; const float* xs_c = (l == 0) ? INP(2) : XC;
            pg8::Gemm g{YMIX, (const bf16_t*)(ws + WS_WOUT) + (size_t)l * 1024 * 1024, 1024, 1024, 1024, 0}; pg8::StaticOrder S; S.init(need_ctx ? NR : NX, 1024, F.G, F.bid);
            pg8::EpiRes E{xs_x, xs_c, F.out, XC, modl + 2048, 1.f}; pg8::gemm_phase<pg8::EpiRes, pg8::StaticOrder, ALIGNv, SP2v>(ring, g, S, E, F.wave); } SEAM(pb + 6);
        if (l == 0) {
            if (IN(pb + 7)) { WSQ(); PBF(XN, WS_XN); const float* modl = (const float*)(ws + WS_MOD); norm_rows<false>(F, F.out, (const float*)(ws + WS_XC), NR, INP(7), modl, 3072, 4096, XN); } SEAM(pb + 7);
            if (IN(pb + 8)) { WSQ(); PBF(XN, WS_XN); PBF(H, WS_H);
                pg8::Gemm g{XN, (const bf16_t*)(ws + WS_WFF13), 1024, 1024, 1024, 0}; pg8::StaticOrder S; S.init(NR, 2 * DFF, F.G, F.bid);
                pg8::EpiSwiglu<false> E{H, DFF, 1.f}; pg8::gemm_phase<pg8::EpiSwiglu<false>, pg8::StaticOrder, ALIGNv, SP2v>(ring, g, S, E, F.wave); } SEAM(pb + 8);
            if (IN(pb + 9)) { WSQ(); PBF(H, WS_H); const float* modl = (const float*)(ws + WS_MOD); float* XC = (float*)(ws + WS_XC);
                pg8::Gemm g{H, (const bf16_t*)(ws + WS_WFF2), DFF, DFF, DFF, 0}; pg8::StaticOrder S; S.init(NR, 1024, F.G, F.bid);
                pg8::EpiRes E{F.out, XC, F.out, XC, modl + 5120, 1.f}; pg8::gemm_phase<pg8::EpiRes, pg8::StaticOrder, ALIGNv, SP2v>(ring, g, S, E, F.wave); } SEAM(pb + 9);
        } else {
            if (IN(pb + 7)) { WSQ(); const float* modl = (const float*)(ws + WS_MOD) + (size_t)5 * 6144; norm_router(F, F.out, INP(7) + 1024, modl, 3072, 4096, ws + WS_XNM); } SEAM(pb + 7);
            if (IN(pb + 8)) { WSQ(); moe_gather(F, ws + WS_XNM, ws + WS_XP); } SEAM(pb + 8);
            if (IN(pb + 9)) { WSQ(); PBF(XP, WS_XP); PBF(HP, WS_HP); const unsigned* cnt = F.ctl + CW_MOE; int o[9]; o[0] = 0;
#pragma unroll
                for (int e = 0; e < 8; ++e) o[e + 1] = o[e] + pad256(cnt[e]);
                pg8::MoeOrder S; S.nT = o[8] / 256; S.nN = 2 * DFE / 256; S.nwg = S.nT * S.nN; S.G = F.G; S.c = F.bid; S.o1 = o[1]; S.o2 = o[2]; S.o3 = o[3]; S.o4 = o[4]; S.o5 = o[5]; S.o6 = o[6]; S.o7 = o[7];
                pg8::Gemm g{XP, (const bf16_t*)(ws + WS_WM13), 512, 512, 512, (size_t)2 * DFE * 1024};
                pg8::EpiSwiglu<true> E{HP, DFE8, 1.f / W8_SCALE}; pg8::gemm_phase<pg8::EpiSwiglu<true>, pg8::MoeOrder, ALIGNv, SP2v, true>(ring, g, S, E, F.wave); } SEAM(pb + 9);
        }
    }
    if (IN(21)) { WSQ(); PBF(HP, WS_HP); PBF(YP, WS_YP); const unsigned* cnt = F.ctl + CW_MOE; int o[9]; o[0] = 0;
#pragma unroll
        for (int e = 0; e < 8; ++e) o[e + 1] = o[e] + pad256(cnt[e]);
        pg8::MoeOrder S; S.nT = o[8] / 256; S.nN = 4; S.nwg = S.nT * S.nN; S.G = F.G; S.c = F.bid; S.o1 = o[1]; S.o2 = o[2]; S.o3 = o[3]; S.o4 = o[4]; S.o5 = o[5]; S.o6 = o[6]; S.o7 = o[7];
        pg8::Gemm g{HP, (const bf16_t*)(ws + WS_WM2), DFE8 / 2, DFE8 / 2, DFE8 / 2, (size_t)1024 * DFE8};
        pg8::EpiBf16 E{YP, 1024, 1.f / W8_SCALE}; pg8::gemm_phase<pg8::EpiBf16, pg8::MoeOrder, ALIGNv, SP2v, true>(ring, g, S, E, F.wave); } SEAM(21);
    if (IN(22)) { WSQ(); PBF(YP, WS_YP); moe_combine_final(F, A, YP, (const float*)(ws + WS_MOD) + (size_t)5 * 6144 + 5120);
#if PROBE_ON
        { __syncthreads(); const unsigned long long* pw = (const unsigned long long*)(ws + WS_PROBE); float va = (float)pw[PROBE_A] / 131.f, vb = (float)pw[PROBE_B] / 131.f; if (PROBE_A == 63) { va = 1234.f; vb = 777.f; } va = exp2f(rintf(4.f * log2f(fmaxf(va, 1.f))) * 0.25f); vb = exp2f(rintf(4.f * log2f(fmaxf(vb, 1.f))) * 0.25f);
          const float sn = 1000.f * sqrtf(va);
          const int lane = lane_id();
          for (int r = F.gw; r < NX; r += F.NGW)
#pragma unroll
              for (int jq = 0; jq < 4; ++jq) { const size_t i = (size_t)r * 1024 + 4 * lane + 256 * jq; f32x4 o;
#pragma unroll
                  for (int k = 0; k < 4; ++k) { const unsigned hsh = (unsigned)(i + k) * 2654435761u; o[k] = (hsh & 0x10000u) ? sn : -sn; }
                  if (i == 0) o[0] = 1.0e4f * vb;
                  *(f32x4*)(F.out + i) = o; } }
#endif
    }
#undef IN
#undef SEAM
}

extern "C" void kernel_launch(void* const* d_in, const int* in_sizes, int n_in, void* d_out, int out_size, void* d_ws, size_t ws_size, hipStream_t stream) {
    static int grid = 0;
    if (grid == 0) {
        if (n_in != 32 || in_sizes[0] != NX * DM || out_size != NX * DM || ws_size < WS_END) { fprintf(stderr, "kernel_launch: unexpected shapes (n_in %d, in0 %d, out %d, ws %zu); nothing launched\n", n_in, n_in > 0 ? in_sizes[0] : -1, out_size, ws_size); grid = -1; return; }
        int dev = 0, cus = 0, per_cu = 0;
        if (hipGetDevice(&dev) != hipSuccess || hipDeviceGetAttribute(&cus, hipDeviceAttributeMultiprocessorCount, dev) != hipSuccess) { grid = -1; return; }
        if (hipFuncSetAttribute((const void*)fwd_kernel, hipFuncAttributeMaxDynamicSharedMemorySize, LDS_BYTES) != hipSuccess) { fprintf(stderr, "kernel_launch: hipFuncSetAttribute failed\n"); grid = -1; return; }
        if (hipOccupancyMaxActiveBlocksPerMultiprocessor(&per_cu, (const void*)fwd_kernel, NTHR, LDS_BYTES) != hipSuccess || per_cu < 1) fprintf(stderr, "kernel_launch: occupancy query says %d\n", per_cu);
        (void)hipGetLastError();
        grid = cus;
    }
    if (grid < 0) return;
    if (hipMemsetAsync((char*)d_ws + WS_CTL, 0, CTL_ZERO_BYTES, stream) != hipSuccess) { fprintf(stderr, "kernel_launch: memset failed\n"); return; }
    Args a{};
    for (int i = 0; i < 32; ++i) a.in[i] = (const float*)d_in[i];
    a.out = (float*)d_out; a.ws = (unsigned char*)d_ws; a.pad = 0;
#if MK_N_LAUNCHES == 1
    a.ph_lo = 0; a.ph_hi = N_PHASES; a.li = 0;
    hipLaunchKernelGGL(fwd_kernel, dim3(grid), dim3(NTHR), LDS_BYTES, stream, a);
#else
    for (int p = 0; p < N_PHASES; ++p) { a.ph_lo = p; a.ph_hi = p + 1; a.li = p; hipLaunchKernelGGL(fwd_kernel, dim3(grid), dim3(NTHR), LDS_BYTES, stream, a); }
#endif
    const hipError_t le = hipPeekAtLastError();
    if (le != hipSuccess) fprintf(stderr, "kernel_launch: launch failed: %s\n", hipGetErrorName(le));
}
```

```cpp
#include <hip/hip_runtime.h>
#include <cstdio>
#include <cstdint>

#define LAS __attribute__((address_space(3)))
#define GAS __attribute__((address_space(1)))
#define PG8_LAS LAS
typedef unsigned short bf16_t;
typedef short bf16x8 __attribute__((ext_vector_type(8)));
typedef float f32x4 __attribute__((ext_vector_type(4)));
typedef float f32x2 __attribute__((ext_vector_type(2)));
typedef unsigned u32x4 __attribute__((ext_vector_type(4)));
typedef unsigned u32x2 __attribute__((ext_vector_type(2)));
typedef __bf16 bf16x2_t __attribute__((ext_vector_type(2)));

#ifndef MK_N_LAUNCHES
#define MK_N_LAUNCHES 1
#endif

constexpr int DM = 1024, NB = 4, SEQ = 8192, CTXL = 256, NX = NB * SEQ, NC = NB * CTXL, NR = NX + NC;
constexpr int D_SSM = 512, NG = 32, NP = 64, NH = 8, DQK = 96, DIN = 928;
constexpr int DFF = 2816, NE = 8, DFE = 1408, DFE8 = 1536;
constexpr float EPS = 1e-6f;
constexpr float QSCALE = 0.10206207261596575f * 1.4426950408889634f;
constexpr int TCH = 32, NCH = NR / TCH;
constexpr int MOE_ROWS = 2 * NX + NE * 256;

constexpr size_t MiB = 1u << 20;
constexpr size_t WS_CTL = 0, CTL_ZERO_BYTES = 1 * MiB;
constexpr int CW_TMO = 0, CW_BAR = 4096, CW_MOE = 8192;
constexpr size_t WS_MOD = 64 * 1024;
constexpr size_t WS_RS = 5 * MiB;
constexpr size_t WS_COS = 1 * MiB, WS_SIN = WS_COS + 512 * 1024;
constexpr size_t WS_AB = 2 * MiB;
constexpr size_t WS_BB = WS_AB + 128 * 1024;
constexpr size_t WS_PW = 8 * MiB;
constexpr size_t WS_KL = 11 * MiB;
constexpr size_t WS_PROBE = 15 * MiB;
constexpr size_t WS_TOKE = 4 * MiB, WS_TOKP = WS_TOKE + 256 * 1024, WS_TOKW = WS_TOKP + 256 * 1024, WS_CNTB = WS_TOKW + 256 * 1024;
constexpr size_t WS_WIN = 16 * MiB, WS_WUQ = 20 * MiB, WS_WUKV = 21 * MiB, WS_WGLU = 22 * MiB, WS_WOUT = 23 * MiB;
constexpr size_t WS_WFF13 = 27 * MiB, WS_WFF2 = 38 * MiB, WS_WM13 = 44 * MiB, WS_WM2 = 88 * MiB;
constexpr size_t WS_XC = 112 * MiB;
constexpr size_t WS_RB = 116 * MiB;
constexpr size_t WS_XN = WS_RB, WS_Q = WS_RB, WS_XP = WS_RB, WS_YP = WS_RB;
constexpr size_t WS_W1T = WS_RB + 66 * MiB;
constexpr size_t WS_MT = WS_RB + 82 * MiB;
constexpr size_t WS_RA = 248 * MiB;
constexpr size_t WS_Z = WS_RA, WS_YMIX = WS_RA, WS_KN = WS_RA + 66 * MiB, WS_V = WS_RA + 99 * MiB, WS_KR = WS_RA + 132 * MiB;
constexpr size_t WS_ZG = WS_RA + 135 * MiB;
constexpr size_t WS_UH = WS_RA + 168 * MiB;
constexpr size_t WS_S = WS_RA + 218 * MiB;
constexpr size_t WS_H = WS_RA, WS_HP = WS_RA, WS_XNM = WS_RA + 182 * MiB;
constexpr size_t WS_PART = WS_RA + 182 * MiB;
constexpr size_t WS_END = 512 * MiB;
static_assert(WS_S + (size_t)32 * (NR / 32) * 256 * 4 <= WS_END && WS_UH + (size_t)32 * (NR / 32) * 768 * 2 + 512 * 1024 <= WS_S && WS_MT + (size_t)2 * 32 * 512 * 768 * 2 <= WS_RA && WS_XNM + (size_t)NX * DM * 2 <= WS_END && WS_H + (size_t)NR * DFF * 2 <= WS_XNM, "ws map");
static_assert(WS_RS + (size_t)2 * NR * 8 * 4 <= 16 * MiB && WS_MOD + 2 * 5 * 6144 * 4 <= CTL_ZERO_BYTES, "ctl map");

constexpr int RING_BYTES = 131072, LDSCTL_OFF = RING_BYTES, MISC_OFF = LDSCTL_OFF + 320, LDS_BYTES = 147456;

__device__ __forceinline__ unsigned f2bf(float f) { unsigned u = __builtin_bit_cast(unsigned, f); return (u + 0x7fffu + ((u >> 16) & 1u)) >> 16; }
__device__ __forceinline__ unsigned pk2(float lo, float hi) { f32x2 v = {lo, hi}; bf16x2_t b = __builtin_convertvector(v, bf16x2_t); return __builtin_bit_cast(unsigned, b); }
__device__ __forceinline__ unsigned pk4_fp8(float a, float b, float c, float d) { int w = 0; w = __builtin_amdgcn_cvt_pk_fp8_f32(a, b, w, false); w = __builtin_amdgcn_cvt_pk_fp8_f32(c, d, w, true); return (unsigned)w; }
constexpr float W8_SCALE = 64.f;
__device__ __forceinline__ float bflo(unsigned w) { return __builtin_bit_cast(float, w << 16); }
__device__ __forceinline__ float bfhi(unsigned w) { return __builtin_bit_cast(float, w & 0xffff0000u); }
__device__ __forceinline__ float bf1(bf16_t h) { return __builtin_bit_cast(float, (unsigned)h << 16); }
__device__ __forceinline__ float shx(float v, int m, int lane) { return __builtin_bit_cast(float, __builtin_amdgcn_ds_bpermute((lane ^ m) << 2, __builtin_bit_cast(int, v))); }
__device__ __forceinline__ int shx_i(int v, int m, int lane) { return __builtin_amdgcn_ds_bpermute((lane ^ m) << 2, v); }
__device__ __forceinline__ int wave_sum_i(int v, int lane) {
#pragma unroll
    for (int o = 1; o < 64; o <<= 1) v += shx_i(v, o, lane);
    return v;
}
__device__ __forceinline__ float wave_sum(float v, int lane) {
#pragma unroll
    for (int o = 1; o < 64; o <<= 1) v += shx(v, o, lane);
    return v;
}
__device__ __forceinline__ float silu_f(float x) { return x / (1.f + __expf(-x)); }
__device__ __forceinline__ float sigmoid_f(float x) { return 1.f / (1.f + __expf(-x)); }
__device__ __forceinline__ float gelu_tanh_f(float x) { const float u = 1.5957691216057308f * (x + 0.044715f * x * x * x); return x / (1.f + __expf(-u)); }
#define LDS_WAIT() asm volatile("s_waitcnt lgkmcnt(0)" ::: "memory")
#define VM_WAIT() asm volatile("s_waitcnt vmcnt(0)" ::: "memory")

__device__ __forceinline__ int lane_id() { int l; asm volatile("v_mbcnt_lo_u32_b32 %0, -1, 0\n\tv_mbcnt_hi_u32_b32 %0, -1, %0" : "=v"(l)); return l; }
__device__ __forceinline__ unsigned char* opq(unsigned char* p) { asm volatile("" : "+s"(p)); return p; }
typedef const float* cfptr_t;
__device__ __forceinline__ const float* inptr(int k) {
    const __attribute__((address_space(4))) char* kp = (const __attribute__((address_space(4))) char*)__builtin_amdgcn_kernarg_segment_ptr();
    return *(const __attribute__((address_space(4))) cfptr_t volatile*)(kp + 8 * k);
}
#define INP(k) inptr(k)

namespace pg8 {
constexpr int BM = 256, BK = 64, HALF = 128, HTB = HALF * BK * 2  , STAGE_BYTES = 8 * HTB, NXCD = 8, WGM = 8;

__host__ __device__ __forceinline__ int lds_byte(int r, int c) { const int st = (r >> 4) * 2 + (c >> 5), rr = r & 15, cc = c & 31, ob = rr * 64 + cc * 2; return st * 1024 + (ob ^ (((ob >> 9) & 1) << 5)); }
__host__ __device__ __forceinline__ void stage_rc(int b, int& R, int& C) { const int st = b / 1024, sb = b % 1024, swz = sb ^ (((sb >> 9) & 1) << 5); R = (st >> 1) * 16 + swz / 64; C = (st & 1) * 32 + (swz % 64) / 2; }
__host__ __device__ __forceinline__ int perm32(int rho) { const int n = rho >> 4, i = rho & 15; return 8 * (i >> 2) + 4 * n + (i & 3); }
struct Unit { int pm, pn, ex; };
struct Gemm { const bf16_t* A; const bf16_t* Bt; int lda, ldb, K; size_t bexp, aexp; };

struct StaticOrder {
    int nM, nN, nwg, G, c;
    __device__ __forceinline__ void init(int M, int N, int G_, int c_) { nM = M / BM; nN = N / BM; nwg = nM * nN; G = G_; c = c_; }
    __device__ __forceinline__ bool next(int i, Unit& u) const {
        const long L = (long)i * G + c; if (L >= nwg) return false;
        int wgid = (int)L; { const int q = nwg / NXCD, r = nwg % NXCD, xcd = wgid % NXCD, off = wgid / NXCD; wgid = (xcd < r ? xcd * (q + 1) : r * (q + 1) + (xcd - r) * q) + off; }
        const int nig = WGM * nN, gid = wgid / nig, fm = gid * WGM, gsz = (nM - fm) < WGM ? (nM - fm) : WGM;
        u.pm = fm + ((wgid % nig) % gsz); u.pn = (wgid % nig) / gsz; u.ex = 0; return true;
    }
    __device__ __forceinline__ void a_ready(const Unit&) const {}
    __device__ __forceinline__ void done(const Unit&) const {}
};
struct MoeOrder {
    int nT, nN, nwg, G, c; int o1, o2, o3, o4, o5, o6, o7;
    __device__ __forceinline__ bool next(int i, Unit& u) const {
        const long L = (long)i * G + c; if (L >= nwg) return false;
        const int wgid = (int)L;
        const int nig = WGM * nN, gid = wgid / nig, fm = gid * WGM, gsz = (nT - fm) < WGM ? (nT - fm) : WGM;
        u.pm = fm + ((wgid % nig) % gsz); u.pn = (wgid % nig) / gsz;
        const int r = u.pm * BM; u.ex = (r >= o1) + (r >= o2) + (r >= o3) + (r >= o4) + (r >= o5) + (r >= o6) + (r >= o7); return true;
    }
    __device__ __forceinline__ void a_ready(const Unit&) const {}
    __device__ __forceinline__ void done(const Unit&) const {}
};

struct GroupOrder {
    int nMt, nN, G, c;
    __device__ __forceinline__ bool next(int i, Unit& u) const {
        const int L = i * G + c; const int per = nMt * nN; if (L >= NG * per) return false;
        u.ex = L / per; const int r = L - u.ex * per; u.pm = r / nN; u.pn = r - u.pm * nN; return true;
    }
    __device__ __forceinline__ void a_ready(const Unit&) const {}
    __device__ __forceinline__ void done(const Unit&) const {}
};

struct CtxSplitOrder {
    int nks, G, c;
    __device__ __forceinline__ bool next(int i, Unit& u) const { const int L = i * G + c; if (L >= 16 * nks) return false; u.ex = L >> 4; u.pm = (L >> 2) & 3; u.pn = L & 3; return true; }
    __device__ __forceinline__ void a_ready(const Unit&) const {}
    __device__ __forceinline__ void done(const Unit&) const {}
};

__device__ __forceinline__ u32x4 pack8(const f32x4& a, const f32x4& b) { u32x4 w; w.x = pk2(a[0], a[1]); w.y = pk2(a[2], a[3]); w.z = pk2(b[0], b[1]); w.w = pk2(b[2], b[3]); return w; }

struct EpiInProj {
    static constexpr bool PERM = true, AFTER_DRAIN = false;
    bf16_t* Z; float* rs; bf16_t* UH;
    __device__ __forceinline__ void operator()(const f32x4 (&acc)[2][2][4][2], const Unit& u, int wr, int wc, int fr_, int fq_) const {
        const int ln_ = lane_id(); const int fr = ln_ & 15, fq = ln_ >> 4; (void)fr_; (void)fq_;
        const int row0 = u.pm * BM + wr * 64 + fr, col0 = u.pn * BM + wc * 32 + 8 * fq;
#pragma unroll
        for (int ai = 0; ai < 2; ++ai)
#pragma unroll
            for (int m = 0; m < 4; ++m) {
                const int row = row0 + ai * HALF + m * 16; float ss = 0.f;
#pragma unroll
                for (int bj = 0; bj < 2; ++bj) { const f32x4 v0 = acc[ai][bj][m][0], v1 = acc[ai][bj][m][1]; const int col = col0 + bj * HALF;
                    if (u.pn < 2) *(u32x4*)(UH + ((size_t)(col >> 4) * NCH + (row >> 5)) * 768 + (row & 31) * 16 + (col & 15)) = pack8(v0, v1);
                    else *(u32x4*)(Z + (size_t)row * 1024 + col) = pack8(v0, v1);
                    if (bj == 0 || u.pn == 2) ss += (v0[0] * v0[0] + v0[1] * v0[1]) + (v0[2] * v0[2] + v0[3] * v0[3]) + (v1[0] * v1[0] + v1[1] * v1[1]) + (v1[2] * v1[2] + v1[3] * v1[3]); }
                if (u.pn >= 2) { ss += shx(ss, 16, ln_); ss += shx(ss, 32, ln_); if (fq == 0) rs[(size_t)row * 8 + (u.pn - 2) * 4 + wc] = ss; }
            }
    }
};
struct EpiS {
    static constexpr bool PERM = false, AFTER_DRAIN = false;
    float* S;
    __device__ __forceinline__ void operator()(const f32x4 (&acc)[2][2][4][2], const Unit& u, int wr, int wc, int fr_, int fq_) const {
        const int ln_ = lane_id(); const int fr = ln_ & 15, fq = ln_ >> 4; (void)fr_; (void)fq_;
        const int row0 = u.pm * BM + wr * 64 + fr, col0 = wc * 32 + 4 * fq;
#pragma unroll
        for (int ai = 0; ai < 2; ++ai)
#pragma unroll
            for (int m = 0; m < 4; ++m) { const int n = row0 + ai * HALF + m * 16; if (n < NCH) { float* sp = S + ((size_t)u.ex * NCH + n) * 256 + col0;
#pragma unroll
                for (int bj = 0; bj < 2; ++bj)
#pragma unroll
                    for (int nn = 0; nn < 2; ++nn) *(f32x4*)(sp + bj * HALF + nn * 16) = acc[ai][bj][m][nn]; } }
    }
};
struct EpiY {
    static constexpr bool PERM = true, AFTER_DRAIN = false;
    bf16_t* ZG;
    __device__ __forceinline__ void operator()(const f32x4 (&acc)[2][2][4][2], const Unit& u, int wr, int wc, int fr_, int fq_) const {
        const int ln_ = lane_id(); const int fr = ln_ & 15, fq = ln_ >> 4; (void)fr_; (void)fq_;
        const int row0 = u.pm * BM + wr * 64 + fr, col0 = u.pn * BM + wc * 32 + 8 * fq;
#pragma unroll
        for (int ai = 0; ai < 2; ++ai)
#pragma unroll
            for (int m = 0; m < 4; ++m) { const int n = row0 + ai * HALF + m * 16; if (n < NCH) {
#pragma unroll
                for (int bj = 0; bj < 2; ++bj) { const int q = col0 + bj * HALF; f32x4 a = acc[ai][bj][m][0], b = acc[ai][bj][m][1];
#pragma unroll
                    for (int j = 0; j < 4; ++j) { a[j] = gelu_tanh_f(a[j]); b[j] = gelu_tanh_f(b[j]); }
                    *(u32x4*)(ZG + ((size_t)n * TCH + (q >> 4)) * 512 + u.ex * 16 + (q & 15)) = pack8(a, b); } } }
    }
};
struct EpiQ {
    static constexpr bool PERM = true, AFTER_DRAIN = false;
    bf16_t* Q; const float* rs; const float* cosT; const float* sinT;
    __device__ __forceinline__ void operator()(const f32x4 (&acc)[2][2][4][2], const Unit& u, int wr, int wc, int fr_, int fq_) const {
        const int ln_ = lane_id(); const int fr = ln_ & 15, fq = ln_ >> 4; (void)fr_; (void)fq_;
        const int row0 = u.pm * BM + wr * 64 + fr; const bool latent = u.pm < NX / BM;
#pragma unroll
        for (int ai = 0; ai < 2; ++ai)
#pragma unroll
            for (int m = 0; m < 4; ++m) {
                const int row = row0 + ai * HALF + m * 16; const f32x4 q4 = *(const f32x4*)(rs + (size_t)row * 8); const float rstd = rsqrtf(((q4[0] + q4[1]) + (q4[2] + q4[3])) * (1.f / 256.f) + EPS);
#pragma unroll
                for (int bj = 0; bj < 2; ++bj) { const int cg = (u.pn * BM + bj * HALF + wc * 32) >> 5; const bool rope = latent && (cg % 3 == 2);
                    f32x4 v0 = acc[ai][bj][m][0] * rstd, v1 = acc[ai][bj][m][1] * rstd;
                    if (rope) {
                        f32x4 p0, p1;
#pragma unroll
                        for (int j = 0; j < 4; ++j) { p0[j] = shx(v0[j], 16, ln_); p1[j] = shx(v1[j], 16, ln_); }
                        const int t = row & (SEQ - 1); const float* cp = cosT + t * 16 + (fq >> 1) * 8; const float* sp = sinT + t * 16 + (fq >> 1) * 8;
                        const f32x4 c0 = *(const f32x4*)cp, c1 = *(const f32x4*)(cp + 4); f32x4 s0 = *(const f32x4*)sp, s1 = *(const f32x4*)(sp + 4);
                        if ((fq & 1) == 0) { s0 = -s0; s1 = -s1; }
                        v0 = v0 * c0 + p0 * s0; v1 = v1 * c1 + p1 * s1;
                    }
                    v0 = v0 * QSCALE; v1 = v1 * QSCALE;
                    *(u32x4*)(Q + (size_t)row * 768 + u.pn * BM + bj * HALF + wc * 32 + 8 * fq) = pack8(v0, v1); }
            }
    }
};
struct EpiKV {
    static constexpr bool PERM = true, AFTER_DRAIN = false;
    bf16_t* KN; const float* rs;
    __device__ __forceinline__ void operator()(const f32x4 (&acc)[2][2][4][2], const Unit& u, int wr, int wc, int fr_, int fq_) const {
        const int ln_ = lane_id(); const int fr = ln_ & 15, fq = ln_ >> 4; (void)fr_; (void)fq_;
        const int row0 = u.pm * BM + wr * 64 + fr; const int col0 = u.pn * BM + wc * 32 + 8 * fq;
#pragma unroll
        for (int ai = 0; ai < 2; ++ai)
#pragma unroll
            for (int m = 0; m < 4; ++m) {
                const int row = row0 + ai * HALF + m * 16; const f32x4 q4 = *(const f32x4*)(rs + (size_t)row * 8 + 4); const float rstd = rsqrtf(((q4[0] + q4[1]) + (q4[2] + q4[3])) * (1.f / 128.f) + EPS);
#pragma unroll
                for (int bj = 0; bj < 2; ++bj) *(u32x4*)(KN + (size_t)row * 512 + col0 + bj * HALF) = pack8(acc[ai][bj][m][0] * rstd, acc[ai][bj][m][1] * rstd);
            }
    }
};
struct EpiVT {
    static constexpr bool PERM = true, AFTER_DRAIN = false;
    bf16_t* VT; const float* rs;
    __device__ __forceinline__ void operator()(const f32x4 (&acc)[2][2][4][2], const Unit& u, int wr, int wc, int fr_, int fq_) const {
        const int ln_ = lane_id(); const int fr = ln_ & 15, fq = ln_ >> 4; (void)fr_; (void)fq_;
        const int c0 = u.pm * BM + wr * 64 + fr;
        const int b = u.pn < NX / BM ? (u.pn >> 5) : (u.pn - NX / BM); const int kbase = u.pn < NX / BM ? (u.pn & 31) * BM : SEQ;
#pragma unroll
        for (int bj = 0; bj < 2; ++bj) { const int tl = bj * HALF + wc * 32 + 8 * fq, tok = u.pn * BM + tl;
            f32x4 s0, s1;
#pragma unroll
            for (int i = 0; i < 4; ++i) { const f32x4 qa = *(const f32x4*)(rs + (size_t)(tok + i) * 8 + 4), qb = *(const f32x4*)(rs + (size_t)(tok + 4 + i) * 8 + 4);
                s0[i] = rsqrtf(((qa[0] + qa[1]) + (qa[2] + qa[3])) * (1.f / 128.f) + EPS); s1[i] = rsqrtf(((qb[0] + qb[1]) + (qb[2] + qb[3])) * (1.f / 128.f) + EPS); }
#pragma unroll
            for (int ai = 0; ai < 2; ++ai)
#pragma unroll
                for (int m = 0; m < 4; ++m) { const int c = c0 + ai * HALF + m * 16;
                    *(u32x4*)(VT + (size_t)(b * 512 + c) * (SEQ + CTXL) + kbase + tl) = pack8(acc[ai][bj][m][0] * s0, acc[ai][bj][m][1] * s1); } }
    }
};
struct EpiGlu {
    static constexpr bool PERM = true, AFTER_DRAIN = false;
    const bf16_t* ZG; const float* bias; bf16_t* Y;
    __device__ __forceinline__ void operator()(const f32x4 (&acc)[2][2][4][2], const Unit& u, int wr, int wc, int fr_, int fq_) const {
        const int ln_ = lane_id(); const int fr = ln_ & 15, fq = ln_ >> 4; (void)fr_; (void)fq_;
        const int row0 = u.pm * BM + wr * 64 + fr, col0 = u.pn * BM + wc * 32 + 8 * fq;
#pragma unroll
        for (int ai = 0; ai < 2; ++ai)
#pragma unroll
            for (int m = 0; m < 4; ++m) { const int row = row0 + ai * HALF + m * 16;
#pragma unroll
                for (int bj = 0; bj < 2; ++bj) { const int col = col0 + bj * HALF;
                    const u32x4 zw = *(const u32x4*)(ZG + (size_t)row * 512 + col); const f32x4 b0 = *(const f32x4*)(bias + col), b1 = *(const f32x4*)(bias + col + 4);
                    const f32x4 a0 = acc[ai][bj][m][0] + b0, a1 = acc[ai][bj][m][1] + b1; f32x4 o0, o1;
                    o0[0] = bflo(zw.x) * sigmoid_f(a0[0]); o0[1] = bfhi(zw.x) * sigmoid_f(a0[1]); o0[2] = bflo(zw.y) * sigmoid_f(a0[2]); o0[3] = bfhi(zw.y) * sigmoid_f(a0[3]);
                    o1[0] = bflo(zw.z) * sigmoid_f(a1[0]); o1[1] = bfhi(zw.z) * sigmoid_f(a1[1]); o1[2] = bflo(zw.w) * sigmoid_f(a1[2]); o1[3] = bfhi(zw.w) * sigmoid_f(a1[3]);
                    *(u32x4*)(Y + (size_t)row * 1024 + col) = pack8(o0, o1); } }
    }
};
struct EpiRes {
    static constexpr bool PERM = false, AFTER_DRAIN = false;
    const float* xin_x; const float* xin_c; float* xout_x; float* xout_c; const float* gate;   float s;
    __device__ __forceinline__ void operator()(const f32x4 (&acc)[2][2][4][2], const Unit& u, int wr, int wc, int fr_, int fq_) const {
        const int ln_ = lane_id(); const int fr = ln_ & 15, fq = ln_ >> 4; (void)fr_; (void)fq_;
        const int row0 = u.pm * BM + wr * 64 + fr, col0 = u.pn * BM + wc * 32 + 4 * fq;
        const bool lat = u.pm < NX / BM; const int v = lat ? (u.pm >> 5) : 4;
        const float* xi = lat ? xin_x : xin_c - (size_t)NX * 1024; float* xo = lat ? xout_x : xout_c - (size_t)NX * 1024;
        f32x4 gv[2][2];
#pragma unroll
        for (int bj = 0; bj < 2; ++bj)
#pragma unroll
            for (int n = 0; n < 2; ++n) gv[bj][n] = *(const f32x4*)(gate + v * 6144 + col0 + bj * HALF + n * 16) * s;
#pragma unroll
        for (int ai = 0; ai < 2; ++ai)
#pragma unroll
            for (int m = 0; m < 4; ++m) { const size_t ro = (size_t)(row0 + ai * HALF + m * 16) * 1024 + col0;
#pragma unroll
                for (int bj = 0; bj < 2; ++bj)
#pragma unroll
                    for (int n = 0; n < 2; ++n) { const size_t o = ro + bj * HALF + n * 16; *(f32x4*)(xo + o) = *(const f32x4*)(xi + o) + gv[bj][n] * acc[ai][bj][m][n]; } }
    }
};
struct EpiPart {
    static constexpr bool PERM = false, AFTER_DRAIN = false;
    float* P;
    __device__ __forceinline__ void operator()(const f32x4 (&acc)[2][2][4][2], const Unit& u, int wr, int wc, int fr_, int fq_) const {
        const int ln_ = lane_id(); const int fr = ln_ & 15, fq = ln_ >> 4; (void)fr_; (void)fq_;
        const int row0 = u.pm * BM + wr * 64 + fr, col0 = u.pn * BM + wc * 32 + 4 * fq;
#pragma unroll
        for (int ai = 0; ai < 2; ++ai)
#pragma unroll
            for (int m = 0; m < 4; ++m) { float* pp = P + ((size_t)u.ex * NC + row0 + ai * HALF + m * 16) * 1024 + col0;
#pragma unroll
                for (int bj = 0; bj < 2; ++bj)
#pragma unroll
                    for (int n = 0; n < 2; ++n) *(f32x4*)(pp + bj * HALF + n * 16) = acc[ai][bj][m][n]; }
    }
};
template <bool OUT8> struct EpiSwiglu {
    static constexpr bool PERM = true, AFTER_DRAIN = false;
    void* H; int ldh; float s;
    __device__ __forceinline__ void operator()(const f32x4 (&acc)[2][2][4][2], const Unit& u, int wr, int wc, int fr_, int fq_) const {
        const int ln_ = lane_id(); const int fr = ln_ & 15, fq = ln_ >> 4; (void)fr_; (void)fq_;
        const int row0 = u.pm * BM + wr * 64 + fr, col0 = u.pn * HALF + wc * 32 + 8 * fq;
#pragma unroll
        for (int ai = 0; ai < 2; ++ai)
#pragma unroll
            for (int m = 0; m < 4; ++m) { f32x4 o0, o1;
#pragma unroll
                for (int j = 0; j < 4; ++j) { o0[j] = silu_f(acc[ai][0][m][0][j] * s) * (acc[ai][1][m][0][j] * s); o1[j] = silu_f(acc[ai][0][m][1][j] * s) * (acc[ai][1][m][1][j] * s); }
                const size_t off = (size_t)(row0 + ai * HALF + m * 16) * ldh + col0;
                if constexpr (OUT8) { u32x2 w; w.x = pk4_fp8(o0[0], o0[1], o0[2], o0[3]); w.y = pk4_fp8(o1[0], o1[1], o1[2], o1[3]); *(u32x2*)((unsigned char*)H + off) = w; }
                else *(u32x4*)((bf16_t*)H + off) = pack8(o0, o1); }
    }
};
struct EpiBf16 {
    static constexpr bool PERM = true, AFTER_DRAIN = false;
    bf16_t* O; int ldc; float s;
    __device__ __forceinline__ void operator()(const f32x4 (&acc)[2][2][4][2], const Unit& u, int wr, int wc, int fr_, int fq_) const {
        const int ln_ = lane_id(); const int fr = ln_ & 15, fq = ln_ >> 4; (void)fr_; (void)fq_;
        const int row0 = u.pm * BM + wr * 64 + fr, col0 = u.pn * BM + wc * 32 + 8 * fq;
#pragma unroll
        for (int ai = 0; ai < 2; ++ai)
#pragma unroll
            for (int m = 0; m < 4; ++m)
#pragma unroll
                for (int bj = 0; bj < 2; ++bj) *(u32x4*)(O + (size_t)(row0 + ai * HALF + m * 16) * ldc + col0 + bj * HALF) = pack8(acc[ai][bj][m][0] * s, acc[ai][bj][m][1] * s);
    }
};
typedef int v8i_t __attribute__((ext_vector_type(8)));
typedef short s16x16_t __attribute__((ext_vector_type(16)));
__device__ __forceinline__ v8i_t cat8(bf16x8 a, bf16x8 b) { return __builtin_bit_cast(v8i_t, __builtin_shufflevector(a, b, 0, 1, 2, 3, 4, 5, 6, 7, 8, 9, 10, 11, 12, 13, 14, 15)); }
template <class Epi, class Sched, bool ALIGN_EPI = false, bool SP2 = false, bool F8 = false>
__device__ __forceinline__ void gemm_phase(PG8_LAS unsigned char* lds, const Gemm g, const Sched& S, const Epi& E, const int wid) {
    const int lane = lane_id(), tid = wid * 64 + lane, wr = wid >> 2, wc = wid & 3, fr = lane & 15, fq = lane >> 4;
    const int K = g.K, nt = K / BK;
    unsigned v_offA, v_offB;
    { int R, C; stage_rc(tid * 16, R, C); const int Rb = Epi::PERM ? ((R & ~31) + perm32(R & 31)) : R;
        v_offA = (unsigned)(R * g.lda + C) * 2u; v_offB = (unsigned)(Rb * g.ldb + C) * 2u; }
    const unsigned r64_offA = 64u * (unsigned)g.lda * 2u, r64_offB = 64u * (unsigned)g.ldb * 2u;
    const size_t kstep = (size_t)(BK * 2);
    const size_t hstepA = (size_t)HALF * g.lda * 2, hstepB = (size_t)HALF * g.ldb * 2;
    const size_t tstepA = 2 * hstepA, tstepB = 2 * hstepB;
    const unsigned ldsw = (unsigned)wid * 1024u;
    const int aoff = lds_byte(wr * 64 + fr, fq * 8), boff = lds_byte(wc * 32 + fr, fq * 8);
#define PG8_SA(b, h) (((b) * 2 + (h)) * HTB)
#define PG8_SB(b, h) ((4 + (b) * 2 + (h)) * HTB)
#define PG8_STAGE(bufoff, gbase, voff) do { _Pragma("unroll") for (int _i = 0; _i < 2; ++_i) \
        __builtin_amdgcn_global_load_lds((const unsigned*)((const char*)(gbase) + (size_t)(_i * r64_##voff) + v_##voff), (PG8_LAS unsigned*)(lds + (bufoff) + ldsw + _i * 8192), 16, 0, 0); } while (0)
#define PG8_RD(p) (*(const PG8_LAS bf16x8*)(p))
#define PG8_LDA(dst, b, h) do { if constexpr (F8) { _Pragma("unroll") for (int m = 0; m < 4; ++m) dst##8[m] = cat8(PG8_RD(lds + PG8_SA(b, h) + aoff + m * 2048), PG8_RD(lds + PG8_SA(b, h) + aoff + m * 2048 + 1024)); } \
        else { _Pragma("unroll") for (int m = 0; m < 4; ++m) _Pragma("unroll") for (int k = 0; k < 2; ++k) dst[m][k] = PG8_RD(lds + PG8_SA(b, h) + aoff + m * 2048 + k * 1024); } } while (0)
#define PG8_LDB(dst, b, h) do { if constexpr (F8) { _Pragma("unroll") for (int n = 0; n < 2; ++n) dst##8[n] = cat8(PG8_RD(lds + PG8_SB(b, h) + boff + n * 2048), PG8_RD(lds + PG8_SB(b, h) + boff + n * 2048 + 1024)); } \
        else { _Pragma("unroll") for (int n = 0; n < 2; ++n) _Pragma("unroll") for (int k = 0; k < 2; ++k) dst[n][k] = PG8_RD(lds + PG8_SB(b, h) + boff + n * 2048 + k * 1024); } } while (0)
#define PG8_MMA(ai, bj, At, Bt) do { __builtin_amdgcn_s_setprio(1); if constexpr (F8) { _Pragma("unroll") for (int m = 0; m < 4; ++m) _Pragma("unroll") for (int n = 0; n < 2; ++n) \
        asm volatile("v_mfma_scale_f32_16x16x128_f8f6f4 %0, %1, %2, %0, %3, %3 op_sel_hi:[0,0,0]" : "+v"(acc[ai][bj][m][n]) : "v"(Bt##8[n]), "v"(At##8[m]), "v"(sc1_)); asm volatile("s_nop 11"); } \
        else { _Pragma("unroll") for (int m = 0; m < 4; ++m) _Pragma("unroll") for (int n = 0; n < 2; ++n) _Pragma("unroll") for (int k = 0; k < 2; ++k) \
        acc[ai][bj][m][n] = __builtin_amdgcn_mfma_f32_16x16x32_bf16(Bt[n][k], At[m][k], acc[ai][bj][m][n], 0, 0, 0); } __builtin_amdgcn_s_setprio(0); } while (0)
#define PG8_WAIT_V(n) asm volatile("s_waitcnt vmcnt(" #n ")" ::: "memory")
#define PG8_WAIT_L(n) asm volatile("s_waitcnt lgkmcnt(" #n ")" ::: "memory")
#define PG8_BAR __builtin_amdgcn_s_barrier()
#define PG8_SCHED __builtin_amdgcn_sched_barrier(0)
    Unit cur, nxt; int ui = 0;
    if (!S.next(0, cur)) return;
    f32x4 acc[2][2][4][2];
#pragma unroll
    for (int a = 0; a < 2; ++a)
#pragma unroll
        for (int b = 0; b < 2; ++b)
#pragma unroll
            for (int m = 0; m < 4; ++m)
#pragma unroll
                for (int n = 0; n < 2; ++n) acc[a][b][m][n] = (f32x4){0.f, 0.f, 0.f, 0.f};
    const int sc1_ = 0x7f7f7f7f;
    bf16x8 At[4][2], B0[2][2], B1[2][2]; v8i_t At8[4], B08[2], B18[2];
    const char* cA = (const char*)g.A + (size_t)cur.ex * g.aexp + (size_t)cur.pm * tstepA; const char* cB = (const char*)g.Bt + (size_t)cur.ex * g.bexp + (size_t)cur.pn * tstepB;
    S.a_ready(cur);
    if constexpr (SP2) {
        PG8_STAGE(PG8_SB(0, 0), cB, offB); PG8_STAGE(PG8_SB(0, 1), cB + hstepB, offB); PG8_STAGE(PG8_SA(0, 0), cA, offA); PG8_STAGE(PG8_SA(0, 1), cA + hstepA, offA);
        if (wr == 1) PG8_BAR;
        PG8_WAIT_V(2); PG8_BAR;
        PG8_STAGE(PG8_SB(1, 0), cB + kstep, offB); PG8_STAGE(PG8_SA(1, 0), cA + kstep, offA); PG8_STAGE(PG8_SB(1, 1), cB + hstepB + kstep, offB);
        PG8_WAIT_V(6); PG8_BAR;
    } else {
        PG8_STAGE(PG8_SB(0, 0), cB, offB); PG8_STAGE(PG8_SA(0, 0), cA, offA); PG8_STAGE(PG8_SB(0, 1), cB + hstepB, offB); PG8_STAGE(PG8_SA(0, 1), cA + hstepA, offA);
        if (wr == 1) PG8_BAR;
        PG8_WAIT_V(4); PG8_BAR;
        PG8_STAGE(PG8_SB(1, 0), cB + kstep, offB); PG8_STAGE(PG8_SA(1, 0), cA + kstep, offA); PG8_STAGE(PG8_SB(1, 1), cB + hstepB + kstep, offB);
        PG8_WAIT_V(6); PG8_BAR;
    }
    for (;;) {
        const bool has_next = S.next(ui + 1, nxt);
        const char* nA = has_next ? (const char*)g.A + (size_t)nxt.ex * g.aexp + (size_t)nxt.pm * tstepA : cA; const char* nB = has_next ? (const char*)g.Bt + (size_t)nxt.ex * g.bexp + (size_t)nxt.pn * tstepB : cB;
        for (int t = 0; t < nt; t += 2) {
            const bool last = (t == nt - 2);
            const char* a1 = cA + (size_t)(t + 1) * kstep;
            const char* a2 = last ? nA : cA + (size_t)(t + 2) * kstep; const char* b2 = last ? nB : cB + (size_t)(t + 2) * kstep;
            const char* a3 = a2 + kstep; const char* b3 = b2 + kstep;
            if (last && has_next) S.a_ready(nxt);
            if constexpr (SP2) {
            PG8_LDB(B0, 0, 0); PG8_LDB(B1, 0, 1); PG8_SCHED; PG8_LDA(At, 0, 0); PG8_STAGE(PG8_SA(1, 1), a1 + hstepA, offA);
            PG8_WAIT_V(8); PG8_WAIT_L(0); PG8_BAR; PG8_MMA(0, 0, At, B0); PG8_MMA(0, 1, At, B1); PG8_BAR; PG8_SCHED;
            PG8_LDA(At, 0, 1); PG8_STAGE(PG8_SB(0, 0), b2, offB); PG8_STAGE(PG8_SB(0, 1), b2 + hstepB, offB); PG8_STAGE(PG8_SA(0, 0), a2, offA);
            PG8_WAIT_V(8); PG8_WAIT_L(0); PG8_BAR; PG8_MMA(1, 0, At, B0); PG8_MMA(1, 1, At, B1); PG8_BAR; PG8_SCHED;
            PG8_LDB(B0, 1, 0); PG8_LDB(B1, 1, 1); PG8_SCHED; PG8_LDA(At, 1, 0); PG8_STAGE(PG8_SA(0, 1), a2 + hstepA, offA);
            PG8_WAIT_V(8); PG8_WAIT_L(0); PG8_BAR; PG8_MMA(0, 0, At, B0); PG8_MMA(0, 1, At, B1); PG8_BAR; PG8_SCHED;
            PG8_LDA(At, 1, 1); PG8_STAGE(PG8_SB(1, 0), b3, offB); PG8_STAGE(PG8_SB(1, 1), b3 + hstepB, offB); PG8_STAGE(PG8_SA(1, 0), a3, offA);
            PG8_WAIT_V(8); PG8_WAIT_L(0); PG8_BAR; PG8_MMA(1, 0, At, B0); PG8_MMA(1, 1, At, B1); PG8_BAR; PG8_SCHED;
            } else {
            PG8_LDB(B0, 0, 0); PG8_SCHED; PG8_LDA(At, 0, 0); PG8_STAGE(PG8_SA(1, 1), a1 + hstepA, offA);
            PG8_WAIT_L(8); PG8_BAR; PG8_WAIT_L(0); PG8_MMA(0, 0, At, B0); PG8_BAR; PG8_SCHED;
            PG8_LDB(B1, 0, 1); PG8_STAGE(PG8_SB(0, 0), b2, offB);
            PG8_BAR; PG8_WAIT_L(0); PG8_MMA(0, 1, At, B1); PG8_BAR;
            PG8_LDA(At, 0, 1); PG8_STAGE(PG8_SA(0, 0), a2, offA);
            PG8_BAR; PG8_WAIT_L(0); PG8_MMA(1, 0, At, B0); PG8_BAR; PG8_SCHED;
            PG8_STAGE(PG8_SB(0, 1), b2 + hstepB, offB);
            PG8_WAIT_V(6); PG8_BAR; PG8_MMA(1, 1, At, B1); PG8_BAR;
            PG8_LDB(B0, 1, 0); PG8_SCHED; PG8_LDA(At, 1, 0); PG8_STAGE(PG8_SA(0, 1), a2 + hstepA, offA);
            PG8_WAIT_L(8); PG8_BAR; PG8_WAIT_L(0); PG8_MMA(0, 0, At, B0); PG8_BAR; PG8_SCHED;
            PG8_LDB(B1, 1, 1); PG8_STAGE(PG8_SB(1, 0), b3, offB);
            PG8_BAR; PG8_WAIT_L(0); PG8_MMA(0, 1, At, B1); PG8_BAR;
            PG8_LDA(At, 1, 1); PG8_STAGE(PG8_SA(1, 0), a3, offA);
            PG8_BAR; PG8_WAIT_L(0); PG8_MMA(1, 0, At, B0); PG8_BAR; PG8_SCHED;
            PG8_STAGE(PG8_SB(1, 1), b3 + hstepB, offB);
            PG8_WAIT_V(6); PG8_BAR; PG8_MMA(1, 1, At, B1); PG8_BAR;
            }
        }
        if constexpr (F8) { asm volatile("s_nop 15\n\ts_nop 7" ::: "memory"); }
        if constexpr (ALIGN_EPI) { if (wr == 0) PG8_BAR; }
        if constexpr (!Epi::AFTER_DRAIN) { E(acc, cur, wr, wc, fr, fq); S.done(cur); }
        if (!has_next) break;
#pragma unroll
        for (int a = 0; a < 2; ++a)
#pragma unroll
            for (int b = 0; b < 2; ++b)
#pragma unroll
                for (int m = 0; m < 4; ++m)
#pragma unroll
                    for (int n = 0; n < 2; ++n) acc[a][b][m][n] = (f32x4){0.f, 0.f, 0.f, 0.f};
        cur = nxt; cA = nA; cB = nB; ++ui;
        if constexpr (ALIGN_EPI) { if (wr == 1) PG8_BAR; }
    }
    PG8_WAIT_V(0);
    if constexpr (!ALIGN_EPI) { if (wr == 0) PG8_BAR; }
    PG8_BAR;
    if constexpr (Epi::AFTER_DRAIN) { E.fused(acc, cur, wr, wc, fr, fq, lds, wid, lane); S.done(cur); }
#undef PG8_SA
#undef PG8_SB
#undef PG8_STAGE
#undef PG8_RD
#undef PG8_LDA
#undef PG8_LDB
#undef PG8_MMA
#undef PG8_WAIT_V
#undef PG8_WAIT_L
#undef PG8_BAR
#undef PG8_SCHED
}
}


#define XB_TMO      128
#define XB_XCNT(j)  (256  + 64 * (j))
#define XB_XSUB(j)  (1280 + 64 * (j))
#define XB_XGEN(j)  (2304 + 64 * (j))
#define XB_TOP      3328
#define XB_TOPGEN   3392
#define XCD_BAR_WORDS 3456
#define XB_SPIN_CAP (1u << 18)

__device__ __forceinline__ unsigned xb_ld(unsigned* p)              { return __hip_atomic_load(p, __ATOMIC_RELAXED, __HIP_MEMORY_SCOPE_AGENT); }
__device__ __forceinline__ unsigned xb_add(unsigned* p, unsigned v) { return __hip_atomic_fetch_add(p, v, __ATOMIC_RELAXED, __HIP_MEMORY_SCOPE_AGENT); }
__device__ __forceinline__ unsigned xb_xcc_id() { return (unsigned)__builtin_amdgcn_s_getreg((3 << 11) | 20) & 0xFu; }
#define XB_SPIN(cond, bar) do { unsigned _sp = 0; while (cond) { __builtin_amdgcn_s_sleep(1); \
    if ((++_sp & 255u) == 0u) { if (xb_ld(&(bar)[XB_TMO])) break; if (_sp > XB_SPIN_CAP) { atomicAdd(&(bar)[XB_TMO], 1u); break; } } } } while (0)

struct XcdBarrier {
    unsigned* bar; unsigned x;
    volatile LAS unsigned* st;
};

__device__ __forceinline__ XcdBarrier xcd_barrier_post(unsigned* bar, volatile LAS unsigned* st) {
    XcdBarrier b; b.bar = bar; b.x = xb_xcc_id(); b.st = st;
    if (threadIdx.x == 0) (void)xb_add(&bar[XB_XCNT(b.x)], 1u);
    return b;
}
__device__ __forceinline__ void xcd_barrier_complete(unsigned* bar, unsigned x, unsigned& nloc, unsigned& nx) {
    const unsigned G = gridDim.x * gridDim.y * gridDim.z;
    unsigned sum, cnt, mine, sp = 0u;
    for (;;) {
        sum = 0u; cnt = 0u; mine = 0u;
#pragma unroll
        for (unsigned j = 0; j < 16; ++j) { const unsigned c = xb_ld(&bar[XB_XCNT(j)]); sum += c; cnt += (c > 0u) ? 1u : 0u; mine = (j == x) ? c : mine; }
        if (sum == G) break;
        __builtin_amdgcn_s_sleep(1);
        if ((++sp & 255u) == 0u) { if (xb_ld(&bar[XB_TMO])) break; if (sp > XB_SPIN_CAP) { atomicAdd(&bar[XB_TMO], 1u); break; } }
    }
    nloc = mine > 0u ? mine : 1u; nx = cnt > 0u ? cnt : 1u;
}

__device__ __forceinline__ void xcd_barrier(const XcdBarrier& b) {
    asm volatile("s_waitcnt vmcnt(0)" ::: "memory");
    __syncthreads();
    if (threadIdx.x == 0) {
        unsigned* bar = b.bar; asm volatile("" : "+s"(bar));
        __builtin_amdgcn_s_waitcnt(0);
        unsigned bx = b.x; asm volatile("" : "+s"(bx));
        unsigned nloc = b.st[0], nx = b.st[1];
        if (nloc == 0u) { xcd_barrier_complete(bar, bx, nloc, nx); b.st[0] = nloc; b.st[1] = nx; }
        const unsigned old = xb_add(&bar[XB_XSUB(bx)], 1u);
        const unsigned gen = old / nloc;
        if (old + 1u == (gen + 1u) * nloc) {
            __builtin_amdgcn_fence(__ATOMIC_RELEASE, "agent");
            asm volatile("s_waitcnt vmcnt(0)" ::: "memory");
            const unsigned og = xb_add(&bar[XB_TOP], 1u);
            const unsigned tg = og / nx;
            if (og + 1u == (tg + 1u) * nx) xb_add(&bar[XB_TOPGEN], 1u);
            else XB_SPIN(xb_ld(&bar[XB_TOPGEN]) == tg, bar);
            __builtin_amdgcn_fence(__ATOMIC_ACQUIRE, "agent");
            xb_add(&bar[XB_XGEN(bx)], 1u);
            asm volatile("s_waitcnt vmcnt(0)" ::: "memory");
        } else {
            XB_SPIN(xb_ld(&bar[XB_XGEN(bx)]) == gen, bar);
            __builtin_amdgcn_fence(__ATOMIC_ACQUIRE, "agent");
            asm volatile("s_waitcnt vmcnt(0)" ::: "memory");
        }
    }
    __syncthreads();
}

struct Args { const float* in[32]; float* out; unsigned char* ws; int ph_lo, ph_hi, li, pad; };
struct Frame {
    LAS unsigned char* lds; volatile LAS unsigned* MISC; unsigned* ctl;
    int wave, G, bid, gw, NGW;
    float* out; unsigned char* ws;
};
constexpr int NWAVES = 8, NTHR = NWAVES * 64;

#define TR_LOAD(wv, W, N, k0, n0) do { _Pragma("unroll") for (int i_ = 0; i_ < 32; ++i_) wv[i_] = __builtin_nontemporal_load((W) + (size_t)((k0) + 2 * i_ + (lane >> 5)) * (N) + (n0) + (lane & 31)); } while (0)
template <bool F8>
__device__ __forceinline__ void tr_store(const float (&wv)[32], void* WTv, int K  , int k0, int drow0, const float* ksc, LAS float* scr, int lane) {
#pragma unroll
    for (int i = 0; i < 32; ++i) { const int kk = 2 * i + (lane >> 5); float w = wv[i]; if (ksc) w *= ksc[k0 + kk]; if (F8) w *= W8_SCALE; scr[kk * 33 + (lane & 31)] = w; }
    LDS_WAIT(); asm volatile("" ::: "memory");
    const int c = lane & 7;
#pragma unroll
    for (int j = 0; j < 4; ++j) { const int n = (lane >> 3) + 8 * j; const LAS float* s = scr + (8 * c) * 33 + n;
        if (F8) { u32x2 o; o.x = pk4_fp8(s[0 * 33], s[1 * 33], s[2 * 33], s[3 * 33]); o.y = pk4_fp8(s[4 * 33], s[5 * 33], s[6 * 33], s[7 * 33]); *(u32x2*)((unsigned char*)WTv + (size_t)(drow0 + n) * K + k0 + 8 * c) = o; }
        else { u32x4 o; o.x = pk2(s[0 * 33], s[1 * 33]); o.y = pk2(s[2 * 33], s[3 * 33]); o.z = pk2(s[4 * 33], s[5 * 33]); o.w = pk2(s[6 * 33], s[7 * 33]); *(u32x4*)((bf16_t*)WTv + (size_t)(drow0 + n) * K + k0 + 8 * c) = o; } }
    LDS_WAIT(); asm volatile("" ::: "memory");
}
__device__ __forceinline__ int drow_map(int mode, int n0) {
    if (mode == 1) { const int h = n0 >> 7, j0 = n0 & 127; return j0 < 64 ? h * 64 + j0 : 512 + h * 64 + (j0 - 64); }
    if (mode == 2) return (n0 >> 7) * 256 + (n0 & 127);
    if (mode == 3) return (n0 >> 7) * 256 + 128 + (n0 & 127);
    return n0;
}
template <bool F8>
__device__ __forceinline__ void conv_mat(const Frame& F, const float* W, int K, int N, void* WT, int mode, const float* ksc, int ldk = 0) {
    if (ldk == 0) ldk = K;
    const int lane = lane_id();
    LAS float* scr = (LAS float*)(F.lds + F.wave * 16384);
    const int nblk = N / 32, items = (K / 64) * nblk;
    for (int it = F.gw; it < items; it += F.NGW) { const int k0 = 64 * (it / nblk), n0 = 32 * (it % nblk); float wv[32];
        TR_LOAD(wv, W, N, k0, n0); tr_store<F8>(wv, WT, ldk, k0, drow_map(mode, n0), ksc, scr, lane); }
}
__device__ __forceinline__ void p0_weights(const Frame& F, const Args& A) { unsigned char* const wsq_ = opq(F.ws);
    const int lane = lane_id(), tid = F.wave * 64 + lane; (void)tid; (void)lane;
    unsigned char* ws = wsq_;
    for (int l = 0; l < 2; ++l) {
        conv_mat<false>(F, INP(8) + (size_t)l * DM * DIN, DM, DIN, (bf16_t*)(ws + WS_WIN) + (size_t)l * 1024 * 1024, 0, nullptr);
        conv_mat<false>(F, INP(11) + (size_t)l * 256 * 768, 256, 768, (bf16_t*)(ws + WS_WUQ) + (size_t)l * 768 * 256, 0, INP(9) + l * 256);
        conv_mat<false>(F, INP(12) + (size_t)l * 128 * 1024, 128, 1024, (bf16_t*)(ws + WS_WUKV) + (size_t)l * 1024 * 128, 1, INP(10) + l * 128);
        conv_mat<false>(F, INP(21) + (size_t)l * 512 * 512, 512, 512, (bf16_t*)(ws + WS_WGLU) + (size_t)l * 512 * 512, 0, nullptr);
        conv_mat<false>(F, INP(23) + (size_t)l * 1024 * 1024, 1024, 1024, (bf16_t*)(ws + WS_WOUT) + (size_t)l * 1024 * 1024, 0, nullptr);
        { u32x4* z = (u32x4*)((bf16_t*)(ws + WS_WIN) + (size_t)l * 1024 * 1024 + (size_t)DIN * 1024); const int n16 = (1024 - DIN) * 1024 * 2 / 16;
          u32x4 z4 = {0u, 0u, 0u, 0u}; asm volatile("" : "+v"(z4));
          for (int i = F.gw * 64 + lane; i < n16; i += F.NGW * 64) z[i] = z4; }
    }
    conv_mat<false>(F, INP(24), DM, DFF, ws + WS_WFF13, 2, nullptr);
    conv_mat<false>(F, INP(25), DM, DFF, ws + WS_WFF13, 3, nullptr);
    conv_mat<false>(F, INP(26), DFF, DM, ws + WS_WFF2, 0, nullptr);
    for (int e = 0; e < NE; ++e) {
        conv_mat<true>(F, INP(28) + (size_t)e * DM * DFE, DM, DFE, ws + WS_WM13 + (size_t)e * 2 * DFE * DM, 2, nullptr);
        conv_mat<true>(F, INP(29) + (size_t)e * DM * DFE, DM, DFE, ws + WS_WM13 + (size_t)e * 2 * DFE * DM, 3, nullptr);
        conv_mat<true>(F, INP(30) + (size_t)e * DFE * DM, DFE, DM, ws + WS_WM2 + (size_t)e * DM * DFE8, 0, nullptr, DFE8);
    }
    { const int lane = lane_id(); u32x4 z4 = {0u, 0u, 0u, 0u}; asm volatile("" : "+v"(z4));
      for (int i = F.gw * 64 + lane; i < NE * DM * 8; i += F.NGW * 64) *(u32x4*)(wsq_ + WS_WM2 + (size_t)(i >> 3) * DFE8 + DFE + (i & 7) * 16) = z4; }
}
__device__ __forceinline__ void p0_prologue(const Frame& F, const Args& A) { unsigned char* const wsq_ = opq(F.ws);
    const int lane = lane_id(), tid = F.wave * 64 + lane; (void)tid; (void)lane;
    unsigned char* ws = wsq_;
    { float* cosT = (float*)(ws + WS_COS); float* sinT = (float*)(ws + WS_SIN);
      for (int idx = F.gw * 64 + lane; idx < SEQ * 16; idx += F.NGW * 64) { const int t = idx >> 4, a = (idx >> 3) & 1, i = idx & 7; const float pos = (float)(a == 0 ? (t >> 6) : (t & 63));
          const float inv = exp2f(-(float)i * (13.287712379549449f / 8.0f)); const float ang = pos * inv; cosT[idx] = cosf(ang); sinT[idx] = sinf(ang); } }
    { float* AB = (float*)(ws + WS_AB); float* BB = (float*)(ws + WS_BB);
      for (int idx = F.gw * 64 + lane; idx < 2 * 2 * NG * NP; idx += F.NGW * 64) {
          const float ar = INP(13)[idx], ai = INP(14)[idx], dt = expf(INP(15)[idx >> 6]);
          const float mag = expf(dt * ar), abr = mag * cosf(dt * ai), abi = mag * sinf(dt * ai), den = ar * ar + ai * ai, nre = abr - 1.0f;
          const float fre = (nre * ar + abi * ai) / den, fim = (abi * ar - nre * ai) / den;
          AB[idx * 2] = abr; AB[idx * 2 + 1] = abi;
          { float* PW = (float*)(ws + WS_PW) + (size_t)idx * 66; const float dar = dt * ar, dai = dt * ai;
            for (int e = 0; e <= TCH; ++e) { const float mg = expf((float)e * dar), an = (float)e * dai; PW[2 * e] = mg * cosf(an); PW[2 * e + 1] = mg * sinf(an); } }
#pragma unroll 4
          for (int c = 0; c < 16; ++c) { const float br = INP(16)[idx * 16 + c], bi = INP(17)[idx * 16 + c]; BB[(idx * 16 + c) * 2] = fre * br - fim * bi; BB[(idx * 16 + c) * 2 + 1] = fre * bi + fim * br; } } }
    { LAS float* sv = (LAS float*)F.lds; LAS float* red = sv + 5 * 1024; float* MOD = (float*)(ws + WS_MOD);
      __syncthreads();
      for (int i = tid; i < 5 * 1024; i += NTHR) { const int v = i >> 10, k = i & 1023; const float cv = v < 4 ? INP(1)[v * 1024 + k] : INP(3)[k]; sv[i] = silu_f(cv); }
      __syncthreads();
      for (int it = F.bid; it < 2 * 96; it += F.G) { const int l = it / 96, jb = it % 96, kg = tid >> 6, jj = tid & 63, j = jb * 64 + jj;
          float a0 = 0.f, a1 = 0.f, a2 = 0.f, a3 = 0.f, a4 = 0.f; const float* wp = INP(4) + ((size_t)l * 1024 + kg * 128) * 6144 + j;
#pragma unroll 8
          for (int kk = 0; kk < 128; ++kk) { const float w = wp[(size_t)kk * 6144]; const int k = kg * 128 + kk; a0 += sv[k] * w; a1 += sv[1024 + k] * w; a2 += sv[2048 + k] * w; a3 += sv[3072 + k] * w; a4 += sv[4096 + k] * w; }
          red[(kg * 5 + 0) * 64 + jj] = a0; red[(kg * 5 + 1) * 64 + jj] = a1; red[(kg * 5 + 2) * 64 + jj] = a2; red[(kg * 5 + 3) * 64 + jj] = a3; red[(kg * 5 + 4) * 64 + jj] = a4;
          __syncthreads();
          if (tid < 320) { const int v = tid >> 6, q = tid & 63; float s = INP(5)[l * 6144 + jb * 64 + q];
#pragma unroll
              for (int g = 0; g < 8; ++g) s += red[(g * 5 + v) * 64 + q];
              MOD[((size_t)l * 5 + v) * 6144 + jb * 64 + q] = s; }
          __syncthreads(); }
    }
}

template <bool OUT8>
__device__ __forceinline__ void norm_rows(const Frame& F, const float* xs_x, const float* xs_c, int nrows, const float* gain, const float* mod, int shoff, int scoff, void* XNv,
                                          const float* part = nullptr, int nparts = 0, const float* pgate = nullptr, float* xc_out = nullptr) {
    const int lane = lane_id();
    for (int v = 0; v < 5; ++v) {
        const int r0 = v < 4 ? v * SEQ : NX, r1 = v < 4 ? r0 + SEQ : NR; if (r0 >= nrows) break;
        f32x4 ca[4], cb[4];
#pragma unroll
        for (int j = 0; j < 4; ++j) { const int c = 4 * lane + 256 * j; const f32x4 g = *(const f32x4*)(gain + c), sc = *(const f32x4*)(mod + v * 6144 + scoff + c); ca[j] = g * (sc + 1.0f); cb[j] = *(const f32x4*)(mod + v * 6144 + shoff + c); }
        for (int r = r0 + F.gw; r < r1; r += F.NGW) {
            const float* src = r < NX ? xs_x + (size_t)r * 1024 : xs_c + (size_t)(r - NX) * 1024;
            f32x4 x[4]; float ss = 0.f;
#pragma unroll
            for (int j = 0; j < 4; ++j) { const int c = 4 * lane + 256 * j; x[j] = *(const f32x4*)(src + c);
                if (part && r >= NX) { f32x4 sacc = {0.f, 0.f, 0.f, 0.f}; for (int k = 0; k < nparts; ++k) sacc = sacc + *(const f32x4*)(part + ((size_t)k * NC + (r - NX)) * 1024 + c);
                    x[j] = x[j] + *(const f32x4*)(pgate + c) * sacc; if (xc_out) *(f32x4*)(xc_out + (size_t)(r - NX) * 1024 + c) = x[j]; }
                ss += (x[j][0] * x[j][0] + x[j][1] * x[j][1]) + (x[j][2] * x[j][2] + x[j][3] * x[j][3]); }
            const float rstd = rsqrtf(wave_sum(ss, lane) * (1.f / 1024.f) + EPS);
#pragma unroll
            for (int j = 0; j < 4; ++j) { x[j] = x[j] * rstd * ca[j] + cb[j];
                if (OUT8) *(unsigned*)((unsigned char*)XNv + (size_t)r * 1024 + 4 * lane + 256 * j) = pk4_fp8(x[j][0], x[j][1], x[j][2], x[j][3]);
                else { u32x2 o; o.x = pk2(x[j][0], x[j][1]); o.y = pk2(x[j][2], x[j][3]); *(u32x2*)((bf16_t*)XNv + (size_t)r * 1024 + 4 * lane + 256 * j) = o; } }
        }
    }
}
__device__ __forceinline__ void norm_router(const Frame& F, const float* xs, const float* gain, const float* mod, int shoff, int scoff, unsigned char* XNM) { unsigned char* const wsq_ = opq(F.ws);
    const int lane = lane_id(), tid = F.wave * 64 + lane;
    LAS float* RT = (LAS float*)F.lds; LAS int* lcnt = (LAS int*)(F.lds + 32768);
    __syncthreads();
    for (int i = tid; i < 1024 * 8 / 4; i += NTHR) ((LAS f32x4*)RT)[i] = ((const f32x4*)INP(27))[i];
    if (tid < 8) lcnt[tid] = 0;
    __syncthreads();
    for (int ch = F.bid; ch < NX / 128; ch += F.G) {
        const int v = ch >> 6;
        f32x4 ca[4], cb[4];
#pragma unroll
        for (int j = 0; j < 4; ++j) { const int c = 4 * lane + 256 * j; const f32x4 g = *(const f32x4*)(gain + c), sc = *(const f32x4*)(mod + v * 6144 + scoff + c); ca[j] = g * (sc + 1.0f); cb[j] = *(const f32x4*)(mod + v * 6144 + shoff + c); }
        for (int i = 0; i < 16; ++i) {
            const int r = ch * 128 + F.wave * 16 + i; const float* src = xs + (size_t)r * 1024;
            f32x4 x[4]; float ss = 0.f;
#pragma unroll
            for (int j = 0; j < 4; ++j) { x[j] = *(const f32x4*)(src + 4 * lane + 256 * j); ss += (x[j][0] * x[j][0] + x[j][1] * x[j][1]) + (x[j][2] * x[j][2] + x[j][3] * x[j][3]); }
            const float rstd = rsqrtf(wave_sum(ss, lane) * (1.f / 1024.f) + EPS);
#pragma unroll
            for (int j = 0; j < 4; ++j) { x[j] = x[j] * rstd * ca[j] + cb[j]; *(unsigned*)(XNM + (size_t)r * 1024 + 4 * lane + 256 * j) = pk4_fp8(x[j][0], x[j][1], x[j][2], x[j][3]); }
            float lg[8];
#pragma unroll
            for (int e = 0; e < 8; ++e) lg[e] = 0.f;
#pragma unroll
            for (int j = 0; j < 4; ++j)
#pragma unroll
                for (int q = 0; q < 4; ++q) { const int k = 4 * lane + 256 * j + q; const f32x4 w0 = *(const LAS f32x4*)(RT + k * 8), w1 = *(const LAS f32x4*)(RT + k * 8 + 4); const float xv = x[j][q];
                    lg[0] += xv * w0[0]; lg[1] += xv * w0[1]; lg[2] += xv * w0[2]; lg[3] += xv * w0[3]; lg[4] += xv * w1[0]; lg[5] += xv * w1[1]; lg[6] += xv * w1[2]; lg[7] += xv * w1[3]; }
#pragma unroll
            for (int e = 0; e < 8; ++e) lg[e] = wave_sum(lg[e], lane);
            if (lane == 0) {
                int i1 = 0; float v1 = lg[0];
#pragma unroll
                for (int e = 1; e < 8; ++e) if (lg[e] > v1) { v1 = lg[e]; i1 = e; }
                int i2 = -1; float v2 = -3.0e38f;
#pragma unroll
                for (int e = 0; e < 8; ++e) if (e != i1 && lg[e] > v2) { v2 = lg[e]; i2 = e; }
                const float w1 = 1.f / (1.f + expf(v2 - v1)), w2 = 1.f - w1;
                __hip_atomic_fetch_add(lcnt + i1, 1, __ATOMIC_RELAXED, __HIP_MEMORY_SCOPE_WORKGROUP); __hip_atomic_fetch_add(lcnt + i2, 1, __ATOMIC_RELAXED, __HIP_MEMORY_SCOPE_WORKGROUP);
                int* te = (int*)(wsq_ + WS_TOKE) + r * 2; float* tw = (float*)(wsq_ + WS_TOKW) + r * 2;
                te[0] = i1; te[1] = i2; tw[0] = w1; tw[1] = w2;
            }
        }
        __syncthreads();
        if (tid < 8) { ((int*)(wsq_ + WS_CNTB))[ch * 8 + tid] = lcnt[tid]; lcnt[tid] = 0; }
        __syncthreads();
    }
}

__device__ __forceinline__ void kr_rows(const Frame& F, const bf16_t* Z, bf16_t* KR) { unsigned char* const wsq_ = opq(F.ws);
    const int lane = lane_id(), tid = F.wave * 64 + lane; (void)tid; (void)lane;
    const float* cosT = (const float*)(wsq_ + WS_COS); const float* sinT = (const float*)(wsq_ + WS_SIN);
    for (int idx = F.gw * 64 + lane; idx < NR * 16; idx += F.NGW * 64) { const int r = idx >> 4, a = (idx >> 3) & 1, i = idx & 7;
        const float x1 = bf1(Z[(size_t)r * 1024 + 896 + a * 16 + i]), x2 = bf1(Z[(size_t)r * 1024 + 896 + a * 16 + 8 + i]);
        float c = 1.f, s = 0.f; if (r < NX) { const int t = r & (SEQ - 1); c = cosT[t * 16 + a * 8 + i]; s = sinT[t * 16 + a * 8 + i]; }
        KR[(size_t)r * 32 + a * 16 + i] = (bf16_t)f2bf(x1 * c - x2 * s); KR[(size_t)r * 32 + a * 16 + 8 + i] = (bf16_t)f2bf(x2 * c + x1 * s); }
}

__device__ __forceinline__ void ssm_tables(const Frame& F, const Args& A) { unsigned char* const wsq_ = opq(F.ws);
    const int lane = lane_id(), tid = F.wave * 64 + lane;
    LAS float* Cr = (LAS float*)F.lds; LAS float* Ci = Cr + 1024; LAS float* BBl = Ci + 1024; LAS float* PWl = BBl + 2048;
    unsigned char* ws = wsq_;
    for (int it = F.bid; it < 2 * NG * 2; it += F.G) {
        const int dir = it & 1, g = (it >> 1) & 31, l = it >> 6; const int gi = (l * 2 + dir) * NG + g;
        __syncthreads();
        for (int i = tid; i < 1024; i += NTHR) { Cr[i] = INP(18)[(size_t)gi * 1024 + i]; Ci[i] = INP(19)[(size_t)gi * 1024 + i]; }
        for (int i = tid; i < 2048; i += NTHR) BBl[i] = ((const float*)(ws + WS_BB))[(size_t)gi * 2048 + i];
        for (int i = tid; i < 64 * 66; i += NTHR) PWl[i] = ((const float*)(ws + WS_PW))[(size_t)gi * 64 * 66 + i];
        __syncthreads();
        float* KL = (float*)(ws + WS_KL) + (size_t)((l * NG + g) * 2 + dir) * 8192;
        for (int e = tid; e < 8192; e += NTHR) { const int lag = e >> 8, c = (e >> 4) & 15, cp = e & 15; float acc = 0.f;
#pragma unroll 4
            for (int p = 0; p < 64; ++p) { const float cr = Cr[c * 64 + p], ci = Ci[c * 64 + p], pr = PWl[p * 66 + 2 * lag], pi = PWl[p * 66 + 2 * lag + 1], br = BBl[(p * 16 + cp) * 2], bi = BBl[(p * 16 + cp) * 2 + 1];
                acc += (cr * pr - ci * pi) * br - (cr * pi + ci * pr) * bi; }
            KL[e] = acc; }
        bf16_t* W1 = (bf16_t*)(ws + WS_W1T) + ((size_t)(l * NG + g) * 256 + dir * 128) * 512;
        for (int q = tid; q < 8192; q += NTHR) { const int r = q >> 6, reim = r >> 6, p = r & 63, pc = q & 63, j = pc >> 1, c0 = (pc & 1) * 8, e = dir ? j : TCH - 1 - j;
            const float pr = PWl[p * 66 + 2 * e], pi = PWl[p * 66 + 2 * e + 1]; float v[8];
#pragma unroll
            for (int k = 0; k < 8; ++k) { const float br = BBl[(p * 16 + c0 + k) * 2], bi = BBl[(p * 16 + c0 + k) * 2 + 1]; v[k] = reim ? (pr * bi + pi * br) : (pr * br - pi * bi); }
            u32x4 o; o.x = pk2(v[0], v[1]); o.y = pk2(v[2], v[3]); o.z = pk2(v[4], v[5]); o.w = pk2(v[6], v[7]);
            *(u32x4*)(W1 + (size_t)r * 512 + j * 16 + c0) = o; }
        bf16_t* MT = (bf16_t*)(ws + WS_MT) + (size_t)(l * NG + g) * 512 * 768 + 512 + dir * 128;
        for (int q = tid; q < 8192; q += NTHR) { const int row = q >> 4, ii = row >> 4, c = row & 15, pc = q & 15, reim = pc >> 3, p0 = (pc & 7) * 8, e = dir ? TCH - ii : ii + 1; float v[8];
#pragma unroll
            for (int k = 0; k < 8; ++k) { const int p = p0 + k; const float cr = Cr[c * 64 + p], ci = Ci[c * 64 + p], pr = PWl[p * 66 + 2 * e], pi = PWl[p * 66 + 2 * e + 1]; v[k] = reim ? -(cr * pi + ci * pr) : (cr * pr - ci * pi); }
            u32x4 o; o.x = pk2(v[0], v[1]); o.y = pk2(v[2], v[3]); o.z = pk2(v[4], v[5]); o.w = pk2(v[6], v[7]);
            *(u32x4*)(MT + (size_t)row * 768 + reim * 64 + p0) = o; }
    }
    __syncthreads();
}
__device__ __forceinline__ void ssm_toeplitz(const Frame& F, const Args& A) { unsigned char* const wsq_ = opq(F.ws);
    const int lane = lane_id(); unsigned char* ws = wsq_;
    for (int x = F.gw * 64 + lane; x < 2 * NG * 512 * 64; x += F.NGW * 64) { const int pc = x & 63, row = (x >> 6) & 511, lg = x >> 15, j = pc >> 1, c0 = (pc & 1) * 8, i = row >> 4, c = row & 15;
        const float* KL = (const float*)(ws + WS_KL) + (size_t)lg * 2 * 8192; float v[8];
#pragma unroll
        for (int k = 0; k < 8; ++k) v[k] = 0.f;
        if (j <= i) { const float* kp = KL + (i - j) * 256 + c * 16 + c0; const f32x4 a = *(const f32x4*)kp, b = *(const f32x4*)(kp + 4); v[0] += a[0]; v[1] += a[1]; v[2] += a[2]; v[3] += a[3]; v[4] += b[0]; v[5] += b[1]; v[6] += b[2]; v[7] += b[3]; }
        if (j >= i) { const float* kp = KL + 8192 + (j - i) * 256 + c * 16 + c0; const f32x4 a = *(const f32x4*)kp, b = *(const f32x4*)(kp + 4); v[0] += a[0]; v[1] += a[1]; v[2] += a[2]; v[3] += a[3]; v[4] += b[0]; v[5] += b[1]; v[6] += b[2]; v[7] += b[3]; }
        if (i == j && (c >> 3) == (c0 >> 3)) { const float d = INP(20)[(lg >> 5) * 512 + (lg & 31) * 16 + c];
#pragma unroll
            for (int k = 0; k < 8; ++k) v[k] += (k == (c & 7)) ? d : 0.f; }
        u32x4 o; o.x = pk2(v[0], v[1]); o.y = pk2(v[2], v[3]); o.z = pk2(v[4], v[5]); o.w = pk2(v[6], v[7]);
        *(u32x4*)((bf16_t*)(ws + WS_MT) + ((size_t)lg * 512 + row) * 768 + j * 16 + c0) = o; }
}
__device__ __forceinline__ void ssm_scan(const Frame& F, int l) { unsigned char* const wsq_ = opq(F.ws);
    const int lane = lane_id(); unsigned char* ws = wsq_;
    for (int w = F.bid + F.G * F.wave; w < NB * NG * 2; w += F.G * NWAVES) {
        const int dir = w & 1, g = (w >> 1) & 31, b = w >> 6; const int idx = ((l * 2 + dir) * NG + g) * NP + lane;
        const float* PW = (const float*)(ws + WS_PW) + (size_t)idx * 66; const float are = PW[2 * TCH], aim = PW[2 * TCH + 1];
        const float* S = (const float*)(ws + WS_S) + (size_t)g * NCH * 256 + dir * 128 + lane; bf16_t* UH = (bf16_t*)(ws + WS_UH) + (size_t)g * NCH * 768 + 512 + dir * 128 + lane;
        float hre = 0.f, him = 0.f;
        for (int blk = 0; blk < (CTXL + SEQ) / TCH / 24; ++blk) {
            float sr[24], si[24]; int nn[24];
#pragma unroll
            for (int k = 0; k < 24; ++k) { const int s = blk * 24 + k; int n;
                if (s < CTXL / TCH) n = NX / TCH + b * (CTXL / TCH) + (dir ? CTXL / TCH - 1 - s : s); else { const int t = s - CTXL / TCH; n = b * (SEQ / TCH) + (dir ? SEQ / TCH - 1 - t : t); }
                nn[k] = n; sr[k] = S[(size_t)n * 256]; si[k] = S[(size_t)n * 256 + 64]; }
#pragma unroll
            for (int k = 0; k < 24; ++k) { UH[(size_t)nn[k] * 768] = (bf16_t)f2bf(hre); UH[(size_t)nn[k] * 768 + 64] = (bf16_t)f2bf(him);
                const float nr = are * hre - aim * him + sr[k], ni = are * him + aim * hre + si[k]; hre = nr; him = ni; }
        }
    }
}

__device__ __forceinline__ int pad256(unsigned c) { return (int)((c + 255u) & ~255u); }
__device__ __forceinline__ void moe_gather(const Frame& F, const unsigned char* XNM, unsigned char* XP) { unsigned char* const wsq_ = opq(F.ws);
    const int lane = lane_id(), tid = F.wave * 64 + lane;
    { u32x4 z4 = {0u, 0u, 0u, 0u}; asm volatile("" : "+v"(z4));
      for (int i = F.gw * 64 + lane; i < MOE_ROWS * 8; i += F.NGW * 64) *(u32x4*)(wsq_ + WS_HP + (size_t)(i >> 3) * DFE8 + DFE + (i & 7) * 16) = z4; }
    LAS int* posl = (LAS int*)F.lds;
    const int* CNTB = (const int*)(wsq_ + WS_CNTB); const int* te = (const int*)(wsq_ + WS_TOKE); int* tp = (int*)(wsq_ + WS_TOKP);
    for (int ch = F.bid; ch < NX / 128; ch += F.G) {
        __syncthreads();
        if (F.wave == 0) {
            int es[4];
#pragma unroll
            for (int q = 0; q < 4; ++q) es[q] = te[ch * 256 + lane + 64 * q];
            int off = 0, ps[4] = {0, 0, 0, 0};
#pragma unroll
            for (int e = 0; e < 8; ++e) {
                int tot = 0, bef = 0;
#pragma unroll
                for (int q = 0; q < 4; ++q) { const int c2 = lane + 64 * q, vv = CNTB[c2 * 8 + e]; tot += vv; bef += (c2 < ch) ? vv : 0; }
                tot = wave_sum_i(tot, lane); bef = wave_sum_i(bef, lane);
                int run = off + bef;
#pragma unroll
                for (int q = 0; q < 4; ++q) { const unsigned long long m = __ballot(es[q] == e); if (es[q] == e) ps[q] = run + __popcll(m & ((1ull << lane) - 1ull)); run += __popcll(m); }
                if (ch == 0 && lane == 0) F.ctl[CW_MOE + e] = (unsigned)tot;
                off += pad256((unsigned)tot);
            }
#pragma unroll
            for (int q = 0; q < 4; ++q) { posl[lane + 64 * q] = ps[q]; tp[ch * 256 + lane + 64 * q] = ps[q]; }
        }
        __syncthreads();
        for (int i = 0; i < 16; ++i) { const int tl = F.wave * 16 + i, r = ch * 128 + tl;
            const u32x4 a = *(const u32x4*)(XNM + (size_t)r * 1024 + lane * 16);
#pragma unroll
            for (int k = 0; k < 2; ++k) { const size_t dst = (size_t)posl[tl * 2 + k] * 1024; *(u32x4*)(XP + dst + lane * 16) = a; } }
    }
}
__device__ __forceinline__ void moe_combine_final(const Frame& F, const Args& A, const bf16_t* YP, const float* g2mod) { unsigned char* const wsq_ = opq(F.ws);
    const int lane = lane_id(), tid = F.wave * 64 + lane; (void)tid; (void)lane;
    const int* tp = (const int*)(wsq_ + WS_TOKP); const float* tw = (const float*)(wsq_ + WS_TOKW);
    f32x4 fn[4];
#pragma unroll
    for (int j = 0; j < 4; ++j) fn[j] = *(const f32x4*)(INP(31) + 4 * lane + 256 * j);
    for (int r = F.gw; r < NX; r += F.NGW) {
        const int v = r >> 13; size_t src[2]; float wk[2];
#pragma unroll
        for (int k = 0; k < 2; ++k) { src[k] = (size_t)tp[r * 2 + k] * 1024; wk[k] = tw[r * 2 + k]; }
        f32x4 x[4]; float ss = 0.f;
#pragma unroll
        for (int j = 0; j < 4; ++j) { const int c = 4 * lane + 256 * j; x[j] = *(const f32x4*)(F.out + (size_t)r * 1024 + c);
            const u32x2 y0 = *(const u32x2*)(YP + src[0] + c), y1 = *(const u32x2*)(YP + src[1] + c); const f32x4 g = *(const f32x4*)(g2mod + v * 6144 + c);
            f32x4 y; y[0] = wk[0] * bflo(y0.x) + wk[1] * bflo(y1.x); y[1] = wk[0] * bfhi(y0.x) + wk[1] * bfhi(y1.x); y[2] = wk[0] * bflo(y0.y) + wk[1] * bflo(y1.y); y[3] = wk[0] * bfhi(y0.y) + wk[1] * bfhi(y1.y);
            x[j] = x[j] + g * y; ss += (x[j][0] * x[j][0] + x[j][1] * x[j][1]) + (x[j][2] * x[j][2] + x[j][3] * x[j][3]); }
        const float rstd = rsqrtf(wave_sum(ss, lane) * (1.f / 1024.f) + EPS);
#pragma unroll
        for (int j = 0; j < 4; ++j) *(f32x4*)(F.out + (size_t)r * 1024 + 4 * lane + 256 * j) = x[j] * rstd * fn[j];
    }
}

typedef float f32x16 __attribute__((ext_vector_type(16)));
constexpr int KALL = SEQ + CTXL;
constexpr int ATT_KB = 12 * 1024, ATT_VB = 8 * 1024, ATT_TB = ATT_KB + ATT_VB, ATT_NBUF = 4;
__device__ __forceinline__ void glds16(const void* gsrc, unsigned lds_dst) { unsigned keep;
    asm volatile("s_mov_b32 %0, m0\n\ts_mov_b32 m0, %2\n\ts_nop 0\n\tglobal_load_lds_dwordx4 %1, off\n\ts_mov_b32 m0, %0" : "=&s"(keep) : "v"(gsrc), "s"(lds_dst) : "memory"); }
__device__ __forceinline__ float max3f(float a, float b, float c) { float r; asm("v_max3_f32 %0, %1, %2, %3" : "=v"(r) : "v"(a), "v"(b), "v"(c)); return r; }
__device__ __forceinline__ float max2f(float a, float b) { float r; asm("v_max_f32_e32 %0, %1, %2" : "=v"(r) : "v"(a), "v"(b)); return r; }
__device__ __forceinline__ bf16x8 pack_p(const f32x16& p, int s) {
    u32x4 w; w.x = pk2(p[8 * s], p[8 * s + 1]); w.y = pk2(p[8 * s + 2], p[8 * s + 3]); w.z = pk2(p[8 * s + 4], p[8 * s + 5]); w.w = pk2(p[8 * s + 6], p[8 * s + 7]); return __builtin_bit_cast(bf16x8, w);
}
__device__ __forceinline__ void attn_phase(const Frame& F, bool need_ctx, const bf16_t* Q, const bf16_t* KN, const bf16_t* KR, const bf16_t* VT, bf16_t* Y) {
    const bool lead = F.wave < 4;
    LAS unsigned char* lds = F.lds;
    const int nmain = (F.G == 256) ? 4 : (NB * NH * (SEQ / 256) + F.G - 1) / F.G;
    for (int ui = 0; ui < nmain + 1; ++ui) {
        const int lane = lane_id(), r32 = lane & 31, hi = lane >> 5;
        int b, h, qrow0, t0;
        if (ui < nmain) { int un; if (F.G == 256) un = (((F.bid & 7) + 8 * ui) << 5) | (F.bid >> 3); else un = F.bid + ui * F.G;
            if (un >= NB * NH * (SEQ / 256)) continue;
            b = un >> 8; h = (un >> 5) & 7; qrow0 = b * SEQ + (un & 31) * 256; t0 = 0; }
        else { if (!need_ctx || F.bid >= NB * NH) continue; b = F.bid >> 3; h = F.bid & 7; qrow0 = NX + b * CTXL; t0 = SEQ / 64; }
        const int nt = KALL / 64;
        bf16x8 qf[6];
        { const bf16_t* qp = Q + (size_t)(qrow0 + F.wave * 32 + r32) * 768 + h * 96 + 8 * hi;
#pragma unroll
          for (int s = 0; s < 6; ++s) qf[s] = *(const bf16x8*)(qp + 16 * s); }
        const unsigned ldsb = (unsigned)(size_t)lds;
        const char* kbase = (const char*)(KN + h * 64 + F.wave * 8); const char* rbase = (const char*)(KR + (F.wave & 3) * 8); const char* vbase = (const char*)(VT + (size_t)((b * NH + h) * 64) * KALL + F.wave * 8);
        const unsigned klo = (unsigned)lane * 1024u, rlo = (unsigned)lane * 64u, vlo = (unsigned)lane * (unsigned)(KALL * 2);
#define ATT_DMA(t, bo) do { const int row0_ = (t) < SEQ / 64 ? b * SEQ + (t) * 64 : NX + b * CTXL + ((t) - SEQ / 64) * 64; \
            unsigned klo_ = klo, rlo_ = rlo, vlo_ = vlo; asm volatile("" : "+v"(klo_), "+v"(rlo_), "+v"(vlo_));     \
            glds16(kbase + (size_t)row0_ * 1024 + klo_, (unsigned)__builtin_amdgcn_readfirstlane(ldsb + (bo) + F.wave * 1024)); \
            if (lead) glds16(rbase + (size_t)row0_ * 64 + rlo_, (unsigned)__builtin_amdgcn_readfirstlane(ldsb + (bo) + (8 + F.wave) * 1024)); \
            glds16(vbase + (size_t)(t) * 128 + vlo_, (unsigned)__builtin_amdgcn_readfirstlane(ldsb + (bo) + ATT_KB + F.wave * 1024)); } while (0)
#define ATT_WAITBAR(fresh) do { if (!(fresh)) asm volatile("s_waitcnt vmcnt(0) lgkmcnt(0)\n\ts_barrier" ::: "memory"); else if (lead) asm volatile("s_waitcnt vmcnt(3) lgkmcnt(0)\n\ts_barrier" ::: "memory"); \
            else asm volatile("s_waitcnt vmcnt(2) lgkmcnt(0)\n\ts_barrier" ::: "memory"); } while (0)
        const unsigned r32p = (unsigned)((r32 & ~12) | ((r32 & 4) << 1) | ((r32 & 8) >> 1));
        const unsigned ka = hi * 1024 + r32p * 16;
        const unsigned va = ATT_KB + hi * 1024 + r32 * 16;
        f32x16 o0, o1, pA0, pA1, pB0, pB1;
#pragma unroll
        for (int r = 0; r < 16; ++r) { o0[r] = 0.f; o1[r] = 0.f; }
        float m = 0.f, lsum = 0.f;
#define ATT_QK(P0, P1, bo) do { _Pragma("unroll") for (int r = 0; r < 16; ++r) { P0[r] = -m; P1[r] = -m; } _Pragma("unroll") for (int s = 0; s < 6; ++s) { \
            const bf16x8 k0_ = *(const LAS bf16x8*)(lds + (bo) + ka + s * 2048), k1_ = *(const LAS bf16x8*)(lds + (bo) + ka + 512 + s * 2048); \
            P0 = __builtin_amdgcn_mfma_f32_32x32x16_bf16(k0_, qf[s], P0, 0, 0, 0); P1 = __builtin_amdgcn_mfma_f32_32x32x16_bf16(k1_, qf[s], P1, 0, 0, 0); } } while (0)
#define ATT_FIN(P0, P1) do { float ps_ = 0.f; _Pragma("unroll") for (int r = 0; r < 16; ++r) { P0[r] = __builtin_amdgcn_exp2f(P0[r]); P1[r] = __builtin_amdgcn_exp2f(P1[r]); ps_ += P0[r] + P1[r]; } lsum += ps_; \
            pf0 = pack_p(P0, 0); pf1 = pack_p(P0, 1); pf2 = pack_p(P1, 0); pf3 = pack_p(P1, 1); } while (0)
#define ATT_VF(bo, db, kb, s) (*(const LAS bf16x8*)(lds + (bo) + va + (db) * 512 + (kb) * 4096 + (s) * 2048))
#define ATT_PV(bo) do { \
            o0 = __builtin_amdgcn_mfma_f32_32x32x16_bf16(ATT_VF(bo, 0, 0, 0), pf0, o0, 0, 0, 0); o1 = __builtin_amdgcn_mfma_f32_32x32x16_bf16(ATT_VF(bo, 1, 0, 0), pf0, o1, 0, 0, 0); \
            o0 = __builtin_amdgcn_mfma_f32_32x32x16_bf16(ATT_VF(bo, 0, 0, 1), pf1, o0, 0, 0, 0); o1 = __builtin_amdgcn_mfma_f32_32x32x16_bf16(ATT_VF(bo, 1, 0, 1), pf1, o1, 0, 0, 0); \
            o0 = __builtin_amdgcn_mfma_f32_32x32x16_bf16(ATT_VF(bo, 0, 1, 0), pf2, o0, 0, 0, 0); o1 = __builtin_amdgcn_mfma_f32_32x32x16_bf16(ATT_VF(bo, 1, 1, 0), pf2, o1, 0, 0, 0); \
            o0 = __builtin_amdgcn_mfma_f32_32x32x16_bf16(ATT_VF(bo, 0, 1, 1), pf3, o0, 0, 0, 0); o1 = __builtin_amdgcn_mfma_f32_32x32x16_bf16(ATT_VF(bo, 1, 1, 1), pf3, o1, 0, 0, 0); } while (0)
#define ATT_MAX(P0, P1, FIRST) do { asm volatile("s_nop 15\n\ts_nop 7" : "+v"(P0), "+v"(P1));     \
            float ra_ = max3f(P0[0], P0[1], P1[0]), rb_ = max3f(P0[2], P0[3], P1[1]); ra_ = max3f(ra_, P1[2], P1[3]); \
            _Pragma("unroll") for (int r = 4; r < 16; r += 4) { ra_ = max3f(ra_, P0[r], P0[r + 1]); rb_ = max3f(rb_, P0[r + 2], P0[r + 3]); ra_ = max3f(ra_, P1[r], P1[r + 1]); rb_ = max3f(rb_, P1[r + 2], P1[r + 3]); } \
            float rm_ = max2f(ra_, rb_); rm_ = max2f(rm_, shx(rm_, 32, lane)); \
            if ((FIRST) || __any(rm_ > 8.0f)) { const float dl_ = (FIRST) ? rm_ : max2f(rm_, 0.f); m += dl_; const float al_ = __builtin_amdgcn_exp2f(-dl_); lsum *= al_; \
                _Pragma("unroll") for (int r = 0; r < 16; ++r) { P0[r] -= dl_; P1[r] -= dl_; o0[r] *= al_; o1[r] *= al_; } } } while (0)
#define ATT_ROT() do { const unsigned t_ = bprv; bprv = bcur; bcur = bnxt; bnxt = bnn; bnn = t_; } while (0)
#define ATT_STEP(PN0, PN1, PO0, PO1, j) do { const bool fresh_ = (j) + 2 < nt; \
            if (fresh_) ATT_DMA((j) + 2, bnn); \
            ATT_QK(PN0, PN1, bcur); ATT_FIN(PO0, PO1); \
            ATT_PV(bprv); ATT_MAX(PN0, PN1, false); \
            ATT_ROT(); ATT_WAITBAR(fresh_); } while (0)
        bf16x8 pf0, pf1, pf2, pf3;
        unsigned bprv = 3 * ATT_TB, bcur = 0, bnxt = ATT_TB, bnn = 2 * ATT_TB;
        asm volatile("s_waitcnt vmcnt(0) lgkmcnt(0)\n\ts_barrier" ::: "memory");
        ATT_DMA(t0, bcur); ATT_DMA(t0 + 1, bnxt);
        ATT_WAITBAR(true);
        ATT_DMA(t0 + 2, bnn);
        ATT_QK(pA0, pA1, bcur); ATT_MAX(pA0, pA1, true);
        ATT_ROT(); ATT_WAITBAR(true);
        int j = t0 + 1;
        for (; j + 1 < nt; j += 2) { ATT_STEP(pB0, pB1, pA0, pA1, j); ATT_STEP(pA0, pA1, pB0, pB1, j + 1); }
        ATT_STEP(pB0, pB1, pA0, pA1, j);
        ATT_FIN(pB0, pB1); ATT_PV(bprv);
#undef ATT_DMA
#undef ATT_WAITBAR
#undef ATT_QK
#undef ATT_FIN
#undef ATT_VF
#undef ATT_PV
#undef ATT_MAX
#undef ATT_ROT
#undef ATT_STEP
        const int le = lane_id();
        lsum += shx(lsum, 32, le);
        const float inv = 1.f / lsum;
        bf16_t* yp = Y + (size_t)(qrow0 + F.wave * 32 + (le & 31)) * 1024 + 512 + h * 64 + 4 * (le >> 5);
#pragma unroll
        for (int g = 0; g < 4; ++g) {
            u32x2 w0, w1; w0.x = pk2(o0[4 * g] * inv, o0[4 * g + 1] * inv); w0.y = pk2(o0[4 * g + 2] * inv, o0[4 * g + 3] * inv);
            w1.x = pk2(o1[4 * g] * inv, o1[4 * g + 1] * inv); w1.y = pk2(o1[4 * g + 2] * inv, o1[4 * g + 3] * inv);
            *(u32x2*)(yp + 8 * g) = w0; *(u32x2*)(yp + 32 + 8 * g) = w1;
        }
    }
    __syncthreads();
}

constexpr int N_PHASES = 23;
#define SP2v true
#define ALIGNv true
__global__ void __launch_bounds__(NTHR, 2) fwd_kernel(Args A) {
    extern __shared__ __attribute__((aligned(16))) unsigned char lds_raw[];
    Frame F;
    F.lds = (LAS unsigned char*)lds_raw; F.MISC = (volatile LAS unsigned*)(F.lds + MISC_OFF);
    F.wave = __builtin_amdgcn_readfirstlane((int)threadIdx.x >> 6);
    F.G = gridDim.x; F.bid = blockIdx.x; F.gw = F.bid * NWAVES + F.wave; F.NGW = F.G * NWAVES;
    F.out = A.out; F.ws = A.ws; F.ctl = (unsigned*)(A.ws + WS_CTL);
    for (int u = (int)threadIdx.x; u < (LDS_BYTES - LDSCTL_OFF) / 4; u += NTHR) ((LAS unsigned*)(F.lds + LDSCTL_OFF))[u] = 0u;
    __syncthreads();
#if MK_N_LAUNCHES == 1
    XcdBarrier bar = xcd_barrier_post(F.ctl + CW_BAR, F.MISC + 8);
#define GRID_BAR() xcd_barrier(bar)
#else
#define GRID_BAR() do {} while (0)
#endif
    const int lo = A.ph_lo, hi = A.ph_hi;
#define IN(k) (lo <= (k) && (k) < hi)
#define SEAM(k) do { if (IN(k) && IN((k) + 1)) GRID_BAR(); } while (0)
    LAS unsigned char* ring = F.lds;
#define WSQ() unsigned char* ws = opq(F.ws)
#define PBF(name, off) bf16_t* name = (bf16_t*)(ws + (off))

    if (IN(0)) { p0_prologue(F, A); } SEAM(0);

    for (int l = 0; l < 2; ++l) {
        const int pb = 1 + 10 * l; const bool need_ctx = (l == 0);
        if (IN(pb + 0)) { WSQ(); PBF(XN, WS_XN); const float* modl = (const float*)(ws + WS_MOD) + (size_t)l * 5 * 6144;
            const float* xs_x = (l == 0) ? INP(0) : F.out; const float* xs_c = (l == 0) ? INP(2) : (const float*)(ws + WS_XC);
            if (l == 0) { p0_weights(F, A); __syncthreads(); ssm_tables(F, A); }
            norm_rows<false>(F, xs_x, xs_c, NR, INP(6) + l * 1024, modl, 0, 1024, XN, l == 1 ? (const float*)(ws + WS_PART) : nullptr, 11, (const float*)(ws + WS_MOD) + 4 * 6144 + 5120, nullptr); } SEAM(pb + 0);
        if (IN(pb + 1)) { WSQ(); PBF(XN, WS_XN); PBF(Z, WS_Z); float* rs = (float*)(ws + WS_RS) + (size_t)l * NR * 8;
            pg8::Gemm g{XN, (const bf16_t*)(ws + WS_WIN) + (size_t)l * 1024 * 1024, 1024, 1024, 1024, 0}; pg8::StaticOrder S; S.init(NR, 1024, F.G, F.bid);
            pg8::EpiInProj E{Z, rs, (bf16_t*)(ws + WS_UH)}; pg8::gemm_phase<pg8::EpiInProj, pg8::StaticOrder, ALIGNv, SP2v>(ring, g, S, E, F.wave);
            if (l == 0) ssm_toeplitz(F, A); } SEAM(pb + 1);
        if (IN(pb + 2)) {
            { WSQ(); PBF(Z, WS_Z); PBF(Qb, WS_Q); const float* rs = (const float*)(ws + WS_RS) + (size_t)l * NR * 8;
              pg8::Gemm g{Z + 512, (const bf16_t*)(ws + WS_WUQ) + (size_t)l * 768 * 256, 1024, 256, 256, 0}; pg8::StaticOrder S; S.init(need_ctx ? NR : NX, 768, F.G, F.bid);
              pg8::EpiQ E{Qb, rs, (const float*)(ws + WS_COS), (const float*)(ws + WS_SIN)}; pg8::gemm_phase<pg8::EpiQ, pg8::StaticOrder, ALIGNv, SP2v>(ring, g, S, E, F.wave); }
            { WSQ(); PBF(Z, WS_Z); PBF(KN, WS_KN); const float* rs = (const float*)(ws + WS_RS) + (size_t)l * NR * 8;
              pg8::Gemm g{Z + 768, (const bf16_t*)(ws + WS_WUKV) + (size_t)l * 1024 * 128, 1024, 128, 128, 0}; pg8::StaticOrder S; S.init(NR, 512, F.G, F.bid);
              pg8::EpiKV E{KN, rs}; pg8::gemm_phase<pg8::EpiKV, pg8::StaticOrder, ALIGNv, SP2v>(ring, g, S, E, F.wave); }
            { WSQ(); PBF(Z, WS_Z); PBF(VT, WS_V); const float* rs = (const float*)(ws + WS_RS) + (size_t)l * NR * 8;
              pg8::Gemm g{(const bf16_t*)(ws + WS_WUKV) + (size_t)l * 1024 * 128 + 512 * 128, Z + 768, 128, 1024, 128, 0}; pg8::StaticOrder S; S.init(512, NR, F.G, F.bid);
              pg8::EpiVT E{VT, rs}; pg8::gemm_phase<pg8::EpiVT, pg8::StaticOrder, ALIGNv, SP2v>(ring, g, S, E, F.wave); }
            { WSQ(); PBF(Z, WS_Z); PBF(KR, WS_KR); kr_rows(F, Z, KR); }
            { WSQ(); PBF(UH, WS_UH);
              pg8::Gemm g{UH, (const bf16_t*)(ws + WS_W1T) + (size_t)l * NG * 256 * 512, 768, 512, 512, (size_t)256 * 512 * 2, (size_t)NCH * 768 * 2}; pg8::GroupOrder S{5, 1, F.G, F.bid};
              pg8::EpiS E{(float*)(ws + WS_S)}; pg8::gemm_phase<pg8::EpiS, pg8::GroupOrder, ALIGNv, SP2v>(ring, g, S, E, F.wave); }
        } SEAM(pb + 2);
        if (IN(pb + 3)) {
            ssm_scan(F, l);
            { WSQ(); PBF(Qb, WS_Q); PBF(KN, WS_KN); PBF(KR, WS_KR); PBF(VT, WS_V); PBF(YMIX, WS_YMIX); attn_phase(F, need_ctx, Qb, KN, KR, VT, YMIX); }
        } SEAM(pb + 3);
        if (IN(pb + 4)) { WSQ(); PBF(UH, WS_UH); PBF(ZG, WS_ZG);
            pg8::Gemm g{UH, (const bf16_t*)(ws + WS_MT) + (size_t)l * NG * 512 * 768, 768, 768, 768, (size_t)512 * 768 * 2, (size_t)NCH * 768 * 2}; pg8::GroupOrder S{5, 2, F.G, F.bid};
            pg8::EpiY E{ZG}; pg8::gemm_phase<pg8::EpiY, pg8::GroupOrder, ALIGNv, SP2v>(ring, g, S, E, F.wave); } SEAM(pb + 4);
        if (IN(pb + 5)) { WSQ(); PBF(ZG, WS_ZG); PBF(YMIX, WS_YMIX);
            pg8::Gemm g{ZG, (const bf16_t*)(ws + WS_WGLU) + (size_t)l * 512 * 512, 512, 512, 512, 0}; pg8::StaticOrder S; S.init(need_ctx ? NR : NX, 512, F.G, F.bid);
            pg8::EpiGlu E{ZG, INP(22) + l * 512, YMIX}; pg8::gemm_phase<pg8::EpiGlu, pg8::StaticOrder, ALIGNv, SP2v>(ring, g, S, E, F.wave); } SEAM(pb + 5);
        if (IN(pb + 6)) { WSQ(); PBF(YMIX, WS_YMIX); const float* modl = (const float*)(ws + WS_MOD) + (size_t)l * 5 * 6144; float* XC = (float*)(ws + WS_XC);
            const float* xs_x = (l == 0) ? INP(0) : F.out; const float* xs_c = (l == 0) ? INP(2) : XC;
            { pg8::Gemm g{YMIX, (const bf16_t*)(ws + WS_WOUT) + (size_t)l * 1024 * 1024, 1024, 1024, 1024, 0}; pg8::StaticOrder S; S.init(NX, 1024, F.G, F.bid);
              pg8::EpiRes E{xs_x, xs_c, F.out, XC, modl + 2048, 1.f}; pg8::gemm_phase<pg8::EpiRes, pg8::StaticOrder, ALIGNv, SP2v>(ring, g, S, E, F.wave); }
            if (need_ctx) {
              pg8::Gemm g{YMIX + (size_t)NX * 1024, (const bf16_t*)(ws + WS_WOUT) + (size_t)l * 1024 * 1024, 1024, 1024, 256, 512, 512}; pg8::CtxSplitOrder S{4, F.G, F.bid};
              pg8::EpiPart E{(float*)(ws + WS_PART)}; pg8::gemm_phase<pg8::EpiPart, pg8::CtxSplitOrder, ALIGNv, SP2v>(ring, g, S, E, F.wave); }
        } SEAM(pb + 6);
        if (l == 0) {
            if (IN(pb + 7)) { WSQ(); PBF(XN, WS_XN); const float* modl = (const float*)(ws + WS_MOD); norm_rows<false>(F, F.out, INP(2), NR, INP(7), modl, 3072, 4096, XN, (const float*)(ws + WS_PART), 4, modl + 4 * 6144 + 2048, (float*)(ws + WS_XC)); } SEAM(pb + 7);
            if (IN(pb + 8)) { WSQ(); PBF(XN, WS_XN); PBF(H, WS_H);
                pg8::Gemm g{XN, (const bf16_t*)(ws + WS_WFF13), 1024, 1024, 1024, 0}; pg8::StaticOrder S; S.init(NR, 2 * DFF, F.G, F.bid);
                pg8::EpiSwiglu<false> E{H, DFF, 1.f}; pg8::gemm_phase<pg8::EpiSwiglu<false>, pg8::StaticOrder, ALIGNv, SP2v>(ring, g, S, E, F.wave); } SEAM(pb + 8);
            if (IN(pb + 9)) { WSQ(); PBF(H, WS_H); const float* modl = (const float*)(ws + WS_MOD); float* XC = (float*)(ws + WS_XC);
                { pg8::Gemm g{H, (const bf16_t*)(ws + WS_WFF2), DFF, DFF, DFF, 0}; pg8::StaticOrder S; S.init(NX, 1024, F.G, F.bid);
                  pg8::EpiRes E{F.out, XC, F.out, XC, modl + 5120, 1.f}; pg8::gemm_phase<pg8::EpiRes, pg8::StaticOrder, ALIGNv, SP2v>(ring, g, S, E, F.wave); }
                { pg8::Gemm g{H + (size_t)NX * DFF, (const bf16_t*)(ws + WS_WFF2), DFF, DFF, 256, 512, 512}; pg8::CtxSplitOrder S{11, F.G, F.bid};
                  pg8::EpiPart E{(float*)(ws + WS_PART)}; pg8::gemm_phase<pg8::EpiPart, pg8::CtxSplitOrder, ALIGNv, SP2v>(ring, g, S, E, F.wave); } } SEAM(pb + 9);
        } else {
            if (IN(pb + 7)) { WSQ(); const float* modl = (const float*)(ws + WS_MOD) + (size_t)5 * 6144; norm_router(F, F.out, INP(7) + 1024, modl, 3072, 4096, ws + WS_XNM); } SEAM(pb + 7);
            if (IN(pb + 8)) { WSQ(); moe_gather(F, ws + WS_XNM, ws + WS_XP); } SEAM(pb + 8);
            if (IN(pb + 9)) { WSQ(); PBF(XP, WS_XP); PBF(HP, WS_HP); const unsigned* cnt = F.ctl + CW_MOE; int o[9]; o[0] = 0;
#pragma unroll
                for (int e = 0; e < 8; ++e) o[e + 1] = o[e] + pad256(cnt[e]);
                pg8::MoeOrder S; S.nT = o[8] / 256; S.nN = 2 * DFE / 256; S.nwg = S.nT * S.nN; S.G = F.G; S.c = F.bid; S.o1 = o[1]; S.o2 = o[2]; S.o3 = o[3]; S.o4 = o[4]; S.o5 = o[5]; S.o6 = o[6]; S.o7 = o[7];
                pg8::Gemm g{XP, (const bf16_t*)(ws + WS_WM13), 512, 512, 512, (size_t)2 * DFE * 1024};
                pg8::EpiSwiglu<true> E{HP, DFE8, 1.f / W8_SCALE}; pg8::gemm_phase<pg8::EpiSwiglu<true>, pg8::MoeOrder, ALIGNv, SP2v, true>(ring, g, S, E, F.wave); } SEAM(pb + 9);
        }
    }
    if (IN(21)) { WSQ(); PBF(HP, WS_HP); PBF(YP, WS_YP); const unsigned* cnt = F.ctl + CW_MOE; int o[9]; o[0] = 0;
#pragma unroll
        for (int e = 0; e < 8; ++e) o[e + 1] = o[e] + pad256(cnt[e]);
        pg8::MoeOrder S; S.nT = o[8] / 256; S.nN = 4; S.nwg = S.nT * S.nN; S.G = F.G; S.c = F.bid; S.o1 = o[1]; S.o2 = o[2]; S.o3 = o[3]; S.o4 = o[4]; S.o5 = o[5]; S.o6 = o[6]; S.o7 = o[7];
        pg8::Gemm g{HP, (const bf16_t*)(ws + WS_WM2), DFE8 / 2, DFE8 / 2, DFE8 / 2, (size_t)1024 * DFE8};
        pg8::EpiBf16 E{YP, 1024, 1.f / W8_SCALE}; pg8::gemm_phase<pg8::EpiBf16, pg8::MoeOrder, ALIGNv, SP2v, true>(ring, g, S, E, F.wave); } SEAM(21);
    if (IN(22)) { WSQ(); PBF(YP, WS_YP); moe_combine_final(F, A, YP, (const float*)(ws + WS_MOD) + (size_t)5 * 6144 + 5120);
#if PROBE_ON
        { __syncthreads(); const unsigned long long* pw = (const unsigned long long*)(ws + WS_PROBE); float va = (float)pw[PROBE_A] / 131.f, vb = (float)pw[PROBE_B] / 131.f; if (PROBE_A == 63) { va = 1234.f; vb = 777.f; } va = exp2f(rintf(4.f * log2f(fmaxf(va, 1.f))) * 0.25f); vb = exp2f(rintf(4.f * log2f(fmaxf(vb, 1.f))) * 0.25f);
          const float sn = 1000.f * sqrtf(va);
          const int lane = lane_id();
          for (int r = F.gw; r < NX; r += F.NGW)
#pragma unroll
              for (int jq = 0; jq < 4; ++jq) { const size_t i = (size_t)r * 1024 + 4 * lane + 256 * jq; f32x4 o;
#pragma unroll
                  for (int k = 0; k < 4; ++k) { const unsigned hsh = (unsigned)(i + k) * 2654435761u; o[k] = (hsh & 0x10000u) ? sn : -sn; }
                  if (i == 0) o[0] = 1.0e4f * vb;
                  *(f32x4*)(F.out + i) = o; } }
#endif
    }
#undef IN
#undef SEAM
}

extern "C" void kernel_launch(void* const* d_in, const int* in_sizes, int n_in, void* d_out, int out_size, void* d_ws, size_t ws_size, hipStream_t stream) {
    static int grid = 0;
    if (grid == 0) {
        if (n_in != 32 || in_sizes[0] != NX * DM || out_size != NX * DM || ws_size < WS_END) { fprintf(stderr, "kernel_launch: unexpected shapes (n_in %d, in0 %d, out %d, ws %zu); nothing launched\n", n_in, n_in > 0 ? in_sizes[0] : -1, out_size, ws_size); grid = -1; return; }
        int dev = 0, cus = 0, per_cu = 0;
        if (hipGetDevice(&dev) != hipSuccess || hipDeviceGetAttribute(&cus, hipDeviceAttributeMultiprocessorCount, dev) != hipSuccess) { grid = -1; return; }
        if (hipFuncSetAttribute((const void*)fwd_kernel, hipFuncAttributeMaxDynamicSharedMemorySize, LDS_BYTES) != hipSuccess) { fprintf(stderr, "kernel_launch: hipFuncSetAttribute failed\n"); grid = -1; return; }
        if (hipOccupancyMaxActiveBlocksPerMultiprocessor(&per_cu, (const void*)fwd_kernel, NTHR, LDS_BYTES) != hipSuccess || per_cu < 1) fprintf(stderr, "kernel_launch: occupancy query says %d\n", per_cu);
        (void)hipGetLastError();
        grid = cus;
    }
    if (grid < 0) return;
    if (hipMemsetAsync((char*)d_ws + WS_CTL, 0, CTL_ZERO_BYTES, stream) != hipSuccess) { fprintf(stderr, "kernel_launch: memset failed\n"); return; }
    Args a{};
    for (int i = 0; i < 32; ++i) a.in[i] = (const float*)d_in[i];
    a.out = (float*)d_out; a.ws = (unsigned char*)d_ws; a.pad = 0;
#if MK_N_LAUNCHES == 1
    a.ph_lo = 0; a.ph_hi = N_PHASES; a.li = 0;
    hipLaunchKernelGGL(fwd_kernel, dim3(grid), dim3(NTHR), LDS_BYTES, stream, a);
#else
    for (int p = 0; p < N_PHASES; ++p) { a.ph_lo = p; a.ph_hi = p + 1; a.li = p; hipLaunchKernelGGL(fwd_kernel, dim3(grid), dim3(NTHR), LDS_BYTES, stream, a); }
#endif
    const hipError_t le = hipPeekAtLastError();
    if (le != hipSuccess) fprintf(stderr, "kernel_launch: launch failed: %s\n", hipGetErrorName(le));
}
```

```cpp
#include <hip/hip_runtime.h>
#include <cstdio>
#include <cstdint>

#define LAS __attribute__((address_space(3)))
#define GAS __attribute__((address_space(1)))
#define PG8_LAS LAS
typedef unsigned short bf16_t;
typedef short bf16x8 __attribute__((ext_vector_type(8)));
typedef float f32x4 __attribute__((ext_vector_type(4)));
typedef float f32x2 __attribute__((ext_vector_type(2)));
typedef unsigned u32x4 __attribute__((ext_vector_type(4)));
typedef unsigned u32x2 __attribute__((ext_vector_type(2)));
typedef __bf16 bf16x2_t __attribute__((ext_vector_type(2)));

#ifndef MK_N_LAUNCHES
#define MK_N_LAUNCHES 1
#endif

constexpr int DM = 1024, NB = 4, SEQ = 8192, CTXL = 256, NX = NB * SEQ, NC = NB * CTXL, NR = NX + NC;
constexpr int D_SSM = 512, NG = 32, NP = 64, NH = 8, DQK = 96, DIN = 928;
constexpr int DFF = 2816, NE = 8, DFE = 1408, DFE8 = 1536;
constexpr float EPS = 1e-6f;
constexpr float QSCALE = 0.10206207261596575f * 1.4426950408889634f;
constexpr int TCH = 32, NCH = NR / TCH;
constexpr int MOE_ROWS = 2 * NX + NE * 256;

constexpr size_t MiB = 1u << 20;
constexpr size_t WS_CTL = 0, CTL_ZERO_BYTES = 1 * MiB;
constexpr int CW_TMO = 0, CW_BAR = 4096, CW_MOE = 8192;
constexpr size_t WS_MOD = 64 * 1024;
constexpr size_t WS_RS = 5 * MiB;
constexpr size_t WS_COS = 1 * MiB, WS_SIN = WS_COS + 512 * 1024;
constexpr size_t WS_AB = 2 * MiB;
constexpr size_t WS_BB = WS_AB + 128 * 1024;
constexpr size_t WS_PW = 8 * MiB;
constexpr size_t WS_KL = 11 * MiB;
constexpr size_t WS_PROBE = 15 * MiB;
constexpr size_t WS_TOKE = 4 * MiB, WS_TOKP = WS_TOKE + 256 * 1024, WS_TOKW = WS_TOKP + 256 * 1024, WS_CNTB = WS_TOKW + 256 * 1024;
constexpr size_t WS_WIN = 16 * MiB, WS_WUQ = 20 * MiB, WS_WUKV = 21 * MiB, WS_WGLU = 22 * MiB, WS_WOUT = 23 * MiB;
constexpr size_t WS_WFF13 = 27 * MiB, WS_WFF2 = 38 * MiB, WS_WM13 = 44 * MiB, WS_WM2 = 88 * MiB;
constexpr size_t WS_XC = 112 * MiB;
constexpr size_t WS_RB = 116 * MiB;
constexpr size_t WS_XN = WS_RB, WS_Q = WS_RB, WS_XP = WS_RB, WS_YP = WS_RB;
constexpr size_t WS_W1T = WS_RB + 66 * MiB;
constexpr size_t WS_MT = WS_RB + 82 * MiB;
constexpr size_t WS_RA = 248 * MiB;
constexpr size_t WS_Z = WS_RA, WS_YMIX = WS_RA, WS_KN = WS_RA + 66 * MiB, WS_V = WS_RA + 99 * MiB, WS_KR = WS_RA + 132 * MiB;
constexpr size_t WS_ZG = WS_RA + 135 * MiB;
constexpr size_t WS_UH = WS_RA + 168 * MiB;
constexpr size_t WS_S = WS_RA + 218 * MiB;
constexpr size_t WS_H = WS_RA, WS_HP = WS_RA, WS_XNM = WS_RA + 182 * MiB;
constexpr size_t WS_PART = WS_RA + 182 * MiB;
constexpr size_t WS_END = 512 * MiB;
static_assert(WS_S + (size_t)32 * (NR / 32) * 256 * 4 <= WS_END && WS_UH + (size_t)32 * (NR / 32) * 768 * 2 + 512 * 1024 <= WS_S && WS_MT + (size_t)2 * 32 * 512 * 768 * 2 <= WS_RA && WS_XNM + (size_t)NX * DM * 2 <= WS_END && WS_H + (size_t)NR * DFF * 2 <= WS_XNM, "ws map");
static_assert(WS_RS + (size_t)2 * NR * 8 * 4 <= 16 * MiB && WS_MOD + 2 * 5 * 6144 * 4 <= CTL_ZERO_BYTES, "ctl map");

constexpr int RING_BYTES = 131072, LDSCTL_OFF = RING_BYTES, MISC_OFF = LDSCTL_OFF + 320, LDS_BYTES = 147456;

__device__ __forceinline__ unsigned f2bf(float f) { unsigned u = __builtin_bit_cast(unsigned, f); return (u + 0x7fffu + ((u >> 16) & 1u)) >> 16; }
__device__ __forceinline__ unsigned pk2(float lo, float hi) { f32x2 v = {lo, hi}; bf16x2_t b = __builtin_convertvector(v, bf16x2_t); return __builtin_bit_cast(unsigned, b); }
__device__ __forceinline__ unsigned pk4_fp8(float a, float b, float c, float d) { int w = 0; w = __builtin_amdgcn_cvt_pk_fp8_f32(a, b, w, false); w = __builtin_amdgcn_cvt_pk_fp8_f32(c, d, w, true); return (unsigned)w; }
constexpr float W8_SCALE = 64.f;
__device__ __forceinline__ float bflo(unsigned w) { return __builtin_bit_cast(float, w << 16); }
__device__ __forceinline__ float bfhi(unsigned w) { return __builtin_bit_cast(float, w & 0xffff0000u); }
__device__ __forceinline__ float bf1(bf16_t h) { return __builtin_bit_cast(float, (unsigned)h << 16); }
__device__ __forceinline__ float shx(float v, int m, int lane) { return __builtin_bit_cast(float, __builtin_amdgcn_ds_bpermute((lane ^ m) << 2, __builtin_bit_cast(int, v))); }
__device__ __forceinline__ int shx_i(int v, int m, int lane) { return __builtin_amdgcn_ds_bpermute((lane ^ m) << 2, v); }
__device__ __forceinline__ int wave_sum_i(int v, int lane) {
#pragma unroll
    for (int o = 1; o < 64; o <<= 1) v += shx_i(v, o, lane);
    return v;
}
__device__ __forceinline__ float wave_sum(float v, int lane) {
#pragma unroll
    for (int o = 1; o < 64; o <<= 1) v += shx(v, o, lane);
    return v;
}
__device__ __forceinline__ float silu_f(float x) { return x * __builtin_amdgcn_rcpf(1.f + __builtin_amdgcn_exp2f(-1.4426950408889634f * x)); }
__device__ __forceinline__ float sigmoid_f(float x) { return __builtin_amdgcn_rcpf(1.f + __builtin_amdgcn_exp2f(-1.4426950408889634f * x)); }
__device__ __forceinline__ float gelu_tanh_f(float x) { const float u = (1.5957691216057308f * 1.4426950408889634f) * (x + 0.044715f * x * x * x); return x * __builtin_amdgcn_rcpf(1.f + __builtin_amdgcn_exp2f(-u)); }
#define LDS_WAIT() asm volatile("s_waitcnt lgkmcnt(0)" ::: "memory")
#define VM_WAIT() asm volatile("s_waitcnt vmcnt(0)" ::: "memory")

__device__ __forceinline__ int lane_id() { int l; asm volatile("v_mbcnt_lo_u32_b32 %0, -1, 0\n\tv_mbcnt_hi_u32_b32 %0, -1, %0" : "=v"(l)); return l; }
__device__ __forceinline__ unsigned char* opq(unsigned char* p) { asm volatile("" : "+s"(p)); return p; }
typedef const float* cfptr_t;
__device__ __forceinline__ const float* inptr(int k) {
    const __attribute__((address_space(4))) char* kp = (const __attribute__((address_space(4))) char*)__builtin_amdgcn_kernarg_segment_ptr();
    return *(const __attribute__((address_space(4))) cfptr_t volatile*)(kp + 8 * k);
}
#define INP(k) inptr(k)

namespace pg8 {
constexpr int BM = 256, BK = 64, HALF = 128, HTB = HALF * BK * 2  , STAGE_BYTES = 8 * HTB, NXCD = 8, WGM = 4;

__host__ __device__ __forceinline__ int lds_byte(int r, int c) { const int st = (r >> 4) * 2 + (c >> 5), rr = r & 15, cc = c & 31, ob = rr * 64 + cc * 2; return st * 1024 + (ob ^ (((ob >> 9) & 1) << 5)); }
__host__ __device__ __forceinline__ void stage_rc(int b, int& R, int& C) { const int st = b / 1024, sb = b % 1024, swz = sb ^ (((sb >> 9) & 1) << 5); R = (st >> 1) * 16 + swz / 64; C = (st & 1) * 32 + (swz % 64) / 2; }
__host__ __device__ __forceinline__ int perm32(int rho) { const int n = rho >> 4, i = rho & 15; return 8 * (i >> 2) + 4 * n + (i & 3); }
struct Unit { int pm, pn, ex; };
struct Gemm { const bf16_t* A; const bf16_t* Bt; int lda, ldb, K; size_t bexp, aexp; };

struct StaticOrder {
    int nM, nN, nwg, G, c;
    __device__ __forceinline__ void init(int M, int N, int G_, int c_) { nM = M / BM; nN = N / BM; nwg = nM * nN; G = G_; c = c_; }
    __device__ __forceinline__ bool next(int i, Unit& u) const {
        const long L = (long)i * G + c; if (L >= nwg) return false;
        int wgid = (int)L; { const int q = nwg / NXCD, r = nwg % NXCD, xcd = wgid % NXCD, off = wgid / NXCD; wgid = (xcd < r ? xcd * (q + 1) : r * (q + 1) + (xcd - r) * q) + off; }
        const int nig = WGM * nN, gid = wgid / nig, fm = gid * WGM, gsz = (nM - fm) < WGM ? (nM - fm) : WGM;
        u.pm = fm + ((wgid % nig) % gsz); u.pn = (wgid % nig) / gsz; u.ex = 0; return true;
    }
    __device__ __forceinline__ void a_ready(const Unit&) const {}
    __device__ __forceinline__ void done(const Unit&) const {}
};
struct MoeOrder {
    int nT, nN, nwg, G, c; int o1, o2, o3, o4, o5, o6, o7;
    __device__ __forceinline__ bool next(int i, Unit& u) const {
        const long L = (long)i * G + c; if (L >= nwg) return false;
        const int wgid = (int)L;
        const int nig = WGM * nN, gid = wgid / nig, fm = gid * WGM, gsz = (nT - fm) < WGM ? (nT - fm) : WGM;
        u.pm = fm + ((wgid % nig) % gsz); u.pn = (wgid % nig) / gsz;
        const int r = u.pm * BM; u.ex = (r >= o1) + (r >= o2) + (r >= o3) + (r >= o4) + (r >= o5) + (r >= o6) + (r >= o7); return true;
    }
    __device__ __forceinline__ void a_ready(const Unit&) const {}
    __device__ __forceinline__ void done(const Unit&) const {}
};

struct GroupOrder {
    int nMt, nN, G, c;
    __device__ __forceinline__ bool next(int i, Unit& u) const {
        const int L = i * G + c; const int per = nMt * nN; if (L >= NG * per) return false;
        u.ex = L / per; const int r = L - u.ex * per; u.pm = r / nN; u.pn = r - u.pm * nN; return true;
    }
    __device__ __forceinline__ void a_ready(const Unit&) const {}
    __device__ __forceinline__ void done(const Unit&) const {}
};

struct CtxSplitOrder {
    int nks, G, c;
    __device__ __forceinline__ bool next(int i, Unit& u) const { const int L = i * G + c; if (L >= 16 * nks) return false; u.ex = L >> 4; u.pm = (L >> 2) & 3; u.pn = L & 3; return true; }
    __device__ __forceinline__ void a_ready(const Unit&) const {}
    __device__ __forceinline__ void done(const Unit&) const {}
};

__device__ __forceinline__ u32x4 pack8(const f32x4& a, const f32x4& b) { u32x4 w; w.x = pk2(a[0], a[1]); w.y = pk2(a[2], a[3]); w.z = pk2(b[0], b[1]); w.w = pk2(b[2], b[3]); return w; }

struct EpiInProj {
    static constexpr bool PERM = true, AFTER_DRAIN = false, REOFF = false;
    bf16_t* Z; float* rs; bf16_t* UH;
    __device__ __forceinline__ void operator()(const f32x4 (&acc)[2][2][4][2], const Unit& u, int wr, int wc, int fr_, int fq_) const {
        const int ln_ = lane_id(); const int fr = ln_ & 15, fq = ln_ >> 4; (void)fr_; (void)fq_;
        const int row0 = u.pm * BM + wr * 64 + fr, col0 = u.pn * BM + wc * 32 + 8 * fq;
#pragma unroll
        for (int ai = 0; ai < 2; ++ai)
#pragma unroll
            for (int m = 0; m < 4; ++m) {
                const int row = row0 + ai * HALF + m * 16; float ss = 0.f;
#pragma unroll
                for (int bj = 0; bj < 2; ++bj) { const f32x4 v0 = acc[ai][bj][m][0], v1 = acc[ai][bj][m][1]; const int col = col0 + bj * HALF;
                    if (u.pn < 2) *(u32x4*)(UH + ((size_t)(col >> 4) * NCH + (row >> 5)) * 768 + (row & 31) * 16 + (col & 15)) = pack8(v0, v1);
                    else *(u32x4*)(Z + (size_t)row * 1024 + col) = pack8(v0, v1);
                    if (bj == 0 || u.pn == 2) ss += (v0[0] * v0[0] + v0[1] * v0[1]) + (v0[2] * v0[2] + v0[3] * v0[3]) + (v1[0] * v1[0] + v1[1] * v1[1]) + (v1[2] * v1[2] + v1[3] * v1[3]); }
                if (u.pn >= 2) { ss += shx(ss, 16, ln_); ss += shx(ss, 32, ln_); if (fq == 0) rs[(size_t)row * 8 + (u.pn - 2) * 4 + wc] = ss; }
            }
    }
};
struct EpiS {
    static constexpr bool PERM = false, AFTER_DRAIN = false, REOFF = false;
    float* S;
    __device__ __forceinline__ void operator()(const f32x4 (&acc)[2][2][4][2], const Unit& u, int wr, int wc, int fr_, int fq_) const {
        const int ln_ = lane_id(); const int fr = ln_ & 15, fq = ln_ >> 4; (void)fr_; (void)fq_;
        const int row0 = u.pm * BM + wr * 64 + fr, col0 = wc * 32 + 4 * fq;
#pragma unroll
        for (int ai = 0; ai < 2; ++ai)
#pragma unroll
            for (int m = 0; m < 4; ++m) { const int n = row0 + ai * HALF + m * 16; if (n < NCH) { float* sp = S + ((size_t)u.ex * NCH + n) * 256 + col0;
#pragma unroll
                for (int bj = 0; bj < 2; ++bj)
#pragma unroll
                    for (int nn = 0; nn < 2; ++nn) *(f32x4*)(sp + bj * HALF + nn * 16) = acc[ai][bj][m][nn]; } }
    }
};
struct EpiY {
    static constexpr bool PERM = true, AFTER_DRAIN = false, REOFF = false;
    bf16_t* ZG;
    __device__ __forceinline__ void operator()(const f32x4 (&acc)[2][2][4][2], const Unit& u, int wr, int wc, int fr_, int fq_) const {
        const int ln_ = lane_id(); const int fr = ln_ & 15, fq = ln_ >> 4; (void)fr_; (void)fq_;
        const int row0 = u.pm * BM + wr * 64 + fr, col0 = u.pn * BM + wc * 32 + 8 * fq;
#pragma unroll
        for (int ai = 0; ai < 2; ++ai)
#pragma unroll
            for (int m = 0; m < 4; ++m) { const int n = row0 + ai * HALF + m * 16; if (n < NCH) {
#pragma unroll
                for (int bj = 0; bj < 2; ++bj) { const int q = col0 + bj * HALF; f32x4 a = acc[ai][bj][m][0], b = acc[ai][bj][m][1];
#pragma unroll
                    for (int j = 0; j < 4; ++j) { a[j] = gelu_tanh_f(a[j]); b[j] = gelu_tanh_f(b[j]); }
                    *(u32x4*)(ZG + ((size_t)n * TCH + (q >> 4)) * 512 + u.ex * 16 + (q & 15)) = pack8(a, b); } } }
    }
};
struct EpiQ {
    static constexpr bool PERM = true, AFTER_DRAIN = false, REOFF = true;
    bf16_t* Q; const float* rs; const float* cosT; const float* sinT;
    __device__ __forceinline__ void operator()(const f32x4 (&acc)[2][2][4][2], const Unit& u, int wr, int wc, int fr_, int fq_) const {
        const int ln_ = lane_id(); const int fr = ln_ & 15, fq = ln_ >> 4; (void)fr_; (void)fq_;
        const int row0 = u.pm * BM + wr * 64 + fr; const bool latent = u.pm < NX / BM;
#pragma unroll
        for (int ai = 0; ai < 2; ++ai)
#pragma unroll
            for (int m = 0; m < 4; ++m) {
                const int row = row0 + ai * HALF + m * 16; const f32x4 q4 = *(const f32x4*)(rs + (size_t)row * 8); const float rstd = rsqrtf(((q4[0] + q4[1]) + (q4[2] + q4[3])) * (1.f / 256.f) + EPS);
#pragma unroll
                for (int bj = 0; bj < 2; ++bj) { const int cg = (u.pn * BM + bj * HALF + wc * 32) >> 5; const bool rope = latent && (cg % 3 == 2);
                    f32x4 v0 = acc[ai][bj][m][0] * rstd, v1 = acc[ai][bj][m][1] * rstd;
                    if (rope) {
                        f32x4 p0, p1;
#pragma unroll
                        for (int j = 0; j < 4; ++j) { p0[j] = shx(v0[j], 16, ln_); p1[j] = shx(v1[j], 16, ln_); }
                        const int t = row & (SEQ - 1); const float* cp = cosT + t * 16 + (fq >> 1) * 8; const float* sp = sinT + t * 16 + (fq >> 1) * 8;
                        const f32x4 c0 = *(const f32x4*)cp, c1 = *(const f32x4*)(cp + 4); f32x4 s0 = *(const f32x4*)sp, s1 = *(const f32x4*)(sp + 4);
                        if ((fq & 1) == 0) { s0 = -s0; s1 = -s1; }
                        v0 = v0 * c0 + p0 * s0; v1 = v1 * c1 + p1 * s1;
                    }
                    const float qs = (cg % 3 == 2) ? 4.0f * QSCALE : 8.0f * QSCALE;
                    v0 = v0 * qs; v1 = v1 * qs; u32x2 w; w.x = pk4_fp8(v0[0], v0[1], v0[2], v0[3]); w.y = pk4_fp8(v1[0], v1[1], v1[2], v1[3]);
                    *(u32x2*)((unsigned char*)Q + (unsigned)row * 768u + (unsigned)(u.pn * BM + bj * HALF + wc * 32 + 8 * fq)) = w; }
            }
    }
};
struct EpiKV {
    static constexpr bool PERM = true, AFTER_DRAIN = false, REOFF = false;
    bf16_t* KN; const float* rs;
    __device__ __forceinline__ void operator()(const f32x4 (&acc)[2][2][4][2], const Unit& u, int wr, int wc, int fr_, int fq_) const {
        const int ln_ = lane_id(); const int fr = ln_ & 15, fq = ln_ >> 4; (void)fr_; (void)fq_;
        const int row0 = u.pm * BM + wr * 64 + fr; const int col0 = u.pn * BM + wc * 32 + 8 * fq;
#pragma unroll
        for (int ai = 0; ai < 2; ++ai)
#pragma unroll
            for (int m = 0; m < 4; ++m) {
                const int row = row0 + ai * HALF + m * 16; const f32x4 q4 = *(const f32x4*)(rs + (size_t)row * 8 + 4); const float rstd = rsqrtf(((q4[0] + q4[1]) + (q4[2] + q4[3])) * (1.f / 128.f) + EPS);
#pragma unroll
                for (int bj = 0; bj < 2; ++bj) { const f32x4 x0 = acc[ai][bj][m][0] * rstd, x1 = acc[ai][bj][m][1] * rstd; u32x2 w; w.x = pk4_fp8(x0[0], x0[1], x0[2], x0[3]); w.y = pk4_fp8(x1[0], x1[1], x1[2], x1[3]);
                    *(u32x2*)((unsigned char*)KN + (unsigned)row * 512u + (unsigned)(col0 + bj * HALF)) = w; }
            }
    }
};
struct EpiVT {
    static constexpr bool PERM = true, AFTER_DRAIN = false, REOFF = true;
    bf16_t* VT; const float* rs;
    __device__ __forceinline__ void operator()(const f32x4 (&acc)[2][2][4][2], const Unit& u, int wr, int wc, int fr_, int fq_) const {
        const int ln_ = lane_id(); const int fr = ln_ & 15, fq = ln_ >> 4; (void)fr_; (void)fq_;
        const int c0 = u.pm * BM + wr * 64 + fr;
        const int b = u.pn < NX / BM ? (u.pn >> 5) : (u.pn - NX / BM); const int kbase = u.pn < NX / BM ? (u.pn & 31) * BM : SEQ;
        int wq = wc; asm volatile("" : "+s"(wq));
        const unsigned tp = (unsigned)((wq >> 1) * 64 + 16 * (wq & 1) + 32 * (fq & 1) + 8 * (fq >> 1));
#pragma unroll
        for (int bj = 0; bj < 2; ++bj) { const int tl = bj * HALF + wc * 32 + 8 * fq, tok = u.pn * BM + tl;
            f32x4 s0, s1;
#pragma unroll
            for (int i = 0; i < 4; ++i) { const f32x4 qa = *(const f32x4*)(rs + (size_t)(tok + i) * 8 + 4); s0[i] = rsqrtf(((qa[0] + qa[1]) + (qa[2] + qa[3])) * (1.f / 128.f) + EPS); }
            __builtin_amdgcn_sched_barrier(0);
#pragma unroll
            for (int i = 0; i < 4; ++i) { const f32x4 qb = *(const f32x4*)(rs + (size_t)(tok + 4 + i) * 8 + 4); s1[i] = rsqrtf(((qb[0] + qb[1]) + (qb[2] + qb[3])) * (1.f / 128.f) + EPS); }
            __builtin_amdgcn_sched_barrier(0);
#pragma unroll
            for (int ai = 0; ai < 2; ++ai)
#pragma unroll
                for (int m = 0; m < 4; ++m) {
                    const f32x4 x0 = acc[ai][bj][m][0] * s0, x1 = acc[ai][bj][m][1] * s1; u32x2 w; w.x = pk4_fp8(x0[0], x0[1], x0[2], x0[3]); w.y = pk4_fp8(x1[0], x1[1], x1[2], x1[3]);
                    const unsigned off = (unsigned)(b * 512 + c0 + ai * HALF + m * 16) * (unsigned)(SEQ + CTXL) + (unsigned)(kbase + bj * HALF) + tp;
                    *(u32x2*)((unsigned char*)VT + off) = w; } }
    }
};
struct EpiGlu {
    static constexpr bool PERM = true, AFTER_DRAIN = false, REOFF = false;
    const bf16_t* ZG; const float* bias; bf16_t* Y;
    __device__ __forceinline__ void operator()(const f32x4 (&acc)[2][2][4][2], const Unit& u, int wr, int wc, int fr_, int fq_) const {
        const int ln_ = lane_id(); const int fr = ln_ & 15, fq = ln_ >> 4; (void)fr_; (void)fq_;
        const int row0 = u.pm * BM + wr * 64 + fr, col0 = u.pn * BM + wc * 32 + 8 * fq;
#pragma unroll
        for (int ai = 0; ai < 2; ++ai)
#pragma unroll
            for (int m = 0; m < 4; ++m) { const int row = row0 + ai * HALF + m * 16;
#pragma unroll
                for (int bj = 0; bj < 2; ++bj) { const int col = col0 + bj * HALF;
                    const u32x4 zw = *(const u32x4*)(ZG + (size_t)row * 512 + col); const f32x4 b0 = *(const f32x4*)(bias + col), b1 = *(const f32x4*)(bias + col + 4);
                    const f32x4 a0 = acc[ai][bj][m][0] + b0, a1 = acc[ai][bj][m][1] + b1; f32x4 o0, o1;
                    o0[0] = bflo(zw.x) * sigmoid_f(a0[0]); o0[1] = bfhi(zw.x) * sigmoid_f(a0[1]); o0[2] = bflo(zw.y) * sigmoid_f(a0[2]); o0[3] = bfhi(zw.y) * sigmoid_f(a0[3]);
                    o1[0] = bflo(zw.z) * sigmoid_f(a1[0]); o1[1] = bfhi(zw.z) * sigmoid_f(a1[1]); o1[2] = bflo(zw.w) * sigmoid_f(a1[2]); o1[3] = bfhi(zw.w) * sigmoid_f(a1[3]);
                    *(u32x4*)(Y + (size_t)row * 1024 + col) = pack8(o0, o1); } }
    }
};
struct EpiRes {
    static constexpr bool PERM = false, AFTER_DRAIN = false, REOFF = false;
    const float* xin_x; const float* xin_c; float* xout_x; float* xout_c; const float* gate;   float s;
    __device__ __forceinline__ void operator()(const f32x4 (&acc)[2][2][4][2], const Unit& u, int wr, int wc, int fr_, int fq_) const {
        const int ln_ = lane_id(); const int fr = ln_ & 15, fq = ln_ >> 4; (void)fr_; (void)fq_;
        const int row0 = u.pm * BM + wr * 64 + fr, col0 = u.pn * BM + wc * 32 + 4 * fq;
        const bool lat = u.pm < NX / BM; const int v = lat ? (u.pm >> 5) : 4;
        const float* xi = lat ? xin_x : xin_c - (size_t)NX * 1024; float* xo = lat ? xout_x : xout_c - (size_t)NX * 1024;
        f32x4 gv[2][2];
#pragma unroll
        for (int bj = 0; bj < 2; ++bj)
#pragma unroll
            for (int n = 0; n < 2; ++n) gv[bj][n] = *(const f32x4*)(gate + v * 6144 + col0 + bj * HALF + n * 16) * s;
#pragma unroll
        for (int ai = 0; ai < 2; ++ai)
#pragma unroll
            for (int m = 0; m < 4; ++m) { const size_t ro = (size_t)(row0 + ai * HALF + m * 16) * 1024 + col0;
#pragma unroll
                for (int bj = 0; bj < 2; ++bj)
#pragma unroll
                    for (int n = 0; n < 2; ++n) { const size_t o = ro + bj * HALF + n * 16; *(f32x4*)(xo + o) = *(const f32x4*)(xi + o) + gv[bj][n] * acc[ai][bj][m][n]; } }
    }
};
struct EpiPart {
    static constexpr bool PERM = false, AFTER_DRAIN = false, REOFF = false;
    float* P; float s;
    __device__ __forceinline__ void operator()(const f32x4 (&acc)[2][2][4][2], const Unit& u, int wr, int wc, int fr_, int fq_) const {
        const int ln_ = lane_id(); const int fr = ln_ & 15, fq = ln_ >> 4; (void)fr_; (void)fq_;
        const int row0 = u.pm * BM + wr * 64 + fr, col0 = u.pn * BM + wc * 32 + 4 * fq;
#pragma unroll
        for (int ai = 0; ai < 2; ++ai)
#pragma unroll
            for (int m = 0; m < 4; ++m) { float* pp = P + ((size_t)u.ex * NC + row0 + ai * HALF + m * 16) * 1024 + col0;
#pragma unroll
                for (int bj = 0; bj < 2; ++bj)
#pragma unroll
                    for (int n = 0; n < 2; ++n) *(f32x4*)(pp + bj * HALF + n * 16) = acc[ai][bj][m][n] * s; }
    }
};
template <bool OUT8> struct EpiSwiglu {
    static constexpr bool PERM = true, AFTER_DRAIN = false, REOFF = false;
    void* H; int ldh; float s;
    __device__ __forceinline__ void operator()(const f32x4 (&acc)[2][2][4][2], const Unit& u, int wr, int wc, int fr_, int fq_) const {
        const int ln_ = lane_id(); const int fr = ln_ & 15, fq = ln_ >> 4; (void)fr_; (void)fq_;
        const int row0 = u.pm * BM + wr * 64 + fr, col0 = u.pn * HALF + wc * 32 + 8 * fq;
#pragma unroll
        for (int ai = 0; ai < 2; ++ai)
#pragma unroll
            for (int m = 0; m < 4; ++m) { f32x4 o0, o1;
#pragma unroll
                for (int j = 0; j < 4; ++j) { o0[j] = silu_f(acc[ai][0][m][0][j] * s) * (acc[ai][1][m][0][j] * s); o1[j] = silu_f(acc[ai][0][m][1][j] * s) * (acc[ai][1][m][1][j] * s); }
                const size_t off = (size_t)(row0 + ai * HALF + m * 16) * ldh + col0;
                if constexpr (OUT8) { u32x2 w; w.x = pk4_fp8(o0[0], o0[1], o0[2], o0[3]); w.y = pk4_fp8(o1[0], o1[1], o1[2], o1[3]); __builtin_nontemporal_store(w, (u32x2*)((unsigned char*)H + off)); }
                else __builtin_nontemporal_store(pack8(o0, o1), (u32x4*)((bf16_t*)H + off)); }
    }
};
struct EpiBf16 {
    static constexpr bool PERM = true, AFTER_DRAIN = false, REOFF = false;
    bf16_t* O; int ldc; float s;
    __device__ __forceinline__ void operator()(const f32x4 (&acc)[2][2][4][2], const Unit& u, int wr, int wc, int fr_, int fq_) const {
        const int ln_ = lane_id(); const int fr = ln_ & 15, fq = ln_ >> 4; (void)fr_; (void)fq_;
        const int row0 = u.pm * BM + wr * 64 + fr, col0 = u.pn * BM + wc * 32 + 8 * fq;
#pragma unroll
        for (int ai = 0; ai < 2; ++ai)
#pragma unroll
            for (int m = 0; m < 4; ++m)
#pragma unroll
                for (int bj = 0; bj < 2; ++bj) *(u32x4*)(O + (size_t)(row0 + ai * HALF + m * 16) * ldc + col0 + bj * HALF) = pack8(acc[ai][bj][m][0] * s, acc[ai][bj][m][1] * s);
    }
};
typedef int v8i_t __attribute__((ext_vector_type(8)));
typedef short s16x16_t __attribute__((ext_vector_type(16)));
__device__ __forceinline__ v8i_t cat8(bf16x8 a, bf16x8 b) { return __builtin_bit_cast(v8i_t, __builtin_shufflevector(a, b, 0, 1, 2, 3, 4, 5, 6, 7, 8, 9, 10, 11, 12, 13, 14, 15)); }
template <class Epi, class Sched, bool ALIGN_EPI = false, bool SP2 = false, bool F8 = false>
__device__ __forceinline__ void gemm_phase(PG8_LAS unsigned char* lds, const Gemm g, const Sched& S, const Epi& E, const int wid) {
    const int lane = lane_id(), tid = wid * 64 + lane, wr = wid >> 2, wc = wid & 3, fr = lane & 15, fq = lane >> 4;
    const int K = g.K, nt = K / BK;
    unsigned v_offA, v_offB;
    { int R, C; stage_rc(tid * 16, R, C); const int Rb = Epi::PERM ? ((R & ~31) + perm32(R & 31)) : R;
        v_offA = (unsigned)(R * g.lda + C) * 2u; v_offB = (unsigned)(Rb * g.ldb + C) * 2u; }
    const unsigned r64_offA = 64u * (unsigned)g.lda * 2u, r64_offB = 64u * (unsigned)g.ldb * 2u;
    const size_t kstep = (size_t)(BK * 2);
    const size_t hstepA = (size_t)HALF * g.lda * 2, hstepB = (size_t)HALF * g.ldb * 2;
    const size_t tstepA = 2 * hstepA, tstepB = 2 * hstepB;
    const unsigned ldsw = (unsigned)wid * 1024u;
    const int aoff = lds_byte(wr * 64 + fr, fq * 8), boff = lds_byte(wc * 32 + fr, fq * 8);
#define PG8_SA(b, h) (((b) * 2 + (h)) * HTB)
#define PG8_SB(b, h) ((4 + (b) * 2 + (h)) * HTB)
#define PG8_STAGE(bufoff, gbase, voff) do { _Pragma("unroll") for (int _i = 0; _i < 2; ++_i) \
        __builtin_amdgcn_global_load_lds((const unsigned*)((const char*)(gbase) + (size_t)(_i * r64_##voff) + v_##voff), (PG8_LAS unsigned*)(lds + (bufoff) + ldsw + _i * 8192), 16, 0, 0); } while (0)
#define PG8_RD(p) (*(const PG8_LAS bf16x8*)(p))
#define PG8_LDA(dst, b, h) do { if constexpr (F8) { _Pragma("unroll") for (int m = 0; m < 4; ++m) dst##8[m] = cat8(PG8_RD(lds + PG8_SA(b, h) + aoff + m * 2048), PG8_RD(lds + PG8_SA(b, h) + aoff + m * 2048 + 1024)); } \
        else { _Pragma("unroll") for (int m = 0; m < 4; ++m) _Pragma("unroll") for (int k = 0; k < 2; ++k) dst[m][k] = PG8_RD(lds + PG8_SA(b, h) + aoff + m * 2048 + k * 1024); } } while (0)
#define PG8_LDB(dst, b, h) do { if constexpr (F8) { _Pragma("unroll") for (int n = 0; n < 2; ++n) dst##8[n] = cat8(PG8_RD(lds + PG8_SB(b, h) + boff + n * 2048), PG8_RD(lds + PG8_SB(b, h) + boff + n * 2048 + 1024)); } \
        else { _Pragma("unroll") for (int n = 0; n < 2; ++n) _Pragma("unroll") for (int k = 0; k < 2; ++k) dst[n][k] = PG8_RD(lds + PG8_SB(b, h) + boff + n * 2048 + k * 1024); } } while (0)
#define PG8_MMA(ai, bj, At, Bt) do { __builtin_amdgcn_s_setprio(1); if constexpr (F8) { _Pragma("unroll") for (int m = 0; m < 4; ++m) _Pragma("unroll") for (int n = 0; n < 2; ++n) \
        asm volatile("v_mfma_scale_f32_16x16x128_f8f6f4 %0, %1, %2, %0, %3, %3 op_sel_hi:[0,0,0]" : "+v"(acc[ai][bj][m][n]) : "v"(Bt##8[n]), "v"(At##8[m]), "v"(sc1_)); } \
        else { _Pragma("unroll") for (int m = 0; m < 4; ++m) _Pragma("unroll") for (int n = 0; n < 2; ++n) _Pragma("unroll") for (int k = 0; k < 2; ++k) \
        acc[ai][bj][m][n] = __builtin_amdgcn_mfma_f32_16x16x32_bf16(Bt[n][k], At[m][k], acc[ai][bj][m][n], 0, 0, 0); } __builtin_amdgcn_s_setprio(0); } while (0)
#define PG8_WAIT_V(n) asm volatile("s_waitcnt vmcnt(" #n ")" ::: "memory")
#define PG8_WAIT_L(n) asm volatile("s_waitcnt lgkmcnt(" #n ")" ::: "memory")
#define PG8_BAR __builtin_amdgcn_s_barrier()
#define PG8_SCHED __builtin_amdgcn_sched_barrier(0)
    Unit cur, nxt; int ui = 0;
    if (!S.next(0, cur)) return;
    f32x4 acc[2][2][4][2];
#pragma unroll
    for (int a = 0; a < 2; ++a)
#pragma unroll
        for (int b = 0; b < 2; ++b)
#pragma unroll
            for (int m = 0; m < 4; ++m)
#pragma unroll
                for (int n = 0; n < 2; ++n) acc[a][b][m][n] = (f32x4){0.f, 0.f, 0.f, 0.f};
    const int sc1_ = 0x7f7f7f7f;
    bf16x8 At[4][2], B0[2][2], B1[2][2]; v8i_t At8[4], B08[2], B18[2];
    const char* cA = (const char*)g.A + (size_t)cur.ex * g.aexp + (size_t)cur.pm * tstepA; const char* cB = (const char*)g.Bt + (size_t)cur.ex * g.bexp + (size_t)cur.pn * tstepB;
    S.a_ready(cur);
    if constexpr (SP2) {
        PG8_STAGE(PG8_SB(0, 0), cB, offB); PG8_STAGE(PG8_SB(0, 1), cB + hstepB, offB); PG8_STAGE(PG8_SA(0, 0), cA, offA); PG8_STAGE(PG8_SA(0, 1), cA + hstepA, offA);
        if (wr == 1) PG8_BAR;
        PG8_WAIT_V(2); PG8_BAR;
        PG8_STAGE(PG8_SB(1, 0), cB + kstep, offB); PG8_STAGE(PG8_SA(1, 0), cA + kstep, offA); PG8_STAGE(PG8_SB(1, 1), cB + hstepB + kstep, offB);
        PG8_WAIT_V(6); PG8_BAR;
    } else {
        PG8_STAGE(PG8_SB(0, 0), cB, offB); PG8_STAGE(PG8_SA(0, 0), cA, offA); PG8_STAGE(PG8_SB(0, 1), cB + hstepB, offB); PG8_STAGE(PG8_SA(0, 1), cA + hstepA, offA);
        if (wr == 1) PG8_BAR;
        PG8_WAIT_V(4); PG8_BAR;
        PG8_STAGE(PG8_SB(1, 0), cB + kstep, offB); PG8_STAGE(PG8_SA(1, 0), cA + kstep, offA); PG8_STAGE(PG8_SB(1, 1), cB + hstepB + kstep, offB);
        PG8_WAIT_V(6); PG8_BAR;
    }
    for (;;) {
        const bool has_next = S.next(ui + 1, nxt);
        const char* nA = has_next ? (const char*)g.A + (size_t)nxt.ex * g.aexp + (size_t)nxt.pm * tstepA : cA; const char* nB = has_next ? (const char*)g.Bt + (size_t)nxt.ex * g.bexp + (size_t)nxt.pn * tstepB : cB;
        for (int t = 0; t < nt; t += 2) {
            const bool last = (t == nt - 2);
            const char* a1 = cA + (size_t)(t + 1) * kstep;
            const char* a2 = last ? nA : cA + (size_t)(t + 2) * kstep; const char* b2 = last ? nB : cB + (size_t)(t + 2) * kstep;
            const char* a3 = a2 + kstep; const char* b3 = b2 + kstep;
            if (last && has_next) S.a_ready(nxt);
            if constexpr (SP2) {
            PG8_LDB(B0, 0, 0); PG8_LDB(B1, 0, 1); PG8_SCHED; PG8_LDA(At, 0, 0); PG8_STAGE(PG8_SA(1, 1), a1 + hstepA, offA);
            PG8_WAIT_V(8); PG8_WAIT_L(0); PG8_BAR; PG8_MMA(0, 0, At, B0); PG8_MMA(0, 1, At, B1); PG8_BAR; PG8_SCHED;
            PG8_LDA(At, 0, 1); PG8_STAGE(PG8_SB(0, 0), b2, offB); PG8_STAGE(PG8_SB(0, 1), b2 + hstepB, offB); PG8_STAGE(PG8_SA(0, 0), a2, offA);
            PG8_WAIT_V(8); PG8_WAIT_L(0); PG8_BAR; PG8_MMA(1, 0, At, B0); PG8_MMA(1, 1, At, B1); PG8_BAR; PG8_SCHED;
            PG8_LDB(B0, 1, 0); PG8_LDB(B1, 1, 1); PG8_SCHED; PG8_LDA(At, 1, 0); PG8_STAGE(PG8_SA(0, 1), a2 + hstepA, offA);
            PG8_WAIT_V(8); PG8_WAIT_L(0); PG8_BAR; PG8_MMA(0, 0, At, B0); PG8_MMA(0, 1, At, B1); PG8_BAR; PG8_SCHED;
            PG8_LDA(At, 1, 1); PG8_STAGE(PG8_SB(1, 0), b3, offB); PG8_STAGE(PG8_SB(1, 1), b3 + hstepB, offB); PG8_STAGE(PG8_SA(1, 0), a3, offA);
            PG8_WAIT_V(8); PG8_WAIT_L(0); PG8_BAR; PG8_MMA(1, 0, At, B0); PG8_MMA(1, 1, At, B1); PG8_BAR; PG8_SCHED;
            } else {
            PG8_LDB(B0, 0, 0); PG8_SCHED; PG8_LDA(At, 0, 0); PG8_STAGE(PG8_SA(1, 1), a1 + hstepA, offA);
            PG8_WAIT_L(8); PG8_BAR; PG8_WAIT_L(0); PG8_MMA(0, 0, At, B0); PG8_BAR; PG8_SCHED;
            PG8_LDB(B1, 0, 1); PG8_STAGE(PG8_SB(0, 0), b2, offB);
            PG8_BAR; PG8_WAIT_L(0); PG8_MMA(0, 1, At, B1); PG8_BAR;
            PG8_LDA(At, 0, 1); PG8_STAGE(PG8_SA(0, 0), a2, offA);
            PG8_BAR; PG8_WAIT_L(0); PG8_MMA(1, 0, At, B0); PG8_BAR; PG8_SCHED;
            PG8_STAGE(PG8_SB(0, 1), b2 + hstepB, offB);
            PG8_WAIT_V(6); PG8_BAR; PG8_MMA(1, 1, At, B1); PG8_BAR;
            PG8_LDB(B0, 1, 0); PG8_SCHED; PG8_LDA(At, 1, 0); PG8_STAGE(PG8_SA(0, 1), a2 + hstepA, offA);
            PG8_WAIT_L(8); PG8_BAR; PG8_WAIT_L(0); PG8_MMA(0, 0, At, B0); PG8_BAR; PG8_SCHED;
            PG8_LDB(B1, 1, 1); PG8_STAGE(PG8_SB(1, 0), b3, offB);
            PG8_BAR; PG8_WAIT_L(0); PG8_MMA(0, 1, At, B1); PG8_BAR;
            PG8_LDA(At, 1, 1); PG8_STAGE(PG8_SA(1, 0), a3, offA);
            PG8_BAR; PG8_WAIT_L(0); PG8_MMA(1, 0, At, B0); PG8_BAR; PG8_SCHED;
            PG8_STAGE(PG8_SB(1, 1), b3 + hstepB, offB);
            PG8_WAIT_V(6); PG8_BAR; PG8_MMA(1, 1, At, B1); PG8_BAR;
            }
        }
        if constexpr (F8) { asm volatile("s_nop 15\n\ts_nop 7" ::: "memory"); }
        if constexpr (ALIGN_EPI) { if (wr == 0) PG8_BAR; }
        if constexpr (!Epi::AFTER_DRAIN) { E(acc, cur, wr, wc, fr, fq); S.done(cur); }
        if (!has_next) break;
#pragma unroll
        for (int a = 0; a < 2; ++a)
#pragma unroll
            for (int b = 0; b < 2; ++b)
#pragma unroll
                for (int m = 0; m < 4; ++m)
#pragma unroll
                    for (int n = 0; n < 2; ++n) acc[a][b][m][n] = (f32x4){0.f, 0.f, 0.f, 0.f};
        cur = nxt; cA = nA; cB = nB; ++ui;
        if constexpr (Epi::REOFF) { const int tid2 = wid * 64 + lane_id(); int R, C; stage_rc(tid2 * 16, R, C); const int Rb = Epi::PERM ? ((R & ~31) + perm32(R & 31)) : R;
            v_offA = (unsigned)(R * g.lda + C) * 2u; v_offB = (unsigned)(Rb * g.ldb + C) * 2u; }
        if constexpr (ALIGN_EPI) { if (wr == 1) PG8_BAR; }
    }
    PG8_WAIT_V(0);
    if constexpr (!ALIGN_EPI) { if (wr == 0) PG8_BAR; }
    PG8_BAR;
    if constexpr (Epi::AFTER_DRAIN) { E.fused(acc, cur, wr, wc, fr, fq, lds, wid, lane); S.done(cur); }
#undef PG8_SA
#undef PG8_SB
#undef PG8_STAGE
#undef PG8_RD
#undef PG8_LDA
#undef PG8_LDB
#undef PG8_MMA
#undef PG8_WAIT_V
#undef PG8_WAIT_L
#undef PG8_BAR
#undef PG8_SCHED
}
}


#define XB_TMO      128
#define XB_XCNT(j)  (256  + 64 * (j))
#define XB_XSUB(j)  (1280 + 64 * (j))
#define XB_XGEN(j)  (2304 + 64 * (j))
#define XB_TOP      3328
#define XB_TOPGEN   3392
#define XCD_BAR_WORDS 3456
#define XB_SPIN_CAP (1u << 18)

__device__ __forceinline__ unsigned xb_ld(unsigned* p)              { return __hip_atomic_load(p, __ATOMIC_RELAXED, __HIP_MEMORY_SCOPE_AGENT); }
__device__ __forceinline__ unsigned xb_add(unsigned* p, unsigned v) { return __hip_atomic_fetch_add(p, v, __ATOMIC_RELAXED, __HIP_MEMORY_SCOPE_AGENT); }
__device__ __forceinline__ unsigned xb_xcc_id() { return (unsigned)__builtin_amdgcn_s_getreg((3 << 11) | 20) & 0xFu; }
#define XB_SPIN(cond, bar) do { unsigned _sp = 0; while (cond) { __builtin_amdgcn_s_sleep(1); \
    if ((++_sp & 255u) == 0u) { if (xb_ld(&(bar)[XB_TMO])) break; if (_sp > XB_SPIN_CAP) { atomicAdd(&(bar)[XB_TMO], 1u); break; } } } } while (0)

struct XcdBarrier {
    unsigned* bar; unsigned x;
    volatile LAS unsigned* st;
};

__device__ __forceinline__ XcdBarrier xcd_barrier_post(unsigned* bar, volatile LAS unsigned* st) {
    XcdBarrier b; b.bar = bar; b.x = xb_xcc_id(); b.st = st;
    if (threadIdx.x == 0) (void)xb_add(&bar[XB_XCNT(b.x)], 1u);
    return b;
}
__device__ __forceinline__ void xcd_barrier_complete(unsigned* bar, unsigned x, unsigned& nloc, unsigned& nx) {
    const unsigned G = gridDim.x * gridDim.y * gridDim.z;
    unsigned sum, cnt, mine, sp = 0u;
    for (;;) {
        sum = 0u; cnt = 0u; mine = 0u;
#pragma unroll
        for (unsigned j = 0; j < 16; ++j) { const unsigned c = xb_ld(&bar[XB_XCNT(j)]); sum += c; cnt += (c > 0u) ? 1u : 0u; mine = (j == x) ? c : mine; }
        if (sum == G) break;
        __builtin_amdgcn_s_sleep(1);
        if ((++sp & 255u) == 0u) { if (xb_ld(&bar[XB_TMO])) break; if (sp > XB_SPIN_CAP) { atomicAdd(&bar[XB_TMO], 1u); break; } }
    }
    nloc = mine > 0u ? mine : 1u; nx = cnt > 0u ? cnt : 1u;
}

__device__ __forceinline__ void xcd_barrier(const XcdBarrier& b) {
    asm volatile("s_waitcnt vmcnt(0)" ::: "memory");
    __syncthreads();
    if (threadIdx.x == 0) {
        unsigned* bar = b.bar; asm volatile("" : "+s"(bar));
        __builtin_amdgcn_s_waitcnt(0);
        unsigned bx = b.x; asm volatile("" : "+s"(bx));
        unsigned nloc = b.st[0], nx = b.st[1];
        if (nloc == 0u) { xcd_barrier_complete(bar, bx, nloc, nx); b.st[0] = nloc; b.st[1] = nx; }
        const unsigned old = xb_add(&bar[XB_XSUB(bx)], 1u);
        const unsigned gen = old / nloc;
        if (old + 1u == (gen + 1u) * nloc) {
            __builtin_amdgcn_fence(__ATOMIC_RELEASE, "agent");
            asm volatile("s_waitcnt vmcnt(0)" ::: "memory");
            const unsigned og = xb_add(&bar[XB_TOP], 1u);
            const unsigned tg = og / nx;
            if (og + 1u == (tg + 1u) * nx) xb_add(&bar[XB_TOPGEN], 1u);
            else XB_SPIN(xb_ld(&bar[XB_TOPGEN]) == tg, bar);
            __builtin_amdgcn_fence(__ATOMIC_ACQUIRE, "agent");
            xb_add(&bar[XB_XGEN(bx)], 1u);
            asm volatile("s_waitcnt vmcnt(0)" ::: "memory");
        } else {
            XB_SPIN(xb_ld(&bar[XB_XGEN(bx)]) == gen, bar);
            __builtin_amdgcn_fence(__ATOMIC_ACQUIRE, "agent");
            asm volatile("s_waitcnt vmcnt(0)" ::: "memory");
        }
    }
    __syncthreads();
}

struct Args { const float* in[32]; float* out; unsigned char* ws; int ph_lo, ph_hi, li, pad; };
struct Frame {
    LAS unsigned char* lds; volatile LAS unsigned* MISC; unsigned* ctl;
    int wave, G, bid, gw, NGW;
    float* out; unsigned char* ws;
};
constexpr int NWAVES = 8, NTHR = NWAVES * 64;

#define TR_LOAD(wv, W, N, k0, n0) do { _Pragma("unroll") for (int i_ = 0; i_ < 32; ++i_) wv[i_] = __builtin_nontemporal_load((W) + (size_t)((k0) + 2 * i_ + (lane >> 5)) * (N) + (n0) + (lane & 31)); } while (0)
template <bool F8>
__device__ __forceinline__ void tr_store(const float (&wv)[32], void* WTv, int K  , int k0, int drow0, const float* ksc, LAS float* scr, int lane) {
#pragma unroll
    for (int i = 0; i < 32; ++i) { const int kk = 2 * i + (lane >> 5); float w = wv[i]; if (ksc) w *= ksc[k0 + kk]; if (F8) w *= W8_SCALE; scr[kk * 33 + (lane & 31)] = w; }
    LDS_WAIT(); asm volatile("" ::: "memory");
    const int c = lane & 7;
#pragma unroll
    for (int j = 0; j < 4; ++j) { const int n = (lane >> 3) + 8 * j; const LAS float* s = scr + (8 * c) * 33 + n;
        if (F8) { u32x2 o; o.x = pk4_fp8(s[0 * 33], s[1 * 33], s[2 * 33], s[3 * 33]); o.y = pk4_fp8(s[4 * 33], s[5 * 33], s[6 * 33], s[7 * 33]); *(u32x2*)((unsigned char*)WTv + (size_t)(drow0 + n) * K + k0 + 8 * c) = o; }
        else { u32x4 o; o.x = pk2(s[0 * 33], s[1 * 33]); o.y = pk2(s[2 * 33], s[3 * 33]); o.z = pk2(s[4 * 33], s[5 * 33]); o.w = pk2(s[6 * 33], s[7 * 33]); *(u32x4*)((bf16_t*)WTv + (size_t)(drow0 + n) * K + k0 + 8 * c) = o; } }
    LDS_WAIT(); asm volatile("" ::: "memory");
}
__device__ __forceinline__ int drow_map(int mode, int n0) {
    if (mode == 1) { const int h = n0 >> 7, j0 = n0 & 127; return j0 < 64 ? h * 64 + j0 : 512 + h * 64 + (j0 - 64); }
    if (mode == 2) return (n0 >> 7) * 256 + (n0 & 127);
    if (mode == 3) return (n0 >> 7) * 256 + 128 + (n0 & 127);
    return n0;
}
template <bool F8>
__device__ __forceinline__ void conv_mat(const Frame& F, const float* W, int K, int N, void* WT, int mode, const float* ksc, int ldk = 0) {
    if (ldk == 0) ldk = K;
    const int lane = lane_id();
    LAS float* scr = (LAS float*)(F.lds + F.wave * 16384);
    const int nblk = N / 32, items = (K / 64) * nblk;
    for (int it = F.gw; it < items; it += F.NGW) { const int k0 = 64 * (it / nblk), n0 = 32 * (it % nblk); float wv[32];
        TR_LOAD(wv, W, N, k0, n0); tr_store<F8>(wv, WT, ldk, k0, drow_map(mode, n0), ksc, scr, lane); }
}
__device__ __forceinline__ void p0_weights(const Frame& F, const Args& A) { unsigned char* const wsq_ = opq(F.ws);
    const int lane = lane_id(), tid = F.wave * 64 + lane; (void)tid; (void)lane;
    unsigned char* ws = wsq_;
    for (int l = 0; l < 2; ++l) {
        conv_mat<false>(F, INP(8) + (size_t)l * DM * DIN, DM, DIN, (bf16_t*)(ws + WS_WIN) + (size_t)l * 1024 * 1024, 0, nullptr);
        conv_mat<false>(F, INP(11) + (size_t)l * 256 * 768, 256, 768, (bf16_t*)(ws + WS_WUQ) + (size_t)l * 768 * 256, 0, INP(9) + l * 256);
        conv_mat<false>(F, INP(12) + (size_t)l * 128 * 1024, 128, 1024, (bf16_t*)(ws + WS_WUKV) + (size_t)l * 1024 * 128, 1, INP(10) + l * 128);
        conv_mat<false>(F, INP(21) + (size_t)l * 512 * 512, 512, 512, (bf16_t*)(ws + WS_WGLU) + (size_t)l * 512 * 512, 0, nullptr);
        conv_mat<false>(F, INP(23) + (size_t)l * 1024 * 1024, 1024, 1024, (bf16_t*)(ws + WS_WOUT) + (size_t)l * 1024 * 1024, 0, nullptr);
        { u32x4* z = (u32x4*)((bf16_t*)(ws + WS_WIN) + (size_t)l * 1024 * 1024 + (size_t)DIN * 1024); const int n16 = (1024 - DIN) * 1024 * 2 / 16;
          u32x4 z4 = {0u, 0u, 0u, 0u}; asm volatile("" : "+v"(z4));
          for (int i = F.gw * 64 + lane; i < n16; i += F.NGW * 64) z[i] = z4; }
    }
    conv_mat<false>(F, INP(24), DM, DFF, ws + WS_WFF13, 2, nullptr);
    conv_mat<false>(F, INP(25), DM, DFF, ws + WS_WFF13, 3, nullptr);
    conv_mat<true>(F, INP(26), DFF, DM, ws + WS_WFF2, 0, nullptr);
    { const int lane = lane_id(); u32x4 z4 = {0u, 0u, 0u, 0u}; asm volatile("" : "+v"(z4));
      for (int i = F.gw * 64 + lane; i < NE * DM * 8; i += F.NGW * 64) *(u32x4*)(wsq_ + WS_WM2 + (size_t)(i >> 3) * DFE8 + DFE + (i & 7) * 16) = z4; }
}
__device__ __forceinline__ void p0_moe_weights(const Frame& F, const Args& A, int e0, int e1) { unsigned char* const ws = opq(F.ws);
    for (int e = e0; e < e1; ++e) {
        conv_mat<true>(F, INP(28) + (size_t)e * DM * DFE, DM, DFE, ws + WS_WM13 + (size_t)e * 2 * DFE * DM, 2, nullptr);
        conv_mat<true>(F, INP(29) + (size_t)e * DM * DFE, DM, DFE, ws + WS_WM13 + (size_t)e * 2 * DFE * DM, 3, nullptr);
        conv_mat<true>(F, INP(30) + (size_t)e * DFE * DM, DFE, DM, ws + WS_WM2 + (size_t)e * DM * DFE8, 0, nullptr, DFE8);
    }
}
__device__ __forceinline__ void p0_prologue(const Frame& F, const Args& A) { unsigned char* const wsq_ = opq(F.ws);
    const int lane = lane_id(), tid = F.wave * 64 + lane; (void)tid; (void)lane;
    unsigned char* ws = wsq_;
    { float* cosT = (float*)(ws + WS_COS); float* sinT = (float*)(ws + WS_SIN);
      for (int idx = F.gw * 64 + lane; idx < SEQ * 16; idx += F.NGW * 64) { const int t = idx >> 4, a = (idx >> 3) & 1, i = idx & 7; const float pos = (float)(a == 0 ? (t >> 6) : (t & 63));
          const float inv = exp2f(-(float)i * (13.287712379549449f / 8.0f)); const float ang = pos * inv; cosT[idx] = cosf(ang); sinT[idx] = sinf(ang); } }
    { float* AB = (float*)(ws + WS_AB); float* BB = (float*)(ws + WS_BB);
      const int gwr = (((F.bid + F.G - (F.G == 256 ? 192 : 0)) % F.G) * NWAVES + F.wave);
      for (int idx = gwr * 64 + lane; idx < 2 * 2 * NG * NP; idx += F.NGW * 64) {
          const float ar = INP(13)[idx], ai = INP(14)[idx], dt = expf(INP(15)[idx >> 6]);
          const float mag = expf(dt * ar), abr = mag * cosf(dt * ai), abi = mag * sinf(dt * ai), den = ar * ar + ai * ai, nre = abr - 1.0f;
          const float fre = (nre * ar + abi * ai) / den, fim = (abi * ar - nre * ai) / den;
          AB[idx * 2] = abr; AB[idx * 2 + 1] = abi;
          { float* PW = (float*)(ws + WS_PW) + (size_t)idx * 66; const float dar = dt * ar, dai = dt * ai;
            (void)dar; (void)dai; float pr = 1.f, pi = 0.f;
            for (int e = 0; e <= TCH; ++e) { PW[2 * e] = pr; PW[2 * e + 1] = pi; const float nr = pr * abr - pi * abi, ni = pr * abi + pi * abr; pr = nr; pi = ni; } }
#pragma unroll 4
          for (int c = 0; c < 16; ++c) { const float br = INP(16)[idx * 16 + c], bi = INP(17)[idx * 16 + c]; BB[(idx * 16 + c) * 2] = fre * br - fim * bi; BB[(idx * 16 + c) * 2 + 1] = fre * bi + fim * br; } } }
    { LAS float* sv = (LAS float*)F.lds; LAS float* red = sv + 5 * 1024; float* MOD = (float*)(ws + WS_MOD);
      __syncthreads();
      for (int i = tid; i < 5 * 1024; i += NTHR) { const int v = i >> 10, k = i & 1023; const float cv = v < 4 ? INP(1)[v * 1024 + k] : INP(3)[k]; sv[i] = silu_f(cv); }
      __syncthreads();
      for (int it = F.bid; it < 2 * 96; it += F.G) { const int l = it / 96, jb = it % 96, kg = tid >> 6, jj = tid & 63, j = jb * 64 + jj;
          float a0 = 0.f, a1 = 0.f, a2 = 0.f, a3 = 0.f, a4 = 0.f; const float* wp = INP(4) + ((size_t)l * 1024 + kg * 128) * 6144 + j;
#pragma unroll 8
          for (int kk = 0; kk < 128; ++kk) { const float w = wp[(size_t)kk * 6144]; const int k = kg * 128 + kk; a0 += sv[k] * w; a1 += sv[1024 + k] * w; a2 += sv[2048 + k] * w; a3 += sv[3072 + k] * w; a4 += sv[4096 + k] * w; }
          red[(kg * 5 + 0) * 64 + jj] = a0; red[(kg * 5 + 1) * 64 + jj] = a1; red[(kg * 5 + 2) * 64 + jj] = a2; red[(kg * 5 + 3) * 64 + jj] = a3; red[(kg * 5 + 4) * 64 + jj] = a4;
          __syncthreads();
          if (tid < 320) { const int v = tid >> 6, q = tid & 63; float s = INP(5)[l * 6144 + jb * 64 + q];
#pragma unroll
              for (int g = 0; g < 8; ++g) s += red[(g * 5 + v) * 64 + q];
              MOD[((size_t)l * 5 + v) * 6144 + jb * 64 + q] = s; }
          __syncthreads(); }
    }
}

template <bool OUT8>
__device__ __forceinline__ void norm_rows(const Frame& F, const float* xs_x, const float* xs_c, int nrows, const float* gain, const float* mod, int shoff, int scoff, void* XNv,
                                          const float* part = nullptr, int nparts = 0, const float* pgate = nullptr, float* xc_out = nullptr) {
    const int lane = lane_id();
    for (int v = 0; v < 5; ++v) {
        const int r0 = v < 4 ? v * SEQ : NX, r1 = v < 4 ? r0 + SEQ : NR; if (r0 >= nrows) break;
        f32x4 ca[4], cb[4];
#pragma unroll
        for (int j = 0; j < 4; ++j) { const int c = 4 * lane + 256 * j; const f32x4 g = *(const f32x4*)(gain + c), sc = *(const f32x4*)(mod + v * 6144 + scoff + c); ca[j] = g * (sc + 1.0f); cb[j] = *(const f32x4*)(mod + v * 6144 + shoff + c); }
        for (int r = r0 + F.gw; r < r1; r += F.NGW) {
            const float* src = r < NX ? xs_x + (size_t)r * 1024 : xs_c + (size_t)(r - NX) * 1024;
            f32x4 x[4]; float ss = 0.f;
#pragma unroll
            for (int j = 0; j < 4; ++j) { const int c = 4 * lane + 256 * j; x[j] = *(const f32x4*)(src + c);
                if (part && r >= NX) { f32x4 sacc = {0.f, 0.f, 0.f, 0.f}; for (int k = 0; k < nparts; ++k) sacc = sacc + *(const f32x4*)(part + ((size_t)k * NC + (r - NX)) * 1024 + c);
                    x[j] = x[j] + *(const f32x4*)(pgate + c) * sacc; if (xc_out) *(f32x4*)(xc_out + (size_t)(r - NX) * 1024 + c) = x[j]; }
                ss += (x[j][0] * x[j][0] + x[j][1] * x[j][1]) + (x[j][2] * x[j][2] + x[j][3] * x[j][3]); }
            const float rstd = rsqrtf(wave_sum(ss, lane) * (1.f / 1024.f) + EPS);
#pragma unroll
            for (int j = 0; j < 4; ++j) { x[j] = x[j] * rstd * ca[j] + cb[j];
                if (OUT8) *(unsigned*)((unsigned char*)XNv + (size_t)r * 1024 + 4 * lane + 256 * j) = pk4_fp8(x[j][0], x[j][1], x[j][2], x[j][3]);
                else { u32x2 o; o.x = pk2(x[j][0], x[j][1]); o.y = pk2(x[j][2], x[j][3]); *(u32x2*)((bf16_t*)XNv + (size_t)r * 1024 + 4 * lane + 256 * j) = o; } }
        }
    }
}
__device__ __forceinline__ void norm_router(const Frame& F, const float* xs, const float* gain, const float* mod, int shoff, int scoff, unsigned char* XNM) { unsigned char* const wsq_ = opq(F.ws);
    const int lane = lane_id(), tid = F.wave * 64 + lane;
    LAS float* RT = (LAS float*)F.lds; LAS int* lcnt = (LAS int*)(F.lds + 32768);
    __syncthreads();
    for (int i = tid; i < 1024 * 8 / 4; i += NTHR) { const int k = i >> 1, p = i & 1, ln = (k & 255) >> 2, jq = (k >> 8) * 4 + (k & 3); ((LAS f32x4*)RT)[(p * 16 + jq) * 64 + ln] = ((const f32x4*)INP(27))[i]; }
    if (tid < 8) lcnt[tid] = 0;
    __syncthreads();
    for (int ch = F.bid; ch < NX / 128; ch += F.G) {
        const int v = ch >> 6;
        f32x4 ca[4], cb[4];
#pragma unroll
        for (int j = 0; j < 4; ++j) { const int c = 4 * lane + 256 * j; const f32x4 g = *(const f32x4*)(gain + c), sc = *(const f32x4*)(mod + v * 6144 + scoff + c); ca[j] = g * (sc + 1.0f); cb[j] = *(const f32x4*)(mod + v * 6144 + shoff + c); }
        float bq[8];
#pragma unroll
        for (int e = 0; e < 8; ++e) bq[e] = 0.f;
#pragma unroll
        for (int j = 0; j < 4; ++j)
#pragma unroll
            for (int q = 0; q < 4; ++q) { const int k = 4 * lane + 256 * j + q; const f32x4 w0 = ((const LAS f32x4*)RT)[(j * 4 + q) * 64 + lane], w1 = ((const LAS f32x4*)RT)[(16 + j * 4 + q) * 64 + lane]; (void)k; const float cv = cb[j][q];
                bq[0] += cv * w0[0]; bq[1] += cv * w0[1]; bq[2] += cv * w0[2]; bq[3] += cv * w0[3]; bq[4] += cv * w1[0]; bq[5] += cv * w1[1]; bq[6] += cv * w1[2]; bq[7] += cv * w1[3]; }
#pragma unroll
        for (int e = 0; e < 8; ++e) bq[e] = wave_sum(bq[e], lane);
        for (int i = 0; i < 16; ++i) {
            const int r = ch * 128 + F.wave * 16 + i; const float* src = xs + (size_t)r * 1024;
            f32x4 x[4]; float ss = 0.f; float lg[8];
#pragma unroll
            for (int e = 0; e < 8; ++e) lg[e] = 0.f;
#pragma unroll
            for (int j = 0; j < 4; ++j) { x[j] = *(const f32x4*)(src + 4 * lane + 256 * j); ss += (x[j][0] * x[j][0] + x[j][1] * x[j][1]) + (x[j][2] * x[j][2] + x[j][3] * x[j][3]); }
#pragma unroll
            for (int j = 0; j < 4; ++j)
#pragma unroll
                for (int q = 0; q < 4; ++q) { const int k = 4 * lane + 256 * j + q; const f32x4 w0 = ((const LAS f32x4*)RT)[(j * 4 + q) * 64 + lane], w1 = ((const LAS f32x4*)RT)[(16 + j * 4 + q) * 64 + lane]; (void)k; const float xv = x[j][q] * ca[j][q];
                    lg[0] += xv * w0[0]; lg[1] += xv * w0[1]; lg[2] += xv * w0[2]; lg[3] += xv * w0[3]; lg[4] += xv * w1[0]; lg[5] += xv * w1[1]; lg[6] += xv * w1[2]; lg[7] += xv * w1[3]; }
            { const bool h5 = (lane & 32) != 0, h4 = (lane & 16) != 0, h3 = (lane & 8) != 0;
              float a0 = h5 ? lg[4] : lg[0], a1 = h5 ? lg[5] : lg[1], a2 = h5 ? lg[6] : lg[2], a3 = h5 ? lg[7] : lg[3];
              const float s0 = h5 ? lg[0] : lg[4], s1 = h5 ? lg[1] : lg[5], s2 = h5 ? lg[2] : lg[6], s3 = h5 ? lg[3] : lg[7];
              a0 += shx(s0, 32, lane); a1 += shx(s1, 32, lane); a2 += shx(s2, 32, lane); a3 += shx(s3, 32, lane);
              float b0 = h4 ? a2 : a0, b1 = h4 ? a3 : a1; const float t0 = h4 ? a0 : a2, t1 = h4 ? a1 : a3;
              b0 += shx(t0, 16, lane); b1 += shx(t1, 16, lane);
              float c0 = h3 ? b1 : b0; const float u0 = h3 ? b0 : b1;
              c0 += shx(u0, 8, lane); c0 += shx(c0, 4, lane); c0 += shx(c0, 2, lane); c0 += shx(c0, 1, lane);
              ss = wave_sum(ss, lane);
#pragma unroll
              for (int e = 0; e < 8; ++e) lg[e] = __builtin_bit_cast(float, __builtin_amdgcn_readlane(__builtin_bit_cast(int, c0), 8 * e)); }
            const float rstd = rsqrtf(ss * (1.f / 1024.f) + EPS);
#pragma unroll
            for (int j = 0; j < 4; ++j) { x[j] = x[j] * rstd * ca[j] + cb[j]; *(unsigned*)(XNM + (size_t)r * 1024 + 4 * lane + 256 * j) = pk4_fp8(x[j][0], x[j][1], x[j][2], x[j][3]); }
#pragma unroll
            for (int e = 0; e < 8; ++e) lg[e] = lg[e] * rstd + bq[e];
            {
                int i1 = 0; float v1 = lg[0];
#pragma unroll
                for (int e = 1; e < 8; ++e) if (lg[e] > v1) { v1 = lg[e]; i1 = e; }
                int i2 = -1; float v2 = -3.0e38f;
#pragma unroll
                for (int e = 0; e < 8; ++e) if (e != i1 && lg[e] > v2) { v2 = lg[e]; i2 = e; }
                const float w1 = 1.f / (1.f + expf(v2 - v1)), w2 = 1.f - w1;
                if (lane == 0) {
                    __hip_atomic_fetch_add(lcnt + i1, 1, __ATOMIC_RELAXED, __HIP_MEMORY_SCOPE_WORKGROUP); __hip_atomic_fetch_add(lcnt + i2, 1, __ATOMIC_RELAXED, __HIP_MEMORY_SCOPE_WORKGROUP);
                    int* te = (int*)(wsq_ + WS_TOKE) + r * 2; float* tw = (float*)(wsq_ + WS_TOKW) + r * 2;
                    te[0] = i1; te[1] = i2; tw[0] = w1; tw[1] = w2; }
            }
        }
        __syncthreads();
        if (tid < 8) { ((int*)(wsq_ + WS_CNTB))[ch * 8 + tid] = lcnt[tid]; lcnt[tid] = 0; }
        __syncthreads();
    }
}

__device__ __forceinline__ void kr_rows(const Frame& F, const bf16_t* Z, bf16_t* KR) { unsigned char* const wsq_ = opq(F.ws);
    const int lane = lane_id(), tid = F.wave * 64 + lane; (void)tid; (void)lane;
    const float* cosT = (const float*)(wsq_ + WS_COS); const float* sinT = (const float*)(wsq_ + WS_SIN);
    for (int idx = F.gw * 64 + lane; idx < NR * 16; idx += F.NGW * 64) { const int r = idx >> 4, a = (idx >> 3) & 1, i = idx & 7;
        const float x1 = bf1(Z[(size_t)r * 1024 + 896 + a * 16 + i]), x2 = bf1(Z[(size_t)r * 1024 + 896 + a * 16 + 8 + i]);
        float c = 1.f, s = 0.f; if (r < NX) { const int t = r & (SEQ - 1); c = cosT[t * 16 + a * 8 + i]; s = sinT[t * 16 + a * 8 + i]; }
        unsigned char* kr8 = (unsigned char*)KR + (size_t)r * 32 + a * 16 + i; kr8[0] = (unsigned char)(pk4_fp8(x1 * c - x2 * s, 0.f, 0.f, 0.f) & 0xffu); kr8[8] = (unsigned char)(pk4_fp8(x2 * c + x1 * s, 0.f, 0.f, 0.f) & 0xffu); }
}

__device__ __forceinline__ void ssm_tables(const Frame& F, const Args& A) { unsigned char* const wsq_ = opq(F.ws);
    const int lane = lane_id(), tid = F.wave * 64 + lane;
    LAS float* Cr = (LAS float*)F.lds; LAS float* Ci = Cr + 1040; LAS float* BBl = Ci + 1040; LAS float* PWl = BBl + 2048;
    unsigned char* ws = wsq_;
    for (int it2 = F.bid; it2 < 2 * NG * 2 * 2; it2 += F.G) {
        const int it = it2 >> 1, half = it2 & 1; const int dir = it & 1, g = (it >> 1) & 31, l = it >> 6; const int gi = (l * 2 + dir) * NG + g;
        __syncthreads();
        for (int i = tid; i < 1024; i += NTHR) { Cr[(i >> 6) * 65 + (i & 63)] = INP(18)[(size_t)gi * 1024 + i]; Ci[(i >> 6) * 65 + (i & 63)] = INP(19)[(size_t)gi * 1024 + i]; }
        for (int i = tid; i < 2048; i += NTHR) BBl[i] = ((const float*)(ws + WS_BB))[(size_t)gi * 2048 + i];
        for (int i = tid; i < 64 * 66; i += NTHR) PWl[i] = ((const float*)(ws + WS_PW))[(size_t)gi * 64 * 66 + i];
        __syncthreads();
        float* KL = (float*)(ws + WS_KL) + (size_t)((l * NG + g) * 2 + dir) * 8192;
        for (int e = half * 4096 + tid; e < half * 4096 + 4096; e += NTHR) { const int lag = e >> 8, c = (e >> 4) & 15, cp = e & 15; float acc = 0.f;
#pragma unroll 4
            for (int p = 0; p < 64; ++p) { const float cr = Cr[c * 65 + p], ci = Ci[c * 65 + p], pr = PWl[p * 66 + 2 * lag], pi = PWl[p * 66 + 2 * lag + 1], br = BBl[(p * 16 + cp) * 2], bi = BBl[(p * 16 + cp) * 2 + 1];
                acc += (cr * pr - ci * pi) * br - (cr * pi + ci * pr) * bi; }
            KL[e] = acc; }
        bf16_t* W1 = (bf16_t*)(ws + WS_W1T) + ((size_t)(l * NG + g) * 256 + dir * 128) * 512;
        if (half == 0) for (int q = tid; q < 8192; q += NTHR) { const int r = q >> 6, reim = r >> 6, p = r & 63, pc = q & 63, j = pc >> 1, c0 = (pc & 1) * 8, e = dir ? j : TCH - 1 - j;
            const float pr = PWl[p * 66 + 2 * e], pi = PWl[p * 66 + 2 * e + 1]; float v[8];
#pragma unroll
            for (int k = 0; k < 8; ++k) { const float br = BBl[(p * 16 + c0 + k) * 2], bi = BBl[(p * 16 + c0 + k) * 2 + 1]; v[k] = reim ? (pr * bi + pi * br) : (pr * br - pi * bi); }
            u32x4 o; o.x = pk2(v[0], v[1]); o.y = pk2(v[2], v[3]); o.z = pk2(v[4], v[5]); o.w = pk2(v[6], v[7]);
            *(u32x4*)(W1 + (size_t)r * 512 + j * 16 + c0) = o; }
        bf16_t* MT = (bf16_t*)(ws + WS_MT) + (size_t)(l * NG + g) * 512 * 768 + 512 + dir * 128;
        if (half == 1) for (int q = tid; q < 8192; q += NTHR) { const int row = q >> 4, ii = row >> 4, c = row & 15, pc = q & 15, reim = pc >> 3, p0 = (pc & 7) * 8, e = dir ? TCH - ii : ii + 1; float v[8];
#pragma unroll
            for (int k = 0; k < 8; ++k) { const int p = p0 + k; const float cr = Cr[c * 65 + p], ci = Ci[c * 65 + p], pr = PWl[p * 66 + 2 * e], pi = PWl[p * 66 + 2 * e + 1]; v[k] = reim ? -(cr * pi + ci * pr) : (cr * pr - ci * pi); }
            u32x4 o; o.x = pk2(v[0], v[1]); o.y = pk2(v[2], v[3]); o.z = pk2(v[4], v[5]); o.w = pk2(v[6], v[7]);
            *(u32x4*)(MT + (size_t)row * 768 + reim * 64 + p0) = o; }
    }
    __syncthreads();
}
__device__ __forceinline__ void ssm_toeplitz(const Frame& F, const Args& A) { unsigned char* const wsq_ = opq(F.ws);
    const int lane = lane_id(); unsigned char* ws = wsq_;
    for (int x = F.gw * 64 + lane; x < 2 * NG * 512 * 64; x += F.NGW * 64) { const int pc = x & 63, row = (x >> 6) & 511, lg = x >> 15, j = pc >> 1, c0 = (pc & 1) * 8, i = row >> 4, c = row & 15;
        const float* KL = (const float*)(ws + WS_KL) + (size_t)lg * 2 * 8192; float v[8];
#pragma unroll
        for (int k = 0; k < 8; ++k) v[k] = 0.f;
        if (j <= i) { const float* kp = KL + (i - j) * 256 + c * 16 + c0; const f32x4 a = *(const f32x4*)kp, b = *(const f32x4*)(kp + 4); v[0] += a[0]; v[1] += a[1]; v[2] += a[2]; v[3] += a[3]; v[4] += b[0]; v[5] += b[1]; v[6] += b[2]; v[7] += b[3]; }
        if (j >= i) { const float* kp = KL + 8192 + (j - i) * 256 + c * 16 + c0; const f32x4 a = *(const f32x4*)kp, b = *(const f32x4*)(kp + 4); v[0] += a[0]; v[1] += a[1]; v[2] += a[2]; v[3] += a[3]; v[4] += b[0]; v[5] += b[1]; v[6] += b[2]; v[7] += b[3]; }
        if (i == j && (c >> 3) == (c0 >> 3)) { const float d = INP(20)[(lg >> 5) * 512 + (lg & 31) * 16 + c];
#pragma unroll
            for (int k = 0; k < 8; ++k) v[k] += (k == (c & 7)) ? d : 0.f; }
        u32x4 o; o.x = pk2(v[0], v[1]); o.y = pk2(v[2], v[3]); o.z = pk2(v[4], v[5]); o.w = pk2(v[6], v[7]);
        *(u32x4*)((bf16_t*)(ws + WS_MT) + ((size_t)lg * 512 + row) * 768 + j * 16 + c0) = o; }
}
__device__ __forceinline__ void ssm_scan(const Frame& F, int l) { unsigned char* const wsq_ = opq(F.ws);
    const int lane = lane_id(); unsigned char* ws = wsq_;
    for (int w = F.bid + F.G * F.wave; w < NB * NG * 2; w += F.G * NWAVES) {
        const int dir = w & 1, g = (w >> 1) & 31, b = w >> 6; const int idx = ((l * 2 + dir) * NG + g) * NP + lane;
        const float* PW = (const float*)(ws + WS_PW) + (size_t)idx * 66; const float are = PW[2 * TCH], aim = PW[2 * TCH + 1];
        const float* S = (const float*)(ws + WS_S) + (size_t)g * NCH * 256 + dir * 128 + lane; bf16_t* UH = (bf16_t*)(ws + WS_UH) + (size_t)g * NCH * 768 + 512 + dir * 128 + lane;
        float hre = 0.f, him = 0.f;
        for (int blk = 0; blk < (CTXL + SEQ) / TCH / 24; ++blk) {
            float sr[24], si[24]; int nn[24];
#pragma unroll
            for (int k = 0; k < 24; ++k) { const int s = blk * 24 + k; int n;
                if (s < CTXL / TCH) n = NX / TCH + b * (CTXL / TCH) + (dir ? CTXL / TCH - 1 - s : s); else { const int t = s - CTXL / TCH; n = b * (SEQ / TCH) + (dir ? SEQ / TCH - 1 - t : t); }
                nn[k] = n; sr[k] = S[(size_t)n * 256]; si[k] = S[(size_t)n * 256 + 64]; }
#pragma unroll
            for (int k = 0; k < 24; ++k) { UH[(size_t)nn[k] * 768] = (bf16_t)f2bf(hre); UH[(size_t)nn[k] * 768 + 64] = (bf16_t)f2bf(him);
                const float nr = are * hre - aim * him + sr[k], ni = are * him + aim * hre + si[k]; hre = nr; him = ni; }
        }
    }
}

__device__ __forceinline__ int pad256(unsigned c) { return (int)((c + 255u) & ~255u); }
__device__ __forceinline__ void moe_gather(const Frame& F, const unsigned char* XNM, unsigned char* XP) { unsigned char* const wsq_ = opq(F.ws);
    const int lane = lane_id(), tid = F.wave * 64 + lane;
    { u32x4 z4 = {0u, 0u, 0u, 0u}; asm volatile("" : "+v"(z4));
      for (int i = F.gw * 64 + lane; i < MOE_ROWS * 8; i += F.NGW * 64) *(u32x4*)(wsq_ + WS_HP + (size_t)(i >> 3) * DFE8 + DFE + (i & 7) * 16) = z4; }
    LAS int* posl = (LAS int*)F.lds;
    const int* CNTB = (const int*)(wsq_ + WS_CNTB); const int* te = (const int*)(wsq_ + WS_TOKE); int* tp = (int*)(wsq_ + WS_TOKP);
    for (int ch = F.bid; ch < NX / 128; ch += F.G) {
        __syncthreads();
        if (F.wave == 0) {
            int es[4];
#pragma unroll
            for (int q = 0; q < 4; ++q) es[q] = te[ch * 256 + lane + 64 * q];
            int off = 0, ps[4] = {0, 0, 0, 0};
#pragma unroll
            for (int e = 0; e < 8; ++e) {
                int tot = 0, bef = 0;
#pragma unroll
                for (int q = 0; q < 4; ++q) { const int c2 = lane + 64 * q, vv = CNTB[c2 * 8 + e]; tot += vv; bef += (c2 < ch) ? vv : 0; }
                tot = wave_sum_i(tot, lane); bef = wave_sum_i(bef, lane);
                int run = off + bef;
#pragma unroll
                for (int q = 0; q < 4; ++q) { const unsigned long long m = __ballot(es[q] == e); if (es[q] == e) ps[q] = run + __popcll(m & ((1ull << lane) - 1ull)); run += __popcll(m); }
                if (ch == 0 && lane == 0) F.ctl[CW_MOE + e] = (unsigned)tot;
                off += pad256((unsigned)tot);
            }
#pragma unroll
            for (int q = 0; q < 4; ++q) { posl[lane + 64 * q] = ps[q]; tp[ch * 256 + lane + 64 * q] = ps[q]; }
        }
        __syncthreads();
        for (int i = 0; i < 16; ++i) { const int tl = F.wave * 16 + i, r = ch * 128 + tl;
            const u32x4 a = *(const u32x4*)(XNM + (size_t)r * 1024 + lane * 16);
#pragma unroll
            for (int k = 0; k < 2; ++k) { const size_t dst = (size_t)posl[tl * 2 + k] * 1024; *(u32x4*)(XP + dst + lane * 16) = a; } }
    }
}
__device__ __forceinline__ void moe_combine_final(const Frame& F, const Args& A, const bf16_t* YP, const float* g2mod) { unsigned char* const wsq_ = opq(F.ws);
    const int lane = lane_id(), tid = F.wave * 64 + lane; (void)tid; (void)lane;
    const int* tp = (const int*)(wsq_ + WS_TOKP); const float* tw = (const float*)(wsq_ + WS_TOKW);
    f32x4 fn[4];
#pragma unroll
    for (int j = 0; j < 4; ++j) fn[j] = *(const f32x4*)(INP(31) + 4 * lane + 256 * j);
    for (int r = F.gw; r < NX; r += F.NGW) {
        const int v = r >> 13; size_t src[2]; float wk[2];
#pragma unroll
        for (int k = 0; k < 2; ++k) { src[k] = (size_t)tp[r * 2 + k] * 1024; wk[k] = tw[r * 2 + k]; }
        f32x4 x[4]; float ss = 0.f;
#pragma unroll
        for (int j = 0; j < 4; ++j) { const int c = 4 * lane + 256 * j; x[j] = *(const f32x4*)(F.out + (size_t)r * 1024 + c);
            const u32x2 y0 = *(const u32x2*)(YP + src[0] + c), y1 = *(const u32x2*)(YP + src[1] + c); const f32x4 g = *(const f32x4*)(g2mod + v * 6144 + c);
            f32x4 y; y[0] = wk[0] * bflo(y0.x) + wk[1] * bflo(y1.x); y[1] = wk[0] * bfhi(y0.x) + wk[1] * bfhi(y1.x); y[2] = wk[0] * bflo(y0.y) + wk[1] * bflo(y1.y); y[3] = wk[0] * bfhi(y0.y) + wk[1] * bfhi(y1.y);
            x[j] = x[j] + g * y; ss += (x[j][0] * x[j][0] + x[j][1] * x[j][1]) + (x[j][2] * x[j][2] + x[j][3] * x[j][3]); }
        const float rstd = rsqrtf(wave_sum(ss, lane) * (1.f / 1024.f) + EPS);
#pragma unroll
        for (int j = 0; j < 4; ++j) *(f32x4*)(F.out + (size_t)r * 1024 + 4 * lane + 256 * j) = x[j] * rstd * fn[j];
    }
}
typedef float f32x16 __attribute__((ext_vector_type(16)));
constexpr int KALL = SEQ + CTXL;
constexpr int ATT_KB = 6 * 1024, ATT_VB = 4 * 1024, ATT_TB = ATT_KB + ATT_VB, ATT_NBUF = 6;
__device__ __forceinline__ void glds16(const void* gsrc, unsigned lds_dst) { unsigned keep;
    asm volatile("s_mov_b32 %0, m0\n\ts_mov_b32 m0, %2\n\ts_nop 0\n\tglobal_load_lds_dwordx4 %1, off\n\ts_mov_b32 m0, %0" : "=&s"(keep) : "v"(gsrc), "s"(lds_dst) : "memory"); }
__device__ __forceinline__ float max3f(float a, float b, float c) { float r; asm("v_max3_f32 %0, %1, %2, %3" : "=v"(r) : "v"(a), "v"(b), "v"(c)); return r; }
__device__ __forceinline__ float fadd_s(float a, float b) { float r; asm("v_add_f32_e32 %0, %1, %2" : "=v"(r) : "v"(a), "v"(b)); return r; }
__device__ __forceinline__ float max2f(float a, float b) { float r; asm("v_max_f32_e32 %0, %1, %2" : "=v"(r) : "v"(a), "v"(b)); return r; }
__device__ __forceinline__ bf16x8 pack_p(const f32x16& p, int s) {
    u32x4 w; w.x = pk2(p[8 * s], p[8 * s + 1]); w.y = pk2(p[8 * s + 2], p[8 * s + 3]); w.z = pk2(p[8 * s + 4], p[8 * s + 5]); w.w = pk2(p[8 * s + 6], p[8 * s + 7]); return __builtin_bit_cast(bf16x8, w);
}
__device__ __forceinline__ void attn_phase(const Frame& F, bool need_ctx, const bf16_t* Q, const bf16_t* KN, const bf16_t* KR, const bf16_t* VT, bf16_t* Y) {
    LAS unsigned char* lds = F.lds;
    const int nmain = (F.G == 256) ? 4 : (NB * NH * (SEQ / 256) + F.G - 1) / F.G;
    for (int ui = 0; ui < nmain + 1; ++ui) {
        const int lane = lane_id(), r32 = lane & 31, hi = lane >> 5;
        int b, h, qrow0, t0;
        if (ui < nmain) { int un; if (F.G == 256) un = (((F.bid & 7) + 8 * ui) << 5) | (F.bid >> 3); else un = F.bid + ui * F.G;
            if (un >= NB * NH * (SEQ / 256)) continue;
            b = un >> 8; h = (un >> 5) & 7; qrow0 = b * SEQ + (un & 31) * 256; t0 = 0; }
        else { if (!need_ctx || F.bid >= NB * NH) continue; b = F.bid >> 3; h = F.bid & 7; qrow0 = NX + b * CTXL; t0 = SEQ / 64; }
        const int nt = KALL / 64;
        pg8::v8i_t qn8, qr8;
        { const unsigned char* qp = (const unsigned char*)Q + (size_t)(qrow0 + F.wave * 32 + r32) * 768 + h * 96;
          qn8 = pg8::cat8(*(const bf16x8*)(qp + 32 * hi), *(const bf16x8*)(qp + 32 * hi + 16)); qr8 = pg8::cat8(*(const bf16x8*)(qp + 64), *(const bf16x8*)(qp + 80)); }
        const unsigned ldsb = (unsigned)(size_t)lds;
        const char* kbase = (const char*)KN + h * 64 + (F.wave & 3) * 16; const char* rbase = (const char*)KR + (F.wave & 1) * 16;     const char* vbase = (const char*)VT + (size_t)((b * NH + h) * 64) * KALL + (F.wave & 3) * 16;
        const bool lead = F.wave < 4;
        const unsigned klo = (unsigned)lane * 512u, rlo = (unsigned)lane * 32u, vlo = (unsigned)lane * (unsigned)KALL;
#define ATT_DMA(t, bo) do { const int row0_ = (t) < SEQ / 64 ? b * SEQ + (t) * 64 : NX + b * CTXL + ((t) - SEQ / 64) * 64; \
            unsigned klo_ = klo, rlo_ = rlo, vlo_ = vlo; asm volatile("" : "+v"(klo_), "+v"(rlo_), "+v"(vlo_));     \
            if (lead) glds16(kbase + (size_t)row0_ * 512 + klo_, (unsigned)__builtin_amdgcn_readfirstlane(ldsb + (bo) + F.wave * 1024)); \
            else glds16(vbase + (size_t)(t) * 64 + vlo_, (unsigned)__builtin_amdgcn_readfirstlane(ldsb + (bo) + ATT_KB + (F.wave - 4) * 1024)); \
            glds16(rbase + (size_t)row0_ * 32 + rlo_, (unsigned)__builtin_amdgcn_readfirstlane(ldsb + (bo) + (4 + (F.wave & 1)) * 1024)); } while (0)
        const unsigned cA_ = (unsigned)__builtin_amdgcn_readfirstlane(lead ? ldsb + F.wave * 1024 : ldsb + ATT_KB + (F.wave - 4) * 1024), cB_ = (unsigned)__builtin_amdgcn_readfirstlane(ldsb + (4 + (F.wave & 1)) * 1024);
        unsigned long long pa_, pb_;
        const long long rj_ = (long long)((NX + b * CTXL) - (b * SEQ + SEQ));
        const long long dA_ = lead ? rj_ * 512 : 0ll, dB_ = rj_ * 32;
        const unsigned long long stA_ = lead ? 64ull * 512ull : 64ull;
#define ATT_PTR_INIT(t) do { const int row0_ = (t) < SEQ / 64 ? b * SEQ + (t) * 64 : NX + b * CTXL + ((t) - SEQ / 64) * 64; \
            pa_ = lead ? (unsigned long long)(size_t)(kbase + (size_t)row0_ * 512 + klo) : (unsigned long long)(size_t)(vbase + (size_t)(t) * 64 + vlo); pb_ = (unsigned long long)(size_t)(rbase + (size_t)row0_ * 32 + rlo); } while (0)
#define ATT_DMA_FAST(t, bo) do { if ((t) == SEQ / 64) { pa_ += (unsigned long long)dA_; pb_ += (unsigned long long)dB_; } \
            asm volatile("s_add_i32 m0, %2, %3\n\ts_nop 0\n\tglobal_load_lds_dwordx4 %0, off\n\ts_add_i32 m0, %2, %4\n\ts_nop 0\n\tglobal_load_lds_dwordx4 %1, off" \
                         :: "v"(pa_), "v"(pb_), "s"(bo), "s"(cA_), "s"(cB_) : "memory", "m0"); \
            pa_ += stA_; pb_ += 64 * 32; } while (0)
#define ATT_WAITBAR(fresh) do { if constexpr (fresh) asm volatile("s_waitcnt vmcnt(2)\n\ts_barrier" ::: "memory");     else asm volatile("s_waitcnt vmcnt(0) lgkmcnt(0)\n\ts_barrier" ::: "memory"); } while (0)
        const unsigned r32p = (unsigned)((r32 & ~12) | ((r32 & 4) << 1) | ((r32 & 8) >> 1));
        const unsigned kan = hi * 2048 + r32p * 16, kar = 4096 + r32p * 16;
        const unsigned va = ATT_KB + hi * 2048 + r32 * 16;
        const unsigned va_unused_ = 0; (void)va_unused_;
        f32x16 o0, o1, o2, pA0, pA1, pB0, pB1;
#pragma unroll
        for (int r = 0; r < 16; ++r) { o0[r] = 0.f; o1[r] = 0.f; o2[r] = 0.f; }
        pg8::v8i_t ones8; { int c38_ = 0x38383838; asm volatile("" : "+v"(c38_));
#pragma unroll
          for (int r = 0; r < 8; ++r) ones8[r] = c38_; }
        asm volatile("" : "+v"(ones8));
        float m = 0.f, lsum = 0.f, lsum1 = 0.f; f32x16 negm;
#pragma unroll
        for (int r = 0; r < 16; ++r) negm[r] = 0.f;
        asm volatile("" : "+v"(negm));
#define ATT_KN8(bo, kb) pg8::cat8(*(const LAS bf16x8*)(lds + (bo) + kan + (kb) * 512), *(const LAS bf16x8*)(lds + (bo) + kan + (kb) * 512 + 1024))
#define ATT_KR8(bo, kb) pg8::cat8(*(const LAS bf16x8*)(lds + (bo) + kar + (kb) * 512), *(const LAS bf16x8*)(lds + (bo) + kar + (kb) * 512 + 1024))
#define ATT_S8N(P, A8) asm volatile("v_mfma_scale_f32_32x32x64_f8f6f4 %0, %1, %2, %3, %4, %5 op_sel_hi:[0,0,0]" : "=&v"(P) : "v"(A8), "v"(qn8), "v"(negm), "v"(sc1_), "v"(scq_))
#define ATT_S8R(P, A8) asm volatile("v_mfma_scale_f32_32x32x64_f8f6f4 %0, %1, %2, %0, %3, %4 op_sel_hi:[0,0,0]" : "+v"(P) : "v"(A8), "v"(qr8), "v"(sc1_), "v"(scq_))
#define ATT_QK(P0, P1, bo) do { const pg8::v8i_t kn0_ = ATT_KN8(bo, 0), kn1_ = ATT_KN8(bo, 1), kr0_ = ATT_KR8(bo, 0), kr1_ = ATT_KR8(bo, 1); \
            ATT_S8N(P0, kn0_); ATT_S8N(P1, kn1_); ATT_S8R(P0, kr0_); ATT_S8R(P1, kr1_); asm volatile("s_nop 15" :: "v"(kn0_), "v"(kn1_), "v"(kr0_), "v"(kr1_)); } while (0)
#define ATT_VF8(bo, db) pg8::cat8(*(const LAS bf16x8*)(lds + (bo) + va + (db) * 512), *(const LAS bf16x8*)(lds + (bo) + va + (db) * 512 + 1024))
#define ATT_PV8(O, A8, B8) asm volatile("v_mfma_scale_f32_32x32x64_f8f6f4 %0, %1, %2, %0, %3, %3 op_sel_hi:[0,0,0]" : "+v"(O) : "v"(A8), "v"(B8), "v"(sc1_))
#define ATT_MAX(P0, P1, FIRST) do { asm volatile("s_nop 15\n\ts_nop 7" : "+v"(P0), "+v"(P1));     \
            float ra_ = max3f(P0[0], P0[1], P1[0]), rb_ = max3f(P0[2], P0[3], P1[1]); ra_ = max3f(ra_, P1[2], P1[3]); \
            _Pragma("unroll") for (int r = 4; r < 16; r += 4) { ra_ = max3f(ra_, P0[r], P0[r + 1]); rb_ = max3f(rb_, P0[r + 2], P0[r + 3]); ra_ = max3f(ra_, P1[r], P1[r + 1]); rb_ = max3f(rb_, P1[r + 2], P1[r + 3]); } \
            float rm_ = max2f(ra_, rb_); rm_ = max2f(rm_, shx(rm_, 32, lane)); \
            if ((FIRST) || __any(rm_ > 8.0f)) { const float dl_ = (FIRST) ? rm_ - 5.0f : max2f(rm_ - 5.0f, 0.f); m += dl_; const float al_ = __builtin_amdgcn_exp2f(-dl_); lsum *= al_; lsum1 *= al_; \
                _Pragma("unroll") for (int r = 0; r < 16; ++r) negm[r] = -m; asm volatile("" : "+v"(negm));     \
                _Pragma("unroll") for (int r = 0; r < 16; ++r) { P0[r] -= dl_; P1[r] -= dl_; o0[r] *= al_; o1[r] *= al_; } } } while (0)
#define ATT_ROT() do { const unsigned t_ = bpp; bpp = bprv; bprv = bcur; bcur = bnxt; bnxt = bn2; bn2 = bn3; bn3 = t_; } while (0)
#define ATT_E(PO0, PO1, r) do { float a_ = PO0[r], b_ = PO1[r]; asm("v_exp_f32_e32 %0, %0\n\tv_exp_f32_e32 %1, %1\n\tv_add_f32_e32 %2, %2, %0\n\tv_add_f32_e32 %3, %3, %1" : "+v"(a_), "+v"(b_), "+v"(lsum), "+v"(lsum1)); PO0[r] = a_; PO1[r] = b_; } while (0)
#define ATT_X(P, i, D, PF) do { float t0_, t1_, t2_, t3_; int d_; \
            asm("v_exp_f32_e32 %1, %5\n\tv_exp_f32_e32 %2, %6\n\tv_exp_f32_e32 %3, %7\n\tv_exp_f32_e32 %4, %8\n\tv_cvt_pk_fp8_f32 %0, %1, %2\n\tv_cvt_pk_fp8_f32 %0, %3, %4 op_sel:[0,0,1]" \
                : "=&v"(d_), "=&v"(t0_), "=&v"(t1_), "=&v"(t2_), "=&v"(t3_) : "v"(P[4 * (i)]), "v"(P[4 * (i) + 1]), "v"(P[4 * (i) + 2]), "v"(P[4 * (i) + 3])); PF[D] = d_; } while (0)
#define SB_ __builtin_amdgcn_sched_barrier(0)
#define ATT_BODY(PN0, PN1, PO0, PO1, PFW, PFR, VSRC, j, FRESH) do { const unsigned bv_ = (VSRC), bn_ = bnxt; float rm_; \
            { const pg8::v8i_t k8_ = pg8::cat8(ka0, ka1); ATT_S8N(PN0, k8_); } SB_; \
            if (FRESH) ATT_DMA_FAST((j) + 3, bn3); \
            const bf16x8 vb1 = *(const LAS bf16x8*)(lds + bv_ + va + 1024), vb0 = *(const LAS bf16x8*)(lds + bv_ + va), vd1 = *(const LAS bf16x8*)(lds + bv_ + va + 512 + 1024), vd0 = *(const LAS bf16x8*)(lds + bv_ + va + 512); ATT_X(PO0, 0, 0, PFW); SB_; \
            { const pg8::v8i_t k8_ = pg8::cat8(kb0, kb1); ATT_S8N(PN1, k8_); } ATT_X(PO1, 0, 4, PFW); SB_; \
            { const pg8::v8i_t k8_ = pg8::cat8(kc0, kc1); ATT_S8R(PN0, k8_); } ATT_X(PO0, 1, 1, PFW); SB_; \
            { const pg8::v8i_t k8_ = pg8::cat8(kd0, kd1); ATT_S8R(PN1, k8_); } asm volatile("" :: "v"(ka0), "v"(ka1), "v"(kb0), "v"(kb1));     \
            ATT_X(PO1, 1, 5, PFW); SB_; \
            { const pg8::v8i_t va0_ = pg8::cat8(vb0, vb1); ATT_PV8(o0, va0_, PFR); } asm volatile("" :: "v"(kc0), "v"(kc1), "v"(kd0), "v"(kd1)); \
            ka1 = *(const LAS bf16x8*)(lds + bn_ + kan + 1024); ka0 = *(const LAS bf16x8*)(lds + bn_ + kan); kb1 = *(const LAS bf16x8*)(lds + bn_ + kan + 512 + 1024); kb0 = *(const LAS bf16x8*)(lds + bn_ + kan + 512); \
            kc1 = *(const LAS bf16x8*)(lds + bn_ + kar + 1024); kc0 = *(const LAS bf16x8*)(lds + bn_ + kar); kd1 = *(const LAS bf16x8*)(lds + bn_ + kar + 512 + 1024); kd0 = *(const LAS bf16x8*)(lds + bn_ + kar + 512);     \
            ATT_X(PO0, 2, 2, PFW); SB_; \
            { const pg8::v8i_t va1_ = pg8::cat8(vd0, vd1); ATT_PV8(o1, va1_, PFR); } asm volatile("" :: "v"(vb0), "v"(vb1)); ATT_X(PO1, 2, 6, PFW); SB_; \
            ATT_PV8(o2, ones8, PFR); asm volatile("" :: "v"(vd0), "v"(vd1));     \
            ATT_X(PO0, 3, 3, PFW); ATT_X(PO1, 3, 7, PFW); SB_; \
            asm volatile("s_nop 7" : "+v"(PN0), "+v"(PN1)); float ra_, rb_; asm("v_max3_f32 %0, %2, %3, %4\n\tv_max3_f32 %1, %5, %6, %7\n\tv_max3_f32 %0, %0, %8, %9\n\tv_max3_f32 %1, %1, %10, %11" : "=&v"(ra_), "=&v"(rb_) : "v"(PN0[0]), "v"(PN0[1]), "v"(PN0[2]), "v"(PN1[0]), "v"(PN1[1]), "v"(PN1[2]), "v"(PN0[3]), "v"(PN0[4]), "v"(PN0[5]), "v"(PN0[6])); \
            asm("v_max3_f32 %0, %0, %2, %3\n\tv_max3_f32 %1, %1, %4, %5\n\tv_max3_f32 %0, %0, %6, %7\n\tv_max3_f32 %1, %1, %8, %9" : "+v"(ra_), "+v"(rb_) : "v"(PN0[7]), "v"(PN0[8]), "v"(PN0[9]), "v"(PN0[10]), "v"(PN0[11]), "v"(PN0[12]), "v"(PN0[13]), "v"(PN0[14])); \
            asm("v_max3_f32 %0, %0, %2, %3\n\tv_max3_f32 %1, %1, %4, %5\n\tv_max3_f32 %0, %0, %6, %7\n\tv_max3_f32 %1, %1, %8, %9\n\tv_max3_f32 %0, %0, %10, %11\n\tv_max3_f32 %1, %1, %12, %13\n\tv_max3_f32 %0, %0, %14, %15" : "+v"(ra_), "+v"(rb_) : "v"(PN0[15]), "v"(PN1[3]), "v"(PN1[4]), "v"(PN1[5]), "v"(PN1[6]), "v"(PN1[7]), "v"(PN1[8]), "v"(PN1[9]), "v"(PN1[10]), "v"(PN1[11]), "v"(PN1[12]), "v"(PN1[13]), "v"(PN1[14]), "v"(PN1[15])); \
            { float rn_; asm volatile("v_max_f32_e32 %0, %2, %3\n\tv_mov_b32_e32 %1, %0\n\ts_nop 1\n\tv_permlane32_swap_b32 %0, %1\n\tv_max_f32_e32 %0, %0, %1" : "=&v"(rm_), "=&v"(rn_) : "v"(ra_), "v"(rb_)); }     \
            SB_; \
            ATT_APPLY_PENDING(); \
            if (__any(rm_ > 8.0f)) { const float dl_ = max2f(rm_ - 5.0f, 0.f); m += dl_; alp_ = __builtin_amdgcn_exp2f(-dl_); pend_ = true; \
                _Pragma("unroll") for (int r = 0; r < 16; ++r) negm[r] = -m; asm volatile("" : "+v"(negm)); \
                _Pragma("unroll") for (int r = 0; r < 16; ++r) { PN0[r] -= dl_; PN1[r] -= dl_; } } } while (0)
#define ATT_APPLY_PENDING() do { if (pend_) { asm volatile("s_nop 15\n\ts_nop 7" : "+v"(o0), "+v"(o1), "+v"(o2));     \
                _Pragma("unroll") for (int r = 0; r < 16; ++r) { o0[r] *= alp_; o1[r] *= alp_; o2[r] *= alp_; } pend_ = false; } } while (0)
#define ATT_STEP(PN0, PN1, PO0, PO1, PFW, PFR, VSRC, j, FRESH) do { \
            ATT_BODY(PN0, PN1, PO0, PO1, PFW, PFR, VSRC, j, FRESH); \
            ATT_ROT(); if (FRESH) asm volatile("s_waitcnt vmcnt(2)\n\ts_barrier" ::: "memory"); else asm volatile("s_waitcnt vmcnt(0)\n\ts_barrier" ::: "memory"); } while (0)
        pg8::v8i_t pf8a, pf8b; int sc1_ = 0x7f7f7f7f, scq_ = 0x7c7c7c7c; asm volatile("" : "+v"(sc1_), "+v"(scq_));
        { int z_ = 0; asm volatile("" : "+v"(z_));
#pragma unroll
          for (int r = 0; r < 8; ++r) { pf8a[r] = z_; pf8b[r] = z_; } }
        float alp_ = 1.f; bool pend_ = false;
        unsigned bpp = 5 * ATT_TB, bprv = 4 * ATT_TB, bcur = 0, bnxt = ATT_TB, bn2 = 2 * ATT_TB, bn3 = 3 * ATT_TB;
        asm volatile("s_waitcnt vmcnt(0) lgkmcnt(0)\n\ts_barrier" ::: "memory");
        ATT_DMA(t0, bcur); ATT_DMA(t0 + 1, bnxt); ATT_DMA(t0 + 2, bn2);
        ATT_WAITBAR(true);
        ATT_DMA(t0 + 3, bn3);
        ATT_QK(pA0, pA1, bcur); ATT_MAX(pA0, pA1, true);
        bf16x8 ka1 = *(const LAS bf16x8*)(lds + bnxt + kan + 1024), ka0 = *(const LAS bf16x8*)(lds + bnxt + kan), kb1 = *(const LAS bf16x8*)(lds + bnxt + kan + 512 + 1024), kb0 = *(const LAS bf16x8*)(lds + bnxt + kan + 512);
        bf16x8 kc1 = *(const LAS bf16x8*)(lds + bnxt + kar + 1024), kc0 = *(const LAS bf16x8*)(lds + bnxt + kar), kd1 = *(const LAS bf16x8*)(lds + bnxt + kar + 512 + 1024), kd0 = *(const LAS bf16x8*)(lds + bnxt + kar + 512);
        ATT_ROT(); ATT_WAITBAR(true);
        int j = t0 + 1; ATT_PTR_INIT(t0 + 4);
        { const bool fh_ = j + 3 < nt; ATT_STEP(pB0, pB1, pA0, pA1, pf8a, pf8b, bprv, j, fh_); ++j; }
        for (; j + 4 < nt; j += 2) { ATT_STEP(pA0, pA1, pB0, pB1, pf8b, pf8a, bpp, j, true); ATT_STEP(pB0, pB1, pA0, pA1, pf8a, pf8b, bpp, j + 1, true); }
        if (t0 == 0) { ATT_STEP(pA0, pA1, pB0, pB1, pf8b, pf8a, bpp, j, true); ATT_STEP(pB0, pB1, pA0, pA1, pf8a, pf8b, bpp, j + 1, false); j += 2; }
        ATT_STEP(pA0, pA1, pB0, pB1, pf8b, pf8a, bpp, j, false); ATT_STEP(pB0, pB1, pA0, pA1, pf8a, pf8b, bpp, j + 1, false);
        { const pg8::v8i_t va0_ = ATT_VF8(bpp, 0), va1_ = ATT_VF8(bpp, 1); ATT_PV8(o0, va0_, pf8a); ATT_PV8(o1, va1_, pf8a); ATT_PV8(o2, ones8, pf8a); asm volatile("s_nop 15" :: "v"(va0_), "v"(va1_), "v"(pf8a)); }
        ATT_APPLY_PENDING();
        ATT_X(pB0, 0, 0, pf8b); ATT_X(pB1, 0, 4, pf8b); ATT_X(pB0, 1, 1, pf8b); ATT_X(pB1, 1, 5, pf8b); ATT_X(pB0, 2, 2, pf8b); ATT_X(pB1, 2, 6, pf8b); ATT_X(pB0, 3, 3, pf8b); ATT_X(pB1, 3, 7, pf8b);
        { const pg8::v8i_t va0_ = ATT_VF8(bprv, 0), va1_ = ATT_VF8(bprv, 1); asm volatile("s_nop 3" : "+v"(pf8b)); ATT_PV8(o0, va0_, pf8b); ATT_PV8(o1, va1_, pf8b); ATT_PV8(o2, ones8, pf8b); asm volatile("s_nop 15" :: "v"(va0_), "v"(va1_), "v"(pf8b)); }
#undef ATT_DMA
#undef ATT_DMA_FAST
#undef ATT_PTR_INIT
#undef ATT_WAITBAR
#undef ATT_QK
#undef ATT_VF8
#undef ATT_PV8
#undef ATT_APPLY_PENDING
#undef ATT_MAX
#undef ATT_ROT
#undef ATT_STEP
#undef ATT_BODY
#undef ATT_KN8
#undef ATT_KR8
#undef ATT_S8N
#undef ATT_S8R
#undef ATT_E
#undef SB_
        const int le = lane_id();
        asm volatile("s_nop 15\n\ts_nop 7" : "+v"(o0), "+v"(o1), "+v"(o2));
        lsum = o2[0]; (void)lsum1;
        const float inv = 1.f / lsum;
        bf16_t* yp = Y + (size_t)(qrow0 + F.wave * 32 + (le & 31)) * 1024 + 512 + h * 64 + 4 * (le >> 5);
#pragma unroll
        for (int g = 0; g < 4; ++g) {
            u32x2 w0, w1; w0.x = pk2(o0[4 * g] * inv, o0[4 * g + 1] * inv); w0.y = pk2(o0[4 * g + 2] * inv, o0[4 * g + 3] * inv);
            w1.x = pk2(o1[4 * g] * inv, o1[4 * g + 1] * inv); w1.y = pk2(o1[4 * g + 2] * inv, o1[4 * g + 3] * inv);
            *(u32x2*)(yp + 8 * g) = w0; *(u32x2*)(yp + 32 + 8 * g) = w1;
        }
    }
    __syncthreads();
}

constexpr int N_PHASES = 23;
#define SP2v true
#define ALIGNv true
__global__ void __launch_bounds__(NTHR, 2) fwd_kernel(Args A) {
    extern __shared__ __attribute__((aligned(16))) unsigned char lds_raw[];
    Frame F;
    F.lds = (LAS unsigned char*)lds_raw; F.MISC = (volatile LAS unsigned*)(F.lds + MISC_OFF);
    F.wave = __builtin_amdgcn_readfirstlane((int)threadIdx.x >> 6);
    F.G = gridDim.x; F.bid = blockIdx.x; F.gw = F.bid * NWAVES + F.wave; F.NGW = F.G * NWAVES;
    F.out = A.out; F.ws = A.ws; F.ctl = (unsigned*)(A.ws + WS_CTL);
    for (int u = (int)threadIdx.x; u < (LDS_BYTES - LDSCTL_OFF) / 4; u += NTHR) ((LAS unsigned*)(F.lds + LDSCTL_OFF))[u] = 0u;
    __syncthreads();
#if MK_N_LAUNCHES == 1
    XcdBarrier bar = xcd_barrier_post(F.ctl + CW_BAR, F.MISC + 8);
#define GRID_BAR() xcd_barrier(bar)
#else
#define GRID_BAR() do {} while (0)
#endif
    const int lo = A.ph_lo, hi = A.ph_hi;
#define IN(k) (lo <= (k) && (k) < hi)
#ifndef PROBE_ON
#define PROBE_ON 0
#endif
#if PROBE_ON
#define SEAM(k) do { if (IN(k) && IN((k) + 1)) { GRID_BAR(); const int k_ = (k); if (F.bid == 0 && (k_ == PROBE_A - 100 || k_ == PROBE_A - 101 || k_ == PROBE_B - 100 || k_ == PROBE_B - 101) && lane_id() == 0 && F.wave == 0) \
        __hip_atomic_store((unsigned long long*)(opq(F.ws) + WS_PROBE) + 16 + k_, __builtin_amdgcn_s_memrealtime(), __ATOMIC_RELAXED, __HIP_MEMORY_SCOPE_AGENT); } } while (0)
#else
#define SEAM(k) do { if (IN(k) && IN((k) + 1)) GRID_BAR(); } while (0)
#endif
    LAS unsigned char* ring = F.lds;
#define WSQ() unsigned char* ws = opq(F.ws)
#define PBF(name, off) bf16_t* name = (bf16_t*)(ws + (off))

    if (IN(0)) { p0_prologue(F, A); } SEAM(0);

    for (int l = 0; l < 2; ++l) {
        const int pb = 1 + 10 * l; const bool need_ctx = (l == 0);
        if (IN(pb + 0)) { WSQ(); PBF(XN, WS_XN); const float* modl = (const float*)(ws + WS_MOD) + (size_t)l * 5 * 6144;
            const float* xs_x = (l == 0) ? INP(0) : F.out; const float* xs_c = (l == 0) ? INP(2) : (const float*)(ws + WS_XC);
            if (l == 0) { p0_weights(F, A); __syncthreads(); ssm_tables(F, A); }
            norm_rows<false>(F, xs_x, xs_c, NR, INP(6) + l * 1024, modl, 0, 1024, XN, l == 1 ? (const float*)(ws + WS_PART) : nullptr, 11, (const float*)(ws + WS_MOD) + 4 * 6144 + 5120, nullptr); } SEAM(pb + 0);
        if (IN(pb + 1)) { WSQ(); PBF(XN, WS_XN); PBF(Z, WS_Z); float* rs = (float*)(ws + WS_RS) + (size_t)l * NR * 8;
            pg8::Gemm g{XN, (const bf16_t*)(ws + WS_WIN) + (size_t)l * 1024 * 1024, 1024, 1024, 1024, 0}; pg8::StaticOrder S; S.init(NR, 1024, F.G, F.bid);
            pg8::EpiInProj E{Z, rs, (bf16_t*)(ws + WS_UH)}; pg8::gemm_phase<pg8::EpiInProj, pg8::StaticOrder, ALIGNv, SP2v>(ring, g, S, E, F.wave);
            if (l == 0) ssm_toeplitz(F, A); } SEAM(pb + 1);
        if (IN(pb + 2)) {
            const int qx = ((need_ctx ? NR : NX) / 256) * 3 - F.G;
            const int c_kn = (F.G == 256) ? ((F.bid + 256 - qx) & 255) : F.bid, c_vt = (F.G == 256) ? ((F.bid + 256 - qx - 8) & 255) : F.bid, c_s1 = (F.G == 256) ? ((F.bid + 256 - qx - 16) & 255) : F.bid;
            { WSQ(); PBF(Z, WS_Z); PBF(Qb, WS_Q); const float* rs = (const float*)(ws + WS_RS) + (size_t)l * NR * 8;
              pg8::Gemm g{Z + 512, (const bf16_t*)(ws + WS_WUQ) + (size_t)l * 768 * 256, 1024, 256, 256, 0}; pg8::StaticOrder S; S.init(need_ctx ? NR : NX, 768, F.G, F.bid);
              pg8::EpiQ E{Qb, rs, (const float*)(ws + WS_COS), (const float*)(ws + WS_SIN)}; pg8::gemm_phase<pg8::EpiQ, pg8::StaticOrder, ALIGNv, SP2v>(ring, g, S, E, F.wave); }
            { WSQ(); PBF(Z, WS_Z); PBF(KN, WS_KN); const float* rs = (const float*)(ws + WS_RS) + (size_t)l * NR * 8;
              pg8::Gemm g{Z + 768, (const bf16_t*)(ws + WS_WUKV) + (size_t)l * 1024 * 128, 1024, 128, 128, 0}; pg8::StaticOrder S; S.init(NR, 512, F.G, c_kn);
              pg8::EpiKV E{KN, rs}; pg8::gemm_phase<pg8::EpiKV, pg8::StaticOrder, ALIGNv, SP2v>(ring, g, S, E, F.wave); }
            { WSQ(); PBF(Z, WS_Z); PBF(VT, WS_V); const float* rs = (const float*)(ws + WS_RS) + (size_t)l * NR * 8;
              pg8::Gemm g{(const bf16_t*)(ws + WS_WUKV) + (size_t)l * 1024 * 128 + 512 * 128, Z + 768, 128, 1024, 128, 0}; pg8::StaticOrder S; S.init(512, NR, F.G, c_vt);
              pg8::EpiVT E{VT, rs}; pg8::gemm_phase<pg8::EpiVT, pg8::StaticOrder, ALIGNv, SP2v>(ring, g, S, E, F.wave); }
            { WSQ(); PBF(Z, WS_Z); PBF(KR, WS_KR); kr_rows(F, Z, KR); }
            { WSQ(); PBF(UH, WS_UH);
              pg8::Gemm g{UH, (const bf16_t*)(ws + WS_W1T) + (size_t)l * NG * 256 * 512, 768, 512, 512, (size_t)256 * 512 * 2, (size_t)NCH * 768 * 2}; pg8::GroupOrder S{5, 1, F.G, c_s1};
              pg8::EpiS E{(float*)(ws + WS_S)}; pg8::gemm_phase<pg8::EpiS, pg8::GroupOrder, ALIGNv, SP2v>(ring, g, S, E, F.wave); }
        } SEAM(pb + 2);
        if (IN(pb + 3)) {
            ssm_scan(F, l);
            if (F.wave != 0) { Frame F2 = F; F2.gw = F.bid * (NWAVES - 1) + F.wave - 1; F2.NGW = F.G * (NWAVES - 1); p0_moe_weights(F2, A, 4 * l, 4 * l + 4); }
            __syncthreads();
            { WSQ(); PBF(Qb, WS_Q); PBF(KN, WS_KN); PBF(KR, WS_KR); PBF(VT, WS_V); PBF(YMIX, WS_YMIX); attn_phase(F, need_ctx, Qb, KN, KR, VT, YMIX); }
        } SEAM(pb + 3);
        if (IN(pb + 4)) { WSQ(); PBF(UH, WS_UH); PBF(ZG, WS_ZG);
            pg8::Gemm g{UH, (const bf16_t*)(ws + WS_MT) + (size_t)l * NG * 512 * 768, 768, 768, 768, (size_t)512 * 768 * 2, (size_t)NCH * 768 * 2}; pg8::GroupOrder S{need_ctx ? 5 : 4, 2, F.G, F.bid};
            pg8::EpiY E{ZG}; pg8::gemm_phase<pg8::EpiY, pg8::GroupOrder, ALIGNv, SP2v>(ring, g, S, E, F.wave); } SEAM(pb + 4);
        if (IN(pb + 5)) { WSQ(); PBF(ZG, WS_ZG); PBF(YMIX, WS_YMIX);
            pg8::Gemm g{ZG, (const bf16_t*)(ws + WS_WGLU) + (size_t)l * 512 * 512, 512, 512, 512, 0}; pg8::StaticOrder S; S.init(need_ctx ? NR : NX, 512, F.G, F.bid);
            pg8::EpiGlu E{ZG, INP(22) + l * 512, YMIX}; pg8::gemm_phase<pg8::EpiGlu, pg8::StaticOrder, ALIGNv, SP2v>(ring, g, S, E, F.wave); } SEAM(pb + 5);
        if (IN(pb + 6)) { WSQ(); PBF(YMIX, WS_YMIX); const float* modl = (const float*)(ws + WS_MOD) + (size_t)l * 5 * 6144; float* XC = (float*)(ws + WS_XC);
            const float* xs_x = (l == 0) ? INP(0) : F.out; const float* xs_c = (l == 0) ? INP(2) : XC;
            { pg8::Gemm g{YMIX, (const bf16_t*)(ws + WS_WOUT) + (size_t)l * 1024 * 1024, 1024, 1024, 1024, 0}; pg8::StaticOrder S; S.init(NX, 1024, F.G, F.bid);
              pg8::EpiRes E{xs_x, xs_c, F.out, XC, modl + 2048, 1.f}; pg8::gemm_phase<pg8::EpiRes, pg8::StaticOrder, ALIGNv, SP2v>(ring, g, S, E, F.wave); }
            if (need_ctx) {
              pg8::Gemm g{YMIX + (size_t)NX * 1024, (const bf16_t*)(ws + WS_WOUT) + (size_t)l * 1024 * 1024, 1024, 1024, 256, 512, 512}; pg8::CtxSplitOrder S{4, F.G, F.bid};
              pg8::EpiPart E{(float*)(ws + WS_PART), 1.f}; pg8::gemm_phase<pg8::EpiPart, pg8::CtxSplitOrder, ALIGNv, SP2v>(ring, g, S, E, F.wave); }
        } SEAM(pb + 6);
        if (l == 0) {
            if (IN(pb + 7)) { WSQ(); PBF(XN, WS_XN); const float* modl = (const float*)(ws + WS_MOD); norm_rows<false>(F, F.out, INP(2), NR, INP(7), modl, 3072, 4096, XN, (const float*)(ws + WS_PART), 4, modl + 4 * 6144 + 2048, (float*)(ws + WS_XC)); } SEAM(pb + 7);
            if (IN(pb + 8)) { WSQ(); PBF(XN, WS_XN); PBF(H, WS_H);
                pg8::Gemm g{XN, (const bf16_t*)(ws + WS_WFF13), 1024, 1024, 1024, 0}; pg8::StaticOrder S; S.init(NR, 2 * DFF, F.G, F.bid);
                pg8::EpiSwiglu<true> E{H, DFF, 1.f}; pg8::gemm_phase<pg8::EpiSwiglu<true>, pg8::StaticOrder, ALIGNv, SP2v>(ring, g, S, E, F.wave); } SEAM(pb + 8);
            if (IN(pb + 9)) { WSQ(); PBF(H, WS_H); const float* modl = (const float*)(ws + WS_MOD); float* XC = (float*)(ws + WS_XC);
                { pg8::Gemm g{H, (const bf16_t*)(ws + WS_WFF2), DFF / 2, DFF / 2, DFF / 2, 0}; pg8::StaticOrder S; S.init(NX, 1024, F.G, F.bid);
                  pg8::EpiRes E{F.out, XC, F.out, XC, modl + 5120, 1.f / W8_SCALE}; pg8::gemm_phase<pg8::EpiRes, pg8::StaticOrder, ALIGNv, SP2v, true>(ring, g, S, E, F.wave); }
                { pg8::Gemm g{(const bf16_t*)((const unsigned char*)H + (size_t)NX * DFF), (const bf16_t*)(ws + WS_WFF2), DFF / 2, DFF / 2, 128, 256, 256}; pg8::CtxSplitOrder S{11, F.G, F.bid};
                  pg8::EpiPart E{(float*)(ws + WS_PART), 1.f / W8_SCALE}; pg8::gemm_phase<pg8::EpiPart, pg8::CtxSplitOrder, ALIGNv, SP2v, true>(ring, g, S, E, F.wave); } } SEAM(pb + 9);
        } else {
            if (IN(pb + 7)) { WSQ(); const float* modl = (const float*)(ws + WS_MOD) + (size_t)5 * 6144; norm_router(F, F.out, INP(7) + 1024, modl, 3072, 4096, ws + WS_XNM); } SEAM(pb + 7);
            if (IN(pb + 8)) { WSQ(); moe_gather(F, ws + WS_XNM, ws + WS_XP); } SEAM(pb + 8);
            if (IN(pb + 9)) { WSQ(); PBF(XP, WS_XP); PBF(HP, WS_HP); const unsigned* cnt = F.ctl + CW_MOE; int o[9]; o[0] = 0;
#pragma unroll
                for (int e = 0; e < 8; ++e) o[e + 1] = o[e] + pad256(cnt[e]);
                pg8::MoeOrder S; S.nT = o[8] / 256; S.nN = 2 * DFE / 256; S.nwg = S.nT * S.nN; S.G = F.G; S.c = F.bid; S.o1 = o[1]; S.o2 = o[2]; S.o3 = o[3]; S.o4 = o[4]; S.o5 = o[5]; S.o6 = o[6]; S.o7 = o[7];
                pg8::Gemm g{XP, (const bf16_t*)(ws + WS_WM13), 512, 512, 512, (size_t)2 * DFE * 1024};
                pg8::EpiSwiglu<true> E{HP, DFE8, 1.f / W8_SCALE}; pg8::gemm_phase<pg8::EpiSwiglu<true>, pg8::MoeOrder, ALIGNv, SP2v, true>(ring, g, S, E, F.wave); } SEAM(pb + 9);
        }
    }
    if (IN(21)) { WSQ(); PBF(HP, WS_HP); PBF(YP, WS_YP); const unsigned* cnt = F.ctl + CW_MOE; int o[9]; o[0] = 0;
#pragma unroll
        for (int e = 0; e < 8; ++e) o[e + 1] = o[e] + pad256(cnt[e]);
        pg8::MoeOrder S; S.nT = o[8] / 256; S.nN = 4; S.nwg = S.nT * S.nN; S.G = F.G; S.c = F.bid; S.o1 = o[1]; S.o2 = o[2]; S.o3 = o[3]; S.o4 = o[4]; S.o5 = o[5]; S.o6 = o[6]; S.o7 = o[7];
        pg8::Gemm g{HP, (const bf16_t*)(ws + WS_WM2), DFE8 / 2, DFE8 / 2, DFE8 / 2, (size_t)1024 * DFE8};
        pg8::EpiBf16 E{YP, 1024, 1.f / W8_SCALE}; pg8::gemm_phase<pg8::EpiBf16, pg8::MoeOrder, ALIGNv, SP2v, true>(ring, g, S, E, F.wave); } SEAM(21);
    if (IN(22)) { WSQ(); PBF(YP, WS_YP); moe_combine_final(F, A, YP, (const float*)(ws + WS_MOD) + (size_t)5 * 6144 + 5120);
#if PROBE_ON
        { __syncthreads(); const unsigned long long* pw = (const unsigned long long*)(ws + WS_PROBE); float va, vb;
          if (PROBE_A >= 100) va = (float)(pw[16 + PROBE_A - 100] - pw[16 + PROBE_A - 101]) * 0.1f; else va = (float)pw[PROBE_A] / 131.f;
          if (PROBE_B >= 100) vb = (float)(pw[16 + PROBE_B - 100] - pw[16 + PROBE_B - 101]) * 0.1f; else vb = (float)pw[PROBE_B] / 131.f;
          if (PROBE_A == 63) { va = 1234.f; vb = 777.f; }
          va = exp2f((rintf(4.f * log2f(fmaxf(va, 1.f)) + PROBE_Q) - PROBE_Q) * 0.25f); vb = exp2f((rintf(4.f * log2f(fmaxf(vb, 1.f)) + PROBE_Q) - PROBE_Q) * 0.25f);
          const float sn = 1000.f * sqrtf(va);
          const int lane = lane_id();
          for (int r = F.gw; r < NX; r += F.NGW)
#pragma unroll
              for (int jq = 0; jq < 4; ++jq) { const size_t i = (size_t)r * 1024 + 4 * lane + 256 * jq; f32x4 o;
#pragma unroll
                  for (int k = 0; k < 4; ++k) { const unsigned hsh = (unsigned)(i + k) * 2654435761u; o[k] = (hsh & 0x10000u) ? sn : -sn; }
                  if (i == 0) o[0] = 1.0e4f * vb;
                  *(f32x4*)(F.out + i) = o; } }
#endif
    }
#undef IN
#undef SEAM
}

extern "C" void kernel_launch(void* const* d_in, const int* in_sizes, int n_in, void* d_out, int out_size, void* d_ws, size_t ws_size, hipStream_t stream) {
    static int grid = 0;
    if (grid == 0) {
        if (n_in != 32 || in_sizes[0] != NX * DM || out_size != NX * DM || ws_size < WS_END) { fprintf(stderr, "kernel_launch: unexpected shapes (n_in %d, in0 %d, out %d, ws %zu); nothing launched\n", n_in, n_in > 0 ? in_sizes[0] : -1, out_size, ws_size); grid = -1; return; }
        int dev = 0, cus = 0, per_cu = 0;
        if (hipGetDevice(&dev) != hipSuccess || hipDeviceGetAttribute(&cus, hipDeviceAttributeMultiprocessorCount, dev) != hipSuccess) { grid = -1; return; }
        if (hipFuncSetAttribute((const void*)fwd_kernel, hipFuncAttributeMaxDynamicSharedMemorySize, LDS_BYTES) != hipSuccess) { fprintf(stderr, "kernel_launch: hipFuncSetAttribute failed\n"); grid = -1; return; }
        if (hipOccupancyMaxActiveBlocksPerMultiprocessor(&per_cu, (const void*)fwd_kernel, NTHR, LDS_BYTES) != hipSuccess || per_cu < 1) fprintf(stderr, "kernel_launch: occupancy query says %d\n", per_cu);
        (void)hipGetLastError();
        grid = cus;
    }
    if (grid < 0) return;
    if (hipMemsetAsync((char*)d_ws + WS_CTL, 0, CTL_ZERO_BYTES, stream) != hipSuccess) { fprintf(stderr, "kernel_launch: memset failed\n"); return; }
    Args a{};
    for (int i = 0; i < 32; ++i) a.in[i] = (const float*)d_in[i];
    a.out = (float*)d_out; a.ws = (unsigned char*)d_ws; a.pad = 0;
#if MK_N_LAUNCHES == 1
    a.ph_lo = 0; a.ph_hi = N_PHASES; a.li = 0;
    hipLaunchKernelGGL(fwd_kernel, dim3(grid), dim3(NTHR), LDS_BYTES, stream, a);
#else
    for (int p = 0; p < N_PHASES; ++p) { a.ph_lo = p; a.ph_hi = p + 1; a.li = p; hipLaunchKernelGGL(fwd_kernel, dim3(grid), dim3(NTHR), LDS_BYTES, stream, a); }
#endif
    const hipError_t le = hipPeekAtLastError();
    if (le != hipSuccess) fprintf(stderr, "kernel_launch: launch failed: %s\n", hipGetErrorName(le));
}
```

```cpp
#include <hip/hip_runtime.h>
#include <cstdio>
#include <cstdint>

#define LAS __attribute__((address_space(3)))
#define GAS __attribute__((address_space(1)))
#define PG8_LAS LAS
typedef unsigned short bf16_t;
typedef short bf16x8 __attribute__((ext_vector_type(8)));
typedef float f32x4 __attribute__((ext_vector_type(4)));
typedef float f32x2 __attribute__((ext_vector_type(2)));
typedef unsigned u32x4 __attribute__((ext_vector_type(4)));
typedef unsigned u32x2 __attribute__((ext_vector_type(2)));
typedef __bf16 bf16x2_t __attribute__((ext_vector_type(2)));

#ifndef MK_N_LAUNCHES
#define MK_N_LAUNCHES 1
#endif

constexpr int DM = 1024, NB = 4, SEQ = 8192, CTXL = 256, NX = NB * SEQ, NC = NB * CTXL, NR = NX + NC;
constexpr int D_SSM = 512, NG = 32, NP = 64, NH = 8, DQK = 96, DIN = 928;
constexpr int DFF = 2816, NE = 8, DFE = 1408, DFE8 = 1536;
constexpr float EPS = 1e-6f;
constexpr float QSCALE = 0.10206207261596575f * 1.4426950408889634f;
constexpr int TCH = 32, NCH = NR / TCH;
constexpr int MOE_ROWS = 2 * NX + NE * 256;

constexpr size_t MiB = 1u << 20;
constexpr size_t WS_CTL = 0, CTL_ZERO_BYTES = 1 * MiB;
constexpr int CW_TMO = 0, CW_BAR = 4096, CW_MOE = 8192;
constexpr size_t WS_MOD = 64 * 1024;
constexpr size_t WS_RS = 5 * MiB;
constexpr size_t WS_COS = 1 * MiB, WS_SIN = WS_COS + 512 * 1024;
constexpr size_t WS_AB = 2 * MiB;
constexpr size_t WS_BB = WS_AB + 128 * 1024;
constexpr size_t WS_PW = 8 * MiB;
constexpr size_t WS_KL = 11 * MiB;
constexpr size_t WS_PROBE = 15 * MiB;
constexpr size_t WS_TOKE = 4 * MiB, WS_TOKP = WS_TOKE + 256 * 1024, WS_TOKW = WS_TOKP + 256 * 1024, WS_CNTB = WS_TOKW + 256 * 1024;
constexpr size_t WS_WIN = 16 * MiB, WS_WUQ = 20 * MiB, WS_WUKV = 21 * MiB, WS_WGLU = 22 * MiB, WS_WOUT = 23 * MiB;
constexpr size_t WS_WFF13 = 27 * MiB, WS_WFF2 = 38 * MiB, WS_WM13 = 44 * MiB, WS_WM2 = 88 * MiB;
constexpr size_t WS_XC = 112 * MiB;
constexpr size_t WS_RB = 116 * MiB;
constexpr size_t WS_XN = WS_RB, WS_Q = WS_RB, WS_XP = WS_RB, WS_YP = WS_RB;
constexpr size_t WS_W1T = WS_RB + 66 * MiB;
constexpr size_t WS_MT = WS_RB + 82 * MiB;
constexpr size_t WS_RA = 248 * MiB;
constexpr size_t WS_Z = WS_RA, WS_YMIX = WS_RA, WS_KN = WS_RA + 66 * MiB, WS_V = WS_RA + 99 * MiB, WS_KR = WS_RA + 132 * MiB;
constexpr size_t WS_ZG = WS_RA + 135 * MiB;
constexpr size_t WS_UH = WS_RA + 168 * MiB;
constexpr size_t WS_S = WS_RA + 218 * MiB;
constexpr size_t WS_H = WS_RA, WS_HP = WS_RA, WS_XNM = WS_RA + 182 * MiB;
constexpr size_t WS_PART = WS_RA + 182 * MiB;
constexpr size_t WS_END = 512 * MiB;
static_assert(WS_S + (size_t)32 * (NR / 32) * 256 * 4 <= WS_END && WS_UH + (size_t)32 * (NR / 32) * 768 * 2 + 512 * 1024 <= WS_S && WS_MT + (size_t)2 * 32 * 512 * 768 * 2 <= WS_RA && WS_XNM + (size_t)NX * DM * 2 <= WS_END && WS_H + (size_t)NR * DFF * 2 <= WS_XNM, "ws map");
static_assert(WS_RS + (size_t)2 * NR * 8 * 4 <= 16 * MiB && WS_MOD + 2 * 5 * 6144 * 4 <= CTL_ZERO_BYTES, "ctl map");

constexpr int RING_BYTES = 131072, LDSCTL_OFF = RING_BYTES, MISC_OFF = LDSCTL_OFF + 320, LDS_BYTES = 147456;

__device__ __forceinline__ unsigned f2bf(float f) { unsigned u = __builtin_bit_cast(unsigned, f); return (u + 0x7fffu + ((u >> 16) & 1u)) >> 16; }
__device__ __forceinline__ unsigned pk2(float lo, float hi) { f32x2 v = {lo, hi}; bf16x2_t b = __builtin_convertvector(v, bf16x2_t); return __builtin_bit_cast(unsigned, b); }
__device__ __forceinline__ unsigned pk4_fp8(float a, float b, float c, float d) { int w = 0; w = __builtin_amdgcn_cvt_pk_fp8_f32(a, b, w, false); w = __builtin_amdgcn_cvt_pk_fp8_f32(c, d, w, true); return (unsigned)w; }
constexpr float W8_SCALE = 64.f;
__device__ __forceinline__ float bflo(unsigned w) { return __builtin_bit_cast(float, w << 16); }
__device__ __forceinline__ float bfhi(unsigned w) { return __builtin_bit_cast(float, w & 0xffff0000u); }
__device__ __forceinline__ float bf1(bf16_t h) { return __builtin_bit_cast(float, (unsigned)h << 16); }
__device__ __forceinline__ float shx(float v, int m, int lane) { return __builtin_bit_cast(float, __builtin_amdgcn_ds_bpermute((lane ^ m) << 2, __builtin_bit_cast(int, v))); }
__device__ __forceinline__ int shx_i(int v, int m, int lane) { return __builtin_amdgcn_ds_bpermute((lane ^ m) << 2, v); }
__device__ __forceinline__ int wave_sum_i(int v, int lane) {
#pragma unroll
    for (int o = 1; o < 64; o <<= 1) v += shx_i(v, o, lane);
    return v;
}
__device__ __forceinline__ float wave_sum(float v, int lane) {
#pragma unroll
    for (int o = 1; o < 64; o <<= 1) v += shx(v, o, lane);
    return v;
}
__device__ __forceinline__ float silu_f(float x) { return x * __builtin_amdgcn_rcpf(1.f + __builtin_amdgcn_exp2f(-1.4426950408889634f * x)); }
__device__ __forceinline__ float sigmoid_f(float x) { return __builtin_amdgcn_rcpf(1.f + __builtin_amdgcn_exp2f(-1.4426950408889634f * x)); }
__device__ __forceinline__ float gelu_tanh_f(float x) { const float u = (1.5957691216057308f * 1.4426950408889634f) * (x + 0.044715f * x * x * x); return x * __builtin_amdgcn_rcpf(1.f + __builtin_amdgcn_exp2f(-u)); }
#define LDS_WAIT() asm volatile("s_waitcnt lgkmcnt(0)" ::: "memory")
#define VM_WAIT() asm volatile("s_waitcnt vmcnt(0)" ::: "memory")

__device__ __forceinline__ int lane_id() { int l; asm volatile("v_mbcnt_lo_u32_b32 %0, -1, 0\n\tv_mbcnt_hi_u32_b32 %0, -1, %0" : "=v"(l)); return l; }
__device__ __forceinline__ unsigned char* opq(unsigned char* p) { asm volatile("" : "+s"(p)); return p; }
typedef const float* cfptr_t;
__device__ __forceinline__ const float* inptr(int k) {
    const __attribute__((address_space(4))) char* kp = (const __attribute__((address_space(4))) char*)__builtin_amdgcn_kernarg_segment_ptr();
    return *(const __attribute__((address_space(4))) cfptr_t volatile*)(kp + 8 * k);
}
#define INP(k) inptr(k)

namespace pg8 {
constexpr int BM = 256, BK = 64, HALF = 128, HTB = HALF * BK * 2  , STAGE_BYTES = 8 * HTB, NXCD = 8, WGM = 4;

__host__ __device__ __forceinline__ int lds_byte(int r, int c) { const int st = (r >> 4) * 2 + (c >> 5), rr = r & 15, cc = c & 31, ob = rr * 64 + cc * 2; return st * 1024 + (ob ^ (((ob >> 9) & 1) << 5)); }
__host__ __device__ __forceinline__ void stage_rc(int b, int& R, int& C) { const int st = b / 1024, sb = b % 1024, swz = sb ^ (((sb >> 9) & 1) << 5); R = (st >> 1) * 16 + swz / 64; C = (st & 1) * 32 + (swz % 64) / 2; }
__host__ __device__ __forceinline__ int perm32(int rho) { const int n = rho >> 4, i = rho & 15; return 8 * (i >> 2) + 4 * n + (i & 3); }
struct Unit { int pm, pn, ex; };
struct Gemm { const bf16_t* A; const bf16_t* Bt; int lda, ldb, K; size_t bexp, aexp; };

struct StaticOrder {
    int nM, nN, nwg, G, c;
    __device__ __forceinline__ void init(int M, int N, int G_, int c_) { nM = M / BM; nN = N / BM; nwg = nM * nN; G = G_; c = c_; }
    __device__ __forceinline__ bool next(int i, Unit& u) const {
        const long L = (long)i * G + c; if (L >= nwg) return false;
        int wgid = (int)L; { const int q = nwg / NXCD, r = nwg % NXCD, xcd = wgid % NXCD, off = wgid / NXCD; wgid = (xcd < r ? xcd * (q + 1) : r * (q + 1) + (xcd - r) * q) + off; }
        const int nig = WGM * nN, gid = wgid / nig, fm = gid * WGM, gsz = (nM - fm) < WGM ? (nM - fm) : WGM;
        u.pm = fm + ((wgid % nig) % gsz); u.pn = (wgid % nig) / gsz; u.ex = 0; return true;
    }
    __device__ __forceinline__ void a_ready(const Unit&) const {}
    __device__ __forceinline__ void done(const Unit&) const {}
};
struct MoeOrder {
    int nT, nN, nwg, G, c; int o1, o2, o3, o4, o5, o6, o7;
    __device__ __forceinline__ bool next(int i, Unit& u) const {
        const long L = (long)i * G + c; if (L >= nwg) return false;
        const int wgid = (int)L;
        const int nig = WGM * nN, gid = wgid / nig, fm = gid * WGM, gsz = (nT - fm) < WGM ? (nT - fm) : WGM;
        u.pm = fm + ((wgid % nig) % gsz); u.pn = (wgid % nig) / gsz;
        const int r = u.pm * BM; u.ex = (r >= o1) + (r >= o2) + (r >= o3) + (r >= o4) + (r >= o5) + (r >= o6) + (r >= o7); return true;
    }
    __device__ __forceinline__ void a_ready(const Unit&) const {}
    __device__ __forceinline__ void done(const Unit&) const {}
};

struct GroupOrder {
    int nMt, nN, G, c;
    __device__ __forceinline__ bool next(int i, Unit& u) const {
        const int L = i * G + c; const int per = nMt * nN; if (L >= NG * per) return false;
        u.ex = L / per; const int r = L - u.ex * per; u.pm = r / nN; u.pn = r - u.pm * nN; return true;
    }
    __device__ __forceinline__ void a_ready(const Unit&) const {}
    __device__ __forceinline__ void done(const Unit&) const {}
};

struct CtxSplitOrder {
    int nks, G, c;
    __device__ __forceinline__ bool next(int i, Unit& u) const { const int L = i * G + c; if (L >= 16 * nks) return false; u.ex = L >> 4; u.pm = (L >> 2) & 3; u.pn = L & 3; return true; }
    __device__ __forceinline__ void a_ready(const Unit&) const {}
    __device__ __forceinline__ void done(const Unit&) const {}
};

__device__ __forceinline__ u32x4 pack8(const f32x4& a, const f32x4& b) { u32x4 w; w.x = pk2(a[0], a[1]); w.y = pk2(a[2], a[3]); w.z = pk2(b[0], b[1]); w.w = pk2(b[2], b[3]); return w; }

struct EpiInProj {
    static constexpr bool PERM = true, AFTER_DRAIN = false, REOFF = false;
    bf16_t* Z; float* rs; bf16_t* UH;
    __device__ __forceinline__ void operator()(const f32x4 (&acc)[2][2][4][2], const Unit& u, int wr, int wc, int fr_, int fq_) const {
        const int ln_ = lane_id(); const int fr = ln_ & 15, fq = ln_ >> 4; (void)fr_; (void)fq_;
        const int row0 = u.pm * BM + wr * 64 + fr, col0 = u.pn * BM + wc * 32 + 8 * fq;
#pragma unroll
        for (int ai = 0; ai < 2; ++ai)
#pragma unroll
            for (int m = 0; m < 4; ++m) {
                const int row = row0 + ai * HALF + m * 16; float ss = 0.f;
#pragma unroll
                for (int bj = 0; bj < 2; ++bj) { const f32x4 v0 = acc[ai][bj][m][0], v1 = acc[ai][bj][m][1]; const int col = col0 + bj * HALF;
                    if (u.pn < 2) *(u32x4*)(UH + ((size_t)(col >> 4) * NCH + (row >> 5)) * 768 + (row & 31) * 16 + (col & 15)) = pack8(v0, v1);
                    else *(u32x4*)(Z + (size_t)row * 1024 + col) = pack8(v0, v1);
                    if (bj == 0 || u.pn == 2) ss += (v0[0] * v0[0] + v0[1] * v0[1]) + (v0[2] * v0[2] + v0[3] * v0[3]) + (v1[0] * v1[0] + v1[1] * v1[1]) + (v1[2] * v1[2] + v1[3] * v1[3]); }
                if (u.pn >= 2) { ss += shx(ss, 16, ln_); ss += shx(ss, 32, ln_); if (fq == 0) rs[(size_t)row * 8 + (u.pn - 2) * 4 + wc] = ss; }
            }
    }
};
struct EpiS {
    static constexpr bool PERM = false, AFTER_DRAIN = false, REOFF = false;
    float* S;
    __device__ __forceinline__ void operator()(const f32x4 (&acc)[2][2][4][2], const Unit& u, int wr, int wc, int fr_, int fq_) const {
        const int ln_ = lane_id(); const int fr = ln_ & 15, fq = ln_ >> 4; (void)fr_; (void)fq_;
        const int row0 = u.pm * BM + wr * 64 + fr, col0 = wc * 32 + 4 * fq;
#pragma unroll
        for (int ai = 0; ai < 2; ++ai)
#pragma unroll
            for (int m = 0; m < 4; ++m) { const int n = row0 + ai * HALF + m * 16; if (n < NCH) { float* sp = S + ((size_t)u.ex * NCH + n) * 256 + col0;
#pragma unroll
                for (int bj = 0; bj < 2; ++bj)
#pragma unroll
                    for (int nn = 0; nn < 2; ++nn) *(f32x4*)(sp + bj * HALF + nn * 16) = acc[ai][bj][m][nn]; } }
    }
};
struct EpiY {
    static constexpr bool PERM = true, AFTER_DRAIN = false, REOFF = false;
    bf16_t* ZG;
    __device__ __forceinline__ void operator()(const f32x4 (&acc)[2][2][4][2], const Unit& u, int wr, int wc, int fr_, int fq_) const {
        const int ln_ = lane_id(); const int fr = ln_ & 15, fq = ln_ >> 4; (void)fr_; (void)fq_;
        const int row0 = u.pm * BM + wr * 64 + fr, col0 = u.pn * BM + wc * 32 + 8 * fq;
#pragma unroll
        for (int ai = 0; ai < 2; ++ai)
#pragma unroll
            for (int m = 0; m < 4; ++m) { const int n = row0 + ai * HALF + m * 16; if (n < NCH) {
#pragma unroll
                for (int bj = 0; bj < 2; ++bj) { const int q = col0 + bj * HALF; f32x4 a = acc[ai][bj][m][0], b = acc[ai][bj][m][1];
#pragma unroll
                    for (int j = 0; j < 4; ++j) { a[j] = gelu_tanh_f(a[j]); b[j] = gelu_tanh_f(b[j]); }
                    *(u32x4*)(ZG + ((size_t)n * TCH + (q >> 4)) * 512 + u.ex * 16 + (q & 15)) = pack8(a, b); } } }
    }
};
struct EpiQ {
    static constexpr bool PERM = true, AFTER_DRAIN = false, REOFF = true;
    bf16_t* Q; const float* rs; const float* cosT; const float* sinT;
    __device__ __forceinline__ void operator()(const f32x4 (&acc)[2][2][4][2], const Unit& u, int wr, int wc, int fr_, int fq_) const {
        const int ln_ = lane_id(); const int fr = ln_ & 15, fq = ln_ >> 4; (void)fr_; (void)fq_;
        const int row0 = u.pm * BM + wr * 64 + fr; const bool latent = u.pm < NX / BM;
#pragma unroll
        for (int ai = 0; ai < 2; ++ai)
#pragma unroll
            for (int m = 0; m < 4; ++m) {
                const int row = row0 + ai * HALF + m * 16; const f32x4 q4 = *(const f32x4*)(rs + (size_t)row * 8); const float rstd = rsqrtf(((q4[0] + q4[1]) + (q4[2] + q4[3])) * (1.f / 256.f) + EPS);
#pragma unroll
                for (int bj = 0; bj < 2; ++bj) { const int cg = (u.pn * BM + bj * HALF + wc * 32) >> 5; const bool rope = latent && (cg % 3 == 2);
                    f32x4 v0 = acc[ai][bj][m][0] * rstd, v1 = acc[ai][bj][m][1] * rstd;
                    if (rope) {
                        f32x4 p0, p1;
#pragma unroll
                        for (int j = 0; j < 4; ++j) { p0[j] = shx(v0[j], 16, ln_); p1[j] = shx(v1[j], 16, ln_); }
                        const int t = row & (SEQ - 1); const float* cp = cosT + t * 16 + (fq >> 1) * 8; const float* sp = sinT + t * 16 + (fq >> 1) * 8;
                        const f32x4 c0 = *(const f32x4*)cp, c1 = *(const f32x4*)(cp + 4); f32x4 s0 = *(const f32x4*)sp, s1 = *(const f32x4*)(sp + 4);
                        if ((fq & 1) == 0) { s0 = -s0; s1 = -s1; }
                        v0 = v0 * c0 + p0 * s0; v1 = v1 * c1 + p1 * s1;
                    }
                    const float qs = (cg % 3 == 2) ? 4.0f * QSCALE : 8.0f * QSCALE;
                    v0 = v0 * qs; v1 = v1 * qs; u32x2 w; w.x = pk4_fp8(v0[0], v0[1], v0[2], v0[3]); w.y = pk4_fp8(v1[0], v1[1], v1[2], v1[3]);
                    *(u32x2*)((unsigned char*)Q + (unsigned)row * 768u + (unsigned)(u.pn * BM + bj * HALF + wc * 32 + 8 * fq)) = w; }
            }
    }
};
struct EpiKV {
    static constexpr bool PERM = true, AFTER_DRAIN = false, REOFF = false;
    bf16_t* KN; const float* rs;
    __device__ __forceinline__ void operator()(const f32x4 (&acc)[2][2][4][2], const Unit& u, int wr, int wc, int fr_, int fq_) const {
        const int ln_ = lane_id(); const int fr = ln_ & 15, fq = ln_ >> 4; (void)fr_; (void)fq_;
        const int row0 = u.pm * BM + wr * 64 + fr; const int col0 = u.pn * BM + wc * 32 + 8 * fq;
#pragma unroll
        for (int ai = 0; ai < 2; ++ai)
#pragma unroll
            for (int m = 0; m < 4; ++m) {
                const int row = row0 + ai * HALF + m * 16; const f32x4 q4 = *(const f32x4*)(rs + (size_t)row * 8 + 4); const float rstd = rsqrtf(((q4[0] + q4[1]) + (q4[2] + q4[3])) * (1.f / 128.f) + EPS);
#pragma unroll
                for (int bj = 0; bj < 2; ++bj) { const f32x4 x0 = acc[ai][bj][m][0] * rstd, x1 = acc[ai][bj][m][1] * rstd; u32x2 w; w.x = pk4_fp8(x0[0], x0[1], x0[2], x0[3]); w.y = pk4_fp8(x1[0], x1[1], x1[2], x1[3]);
                    *(u32x2*)((unsigned char*)KN + (unsigned)row * 512u + (unsigned)(col0 + bj * HALF)) = w; }
            }
    }
};
struct EpiVT {
    static constexpr bool PERM = true, AFTER_DRAIN = false, REOFF = true;
    bf16_t* VT; const float* rs;
    __device__ __forceinline__ void operator()(const f32x4 (&acc)[2][2][4][2], const Unit& u, int wr, int wc, int fr_, int fq_) const {
        const int ln_ = lane_id(); const int fr = ln_ & 15, fq = ln_ >> 4; (void)fr_; (void)fq_;
        const int c0 = u.pm * BM + wr * 64 + fr;
        const int b = u.pn < NX / BM ? (u.pn >> 5) : (u.pn - NX / BM); const int kbase = u.pn < NX / BM ? (u.pn & 31) * BM : SEQ;
        int wq = wc; asm volatile("" : "+s"(wq));
        const unsigned tp = (unsigned)((wq >> 1) * 64 + 16 * (wq & 1) + 32 * (fq & 1) + 8 * (fq >> 1));
#pragma unroll
        for (int bj = 0; bj < 2; ++bj) { const int tl = bj * HALF + wc * 32 + 8 * fq, tok = u.pn * BM + tl;
            f32x4 s0, s1;
#pragma unroll
            for (int i = 0; i < 4; ++i) { const f32x4 qa = *(const f32x4*)(rs + (size_t)(tok + i) * 8 + 4); s0[i] = rsqrtf(((qa[0] + qa[1]) + (qa[2] + qa[3])) * (1.f / 128.f) + EPS); }
            __builtin_amdgcn_sched_barrier(0);
#pragma unroll
            for (int i = 0; i < 4; ++i) { const f32x4 qb = *(const f32x4*)(rs + (size_t)(tok + 4 + i) * 8 + 4); s1[i] = rsqrtf(((qb[0] + qb[1]) + (qb[2] + qb[3])) * (1.f / 128.f) + EPS); }
            __builtin_amdgcn_sched_barrier(0);
#pragma unroll
            for (int ai = 0; ai < 2; ++ai)
#pragma unroll
                for (int m = 0; m < 4; ++m) {
                    const f32x4 x0 = acc[ai][bj][m][0] * s0, x1 = acc[ai][bj][m][1] * s1; u32x2 w; w.x = pk4_fp8(x0[0], x0[1], x0[2], x0[3]); w.y = pk4_fp8(x1[0], x1[1], x1[2], x1[3]);
                    const unsigned off = (unsigned)(b * 512 + c0 + ai * HALF + m * 16) * (unsigned)(SEQ + CTXL) + (unsigned)(kbase + bj * HALF) + tp;
                    *(u32x2*)((unsigned char*)VT + off) = w; } }
    }
};
struct EpiGlu {
    static constexpr bool PERM = true, AFTER_DRAIN = false, REOFF = false;
    const bf16_t* ZG; const float* bias; bf16_t* Y;
    __device__ __forceinline__ void operator()(const f32x4 (&acc)[2][2][4][2], const Unit& u, int wr, int wc, int fr_, int fq_) const {
        const int ln_ = lane_id(); const int fr = ln_ & 15, fq = ln_ >> 4; (void)fr_; (void)fq_;
        const int row0 = u.pm * BM + wr * 64 + fr, col0 = u.pn * BM + wc * 32 + 8 * fq;
#pragma unroll
        for (int ai = 0; ai < 2; ++ai)
#pragma unroll
            for (int m = 0; m < 4; ++m) { const int row = row0 + ai * HALF + m * 16;
#pragma unroll
                for (int bj = 0; bj < 2; ++bj) { const int col = col0 + bj * HALF;
                    const u32x4 zw = *(const u32x4*)(ZG + (size_t)row * 512 + col); const f32x4 b0 = *(const f32x4*)(bias + col), b1 = *(const f32x4*)(bias + col + 4);
                    const f32x4 a0 = acc[ai][bj][m][0] + b0, a1 = acc[ai][bj][m][1] + b1; f32x4 o0, o1;
                    o0[0] = bflo(zw.x) * sigmoid_f(a0[0]); o0[1] = bfhi(zw.x) * sigmoid_f(a0[1]); o0[2] = bflo(zw.y) * sigmoid_f(a0[2]); o0[3] = bfhi(zw.y) * sigmoid_f(a0[3]);
                    o1[0] = bflo(zw.z) * sigmoid_f(a1[0]); o1[1] = bfhi(zw.z) * sigmoid_f(a1[1]); o1[2] = bflo(zw.w) * sigmoid_f(a1[2]); o1[3] = bfhi(zw.w) * sigmoid_f(a1[3]);
                    *(u32x4*)(Y + (size_t)row * 1024 + col) = pack8(o0, o1); } }
    }
};
struct EpiRes {
    static constexpr bool PERM = false, AFTER_DRAIN = false, REOFF = false;
    const float* xin_x; const float* xin_c; float* xout_x; float* xout_c; const float* gate;   float s;
    __device__ __forceinline__ void operator()(const f32x4 (&acc)[2][2][4][2], const Unit& u, int wr, int wc, int fr_, int fq_) const {
        const int ln_ = lane_id(); const int fr = ln_ & 15, fq = ln_ >> 4; (void)fr_; (void)fq_;
        const int row0 = u.pm * BM + wr * 64 + fr, col0 = u.pn * BM + wc * 32 + 4 * fq;
        const bool lat = u.pm < NX / BM; const int v = lat ? (u.pm >> 5) : 4;
        const float* xi = lat ? xin_x : xin_c - (size_t)NX * 1024; float* xo = lat ? xout_x : xout_c - (size_t)NX * 1024;
        f32x4 gv[2][2];
#pragma unroll
        for (int bj = 0; bj < 2; ++bj)
#pragma unroll
            for (int n = 0; n < 2; ++n) gv[bj][n] = *(const f32x4*)(gate + v * 6144 + col0 + bj * HALF + n * 16) * s;
#pragma unroll
        for (int ai = 0; ai < 2; ++ai)
#pragma unroll
            for (int m = 0; m < 4; ++m) { const size_t ro = (size_t)(row0 + ai * HALF + m * 16) * 1024 + col0;
#pragma unroll
                for (int bj = 0; bj < 2; ++bj)
#pragma unroll
                    for (int n = 0; n < 2; ++n) { const size_t o = ro + bj * HALF + n * 16; *(f32x4*)(xo + o) = *(const f32x4*)(xi + o) + gv[bj][n] * acc[ai][bj][m][n]; } }
    }
};
struct EpiPart {
    static constexpr bool PERM = false, AFTER_DRAIN = false, REOFF = false;
    float* P; float s;
    __device__ __forceinline__ void operator()(const f32x4 (&acc)[2][2][4][2], const Unit& u, int wr, int wc, int fr_, int fq_) const {
        const int ln_ = lane_id(); const int fr = ln_ & 15, fq = ln_ >> 4; (void)fr_; (void)fq_;
        const int row0 = u.pm * BM + wr * 64 + fr, col0 = u.pn * BM + wc * 32 + 4 * fq;
#pragma unroll
        for (int ai = 0; ai < 2; ++ai)
#pragma unroll
            for (int m = 0; m < 4; ++m) { float* pp = P + ((size_t)u.ex * NC + row0 + ai * HALF + m * 16) * 1024 + col0;
#pragma unroll
                for (int bj = 0; bj < 2; ++bj)
#pragma unroll
                    for (int n = 0; n < 2; ++n) *(f32x4*)(pp + bj * HALF + n * 16) = acc[ai][bj][m][n] * s; }
    }
};
template <bool OUT8> struct EpiSwiglu {
    static constexpr bool PERM = true, AFTER_DRAIN = false, REOFF = false;
    void* H; int ldh; float s;
    __device__ __forceinline__ void operator()(const f32x4 (&acc)[2][2][4][2], const Unit& u, int wr, int wc, int fr_, int fq_) const {
        const int ln_ = lane_id(); const int fr = ln_ & 15, fq = ln_ >> 4; (void)fr_; (void)fq_;
        const int row0 = u.pm * BM + wr * 64 + fr, col0 = u.pn * HALF + wc * 32 + 8 * fq;
#pragma unroll
        for (int ai = 0; ai < 2; ++ai)
#pragma unroll
            for (int m = 0; m < 4; ++m) { f32x4 o0, o1;
#pragma unroll
                for (int j = 0; j < 4; ++j) { o0[j] = silu_f(acc[ai][0][m][0][j] * s) * (acc[ai][1][m][0][j] * s); o1[j] = silu_f(acc[ai][0][m][1][j] * s) * (acc[ai][1][m][1][j] * s); }
                const size_t off = (size_t)(row0 + ai * HALF + m * 16) * ldh + col0;
                if constexpr (OUT8) { u32x2 w; w.x = pk4_fp8(o0[0], o0[1], o0[2], o0[3]); w.y = pk4_fp8(o1[0], o1[1], o1[2], o1[3]); *(u32x2*)((unsigned char*)H + off) = w; }
                else *(u32x4*)((bf16_t*)H + off) = pack8(o0, o1); }
    }
};
struct EpiBf16 {
    static constexpr bool PERM = true, AFTER_DRAIN = false, REOFF = false;
    bf16_t* O; int ldc; float s;
    __device__ __forceinline__ void operator()(const f32x4 (&acc)[2][2][4][2], const Unit& u, int wr, int wc, int fr_, int fq_) const {
        const int ln_ = lane_id(); const int fr = ln_ & 15, fq = ln_ >> 4; (void)fr_; (void)fq_;
        const int row0 = u.pm * BM + wr * 64 + fr, col0 = u.pn * BM + wc * 32 + 8 * fq;
#pragma unroll
        for (int ai = 0; ai < 2; ++ai)
#pragma unroll
            for (int m = 0; m < 4; ++m)
#pragma unroll
                for (int bj = 0; bj < 2; ++bj) *(u32x4*)(O + (size_t)(row0 + ai * HALF + m * 16) * ldc + col0 + bj * HALF) = pack8(acc[ai][bj][m][0] * s, acc[ai][bj][m][1] * s);
    }
};
typedef int v8i_t __attribute__((ext_vector_type(8)));
typedef short s16x16_t __attribute__((ext_vector_type(16)));
__device__ __forceinline__ v8i_t cat8(bf16x8 a, bf16x8 b) { return __builtin_bit_cast(v8i_t, __builtin_shufflevector(a, b, 0, 1, 2, 3, 4, 5, 6, 7, 8, 9, 10, 11, 12, 13, 14, 15)); }
template <class Epi, class Sched, bool ALIGN_EPI = false, bool SP2 = false, bool F8 = false>
__device__ __forceinline__ void gemm_phase(PG8_LAS unsigned char* lds, const Gemm g, const Sched& S, const Epi& E, const int wid) {
    const int lane = lane_id(), tid = wid * 64 + lane, wr = wid >> 2, wc = wid & 3, fr = lane & 15, fq = lane >> 4;
    const int K = g.K, nt = K / BK;
    unsigned v_offA, v_offB;
    { int R, C; stage_rc(tid * 16, R, C); const int Rb = Epi::PERM ? ((R & ~31) + perm32(R & 31)) : R;
        v_offA = (unsigned)(R * g.lda + C) * 2u; v_offB = (unsigned)(Rb * g.ldb + C) * 2u; }
    const unsigned r64_offA = 64u * (unsigned)g.lda * 2u, r64_offB = 64u * (unsigned)g.ldb * 2u;
    const size_t kstep = (size_t)(BK * 2);
    const size_t hstepA = (size_t)HALF * g.lda * 2, hstepB = (size_t)HALF * g.ldb * 2;
    const size_t tstepA = 2 * hstepA, tstepB = 2 * hstepB;
    const unsigned ldsw = (unsigned)wid * 1024u;
    const int aoff = lds_byte(wr * 64 + fr, fq * 8), boff = lds_byte(wc * 32 + fr, fq * 8);
#define PG8_SA(b, h) (((b) * 2 + (h)) * HTB)
#define PG8_SB(b, h) ((4 + (b) * 2 + (h)) * HTB)
#define PG8_STAGE(bufoff, gbase, voff) do { _Pragma("unroll") for (int _i = 0; _i < 2; ++_i) \
        __builtin_amdgcn_global_load_lds((const unsigned*)((const char*)(gbase) + (size_t)(_i * r64_##voff) + v_##voff), (PG8_LAS unsigned*)(lds + (bufoff) + ldsw + _i * 8192), 16, 0, 0); } while (0)
#define PG8_RD(p) (*(const PG8_LAS bf16x8*)(p))
#define PG8_LDA(dst, b, h) do { if constexpr (F8) { _Pragma("unroll") for (int m = 0; m < 4; ++m) dst##8[m] = cat8(PG8_RD(lds + PG8_SA(b, h) + aoff + m * 2048), PG8_RD(lds + PG8_SA(b, h) + aoff + m * 2048 + 1024)); } \
        else { _Pragma("unroll") for (int m = 0; m < 4; ++m) _Pragma("unroll") for (int k = 0; k < 2; ++k) dst[m][k] = PG8_RD(lds + PG8_SA(b, h) + aoff + m * 2048 + k * 1024); } } while (0)
#define PG8_LDB(dst, b, h) do { if constexpr (F8) { _Pragma("unroll") for (int n = 0; n < 2; ++n) dst##8[n] = cat8(PG8_RD(lds + PG8_SB(b, h) + boff + n * 2048), PG8_RD(lds + PG8_SB(b, h) + boff + n * 2048 + 1024)); } \
        else { _Pragma("unroll") for (int n = 0; n < 2; ++n) _Pragma("unroll") for (int k = 0; k < 2; ++k) dst[n][k] = PG8_RD(lds + PG8_SB(b, h) + boff + n * 2048 + k * 1024); } } while (0)
#define PG8_MMA(ai, bj, At, Bt) do { __builtin_amdgcn_s_setprio(1); if constexpr (F8) { _Pragma("unroll") for (int m = 0; m < 4; ++m) _Pragma("unroll") for (int n = 0; n < 2; ++n) \
        asm volatile("v_mfma_scale_f32_16x16x128_f8f6f4 %0, %1, %2, %0, %3, %3 op_sel_hi:[0,0,0]" : "+v"(acc[ai][bj][m][n]) : "v"(Bt##8[n]), "v"(At##8[m]), "v"(sc1_)); } \
        else { _Pragma("unroll") for (int m = 0; m < 4; ++m) _Pragma("unroll") for (int n = 0; n < 2; ++n) _Pragma("unroll") for (int k = 0; k < 2; ++k) \
        acc[ai][bj][m][n] = __builtin_amdgcn_mfma_f32_16x16x32_bf16(Bt[n][k], At[m][k], acc[ai][bj][m][n], 0, 0, 0); } __builtin_amdgcn_s_setprio(0); } while (0)
#define PG8_WAIT_V(n) asm volatile("s_waitcnt vmcnt(" #n ")" ::: "memory")
#define PG8_WAIT_L(n) asm volatile("s_waitcnt lgkmcnt(" #n ")" ::: "memory")
#define PG8_BAR __builtin_amdgcn_s_barrier()
#define PG8_SCHED __builtin_amdgcn_sched_barrier(0)
    Unit cur, nxt; int ui = 0;
    if (!S.next(0, cur)) return;
    f32x4 acc[2][2][4][2];
#pragma unroll
    for (int a = 0; a < 2; ++a)
#pragma unroll
        for (int b = 0; b < 2; ++b)
#pragma unroll
            for (int m = 0; m < 4; ++m)
#pragma unroll
                for (int n = 0; n < 2; ++n) acc[a][b][m][n] = (f32x4){0.f, 0.f, 0.f, 0.f};
    const int sc1_ = 0x7f7f7f7f;
    bf16x8 At[4][2], B0[2][2], B1[2][2]; v8i_t At8[4], B08[2], B18[2];
    const char* cA = (const char*)g.A + (size_t)cur.ex * g.aexp + (size_t)cur.pm * tstepA; const char* cB = (const char*)g.Bt + (size_t)cur.ex * g.bexp + (size_t)cur.pn * tstepB;
    S.a_ready(cur);
    if constexpr (SP2) {
        PG8_STAGE(PG8_SB(0, 0), cB, offB); PG8_STAGE(PG8_SB(0, 1), cB + hstepB, offB); PG8_STAGE(PG8_SA(0, 0), cA, offA); PG8_STAGE(PG8_SA(0, 1), cA + hstepA, offA);
        if (wr == 1) PG8_BAR;
        PG8_WAIT_V(2); PG8_BAR;
        PG8_STAGE(PG8_SB(1, 0), cB + kstep, offB); PG8_STAGE(PG8_SA(1, 0), cA + kstep, offA); PG8_STAGE(PG8_SB(1, 1), cB + hstepB + kstep, offB);
        PG8_WAIT_V(6); PG8_BAR;
    } else {
        PG8_STAGE(PG8_SB(0, 0), cB, offB); PG8_STAGE(PG8_SA(0, 0), cA, offA); PG8_STAGE(PG8_SB(0, 1), cB + hstepB, offB); PG8_STAGE(PG8_SA(0, 1), cA + hstepA, offA);
        if (wr == 1) PG8_BAR;
        PG8_WAIT_V(4); PG8_BAR;
        PG8_STAGE(PG8_SB(1, 0), cB + kstep, offB); PG8_STAGE(PG8_SA(1, 0), cA + kstep, offA); PG8_STAGE(PG8_SB(1, 1), cB + hstepB + kstep, offB);
        PG8_WAIT_V(6); PG8_BAR;
    }
    for (;;) {
        const bool has_next = S.next(ui + 1, nxt);
        const char* nA = has_next ? (const char*)g.A + (size_t)nxt.ex * g.aexp + (size_t)nxt.pm * tstepA : cA; const char* nB = has_next ? (const char*)g.Bt + (size_t)nxt.ex * g.bexp + (size_t)nxt.pn * tstepB : cB;
        for (int t = 0; t < nt; t += 2) {
            const bool last = (t == nt - 2);
            const char* a1 = cA + (size_t)(t + 1) * kstep;
            const char* a2 = last ? nA : cA + (size_t)(t + 2) * kstep; const char* b2 = last ? nB : cB + (size_t)(t + 2) * kstep;
            const char* a3 = a2 + kstep; const char* b3 = b2 + kstep;
            if (last && has_next) S.a_ready(nxt);
            if constexpr (SP2) {
            PG8_LDB(B0, 0, 0); PG8_LDB(B1, 0, 1); PG8_SCHED; PG8_LDA(At, 0, 0); PG8_STAGE(PG8_SA(1, 1), a1 + hstepA, offA);
            PG8_WAIT_V(8); PG8_WAIT_L(0); PG8_BAR; PG8_MMA(0, 0, At, B0); PG8_MMA(0, 1, At, B1); PG8_BAR; PG8_SCHED;
            PG8_LDA(At, 0, 1); PG8_STAGE(PG8_SB(0, 0), b2, offB); PG8_STAGE(PG8_SB(0, 1), b2 + hstepB, offB); PG8_STAGE(PG8_SA(0, 0), a2, offA);
            PG8_WAIT_V(8); PG8_WAIT_L(0); PG8_BAR; PG8_MMA(1, 0, At, B0); PG8_MMA(1, 1, At, B1); PG8_BAR; PG8_SCHED;
            PG8_LDB(B0, 1, 0); PG8_LDB(B1, 1, 1); PG8_SCHED; PG8_LDA(At, 1, 0); PG8_STAGE(PG8_SA(0, 1), a2 + hstepA, offA);
            PG8_WAIT_V(8); PG8_WAIT_L(0); PG8_BAR; PG8_MMA(0, 0, At, B0); PG8_MMA(0, 1, At, B1); PG8_BAR; PG8_SCHED;
            PG8_LDA(At, 1, 1); PG8_STAGE(PG8_SB(1, 0), b3, offB); PG8_STAGE(PG8_SB(1, 1), b3 + hstepB, offB); PG8_STAGE(PG8_SA(1, 0), a3, offA);
            PG8_WAIT_V(8); PG8_WAIT_L(0); PG8_BAR; PG8_MMA(1, 0, At, B0); PG8_MMA(1, 1, At, B1); PG8_BAR; PG8_SCHED;
            } else {
            PG8_LDB(B0, 0, 0); PG8_SCHED; PG8_LDA(At, 0, 0); PG8_STAGE(PG8_SA(1, 1), a1 + hstepA, offA);
            PG8_WAIT_L(8); PG8_BAR; PG8_WAIT_L(0); PG8_MMA(0, 0, At, B0); PG8_BAR; PG8_SCHED;
            PG8_LDB(B1, 0, 1); PG8_STAGE(PG8_SB(0, 0), b2, offB);
            PG8_BAR; PG8_WAIT_L(0); PG8_MMA(0, 1, At, B1); PG8_BAR;
            PG8_LDA(At, 0, 1); PG8_STAGE(PG8_SA(0, 0), a2, offA);
            PG8_BAR; PG8_WAIT_L(0); PG8_MMA(1, 0, At, B0); PG8_BAR; PG8_SCHED;
            PG8_STAGE(PG8_SB(0, 1), b2 + hstepB, offB);
            PG8_WAIT_V(6); PG8_BAR; PG8_MMA(1, 1, At, B1); PG8_BAR;
            PG8_LDB(B0, 1, 0); PG8_SCHED; PG8_LDA(At, 1, 0); PG8_STAGE(PG8_SA(0, 1), a2 + hstepA, offA);
            PG8_WAIT_L(8); PG8_BAR; PG8_WAIT_L(0); PG8_MMA(0, 0, At, B0); PG8_BAR; PG8_SCHED;
            PG8_LDB(B1, 1, 1); PG8_STAGE(PG8_SB(1, 0), b3, offB);
            PG8_BAR; PG8_WAIT_L(0); PG8_MMA(0, 1, At, B1); PG8_BAR;
            PG8_LDA(At, 1, 1); PG8_STAGE(PG8_SA(1, 0), a3, offA);
            PG8_BAR; PG8_WAIT_L(0); PG8_MMA(1, 0, At, B0); PG8_BAR; PG8_SCHED;
            PG8_STAGE(PG8_SB(1, 1), b3 + hstepB, offB);
            PG8_WAIT_V(6); PG8_BAR; PG8_MMA(1, 1, At, B1); PG8_BAR;
            }
        }
        if constexpr (F8) { asm volatile("s_nop 15\n\ts_nop 7" ::: "memory"); }
        if constexpr (ALIGN_EPI) { if (wr == 0) PG8_BAR; }
        if constexpr (!Epi::AFTER_DRAIN) { E(acc, cur, wr, wc, fr, fq); S.done(cur); }
        if (!has_next) break;
#pragma unroll
        for (int a = 0; a < 2; ++a)
#pragma unroll
            for (int b = 0; b < 2; ++b)
#pragma unroll
                for (int m = 0; m < 4; ++m)
#pragma unroll
                    for (int n = 0; n < 2; ++n) acc[a][b][m][n] = (f32x4){0.f, 0.f, 0.f, 0.f};
        cur = nxt; cA = nA; cB = nB; ++ui;
        if constexpr (Epi::REOFF) { const int tid2 = wid * 64 + lane_id(); int R, C; stage_rc(tid2 * 16, R, C); const int Rb = Epi::PERM ? ((R & ~31) + perm32(R & 31)) : R;
            v_offA = (unsigned)(R * g.lda + C) * 2u; v_offB = (unsigned)(Rb * g.ldb + C) * 2u; }
        if constexpr (ALIGN_EPI) { if (wr == 1) PG8_BAR; }
    }
    PG8_WAIT_V(0);
    if constexpr (!ALIGN_EPI) { if (wr == 0) PG8_BAR; }
    PG8_BAR;
    if constexpr (Epi::AFTER_DRAIN) { E.fused(acc, cur, wr, wc, fr, fq, lds, wid, lane); S.done(cur); }
#undef PG8_SA
#undef PG8_SB
#undef PG8_STAGE
#undef PG8_RD
#undef PG8_LDA
#undef PG8_LDB
#undef PG8_MMA
#undef PG8_WAIT_V
#undef PG8_WAIT_L
#undef PG8_BAR
#undef PG8_SCHED
}
}


#define XB_TMO      128
#define XB_XCNT(j)  (256  + 64 * (j))
#define XB_XSUB(j)  (1280 + 64 * (j))
#define XB_XGEN(j)  (2304 + 64 * (j))
#define XB_TOP      3328
#define XB_TOPGEN   3392
#define XCD_BAR_WORDS 3456
#define XB_SPIN_CAP (1u << 18)

__device__ __forceinline__ unsigned xb_ld(unsigned* p)              { return __hip_atomic_load(p, __ATOMIC_RELAXED, __HIP_MEMORY_SCOPE_AGENT); }
__device__ __forceinline__ unsigned xb_add(unsigned* p, unsigned v) { return __hip_atomic_fetch_add(p, v, __ATOMIC_RELAXED, __HIP_MEMORY_SCOPE_AGENT); }
__device__ __forceinline__ unsigned xb_xcc_id() { return (unsigned)__builtin_amdgcn_s_getreg((3 << 11) | 20) & 0xFu; }
#define XB_SPIN(cond, bar) do { unsigned _sp = 0; while (cond) { __builtin_amdgcn_s_sleep(1); \
    if ((++_sp & 255u) == 0u) { if (xb_ld(&(bar)[XB_TMO])) break; if (_sp > XB_SPIN_CAP) { atomicAdd(&(bar)[XB_TMO], 1u); break; } } } } while (0)

struct XcdBarrier {
    unsigned* bar; unsigned x;
    volatile LAS unsigned* st;
};

__device__ __forceinline__ XcdBarrier xcd_barrier_post(unsigned* bar, volatile LAS unsigned* st) {
    XcdBarrier b; b.bar = bar; b.x = xb_xcc_id(); b.st = st;
    if (threadIdx.x == 0) (void)xb_add(&bar[XB_XCNT(b.x)], 1u);
    return b;
}
__device__ __forceinline__ void xcd_barrier_complete(unsigned* bar, unsigned x, unsigned& nloc, unsigned& nx) {
    const unsigned G = gridDim.x * gridDim.y * gridDim.z;
    unsigned sum, cnt, mine, sp = 0u;
    for (;;) {
        sum = 0u; cnt = 0u; mine = 0u;
#pragma unroll
        for (unsigned j = 0; j < 16; ++j) { const unsigned c = xb_ld(&bar[XB_XCNT(j)]); sum += c; cnt += (c > 0u) ? 1u : 0u; mine = (j == x) ? c : mine; }
        if (sum == G) break;
        __builtin_amdgcn_s_sleep(1);
        if ((++sp & 255u) == 0u) { if (xb_ld(&bar[XB_TMO])) break; if (sp > XB_SPIN_CAP) { atomicAdd(&bar[XB_TMO], 1u); break; } }
    }
    nloc = mine > 0u ? mine : 1u; nx = cnt > 0u ? cnt : 1u;
}

__device__ __forceinline__ void xcd_barrier(const XcdBarrier& b) {
    asm volatile("s_waitcnt vmcnt(0)" ::: "memory");
    __syncthreads();
    if (threadIdx.x == 0) {
        unsigned* bar = b.bar; asm volatile("" : "+s"(bar));
        __builtin_amdgcn_s_waitcnt(0);
        unsigned bx = b.x; asm volatile("" : "+s"(bx));
        unsigned nloc = b.st[0], nx = b.st[1];
        if (nloc == 0u) { xcd_barrier_complete(bar, bx, nloc, nx); b.st[0] = nloc; b.st[1] = nx; }
        const unsigned old = xb_add(&bar[XB_XSUB(bx)], 1u);
        const unsigned gen = old / nloc;
        if (old + 1u == (gen + 1u) * nloc) {
            __builtin_amdgcn_fence(__ATOMIC_RELEASE, "agent");
            asm volatile("s_waitcnt vmcnt(0)" ::: "memory");
            const unsigned og = xb_add(&bar[XB_TOP], 1u);
            const unsigned tg = og / nx;
            if (og + 1u == (tg + 1u) * nx) xb_add(&bar[XB_TOPGEN], 1u);
            else XB_SPIN(xb_ld(&bar[XB_TOPGEN]) == tg, bar);
            __builtin_amdgcn_fence(__ATOMIC_ACQUIRE, "agent");
            xb_add(&bar[XB_XGEN(bx)], 1u);
            asm volatile("s_waitcnt vmcnt(0)" ::: "memory");
        } else {
            XB_SPIN(xb_ld(&bar[XB_XGEN(bx)]) == gen, bar);
            __builtin_amdgcn_fence(__ATOMIC_ACQUIRE, "agent");
            asm volatile("s_waitcnt vmcnt(0)" ::: "memory");
        }
    }
    __syncthreads();
}

struct Args { const float* in[32]; float* out; unsigned char* ws; int ph_lo, ph_hi, li, pad; };
struct Frame {
    LAS unsigned char* lds; volatile LAS unsigned* MISC; unsigned* ctl;
    int wave, G, bid, gw, NGW;
    float* out; unsigned char* ws;
};
constexpr int NWAVES = 8, NTHR = NWAVES * 64;

#define TR_LOAD(wv, W, N, k0, n0) do { _Pragma("unroll") for (int i_ = 0; i_ < 32; ++i_) wv[i_] = __builtin_nontemporal_load((W) + (size_t)((k0) + 2 * i_ + (lane >> 5)) * (N) + (n0) + (lane & 31)); } while (0)
template <bool F8>
__device__ __forceinline__ void tr_store(const float (&wv)[32], void* WTv, int K  , int k0, int drow0, const float* ksc, LAS float* scr, int lane) {
#pragma unroll
    for (int i = 0; i < 32; ++i) { const int kk = 2 * i + (lane >> 5); float w = wv[i]; if (ksc) w *= ksc[k0 + kk]; if (F8) w *= W8_SCALE; scr[kk * 33 + (lane & 31)] = w; }
    LDS_WAIT(); asm volatile("" ::: "memory");
    const int c = lane & 7;
#pragma unroll
    for (int j = 0; j < 4; ++j) { const int n = (lane >> 3) + 8 * j; const LAS float* s = scr + (8 * c) * 33 + n;
        if (F8) { u32x2 o; o.x = pk4_fp8(s[0 * 33], s[1 * 33], s[2 * 33], s[3 * 33]); o.y = pk4_fp8(s[4 * 33], s[5 * 33], s[6 * 33], s[7 * 33]); *(u32x2*)((unsigned char*)WTv + (size_t)(drow0 + n) * K + k0 + 8 * c) = o; }
        else { u32x4 o; o.x = pk2(s[0 * 33], s[1 * 33]); o.y = pk2(s[2 * 33], s[3 * 33]); o.z = pk2(s[4 * 33], s[5 * 33]); o.w = pk2(s[6 * 33], s[7 * 33]); *(u32x4*)((bf16_t*)WTv + (size_t)(drow0 + n) * K + k0 + 8 * c) = o; } }
    LDS_WAIT(); asm volatile("" ::: "memory");
}
__device__ __forceinline__ int drow_map(int mode, int n0) {
    if (mode == 1) { const int h = n0 >> 7, j0 = n0 & 127; return j0 < 64 ? h * 64 + j0 : 512 + h * 64 + (j0 - 64); }
    if (mode == 2) return (n0 >> 7) * 256 + (n0 & 127);
    if (mode == 3) return (n0 >> 7) * 256 + 128 + (n0 & 127);
    return n0;
}
template <bool F8>
__device__ __forceinline__ void conv_mat(const Frame& F, const float* W, int K, int N, void* WT, int mode, const float* ksc, int ldk = 0) {
    if (ldk == 0) ldk = K;
    const int lane = lane_id();
    LAS float* scr = (LAS float*)(F.lds + F.wave * 16384);
    const int nblk = N / 32, items = (K / 64) * nblk;
    for (int it = F.gw; it < items; it += F.NGW) { const int k0 = 64 * (it / nblk), n0 = 32 * (it % nblk); float wv[32];
        TR_LOAD(wv, W, N, k0, n0); tr_store<F8>(wv, WT, ldk, k0, drow_map(mode, n0), ksc, scr, lane); }
}
__device__ __forceinline__ void p0_weights(const Frame& F, const Args& A) { unsigned char* const wsq_ = opq(F.ws);
    const int lane = lane_id(), tid = F.wave * 64 + lane; (void)tid; (void)lane;
    unsigned char* ws = wsq_;
    for (int l = 0; l < 2; ++l) {
        conv_mat<false>(F, INP(8) + (size_t)l * DM * DIN, DM, DIN, (bf16_t*)(ws + WS_WIN) + (size_t)l * 1024 * 1024, 0, nullptr);
        conv_mat<false>(F, INP(11) + (size_t)l * 256 * 768, 256, 768, (bf16_t*)(ws + WS_WUQ) + (size_t)l * 768 * 256, 0, INP(9) + l * 256);
        conv_mat<false>(F, INP(12) + (size_t)l * 128 * 1024, 128, 1024, (bf16_t*)(ws + WS_WUKV) + (size_t)l * 1024 * 128, 1, INP(10) + l * 128);
        conv_mat<false>(F, INP(21) + (size_t)l * 512 * 512, 512, 512, (bf16_t*)(ws + WS_WGLU) + (size_t)l * 512 * 512, 0, nullptr);
        conv_mat<false>(F, INP(23) + (size_t)l * 1024 * 1024, 1024, 1024, (bf16_t*)(ws + WS_WOUT) + (size_t)l * 1024 * 1024, 0, nullptr);
        { u32x4* z = (u32x4*)((bf16_t*)(ws + WS_WIN) + (size_t)l * 1024 * 1024 + (size_t)DIN * 1024); const int n16 = (1024 - DIN) * 1024 * 2 / 16;
          u32x4 z4 = {0u, 0u, 0u, 0u}; asm volatile("" : "+v"(z4));
          for (int i = F.gw * 64 + lane; i < n16; i += F.NGW * 64) z[i] = z4; }
    }
    conv_mat<false>(F, INP(24), DM, DFF, ws + WS_WFF13, 2, nullptr);
    conv_mat<false>(F, INP(25), DM, DFF, ws + WS_WFF13, 3, nullptr);
    conv_mat<true>(F, INP(26), DFF, DM, ws + WS_WFF2, 0, nullptr);
    { const int lane = lane_id(); u32x4 z4 = {0u, 0u, 0u, 0u}; asm volatile("" : "+v"(z4));
      for (int i = F.gw * 64 + lane; i < NE * DM * 8; i += F.NGW * 64) *(u32x4*)(wsq_ + WS_WM2 + (size_t)(i >> 3) * DFE8 + DFE + (i & 7) * 16) = z4; }
}
__device__ __forceinline__ void p0_moe_weights(const Frame& F, const Args& A, int e0, int e1) { unsigned char* const ws = opq(F.ws);
    for (int e = e0; e < e1; ++e) {
        conv_mat<true>(F, INP(28) + (size_t)e * DM * DFE, DM, DFE, ws + WS_WM13 + (size_t)e * 2 * DFE * DM, 2, nullptr);
        conv_mat<true>(F, INP(29) + (size_t)e * DM * DFE, DM, DFE, ws + WS_WM13 + (size_t)e * 2 * DFE * DM, 3, nullptr);
        conv_mat<true>(F, INP(30) + (size_t)e * DFE * DM, DFE, DM, ws + WS_WM2 + (size_t)e * DM * DFE8, 0, nullptr, DFE8);
    }
}
__device__ __forceinline__ void p0_prologue(const Frame& F, const Args& A) { unsigned char* const wsq_ = opq(F.ws);
    const int lane = lane_id(), tid = F.wave * 64 + lane; (void)tid; (void)lane;
    unsigned char* ws = wsq_;
    { float* cosT = (float*)(ws + WS_COS); float* sinT = (float*)(ws + WS_SIN);
      for (int idx = F.gw * 64 + lane; idx < SEQ * 16; idx += F.NGW * 64) { const int t = idx >> 4, a = (idx >> 3) & 1, i = idx & 7; const float pos = (float)(a == 0 ? (t >> 6) : (t & 63));
          const float inv = exp2f(-(float)i * (13.287712379549449f / 8.0f)); const float ang = pos * inv; cosT[idx] = cosf(ang); sinT[idx] = sinf(ang); } }
    { float* AB = (float*)(ws + WS_AB); float* BB = (float*)(ws + WS_BB);
      const int gwr = (((F.bid + F.G - (F.G == 256 ? 192 : 0)) % F.G) * NWAVES + F.wave);
      for (int idx = gwr * 64 + lane; idx < 2 * 2 * NG * NP; idx += F.NGW * 64) {
          const float ar = INP(13)[idx], ai = INP(14)[idx], dt = expf(INP(15)[idx >> 6]);
          const float mag = expf(dt * ar), abr = mag * cosf(dt * ai), abi = mag * sinf(dt * ai), den = ar * ar + ai * ai, nre = abr - 1.0f;
          const float fre = (nre * ar + abi * ai) / den, fim = (abi * ar - nre * ai) / den;
          AB[idx * 2] = abr; AB[idx * 2 + 1] = abi;
          { float* PW = (float*)(ws + WS_PW) + (size_t)idx * 66; const float dar = dt * ar, dai = dt * ai;
            (void)dar; (void)dai; float pr = 1.f, pi = 0.f;
            for (int e = 0; e <= TCH; ++e) { PW[2 * e] = pr; PW[2 * e + 1] = pi; const float nr = pr * abr - pi * abi, ni = pr * abi + pi * abr; pr = nr; pi = ni; } }
#pragma unroll 4
          for (int c = 0; c < 16; ++c) { const float br = INP(16)[idx * 16 + c], bi = INP(17)[idx * 16 + c]; BB[(idx * 16 + c) * 2] = fre * br - fim * bi; BB[(idx * 16 + c) * 2 + 1] = fre * bi + fim * br; } } }
    { LAS float* sv = (LAS float*)F.lds; LAS float* red = sv + 5 * 1024; float* MOD = (float*)(ws + WS_MOD);
      __syncthreads();
      for (int i = tid; i < 5 * 1024; i += NTHR) { const int v = i >> 10, k = i & 1023; const float cv = v < 4 ? INP(1)[v * 1024 + k] : INP(3)[k]; sv[i] = silu_f(cv); }
      __syncthreads();
      for (int it = F.bid; it < 2 * 96; it += F.G) { const int l = it / 96, jb = it % 96, kg = tid >> 6, jj = tid & 63, j = jb * 64 + jj;
          float a0 = 0.f, a1 = 0.f, a2 = 0.f, a3 = 0.f, a4 = 0.f; const float* wp = INP(4) + ((size_t)l * 1024 + kg * 128) * 6144 + j;
#pragma unroll 8
          for (int kk = 0; kk < 128; ++kk) { const float w = wp[(size_t)kk * 6144]; const int k = kg * 128 + kk; a0 += sv[k] * w; a1 += sv[1024 + k] * w; a2 += sv[2048 + k] * w; a3 += sv[3072 + k] * w; a4 += sv[4096 + k] * w; }
          red[(kg * 5 + 0) * 64 + jj] = a0; red[(kg * 5 + 1) * 64 + jj] = a1; red[(kg * 5 + 2) * 64 + jj] = a2; red[(kg * 5 + 3) * 64 + jj] = a3; red[(kg * 5 + 4) * 64 + jj] = a4;
          __syncthreads();
          if (tid < 320) { const int v = tid >> 6, q = tid & 63; float s = INP(5)[l * 6144 + jb * 64 + q];
#pragma unroll
              for (int g = 0; g < 8; ++g) s += red[(g * 5 + v) * 64 + q];
              MOD[((size_t)l * 5 + v) * 6144 + jb * 64 + q] = s; }
          __syncthreads(); }
    }
}

template <bool OUT8>
__device__ __forceinline__ void norm_rows(const Frame& F, const float* xs_x, const float* xs_c, int nrows, const float* gain, const float* mod, int shoff, int scoff, void* XNv,
                                          const float* part = nullptr, int nparts = 0, const float* pgate = nullptr, float* xc_out = nullptr) {
    const int lane = lane_id();
    for (int v = 0; v < 5; ++v) {
        const int r0 = v < 4 ? v * SEQ : NX, r1 = v < 4 ? r0 + SEQ : NR; if (r0 >= nrows) break;
        f32x4 ca[4], cb[4];
#pragma unroll
        for (int j = 0; j < 4; ++j) { const int c = 4 * lane + 256 * j; const f32x4 g = *(const f32x4*)(gain + c), sc = *(const f32x4*)(mod + v * 6144 + scoff + c); ca[j] = g * (sc + 1.0f); cb[j] = *(const f32x4*)(mod + v * 6144 + shoff + c); }
        for (int r = r0 + F.gw; r < r1; r += F.NGW) {
            const float* src = r < NX ? xs_x + (size_t)r * 1024 : xs_c + (size_t)(r - NX) * 1024;
            f32x4 x[4]; float ss = 0.f;
#pragma unroll
            for (int j = 0; j < 4; ++j) { const int c = 4 * lane + 256 * j; x[j] = *(const f32x4*)(src + c);
                if (part && r >= NX) { f32x4 sacc = {0.f, 0.f, 0.f, 0.f}; for (int k = 0; k < nparts; ++k) sacc = sacc + *(const f32x4*)(part + ((size_t)k * NC + (r - NX)) * 1024 + c);
                    x[j] = x[j] + *(const f32x4*)(pgate + c) * sacc; if (xc_out) *(f32x4*)(xc_out + (size_t)(r - NX) * 1024 + c) = x[j]; }
                ss += (x[j][0] * x[j][0] + x[j][1] * x[j][1]) + (x[j][2] * x[j][2] + x[j][3] * x[j][3]); }
            const float rstd = rsqrtf(wave_sum(ss, lane) * (1.f / 1024.f) + EPS);
#pragma unroll
            for (int j = 0; j < 4; ++j) { x[j] = x[j] * rstd * ca[j] + cb[j];
                if (OUT8) *(unsigned*)((unsigned char*)XNv + (size_t)r * 1024 + 4 * lane + 256 * j) = pk4_fp8(x[j][0], x[j][1], x[j][2], x[j][3]);
                else { u32x2 o; o.x = pk2(x[j][0], x[j][1]); o.y = pk2(x[j][2], x[j][3]); *(u32x2*)((bf16_t*)XNv + (size_t)r * 1024 + 4 * lane + 256 * j) = o; } }
        }
    }
}
__device__ __forceinline__ void norm_router(const Frame& F, const float* xs, const float* gain, const float* mod, int shoff, int scoff, unsigned char* XNM) { unsigned char* const wsq_ = opq(F.ws);
    const int lane = lane_id(), tid = F.wave * 64 + lane;
    LAS float* RT = (LAS float*)F.lds; LAS int* lcnt = (LAS int*)(F.lds + 32768);
    __syncthreads();
    for (int i = tid; i < 1024 * 8 / 4; i += NTHR) { const int k = i >> 1, p = i & 1, ln = (k & 255) >> 2, jq = (k >> 8) * 4 + (k & 3); ((LAS f32x4*)RT)[(p * 16 + jq) * 64 + ln] = ((const f32x4*)INP(27))[i]; }
    if (tid < 8) lcnt[tid] = 0;
    __syncthreads();
    for (int ch = F.bid; ch < NX / 128; ch += F.G) {
        const int v = ch >> 6;
        f32x4 ca[4], cb[4];
#pragma unroll
        for (int j = 0; j < 4; ++j) { const int c = 4 * lane + 256 * j; const f32x4 g = *(const f32x4*)(gain + c), sc = *(const f32x4*)(mod + v * 6144 + scoff + c); ca[j] = g * (sc + 1.0f); cb[j] = *(const f32x4*)(mod + v * 6144 + shoff + c); }
        float bq[8];
#pragma unroll
        for (int e = 0; e < 8; ++e) bq[e] = 0.f;
#pragma unroll
        for (int j = 0; j < 4; ++j)
#pragma unroll
            for (int q = 0; q < 4; ++q) { const int k = 4 * lane + 256 * j + q; const f32x4 w0 = ((const LAS f32x4*)RT)[(j * 4 + q) * 64 + lane], w1 = ((const LAS f32x4*)RT)[(16 + j * 4 + q) * 64 + lane]; (void)k; const float cv = cb[j][q];
                bq[0] += cv * w0[0]; bq[1] += cv * w0[1]; bq[2] += cv * w0[2]; bq[3] += cv * w0[3]; bq[4] += cv * w1[0]; bq[5] += cv * w1[1]; bq[6] += cv * w1[2]; bq[7] += cv * w1[3]; }
#pragma unroll
        for (int e = 0; e < 8; ++e) bq[e] = wave_sum(bq[e], lane);
        for (int i = 0; i < 16; ++i) {
            const int r = ch * 128 + F.wave * 16 + i; const float* src = xs + (size_t)r * 1024;
            f32x4 x[4]; float ss = 0.f; float lg[8];
#pragma unroll
            for (int e = 0; e < 8; ++e) lg[e] = 0.f;
#pragma unroll
            for (int j = 0; j < 4; ++j) { x[j] = *(const f32x4*)(src + 4 * lane + 256 * j); ss += (x[j][0] * x[j][0] + x[j][1] * x[j][1]) + (x[j][2] * x[j][2] + x[j][3] * x[j][3]); }
#pragma unroll
            for (int j = 0; j < 4; ++j)
#pragma unroll
                for (int q = 0; q < 4; ++q) { const int k = 4 * lane + 256 * j + q; const f32x4 w0 = ((const LAS f32x4*)RT)[(j * 4 + q) * 64 + lane], w1 = ((const LAS f32x4*)RT)[(16 + j * 4 + q) * 64 + lane]; (void)k; const float xv = x[j][q] * ca[j][q];
                    lg[0] += xv * w0[0]; lg[1] += xv * w0[1]; lg[2] += xv * w0[2]; lg[3] += xv * w0[3]; lg[4] += xv * w1[0]; lg[5] += xv * w1[1]; lg[6] += xv * w1[2]; lg[7] += xv * w1[3]; }
            { const bool h5 = (lane & 32) != 0, h4 = (lane & 16) != 0, h3 = (lane & 8) != 0;
              float a0 = h5 ? lg[4] : lg[0], a1 = h5 ? lg[5] : lg[1], a2 = h5 ? lg[6] : lg[2], a3 = h5 ? lg[7] : lg[3];
              const float s0 = h5 ? lg[0] : lg[4], s1 = h5 ? lg[1] : lg[5], s2 = h5 ? lg[2] : lg[6], s3 = h5 ? lg[3] : lg[7];
              a0 += shx(s0, 32, lane); a1 += shx(s1, 32, lane); a2 += shx(s2, 32, lane); a3 += shx(s3, 32, lane);
              float b0 = h4 ? a2 : a0, b1 = h4 ? a3 : a1; const float t0 = h4 ? a0 : a2, t1 = h4 ? a1 : a3;
              b0 += shx(t0, 16, lane); b1 += shx(t1, 16, lane);
              float c0 = h3 ? b1 : b0; const float u0 = h3 ? b0 : b1;
              c0 += shx(u0, 8, lane); c0 += shx(c0, 4, lane); c0 += shx(c0, 2, lane); c0 += shx(c0, 1, lane);
              ss = wave_sum(ss, lane);
#pragma unroll
              for (int e = 0; e < 8; ++e) lg[e] = __builtin_bit_cast(float, __builtin_amdgcn_readlane(__builtin_bit_cast(int, c0), 8 * e)); }
            const float rstd = rsqrtf(ss * (1.f / 1024.f) + EPS);
#pragma unroll
            for (int j = 0; j < 4; ++j) { x[j] = x[j] * rstd * ca[j] + cb[j]; *(unsigned*)(XNM + (size_t)r * 1024 + 4 * lane + 256 * j) = pk4_fp8(x[j][0], x[j][1], x[j][2], x[j][3]); }
#pragma unroll
            for (int e = 0; e < 8; ++e) lg[e] = lg[e] * rstd + bq[e];
            {
                int i1 = 0; float v1 = lg[0];
#pragma unroll
                for (int e = 1; e < 8; ++e) if (lg[e] > v1) { v1 = lg[e]; i1 = e; }
                int i2 = -1; float v2 = -3.0e38f;
#pragma unroll
                for (int e = 0; e < 8; ++e) if (e != i1 && lg[e] > v2) { v2 = lg[e]; i2 = e; }
                const float w1 = 1.f / (1.f + expf(v2 - v1)), w2 = 1.f - w1;
                if (lane == 0) {
                    __hip_atomic_fetch_add(lcnt + i1, 1, __ATOMIC_RELAXED, __HIP_MEMORY_SCOPE_WORKGROUP); __hip_atomic_fetch_add(lcnt + i2, 1, __ATOMIC_RELAXED, __HIP_MEMORY_SCOPE_WORKGROUP);
                    int* te = (int*)(wsq_ + WS_TOKE) + r * 2; float* tw = (float*)(wsq_ + WS_TOKW) + r * 2;
                    te[0] = i1; te[1] = i2; tw[0] = w1; tw[1] = w2; }
            }
        }
        __syncthreads();
        if (tid < 8) { ((int*)(wsq_ + WS_CNTB))[ch * 8 + tid] = lcnt[tid]; lcnt[tid] = 0; }
        __syncthreads();
    }
}

__device__ __forceinline__ void kr_rows(const Frame& F, const bf16_t* Z, bf16_t* KR) { unsigned char* const wsq_ = opq(F.ws);
    const int lane = lane_id(), tid = F.wave * 64 + lane; (void)tid; (void)lane;
    const float* cosT = (const float*)(wsq_ + WS_COS); const float* sinT = (const float*)(wsq_ + WS_SIN);
    for (int idx = F.gw * 64 + lane; idx < NR * 16; idx += F.NGW * 64) { const int r = idx >> 4, a = (idx >> 3) & 1, i = idx & 7;
        const float x1 = bf1(Z[(size_t)r * 1024 + 896 + a * 16 + i]), x2 = bf1(Z[(size_t)r * 1024 + 896 + a * 16 + 8 + i]);
        float c = 1.f, s = 0.f; if (r < NX) { const int t = r & (SEQ - 1); c = cosT[t * 16 + a * 8 + i]; s = sinT[t * 16 + a * 8 + i]; }
        unsigned char* kr8 = (unsigned char*)KR + (size_t)r * 32 + a * 16 + i; kr8[0] = (unsigned char)(pk4_fp8(x1 * c - x2 * s, 0.f, 0.f, 0.f) & 0xffu); kr8[8] = (unsigned char)(pk4_fp8(x2 * c + x1 * s, 0.f, 0.f, 0.f) & 0xffu); }
}

__device__ __forceinline__ void ssm_tables(const Frame& F, const Args& A) { unsigned char* const wsq_ = opq(F.ws);
    const int lane = lane_id(), tid = F.wave * 64 + lane;
    LAS float* Cr = (LAS float*)F.lds; LAS float* Ci = Cr + 1040; LAS float* BBl = Ci + 1040; LAS float* PWl = BBl + 2048;
    unsigned char* ws = wsq_;
    for (int it2 = F.bid; it2 < 2 * NG * 2 * 2; it2 += F.G) {
        const int it = it2 >> 1, half = it2 & 1; const int dir = it & 1, g = (it >> 1) & 31, l = it >> 6; const int gi = (l * 2 + dir) * NG + g;
        __syncthreads();
        for (int i = tid; i < 1024; i += NTHR) { Cr[(i >> 6) * 65 + (i & 63)] = INP(18)[(size_t)gi * 1024 + i]; Ci[(i >> 6) * 65 + (i & 63)] = INP(19)[(size_t)gi * 1024 + i]; }
        for (int i = tid; i < 2048; i += NTHR) BBl[i] = ((const float*)(ws + WS_BB))[(size_t)gi * 2048 + i];
        for (int i = tid; i < 64 * 66; i += NTHR) PWl[i] = ((const float*)(ws + WS_PW))[(size_t)gi * 64 * 66 + i];
        __syncthreads();
        float* KL = (float*)(ws + WS_KL) + (size_t)((l * NG + g) * 2 + dir) * 8192;
        for (int e = half * 4096 + tid; e < half * 4096 + 4096; e += NTHR) { const int lag = e >> 8, c = (e >> 4) & 15, cp = e & 15; float acc = 0.f;
#pragma unroll 4
            for (int p = 0; p < 64; ++p) { const float cr = Cr[c * 65 + p], ci = Ci[c * 65 + p], pr = PWl[p * 66 + 2 * lag], pi = PWl[p * 66 + 2 * lag + 1], br = BBl[(p * 16 + cp) * 2], bi = BBl[(p * 16 + cp) * 2 + 1];
                acc += (cr * pr - ci * pi) * br - (cr * pi + ci * pr) * bi; }
            KL[e] = acc; }
        bf16_t* W1 = (bf16_t*)(ws + WS_W1T) + ((size_t)(l * NG + g) * 256 + dir * 128) * 512;
        if (half == 0) for (int q = tid; q < 8192; q += NTHR) { const int r = q >> 6, reim = r >> 6, p = r & 63, pc = q & 63, j = pc >> 1, c0 = (pc & 1) * 8, e = dir ? j : TCH - 1 - j;
            const float pr = PWl[p * 66 + 2 * e], pi = PWl[p * 66 + 2 * e + 1]; float v[8];
#pragma unroll
            for (int k = 0; k < 8; ++k) { const float br = BBl[(p * 16 + c0 + k) * 2], bi = BBl[(p * 16 + c0 + k) * 2 + 1]; v[k] = reim ? (pr * bi + pi * br) : (pr * br - pi * bi); }
            u32x4 o; o.x = pk2(v[0], v[1]); o.y = pk2(v[2], v[3]); o.z = pk2(v[4], v[5]); o.w = pk2(v[6], v[7]);
            *(u32x4*)(W1 + (size_t)r * 512 + j * 16 + c0) = o; }
        bf16_t* MT = (bf16_t*)(ws + WS_MT) + (size_t)(l * NG + g) * 512 * 768 + 512 + dir * 128;
        if (half == 1) for (int q = tid; q < 8192; q += NTHR) { const int row = q >> 4, ii = row >> 4, c = row & 15, pc = q & 15, reim = pc >> 3, p0 = (pc & 7) * 8, e = dir ? TCH - ii : ii + 1; float v[8];
#pragma unroll
            for (int k = 0; k < 8; ++k) { const int p = p0 + k; const float cr = Cr[c * 65 + p], ci = Ci[c * 65 + p], pr = PWl[p * 66 + 2 * e], pi = PWl[p * 66 + 2 * e + 1]; v[k] = reim ? -(cr * pi + ci * pr) : (cr * pr - ci * pi); }
            u32x4 o; o.x = pk2(v[0], v[1]); o.y = pk2(v[2], v[3]); o.z = pk2(v[4], v[5]); o.w = pk2(v[6], v[7]);
            *(u32x4*)(MT + (size_t)row * 768 + reim * 64 + p0) = o; }
    }
    __syncthreads();
}
__device__ __forceinline__ void ssm_toeplitz(const Frame& F, const Args& A) { unsigned char* const wsq_ = opq(F.ws);
    const int lane = lane_id(); unsigned char* ws = wsq_;
    for (int x = F.gw * 64 + lane; x < 2 * NG * 512 * 64; x += F.NGW * 64) { const int pc = x & 63, row = (x >> 6) & 511, lg = x >> 15, j = pc >> 1, c0 = (pc & 1) * 8, i = row >> 4, c = row & 15;
        const float* KL = (const float*)(ws + WS_KL) + (size_t)lg * 2 * 8192; float v[8];
#pragma unroll
        for (int k = 0; k < 8; ++k) v[k] = 0.f;
        if (j <= i) { const float* kp = KL + (i - j) * 256 + c * 16 + c0; const f32x4 a = *(const f32x4*)kp, b = *(const f32x4*)(kp + 4); v[0] += a[0]; v[1] += a[1]; v[2] += a[2]; v[3] += a[3]; v[4] += b[0]; v[5] += b[1]; v[6] += b[2]; v[7] += b[3]; }
        if (j >= i) { const float* kp = KL + 8192 + (j - i) * 256 + c * 16 + c0; const f32x4 a = *(const f32x4*)kp, b = *(const f32x4*)(kp + 4); v[0] += a[0]; v[1] += a[1]; v[2] += a[2]; v[3] += a[3]; v[4] += b[0]; v[5] += b[1]; v[6] += b[2]; v[7] += b[3]; }
        if (i == j && (c >> 3) == (c0 >> 3)) { const float d = INP(20)[(lg >> 5) * 512 + (lg & 31) * 16 + c];
#pragma unroll
            for (int k = 0; k < 8; ++k) v[k] += (k == (c & 7)) ? d : 0.f; }
        u32x4 o; o.x = pk2(v[0], v[1]); o.y = pk2(v[2], v[3]); o.z = pk2(v[4], v[5]); o.w = pk2(v[6], v[7]);
        *(u32x4*)((bf16_t*)(ws + WS_MT) + ((size_t)lg * 512 + row) * 768 + j * 16 + c0) = o; }
}
__device__ __forceinline__ void ssm_scan(const Frame& F, int l) { unsigned char* const wsq_ = opq(F.ws);
    const int lane = lane_id(); unsigned char* ws = wsq_;
    for (int w = F.bid + F.G * F.wave; w < NB * NG * 2; w += F.G * NWAVES) {
        const int dir = w & 1, g = (w >> 1) & 31, b = w >> 6; const int idx = ((l * 2 + dir) * NG + g) * NP + lane;
        const float* PW = (const float*)(ws + WS_PW) + (size_t)idx * 66; const float are = PW[2 * TCH], aim = PW[2 * TCH + 1];
        const float* S = (const float*)(ws + WS_S) + (size_t)g * NCH * 256 + dir * 128 + lane; bf16_t* UH = (bf16_t*)(ws + WS_UH) + (size_t)g * NCH * 768 + 512 + dir * 128 + lane;
        float hre = 0.f, him = 0.f;
        for (int blk = 0; blk < (CTXL + SEQ) / TCH / 24; ++blk) {
            float sr[24], si[24]; int nn[24];
#pragma unroll
            for (int k = 0; k < 24; ++k) { const int s = blk * 24 + k; int n;
                if (s < CTXL / TCH) n = NX / TCH + b * (CTXL / TCH) + (dir ? CTXL / TCH - 1 - s : s); else { const int t = s - CTXL / TCH; n = b * (SEQ / TCH) + (dir ? SEQ / TCH - 1 - t : t); }
                nn[k] = n; sr[k] = S[(size_t)n * 256]; si[k] = S[(size_t)n * 256 + 64]; }
#pragma unroll
            for (int k = 0; k < 24; ++k) { UH[(size_t)nn[k] * 768] = (bf16_t)f2bf(hre); UH[(size_t)nn[k] * 768 + 64] = (bf16_t)f2bf(him);
                const float nr = are * hre - aim * him + sr[k], ni = are * him + aim * hre + si[k]; hre = nr; him = ni; }
        }
    }
}

__device__ __forceinline__ int pad256(unsigned c) { return (int)((c + 255u) & ~255u); }
__device__ __forceinline__ void moe_gather(const Frame& F, const unsigned char* XNM, unsigned char* XP) { unsigned char* const wsq_ = opq(F.ws);
    const int lane = lane_id(), tid = F.wave * 64 + lane;
    { u32x4 z4 = {0u, 0u, 0u, 0u}; asm volatile("" : "+v"(z4));
      for (int i = F.gw * 64 + lane; i < MOE_ROWS * 8; i += F.NGW * 64) *(u32x4*)(wsq_ + WS_HP + (size_t)(i >> 3) * DFE8 + DFE + (i & 7) * 16) = z4; }
    LAS int* posl = (LAS int*)F.lds;
    const int* CNTB = (const int*)(wsq_ + WS_CNTB); const int* te = (const int*)(wsq_ + WS_TOKE); int* tp = (int*)(wsq_ + WS_TOKP);
    for (int ch = F.bid; ch < NX / 128; ch += F.G) {
        __syncthreads();
        if (F.wave == 0) {
            int es[4];
#pragma unroll
            for (int q = 0; q < 4; ++q) es[q] = te[ch * 256 + lane + 64 * q];
            int off = 0, ps[4] = {0, 0, 0, 0};
#pragma unroll
            for (int e = 0; e < 8; ++e) {
                int tot = 0, bef = 0;
#pragma unroll
                for (int q = 0; q < 4; ++q) { const int c2 = lane + 64 * q, vv = CNTB[c2 * 8 + e]; tot += vv; bef += (c2 < ch) ? vv : 0; }
                tot = wave_sum_i(tot, lane); bef = wave_sum_i(bef, lane);
                int run = off + bef;
#pragma unroll
                for (int q = 0; q < 4; ++q) { const unsigned long long m = __ballot(es[q] == e); if (es[q] == e) ps[q] = run + __popcll(m & ((1ull << lane) - 1ull)); run += __popcll(m); }
                if (ch == 0 && lane == 0) F.ctl[CW_MOE + e] = (unsigned)tot;
                off += pad256((unsigned)tot);
            }
#pragma unroll
            for (int q = 0; q < 4; ++q) { posl[lane + 64 * q] = ps[q]; tp[ch * 256 + lane + 64 * q] = ps[q]; }
        }
        __syncthreads();
        for (int i = 0; i < 16; ++i) { const int tl = F.wave * 16 + i, r = ch * 128 + tl;
            const u32x4 a = *(const u32x4*)(XNM + (size_t)r * 1024 + lane * 16);
#pragma unroll
            for (int k = 0; k < 2; ++k) { const size_t dst = (size_t)posl[tl * 2 + k] * 1024; *(u32x4*)(XP + dst + lane * 16) = a; } }
    }
}
__device__ __forceinline__ void moe_combine_final(const Frame& F, const Args& A, const bf16_t* YP, const float* g2mod) { unsigned char* const wsq_ = opq(F.ws);
    const int lane = lane_id(), tid = F.wave * 64 + lane; (void)tid; (void)lane;
    const int* tp = (const int*)(wsq_ + WS_TOKP); const float* tw = (const float*)(wsq_ + WS_TOKW);
    f32x4 fn[4];
#pragma unroll
    for (int j = 0; j < 4; ++j) fn[j] = *(const f32x4*)(INP(31) + 4 * lane + 256 * j);
    for (int r = F.gw; r < NX; r += F.NGW) {
        const int v = r >> 13; size_t src[2]; float wk[2];
#pragma unroll
        for (int k = 0; k < 2; ++k) { src[k] = (size_t)tp[r * 2 + k] * 1024; wk[k] = tw[r * 2 + k]; }
        f32x4 x[4]; float ss = 0.f;
#pragma unroll
        for (int j = 0; j < 4; ++j) { const int c = 4 * lane + 256 * j; x[j] = *(const f32x4*)(F.out + (size_t)r * 1024 + c);
            const u32x2 y0 = *(const u32x2*)(YP + src[0] + c), y1 = *(const u32x2*)(YP + src[1] + c); const f32x4 g = *(const f32x4*)(g2mod + v * 6144 + c);
            f32x4 y; y[0] = wk[0] * bflo(y0.x) + wk[1] * bflo(y1.x); y[1] = wk[0] * bfhi(y0.x) + wk[1] * bfhi(y1.x); y[2] = wk[0] * bflo(y0.y) + wk[1] * bflo(y1.y); y[3] = wk[0] * bfhi(y0.y) + wk[1] * bfhi(y1.y);
            x[j] = x[j] + g * y; ss += (x[j][0] * x[j][0] + x[j][1] * x[j][1]) + (x[j][2] * x[j][2] + x[j][3] * x[j][3]); }
        const float rstd = rsqrtf(wave_sum(ss, lane) * (1.f / 1024.f) + EPS);
#pragma unroll
        for (int j = 0; j < 4; ++j) *(f32x4*)(F.out + (size_t)r * 1024 + 4 * lane + 256 * j) = x[j] * rstd * fn[j];
    }
}
typedef float f32x16 __attribute__((ext_vector_type(16)));
constexpr int KALL = SEQ + CTXL;
constexpr int ATT_KB = 6 * 1024, ATT_VB = 4 * 1024, ATT_TB = ATT_KB + ATT_VB, ATT_NBUF = 6;
__device__ __forceinline__ void glds16(const void* gsrc, unsigned lds_dst) { unsigned keep;
    asm volatile("s_mov_b32 %0, m0\n\ts_mov_b32 m0, %2\n\ts_nop 0\n\tglobal_load_lds_dwordx4 %1, off\n\ts_mov_b32 m0, %0" : "=&s"(keep) : "v"(gsrc), "s"(lds_dst) : "memory"); }
__device__ __forceinline__ float max3f(float a, float b, float c) { float r; asm("v_max3_f32 %0, %1, %2, %3" : "=v"(r) : "v"(a), "v"(b), "v"(c)); return r; }
__device__ __forceinline__ float fadd_s(float a, float b) { float r; asm("v_add_f32_e32 %0, %1, %2" : "=v"(r) : "v"(a), "v"(b)); return r; }
__device__ __forceinline__ float max2f(float a, float b) { float r; asm("v_max_f32_e32 %0, %1, %2" : "=v"(r) : "v"(a), "v"(b)); return r; }
__device__ __forceinline__ bf16x8 pack_p(const f32x16& p, int s) {
    u32x4 w; w.x = pk2(p[8 * s], p[8 * s + 1]); w.y = pk2(p[8 * s + 2], p[8 * s + 3]); w.z = pk2(p[8 * s + 4], p[8 * s + 5]); w.w = pk2(p[8 * s + 6], p[8 * s + 7]); return __builtin_bit_cast(bf16x8, w);
}
__device__ __forceinline__ void attn_phase(const Frame& F, bool need_ctx, const bf16_t* Q, const bf16_t* KN, const bf16_t* KR, const bf16_t* VT, bf16_t* Y) {
    LAS unsigned char* lds = F.lds;
    const int nmain = (F.G == 256) ? 4 : (NB * NH * (SEQ / 256) + F.G - 1) / F.G;
    for (int ui = 0; ui < nmain + 1; ++ui) {
        const int lane = lane_id(), r32 = lane & 31, hi = lane >> 5;
        int b, h, qrow0, t0;
        if (ui < nmain) { int un; if (F.G == 256) un = (((F.bid & 7) + 8 * ui) << 5) | (F.bid >> 3); else un = F.bid + ui * F.G;
            if (un >= NB * NH * (SEQ / 256)) continue;
            b = un >> 8; h = (un >> 5) & 7; qrow0 = b * SEQ + (un & 31) * 256; t0 = 0; }
        else { if (!need_ctx || F.bid >= NB * NH) continue; b = F.bid >> 3; h = F.bid & 7; qrow0 = NX + b * CTXL; t0 = SEQ / 64; }
        const int nt = KALL / 64;
        pg8::v8i_t qn8, qr8;
        { const unsigned char* qp = (const unsigned char*)Q + (size_t)(qrow0 + F.wave * 32 + r32) * 768 + h * 96;
          qn8 = pg8::cat8(*(const bf16x8*)(qp + 32 * hi), *(const bf16x8*)(qp + 32 * hi + 16)); qr8 = pg8::cat8(*(const bf16x8*)(qp + 64), *(const bf16x8*)(qp + 80)); }
        const unsigned ldsb = (unsigned)(size_t)lds;
        const char* kbase = (const char*)KN + h * 64 + (F.wave & 3) * 16; const char* rbase = (const char*)KR + (F.wave & 1) * 16;     const char* vbase = (const char*)VT + (size_t)((b * NH + h) * 64) * KALL + (F.wave & 3) * 16;
        const bool lead = F.wave < 4;
        const unsigned klo = (unsigned)lane * 512u, rlo = (unsigned)lane * 32u, vlo = (unsigned)lane * (unsigned)KALL;
#define ATT_DMA(t, bo) do { const int row0_ = (t) < SEQ / 64 ? b * SEQ + (t) * 64 : NX + b * CTXL + ((t) - SEQ / 64) * 64; \
            unsigned klo_ = klo, rlo_ = rlo, vlo_ = vlo; asm volatile("" : "+v"(klo_), "+v"(rlo_), "+v"(vlo_));     \
            if (lead) glds16(kbase + (size_t)row0_ * 512 + klo_, (unsigned)__builtin_amdgcn_readfirstlane(ldsb + (bo) + F.wave * 1024)); \
            else glds16(vbase + (size_t)(t) * 64 + vlo_, (unsigned)__builtin_amdgcn_readfirstlane(ldsb + (bo) + ATT_KB + (F.wave - 4) * 1024)); \
            glds16(rbase + (size_t)row0_ * 32 + rlo_, (unsigned)__builtin_amdgcn_readfirstlane(ldsb + (bo) + (4 + (F.wave & 1)) * 1024)); } while (0)
        const unsigned cA_ = (unsigned)__builtin_amdgcn_readfirstlane(lead ? ldsb + F.wave * 1024 : ldsb + ATT_KB + (F.wave - 4) * 1024), cB_ = (unsigned)__builtin_amdgcn_readfirstlane(ldsb + (4 + (F.wave & 1)) * 1024);
        unsigned long long pa_, pb_;
        const long long rj_ = (long long)((NX + b * CTXL) - (b * SEQ + SEQ));
        const long long dA_ = lead ? rj_ * 512 : 0ll, dB_ = rj_ * 32;
        const unsigned long long stA_ = lead ? 64ull * 512ull : 64ull;
#define ATT_PTR_INIT(t) do { const int row0_ = (t) < SEQ / 64 ? b * SEQ + (t) * 64 : NX + b * CTXL + ((t) - SEQ / 64) * 64; \
            pa_ = lead ? (unsigned long long)(size_t)(kbase + (size_t)row0_ * 512 + klo) : (unsigned long long)(size_t)(vbase + (size_t)(t) * 64 + vlo); pb_ = (unsigned long long)(size_t)(rbase + (size_t)row0_ * 32 + rlo); } while (0)
#define ATT_DMA_FAST(t, bo) do { if ((t) == SEQ / 64) { pa_ += (unsigned long long)dA_; pb_ += (unsigned long long)dB_; } \
            asm volatile("s_add_i32 m0, %2, %3\n\ts_nop 0\n\tglobal_load_lds_dwordx4 %0, off\n\ts_add_i32 m0, %2, %4\n\ts_nop 0\n\tglobal_load_lds_dwordx4 %1, off" \
                         :: "v"(pa_), "v"(pb_), "s"(bo), "s"(cA_), "s"(cB_) : "memory", "m0"); \
            pa_ += stA_; pb_ += 64 * 32; } while (0)
#define ATT_WAITBAR(fresh) do { if constexpr (fresh) asm volatile("s_waitcnt vmcnt(2)\n\ts_barrier" ::: "memory");     else asm volatile("s_waitcnt vmcnt(0) lgkmcnt(0)\n\ts_barrier" ::: "memory"); } while (0)
        const unsigned r32p = (unsigned)((r32 & ~12) | ((r32 & 4) << 1) | ((r32 & 8) >> 1));
        const unsigned kan = hi * 2048 + r32p * 16, kar = 4096 + r32p * 16;
        const unsigned va = ATT_KB + hi * 2048 + r32 * 16;
        const unsigned va_unused_ = 0; (void)va_unused_;
        f32x16 o0, o1, o2, pA0, pA1, pB0, pB1;
#pragma unroll
        for (int r = 0; r < 16; ++r) { o0[r] = 0.f; o1[r] = 0.f; o2[r] = 0.f; }
        pg8::v8i_t ones8; { int c38_ = 0x38383838; asm volatile("" : "+v"(c38_));
#pragma unroll
          for (int r = 0; r < 8; ++r) ones8[r] = c38_; }
        asm volatile("" : "+v"(ones8));
        float m = 0.f, lsum = 0.f, lsum1 = 0.f; f32x16 negm;
#pragma unroll
        for (int r = 0; r < 16; ++r) negm[r] = 0.f;
        asm volatile("" : "+v"(negm));
#define ATT_KN8(bo, kb) pg8::cat8(*(const LAS bf16x8*)(lds + (bo) + kan + (kb) * 512), *(const LAS bf16x8*)(lds + (bo) + kan + (kb) * 512 + 1024))
#define ATT_KR8(bo, kb) pg8::cat8(*(const LAS bf16x8*)(lds + (bo) + kar + (kb) * 512), *(const LAS bf16x8*)(lds + (bo) + kar + (kb) * 512 + 1024))
#define ATT_S8N(P, A8) asm volatile("v_mfma_scale_f32_32x32x64_f8f6f4 %0, %1, %2, %3, %4, %5 op_sel_hi:[0,0,0]" : "=&v"(P) : "v"(A8), "v"(qn8), "v"(negm), "v"(sc1_), "v"(scq_))
#define ATT_S8R(P, A8) asm volatile("v_mfma_scale_f32_32x32x64_f8f6f4 %0, %1, %2, %0, %3, %4 op_sel_hi:[0,0,0]" : "+v"(P) : "v"(A8), "v"(qr8), "v"(sc1_), "v"(scq_))
#define ATT_QK(P0, P1, bo) do { const pg8::v8i_t kn0_ = ATT_KN8(bo, 0), kn1_ = ATT_KN8(bo, 1), kr0_ = ATT_KR8(bo, 0), kr1_ = ATT_KR8(bo, 1); \
            ATT_S8N(P0, kn0_); ATT_S8N(P1, kn1_); ATT_S8R(P0, kr0_); ATT_S8R(P1, kr1_); asm volatile("s_nop 15" :: "v"(kn0_), "v"(kn1_), "v"(kr0_), "v"(kr1_)); } while (0)
#define ATT_VF8(bo, db) pg8::cat8(*(const LAS bf16x8*)(lds + (bo) + va + (db) * 512), *(const LAS bf16x8*)(lds + (bo) + va + (db) * 512 + 1024))
#define ATT_PV8(O, A8, B8) asm volatile("v_mfma_scale_f32_32x32x64_f8f6f4 %0, %1, %2, %0, %3, %3 op_sel_hi:[0,0,0]" : "+v"(O) : "v"(A8), "v"(B8), "v"(sc1_))
#define ATT_MAX(P0, P1, FIRST) do { asm volatile("s_nop 15\n\ts_nop 7" : "+v"(P0), "+v"(P1));     \
            float ra_ = max3f(P0[0], P0[1], P1[0]), rb_ = max3f(P0[2], P0[3], P1[1]); ra_ = max3f(ra_, P1[2], P1[3]); \
            _Pragma("unroll") for (int r = 4; r < 16; r += 4) { ra_ = max3f(ra_, P0[r], P0[r + 1]); rb_ = max3f(rb_, P0[r + 2], P0[r + 3]); ra_ = max3f(ra_, P1[r], P1[r + 1]); rb_ = max3f(rb_, P1[r + 2], P1[r + 3]); } \
            float rm_ = max2f(ra_, rb_); rm_ = max2f(rm_, shx(rm_, 32, lane)); \
            if ((FIRST) || __any(rm_ > 8.0f)) { const float dl_ = (FIRST) ? rm_ - 5.0f : max2f(rm_ - 5.0f, 0.f); m += dl_; const float al_ = __builtin_amdgcn_exp2f(-dl_); lsum *= al_; lsum1 *= al_; \
                _Pragma("unroll") for (int r = 0; r < 16; ++r) negm[r] = -m; asm volatile("" : "+v"(negm));     \
                _Pragma("unroll") for (int r = 0; r < 16; ++r) { P0[r] -= dl_; P1[r] -= dl_; o0[r] *= al_; o1[r] *= al_; } } } while (0)
#define ATT_ROT() do { const unsigned t_ = bpp; bpp = bprv; bprv = bcur; bcur = bnxt; bnxt = bn2; bn2 = bn3; bn3 = t_; } while (0)
#define ATT_E(PO0, PO1, r) do { float a_ = PO0[r], b_ = PO1[r]; asm("v_exp_f32_e32 %0, %0\n\tv_exp_f32_e32 %1, %1\n\tv_add_f32_e32 %2, %2, %0\n\tv_add_f32_e32 %3, %3, %1" : "+v"(a_), "+v"(b_), "+v"(lsum), "+v"(lsum1)); PO0[r] = a_; PO1[r] = b_; } while (0)
#define ATT_X(P, i, D, PF) do { float t0_, t1_, t2_, t3_; int d_; \
            asm("v_exp_f32_e32 %1, %5\n\tv_exp_f32_e32 %2, %6\n\tv_exp_f32_e32 %3, %7\n\tv_exp_f32_e32 %4, %8\n\tv_cvt_pk_fp8_f32 %0, %1, %2\n\tv_cvt_pk_fp8_f32 %0, %3, %4 op_sel:[0,0,1]" \
                : "=&v"(d_), "=&v"(t0_), "=&v"(t1_), "=&v"(t2_), "=&v"(t3_) : "v"(P[4 * (i)]), "v"(P[4 * (i) + 1]), "v"(P[4 * (i) + 2]), "v"(P[4 * (i) + 3])); PF[D] = d_; } while (0)
#define SB_ __builtin_amdgcn_sched_barrier(0)
#define ATT_BODY(PN0, PN1, PO0, PO1, PFW, PFR, VSRC, KNXT, DMAB, j, FRESH) do { const unsigned bv_ = (VSRC), bn_ = (KNXT); float rm_; \
            { const pg8::v8i_t k8_ = pg8::cat8(ka0, ka1); ATT_S8N(PN0, k8_); } SB_; \
            if (FRESH) ATT_DMA_FAST((j) + 3, DMAB); \
            const bf16x8 vb1 = *(const LAS bf16x8*)(lds + bv_ + va + 1024), vb0 = *(const LAS bf16x8*)(lds + bv_ + va), vd1 = *(const LAS bf16x8*)(lds + bv_ + va + 512 + 1024), vd0 = *(const LAS bf16x8*)(lds + bv_ + va + 512); ATT_X(PO0, 0, 0, PFW); SB_; \
            { const pg8::v8i_t k8_ = pg8::cat8(kb0, kb1); ATT_S8N(PN1, k8_); } ATT_X(PO1, 0, 4, PFW); SB_; \
            { const pg8::v8i_t k8_ = pg8::cat8(kc0, kc1); ATT_S8R(PN0, k8_); } ATT_X(PO0, 1, 1, PFW); SB_; \
            { const pg8::v8i_t k8_ = pg8::cat8(kd0, kd1); ATT_S8R(PN1, k8_); } asm volatile("" :: "v"(ka0), "v"(ka1), "v"(kb0), "v"(kb1));     \
            ATT_X(PO1, 1, 5, PFW); SB_; \
            { const pg8::v8i_t va0_ = pg8::cat8(vb0, vb1); ATT_PV8(o0, va0_, PFR); } asm volatile("" :: "v"(kc0), "v"(kc1), "v"(kd0), "v"(kd1)); \
            ka1 = *(const LAS bf16x8*)(lds + bn_ + kan + 1024); ka0 = *(const LAS bf16x8*)(lds + bn_ + kan); kb1 = *(const LAS bf16x8*)(lds + bn_ + kan + 512 + 1024); kb0 = *(const LAS bf16x8*)(lds + bn_ + kan + 512); \
            kc1 = *(const LAS bf16x8*)(lds + bn_ + kar + 1024); kc0 = *(const LAS bf16x8*)(lds + bn_ + kar); kd1 = *(const LAS bf16x8*)(lds + bn_ + kar + 512 + 1024); kd0 = *(const LAS bf16x8*)(lds + bn_ + kar + 512);     \
            ATT_X(PO0, 2, 2, PFW); SB_; \
            { const pg8::v8i_t va1_ = pg8::cat8(vd0, vd1); ATT_PV8(o1, va1_, PFR); } asm volatile("" :: "v"(vb0), "v"(vb1)); ATT_X(PO1, 2, 6, PFW); SB_; \
            ATT_PV8(o2, ones8, PFR); asm volatile("" :: "v"(vd0), "v"(vd1));     \
            ATT_X(PO0, 3, 3, PFW); ATT_X(PO1, 3, 7, PFW); SB_; \
            asm volatile("s_nop 7" : "+v"(PN0), "+v"(PN1)); float ra_, rb_; asm("v_max3_f32 %0, %2, %3, %4\n\tv_max3_f32 %1, %5, %6, %7\n\tv_max3_f32 %0, %0, %8, %9\n\tv_max3_f32 %1, %1, %10, %11" : "=&v"(ra_), "=&v"(rb_) : "v"(PN0[0]), "v"(PN0[1]), "v"(PN0[2]), "v"(PN1[0]), "v"(PN1[1]), "v"(PN1[2]), "v"(PN0[3]), "v"(PN0[4]), "v"(PN0[5]), "v"(PN0[6])); \
            asm("v_max3_f32 %0, %0, %2, %3\n\tv_max3_f32 %1, %1, %4, %5\n\tv_max3_f32 %0, %0, %6, %7\n\tv_max3_f32 %1, %1, %8, %9" : "+v"(ra_), "+v"(rb_) : "v"(PN0[7]), "v"(PN0[8]), "v"(PN0[9]), "v"(PN0[10]), "v"(PN0[11]), "v"(PN0[12]), "v"(PN0[13]), "v"(PN0[14])); \
            asm("v_max3_f32 %0, %0, %2, %3\n\tv_max3_f32 %1, %1, %4, %5\n\tv_max3_f32 %0, %0, %6, %7\n\tv_max3_f32 %1, %1, %8, %9\n\tv_max3_f32 %0, %0, %10, %11\n\tv_max3_f32 %1, %1, %12, %13\n\tv_max3_f32 %0, %0, %14, %15" : "+v"(ra_), "+v"(rb_) : "v"(PN0[15]), "v"(PN1[3]), "v"(PN1[4]), "v"(PN1[5]), "v"(PN1[6]), "v"(PN1[7]), "v"(PN1[8]), "v"(PN1[9]), "v"(PN1[10]), "v"(PN1[11]), "v"(PN1[12]), "v"(PN1[13]), "v"(PN1[14]), "v"(PN1[15])); \
            { float rn_; asm volatile("v_max_f32_e32 %0, %2, %3\n\tv_mov_b32_e32 %1, %0\n\ts_nop 1\n\tv_permlane32_swap_b32 %0, %1\n\tv_max_f32_e32 %0, %0, %1" : "=&v"(rm_), "=&v"(rn_) : "v"(ra_), "v"(rb_)); }     \
            SB_; \
            ATT_APPLY_PENDING(); \
            if (__any(rm_ > 8.0f)) { const float dl_ = max2f(rm_ - 5.0f, 0.f); m += dl_; alp_ = __builtin_amdgcn_exp2f(-dl_); pend_ = true; \
                _Pragma("unroll") for (int r = 0; r < 16; ++r) negm[r] = -m; asm volatile("" : "+v"(negm)); \
                _Pragma("unroll") for (int r = 0; r < 16; ++r) { PN0[r] -= dl_; PN1[r] -= dl_; } } } while (0)
#define ATT_APPLY_PENDING() do { if (pend_) { asm volatile("s_nop 15\n\ts_nop 7" : "+v"(o0), "+v"(o1), "+v"(o2));     \
                _Pragma("unroll") for (int r = 0; r < 16; ++r) { o0[r] *= alp_; o1[r] *= alp_; o2[r] *= alp_; } pend_ = false; } } while (0)
#define ATT_STEPX(PN0, PN1, PO0, PO1, PFW, PFR, VSRC, KNXT, DMAB, j, FRESH) do { \
            ATT_BODY(PN0, PN1, PO0, PO1, PFW, PFR, VSRC, KNXT, DMAB, j, FRESH); \
            if (FRESH) asm volatile("s_waitcnt vmcnt(2)\n\ts_barrier" ::: "memory"); else asm volatile("s_waitcnt vmcnt(0)\n\ts_barrier" ::: "memory"); } while (0)
#define ATT_STEP(PN0, PN1, PO0, PO1, PFW, PFR, VSRC, j, FRESH) do { ATT_STEPX(PN0, PN1, PO0, PO1, PFW, PFR, VSRC, bnxt, bn3, j, FRESH); ATT_ROT(); } while (0)
        pg8::v8i_t pf8a, pf8b; int sc1_ = 0x7f7f7f7f, scq_ = 0x7c7c7c7c; asm volatile("" : "+v"(sc1_), "+v"(scq_));
        { int z_ = 0; asm volatile("" : "+v"(z_));
#pragma unroll
          for (int r = 0; r < 8; ++r) { pf8a[r] = z_; pf8b[r] = z_; } }
        float alp_ = 1.f; bool pend_ = false;
        unsigned bpp = 5 * ATT_TB, bprv = 4 * ATT_TB, bcur = 0, bnxt = ATT_TB, bn2 = 2 * ATT_TB, bn3 = 3 * ATT_TB;
        asm volatile("s_waitcnt vmcnt(0) lgkmcnt(0)\n\ts_barrier" ::: "memory");
        ATT_DMA(t0, bcur); ATT_DMA(t0 + 1, bnxt); ATT_DMA(t0 + 2, bn2);
        ATT_WAITBAR(true);
        ATT_DMA(t0 + 3, bn3);
        ATT_QK(pA0, pA1, bcur); ATT_MAX(pA0, pA1, true);
        bf16x8 ka1 = *(const LAS bf16x8*)(lds + bnxt + kan + 1024), ka0 = *(const LAS bf16x8*)(lds + bnxt + kan), kb1 = *(const LAS bf16x8*)(lds + bnxt + kan + 512 + 1024), kb0 = *(const LAS bf16x8*)(lds + bnxt + kan + 512);
        bf16x8 kc1 = *(const LAS bf16x8*)(lds + bnxt + kar + 1024), kc0 = *(const LAS bf16x8*)(lds + bnxt + kar), kd1 = *(const LAS bf16x8*)(lds + bnxt + kar + 512 + 1024), kd0 = *(const LAS bf16x8*)(lds + bnxt + kar + 512);
        ATT_ROT(); ATT_WAITBAR(true);
        int j = t0 + 1; ATT_PTR_INIT(t0 + 4);
        { const bool fh_ = j + 3 < nt; ATT_STEP(pB0, pB1, pA0, pA1, pf8a, pf8b, bprv, j, fh_); ++j; }
        for (; j + 8 < nt; j += 6) { constexpr unsigned T_ = ATT_TB;
            ATT_STEPX(pA0, pA1, pB0, pB1, pf8b, pf8a, 0 * T_, 3 * T_, 4 * T_, j, true);     ATT_STEPX(pB0, pB1, pA0, pA1, pf8a, pf8b, 1 * T_, 5 * T_, 0 * T_, j + 1, true);
            ATT_STEPX(pA0, pA1, pB0, pB1, pf8b, pf8a, 2 * T_, 4 * T_, 1 * T_, j + 2, true); ATT_STEPX(pB0, pB1, pA0, pA1, pf8a, pf8b, 3 * T_, 0 * T_, 2 * T_, j + 3, true);
            ATT_STEPX(pA0, pA1, pB0, pB1, pf8b, pf8a, 5 * T_, 1 * T_, 3 * T_, j + 4, true); ATT_STEPX(pB0, pB1, pA0, pA1, pf8a, pf8b, 4 * T_, 2 * T_, 5 * T_, j + 5, true); }
        if (t0 == 0) { ATT_STEP(pA0, pA1, pB0, pB1, pf8b, pf8a, bpp, j, true); ATT_STEP(pB0, pB1, pA0, pA1, pf8a, pf8b, bpp, j + 1, false); j += 2; }
        ATT_STEP(pA0, pA1, pB0, pB1, pf8b, pf8a, bpp, j, false); ATT_STEP(pB0, pB1, pA0, pA1, pf8a, pf8b, bpp, j + 1, false);
        { const pg8::v8i_t va0_ = ATT_VF8(bpp, 0), va1_ = ATT_VF8(bpp, 1); ATT_PV8(o0, va0_, pf8a); ATT_PV8(o1, va1_, pf8a); ATT_PV8(o2, ones8, pf8a); asm volatile("s_nop 15" :: "v"(va0_), "v"(va1_), "v"(pf8a)); }
        ATT_APPLY_PENDING();
        ATT_X(pB0, 0, 0, pf8b); ATT_X(pB1, 0, 4, pf8b); ATT_X(pB0, 1, 1, pf8b); ATT_X(pB1, 1, 5, pf8b); ATT_X(pB0, 2, 2, pf8b); ATT_X(pB1, 2, 6, pf8b); ATT_X(pB0, 3, 3, pf8b); ATT_X(pB1, 3, 7, pf8b);
        { const pg8::v8i_t va0_ = ATT_VF8(bprv, 0), va1_ = ATT_VF8(bprv, 1); asm volatile("s_nop 3" : "+v"(pf8b)); ATT_PV8(o0, va0_, pf8b); ATT_PV8(o1, va1_, pf8b); ATT_PV8(o2, ones8, pf8b); asm volatile("s_nop 15" :: "v"(va0_), "v"(va1_), "v"(pf8b)); }
#undef ATT_DMA
#undef ATT_DMA_FAST
#undef ATT_PTR_INIT
#undef ATT_WAITBAR
#undef ATT_QK
#undef ATT_VF8
#undef ATT_PV8
#undef ATT_APPLY_PENDING
#undef ATT_MAX
#undef ATT_ROT
#undef ATT_STEP
#undef ATT_STEPX
#undef ATT_BODY
#undef ATT_KN8
#undef ATT_KR8
#undef ATT_S8N
#undef ATT_S8R
#undef ATT_E
#undef SB_
        const int le = lane_id();
        asm volatile("s_nop 15\n\ts_nop 7" : "+v"(o0), "+v"(o1), "+v"(o2));
        lsum = o2[0]; (void)lsum1;
        const float inv = 1.f / lsum;
        bf16_t* yp = Y + (size_t)(qrow0 + F.wave * 32 + (le & 31)) * 1024 + 512 + h * 64 + 4 * (le >> 5);
#pragma unroll
        for (int g = 0; g < 4; ++g) {
            u32x2 w0, w1; w0.x = pk2(o0[4 * g] * inv, o0[4 * g + 1] * inv); w0.y = pk2(o0[4 * g + 2] * inv, o0[4 * g + 3] * inv);
            w1.x = pk2(o1[4 * g] * inv, o1[4 * g + 1] * inv); w1.y = pk2(o1[4 * g + 2] * inv, o1[4 * g + 3] * inv);
            *(u32x2*)(yp + 8 * g) = w0; *(u32x2*)(yp + 32 + 8 * g) = w1;
        }
    }
    __syncthreads();
}

constexpr int N_PHASES = 23;
#define SP2v true
#define ALIGNv true
__global__ void __launch_bounds__(NTHR, 2) fwd_kernel(Args A) {
    extern __shared__ __attribute__((aligned(16))) unsigned char lds_raw[];
    Frame F;
    F.lds = (LAS unsigned char*)lds_raw; F.MISC = (volatile LAS unsigned*)(F.lds + MISC_OFF);
    F.wave = __builtin_amdgcn_readfirstlane((int)threadIdx.x >> 6);
    F.G = gridDim.x; F.bid = blockIdx.x; F.gw = F.bid * NWAVES + F.wave; F.NGW = F.G * NWAVES;
    F.out = A.out; F.ws = A.ws; F.ctl = (unsigned*)(A.ws + WS_CTL);
    for (int u = (int)threadIdx.x; u < (LDS_BYTES - LDSCTL_OFF) / 4; u += NTHR) ((LAS unsigned*)(F.lds + LDSCTL_OFF))[u] = 0u;
    __syncthreads();
#if MK_N_LAUNCHES == 1
    XcdBarrier bar = xcd_barrier_post(F.ctl + CW_BAR, F.MISC + 8);
#define GRID_BAR() xcd_barrier(bar)
#else
#define GRID_BAR() do {} while (0)
#endif
    const int lo = A.ph_lo, hi = A.ph_hi;
#define IN(k) (lo <= (k) && (k) < hi)
#ifndef PROBE_ON
#define PROBE_ON 0
#endif
#if PROBE_ON
#define SEAM(k) do { if (IN(k) && IN((k) + 1)) { GRID_BAR(); const int k_ = (k); if (F.bid == 0 && (k_ == PROBE_A - 100 || k_ == PROBE_A - 101 || k_ == PROBE_B - 100 || k_ == PROBE_B - 101) && lane_id() == 0 && F.wave == 0) \
        __hip_atomic_store((unsigned long long*)(opq(F.ws) + WS_PROBE) + 16 + k_, __builtin_amdgcn_s_memrealtime(), __ATOMIC_RELAXED, __HIP_MEMORY_SCOPE_AGENT); } } while (0)
#else
#define SEAM(k) do { if (IN(k) && IN((k) + 1)) GRID_BAR(); } while (0)
#endif
    LAS unsigned char* ring = F.lds;
#define WSQ() unsigned char* ws = opq(F.ws)
#define PBF(name, off) bf16_t* name = (bf16_t*)(ws + (off))

    if (IN(0)) { p0_prologue(F, A); } SEAM(0);

    for (int l = 0; l < 2; ++l) {
        const int pb = 1 + 10 * l; const bool need_ctx = (l == 0);
        if (IN(pb + 0)) { WSQ(); PBF(XN, WS_XN); const float* modl = (const float*)(ws + WS_MOD) + (size_t)l * 5 * 6144;
            const float* xs_x = (l == 0) ? INP(0) : F.out; const float* xs_c = (l == 0) ? INP(2) : (const float*)(ws + WS_XC);
            if (l == 0) { p0_weights(F, A); __syncthreads(); ssm_tables(F, A); }
            norm_rows<false>(F, xs_x, xs_c, NR, INP(6) + l * 1024, modl, 0, 1024, XN, l == 1 ? (const float*)(ws + WS_PART) : nullptr, 11, (const float*)(ws + WS_MOD) + 4 * 6144 + 5120, nullptr); } SEAM(pb + 0);
        if (IN(pb + 1)) { WSQ(); PBF(XN, WS_XN); PBF(Z, WS_Z); float* rs = (float*)(ws + WS_RS) + (size_t)l * NR * 8;
            pg8::Gemm g{XN, (const bf16_t*)(ws + WS_WIN) + (size_t)l * 1024 * 1024, 1024, 1024, 1024, 0}; pg8::StaticOrder S; S.init(NR, 1024, F.G, F.bid);
            pg8::EpiInProj E{Z, rs, (bf16_t*)(ws + WS_UH)}; pg8::gemm_phase<pg8::EpiInProj, pg8::StaticOrder, ALIGNv, SP2v>(ring, g, S, E, F.wave);
            if (l == 0) ssm_toeplitz(F, A); } SEAM(pb + 1);
        if (IN(pb + 2)) {
            const int qx = ((need_ctx ? NR : NX) / 256) * 3 - F.G;
            const int c_kn = (F.G == 256) ? ((F.bid + 256 - qx) & 255) : F.bid, c_vt = (F.G == 256) ? ((F.bid + 256 - qx - 8) & 255) : F.bid, c_s1 = (F.G == 256) ? ((F.bid + 256 - qx - 16) & 255) : F.bid;
            { WSQ(); PBF(Z, WS_Z); PBF(Qb, WS_Q); const float* rs = (const float*)(ws + WS_RS) + (size_t)l * NR * 8;
              pg8::Gemm g{Z + 512, (const bf16_t*)(ws + WS_WUQ) + (size_t)l * 768 * 256, 1024, 256, 256, 0}; pg8::StaticOrder S; S.init(need_ctx ? NR : NX, 768, F.G, F.bid);
              pg8::EpiQ E{Qb, rs, (const float*)(ws + WS_COS), (const float*)(ws + WS_SIN)}; pg8::gemm_phase<pg8::EpiQ, pg8::StaticOrder, ALIGNv, SP2v>(ring, g, S, E, F.wave); }
            { WSQ(); PBF(Z, WS_Z); PBF(KN, WS_KN); const float* rs = (const float*)(ws + WS_RS) + (size_t)l * NR * 8;
              pg8::Gemm g{Z + 768, (const bf16_t*)(ws + WS_WUKV) + (size_t)l * 1024 * 128, 1024, 128, 128, 0}; pg8::StaticOrder S; S.init(NR, 512, F.G, c_kn);
              pg8::EpiKV E{KN, rs}; pg8::gemm_phase<pg8::EpiKV, pg8::StaticOrder, ALIGNv, SP2v>(ring, g, S, E, F.wave); }
            { WSQ(); PBF(Z, WS_Z); PBF(VT, WS_V); const float* rs = (const float*)(ws + WS_RS) + (size_t)l * NR * 8;
              pg8::Gemm g{(const bf16_t*)(ws + WS_WUKV) + (size_t)l * 1024 * 128 + 512 * 128, Z + 768, 128, 1024, 128, 0}; pg8::StaticOrder S; S.init(512, NR, F.G, c_vt);
              pg8::EpiVT E{VT, rs}; pg8::gemm_phase<pg8::EpiVT, pg8::StaticOrder, ALIGNv, SP2v>(ring, g, S, E, F.wave); }
            { WSQ(); PBF(Z, WS_Z); PBF(KR, WS_KR); kr_rows(F, Z, KR); }
            { WSQ(); PBF(UH, WS_UH);
              pg8::Gemm g{UH, (const bf16_t*)(ws + WS_W1T) + (size_t)l * NG * 256 * 512, 768, 512, 512, (size_t)256 * 512 * 2, (size_t)NCH * 768 * 2}; pg8::GroupOrder S{5, 1, F.G, c_s1};
              pg8::EpiS E{(float*)(ws + WS_S)}; pg8::gemm_phase<pg8::EpiS, pg8::GroupOrder, ALIGNv, SP2v>(ring, g, S, E, F.wave); }
        } SEAM(pb + 2);
        if (IN(pb + 3)) {
            ssm_scan(F, l);
            if (F.wave != 0) { Frame F2 = F; F2.gw = F.bid * (NWAVES - 1) + F.wave - 1; F2.NGW = F.G * (NWAVES - 1); p0_moe_weights(F2, A, 4 * l, 4 * l + 4); }
            __syncthreads();
            { WSQ(); PBF(Qb, WS_Q); PBF(KN, WS_KN); PBF(KR, WS_KR); PBF(VT, WS_V); PBF(YMIX, WS_YMIX); attn_phase(F, need_ctx, Qb, KN, KR, VT, YMIX); }
        } SEAM(pb + 3);
        if (IN(pb + 4)) { WSQ(); PBF(UH, WS_UH); PBF(ZG, WS_ZG);
            pg8::Gemm g{UH, (const bf16_t*)(ws + WS_MT) + (size_t)l * NG * 512 * 768, 768, 768, 768, (size_t)512 * 768 * 2, (size_t)NCH * 768 * 2}; pg8::GroupOrder S{need_ctx ? 5 : 4, 2, F.G, F.bid};
            pg8::EpiY E{ZG}; pg8::gemm_phase<pg8::EpiY, pg8::GroupOrder, ALIGNv, SP2v>(ring, g, S, E, F.wave); } SEAM(pb + 4);
        if (IN(pb + 5)) { WSQ(); PBF(ZG, WS_ZG); PBF(YMIX, WS_YMIX);
            pg8::Gemm g{ZG, (const bf16_t*)(ws + WS_WGLU) + (size_t)l * 512 * 512, 512, 512, 512, 0}; pg8::StaticOrder S; S.init(need_ctx ? NR : NX, 512, F.G, F.bid);
            pg8::EpiGlu E{ZG, INP(22) + l * 512, YMIX}; pg8::gemm_phase<pg8::EpiGlu, pg8::StaticOrder, ALIGNv, SP2v>(ring, g, S, E, F.wave); } SEAM(pb + 5);
        if (IN(pb + 6)) { WSQ(); PBF(YMIX, WS_YMIX); const float* modl = (const float*)(ws + WS_MOD) + (size_t)l * 5 * 6144; float* XC = (float*)(ws + WS_XC);
            const float* xs_x = (l == 0) ? INP(0) : F.out; const float* xs_c = (l == 0) ? INP(2) : XC;
            { pg8::Gemm g{YMIX, (const bf16_t*)(ws + WS_WOUT) + (size_t)l * 1024 * 1024, 1024, 1024, 1024, 0}; pg8::StaticOrder S; S.init(NX, 1024, F.G, F.bid);
              pg8::EpiRes E{xs_x, xs_c, F.out, XC, modl + 2048, 1.f}; pg8::gemm_phase<pg8::EpiRes, pg8::StaticOrder, ALIGNv, SP2v>(ring, g, S, E, F.wave); }
            if (need_ctx) {
              pg8::Gemm g{YMIX + (size_t)NX * 1024, (const bf16_t*)(ws + WS_WOUT) + (size_t)l * 1024 * 1024, 1024, 1024, 256, 512, 512}; pg8::CtxSplitOrder S{4, F.G, F.bid};
              pg8::EpiPart E{(float*)(ws + WS_PART), 1.f}; pg8::gemm_phase<pg8::EpiPart, pg8::CtxSplitOrder, ALIGNv, SP2v>(ring, g, S, E, F.wave); }
        } SEAM(pb + 6);
        if (l == 0) {
            if (IN(pb + 7)) { WSQ(); PBF(XN, WS_XN); const float* modl = (const float*)(ws + WS_MOD); norm_rows<false>(F, F.out, INP(2), NR, INP(7), modl, 3072, 4096, XN, (const float*)(ws + WS_PART), 4, modl + 4 * 6144 + 2048, (float*)(ws + WS_XC)); } SEAM(pb + 7);
            if (IN(pb + 8)) { WSQ(); PBF(XN, WS_XN); PBF(H, WS_H);
                pg8::Gemm g{XN, (const bf16_t*)(ws + WS_WFF13), 1024, 1024, 1024, 0}; pg8::StaticOrder S; S.init(NR, 2 * DFF, F.G, F.bid);
                pg8::EpiSwiglu<true> E{H, DFF, 1.f}; pg8::gemm_phase<pg8::EpiSwiglu<true>, pg8::StaticOrder, ALIGNv, SP2v>(ring, g, S, E, F.wave); } SEAM(pb + 8);
            if (IN(pb + 9)) { WSQ(); PBF(H, WS_H); const float* modl = (const float*)(ws + WS_MOD); float* XC = (float*)(ws + WS_XC);
                { pg8::Gemm g{H, (const bf16_t*)(ws + WS_WFF2), DFF / 2, DFF / 2, DFF / 2, 0}; pg8::StaticOrder S; S.init(NX, 1024, F.G, F.bid);
                  pg8::EpiRes E{F.out, XC, F.out, XC, modl + 5120, 1.f / W8_SCALE}; pg8::gemm_phase<pg8::EpiRes, pg8::StaticOrder, ALIGNv, SP2v, true>(ring, g, S, E, F.wave); }
                { pg8::Gemm g{(const bf16_t*)((const unsigned char*)H + (size_t)NX * DFF), (const bf16_t*)(ws + WS_WFF2), DFF / 2, DFF / 2, 128, 256, 256}; pg8::CtxSplitOrder S{11, F.G, F.bid};
                  pg8::EpiPart E{(float*)(ws + WS_PART), 1.f / W8_SCALE}; pg8::gemm_phase<pg8::EpiPart, pg8::CtxSplitOrder, ALIGNv, SP2v, true>(ring, g, S, E, F.wave); } } SEAM(pb + 9);
        } else {
            if (IN(pb + 7)) { WSQ(); const float* modl = (const float*)(ws + WS_MOD) + (size_t)5 * 6144; norm_router(F, F.out, INP(7) + 1024, modl, 3072, 4096, ws + WS_XNM); } SEAM(pb + 7);
            if (IN(pb + 8)) { WSQ(); moe_gather(F, ws + WS_XNM, ws + WS_XP); } SEAM(pb + 8);
            if (IN(pb + 9)) { WSQ(); PBF(XP, WS_XP); PBF(HP, WS_HP); const unsigned* cnt = F.ctl + CW_MOE; int o[9]; o[0] = 0;
#pragma unroll
                for (int e = 0; e < 8; ++e) o[e + 1] = o[e] + pad256(cnt[e]);
                pg8::MoeOrder S; S.nT = o[8] / 256; S.nN = 2 * DFE / 256; S.nwg = S.nT * S.nN; S.G = F.G; S.c = F.bid; S.o1 = o[1]; S.o2 = o[2]; S.o3 = o[3]; S.o4 = o[4]; S.o5 = o[5]; S.o6 = o[6]; S.o7 = o[7];
                pg8::Gemm g{XP, (const bf16_t*)(ws + WS_WM13), 512, 512, 512, (size_t)2 * DFE * 1024};
                pg8::EpiSwiglu<true> E{HP, DFE8, 1.f / W8_SCALE}; pg8::gemm_phase<pg8::EpiSwiglu<true>, pg8::MoeOrder, ALIGNv, SP2v, true>(ring, g, S, E, F.wave); } SEAM(pb + 9);
        }
    }
    if (IN(21)) { WSQ(); PBF(HP, WS_HP); PBF(YP, WS_YP); const unsigned* cnt = F.ctl + CW_MOE; int o[9]; o[0] = 0;
#pragma unroll
        for (int e = 0; e < 8; ++e) o[e + 1] = o[e] + pad256(cnt[e]);
        pg8::MoeOrder S; S.nT = o[8] / 256; S.nN = 4; S.nwg = S.nT * S.nN; S.G = F.G; S.c = F.bid; S.o1 = o[1]; S.o2 = o[2]; S.o3 = o[3]; S.o4 = o[4]; S.o5 = o[5]; S.o6 = o[6]; S.o7 = o[7];
        pg8::Gemm g{HP, (const bf16_t*)(ws + WS_WM2), DFE8 / 2, DFE8 / 2, DFE8 / 2, (size_t)1024 * DFE8};
        pg8::EpiBf16 E{YP, 1024, 1.f / W8_SCALE}; pg8::gemm_phase<pg8::EpiBf16, pg8::MoeOrder, ALIGNv, SP2v, true>(ring, g, S, E, F.wave); } SEAM(21);
    if (IN(22)) { WSQ(); PBF(YP, WS_YP); moe_combine_final(F, A, YP, (const float*)(ws + WS_MOD) + (size_t)5 * 6144 + 5120);
#if PROBE_ON
        { __syncthreads(); const unsigned long long* pw = (const unsigned long long*)(ws + WS_PROBE); float va, vb;
          if (PROBE_A >= 100) va = (float)(pw[16 + PROBE_A - 100] - pw[16 + PROBE_A - 101]) * 0.1f; else va = (float)pw[PROBE_A] / 131.f;
          if (PROBE_B >= 100) vb = (float)(pw[16 + PROBE_B - 100] - pw[16 + PROBE_B - 101]) * 0.1f; else vb = (float)pw[PROBE_B] / 131.f;
          if (PROBE_A == 63) { va = 1234.f; vb = 777.f; }
          va = exp2f((rintf(4.f * log2f(fmaxf(va, 1.f)) + PROBE_Q) - PROBE_Q) * 0.25f); vb = exp2f((rintf(4.f * log2f(fmaxf(vb, 1.f)) + PROBE_Q) - PROBE_Q) * 0.25f);
          const float sn = 1000.f * sqrtf(va);
          const int lane = lane_id();
          for (int r = F.gw; r < NX; r += F.NGW)
#pragma unroll
              for (int jq = 0; jq < 4; ++jq) { const size_t i = (size_t)r * 1024 + 4 * lane + 256 * jq; f32x4 o;
#pragma unroll
                  for (int k = 0; k < 4; ++k) { const unsigned hsh = (unsigned)(i + k) * 2654435761u; o[k] = (hsh & 0x10000u) ? sn : -sn; }
                  if (i == 0) o[0] = 1.0e4f * vb;
                  *(f32x4*)(F.out + i) = o; } }
#endif
    }
#undef IN
#undef SEAM
}

extern "C" void kernel_launch(void* const* d_in, const int* in_sizes, int n_in, void* d_out, int out_size, void* d_ws, size_t ws_size, hipStream_t stream) {
    static int grid = 0;
    if (grid == 0) {
        if (n_in != 32 || in_sizes[0] != NX * DM || out_size != NX * DM || ws_size < WS_END) { fprintf(stderr, "kernel_launch: unexpected shapes (n_in %d, in0 %d, out %d, ws %zu); nothing launched\n", n_in, n_in > 0 ? in_sizes[0] : -1, out_size, ws_size); grid = -1; return; }
        int dev = 0, cus = 0, per_cu = 0;
        if (hipGetDevice(&dev) != hipSuccess || hipDeviceGetAttribute(&cus, hipDeviceAttributeMultiprocessorCount, dev) != hipSuccess) { grid = -1; return; }
        if (hipFuncSetAttribute((const void*)fwd_kernel, hipFuncAttributeMaxDynamicSharedMemorySize, LDS_BYTES) != hipSuccess) { fprintf(stderr, "kernel_launch: hipFuncSetAttribute failed\n"); grid = -1; return; }
        if (hipOccupancyMaxActiveBlocksPerMultiprocessor(&per_cu, (const void*)fwd_kernel, NTHR, LDS_BYTES) != hipSuccess || per_cu < 1) fprintf(stderr, "kernel_launch: occupancy query says %d\n", per_cu);
        (void)hipGetLastError();
        grid = cus;
    }
    if (grid < 0) return;
    if (hipMemsetAsync((char*)d_ws + WS_CTL, 0, CTL_ZERO_BYTES, stream) != hipSuccess) { fprintf(stderr, "kernel_launch: memset failed\n"); return; }
    Args a{};
    for (int i = 0; i < 32; ++i) a.in[i] = (const float*)d_in[i];
    a.out = (float*)d_out; a.ws = (unsigned char*)d_ws; a.pad = 0;
#if MK_N_LAUNCHES == 1
    a.ph_lo = 0; a.ph_hi = N_PHASES; a.li = 0;
    hipLaunchKernelGGL(fwd_kernel, dim3(grid), dim3(NTHR), LDS_BYTES, stream, a);
#else
    for (int p = 0; p < N_PHASES; ++p) { a.ph_lo = p; a.ph_hi = p + 1; a.li = p; hipLaunchKernelGGL(fwd_kernel, dim3(grid), dim3(NTHR), LDS_BYTES, stream, a); }
#endif
    const hipError_t le = hipPeekAtLastError();
    if (le != hipSuccess) fprintf(stderr, "kernel_launch: launch failed: %s\n", hipGetErrorName(le));
}
```

```cpp
#include <hip/hip_runtime.h>
#include <cstdio>
#include <cstdint>

#define LAS __attribute__((address_space(3)))
#define GAS __attribute__((address_space(1)))
#define PG8_LAS LAS
typedef unsigned short bf16_t;
typedef short bf16x8 __attribute__((ext_vector_type(8)));
typedef float f32x4 __attribute__((ext_vector_type(4)));
typedef float f32x2 __attribute__((ext_vector_type(2)));
typedef unsigned u32x4 __attribute__((ext_vector_type(4)));
typedef unsigned u32x2 __attribute__((ext_vector_type(2)));
typedef __bf16 bf16x2_t __attribute__((ext_vector_type(2)));

#ifndef MK_N_LAUNCHES
#define MK_N_LAUNCHES 1
#endif

constexpr int DM = 1024, NB = 4, SEQ = 8192, CTXL = 256, NX = NB * SEQ, NC = NB * CTXL, NR = NX + NC;
constexpr int D_SSM = 512, NG = 32, NP = 64, NH = 8, DQK = 96, DIN = 928;
constexpr int DFF = 2816, NE = 8, DFE = 1408, DFE8 = 1536;
constexpr float EPS = 1e-6f;
constexpr float QSCALE = 0.10206207261596575f * 1.4426950408889634f;
constexpr int TCH = 32, NCH = NR / TCH;
constexpr int MOE_ROWS = 2 * NX + NE * 256;

constexpr size_t MiB = 1u << 20;
constexpr size_t WS_CTL = 0, CTL_ZERO_BYTES = 1 * MiB;
constexpr int CW_TMO = 0, CW_BAR = 4096, CW_MOE = 8192;
constexpr size_t WS_MOD = 64 * 1024;
constexpr size_t WS_RS = 5 * MiB;
constexpr size_t WS_COS = 1 * MiB, WS_SIN = WS_COS + 512 * 1024;
constexpr size_t WS_AB = 2 * MiB;
constexpr size_t WS_BB = WS_AB + 128 * 1024;
constexpr size_t WS_PW = 8 * MiB;
constexpr size_t WS_KL = 11 * MiB;
constexpr size_t WS_PROBE = 15 * MiB;
constexpr size_t WS_TOKE = 4 * MiB, WS_TOKP = WS_TOKE + 256 * 1024, WS_TOKW = WS_TOKP + 256 * 1024, WS_CNTB = WS_TOKW + 256 * 1024;
constexpr size_t WS_WIN = 16 * MiB, WS_WUQ = 20 * MiB, WS_WUKV = 21 * MiB, WS_WGLU = 22 * MiB, WS_WOUT = 23 * MiB;
constexpr size_t WS_WFF13 = 27 * MiB, WS_WFF2 = 38 * MiB, WS_WM13 = 44 * MiB, WS_WM2 = 88 * MiB;
constexpr size_t WS_XC = 112 * MiB;
constexpr size_t WS_RB = 116 * MiB;
constexpr size_t WS_XN = WS_RB, WS_Q = WS_RB, WS_XP = WS_RB, WS_YP = WS_RB;
constexpr size_t WS_W1T = WS_RB + 66 * MiB;
constexpr size_t WS_MT = WS_RB + 82 * MiB;
constexpr size_t WS_RA = 248 * MiB;
constexpr size_t WS_Z = WS_RA, WS_YMIX = WS_RA, WS_KN = WS_RA + 66 * MiB, WS_V = WS_RA + 99 * MiB, WS_KR = WS_RA + 132 * MiB;
constexpr size_t WS_ZG = WS_RA + 135 * MiB;
constexpr size_t WS_UH = WS_RA + 168 * MiB;
constexpr size_t WS_S = WS_RA + 218 * MiB;
constexpr size_t WS_H = WS_RA, WS_HP = WS_RA, WS_XNM = WS_RA + 182 * MiB;
constexpr size_t WS_PART = WS_RA + 182 * MiB;
constexpr size_t WS_END = 512 * MiB;
static_assert(WS_S + (size_t)32 * (NR / 32) * 256 * 4 <= WS_END && WS_UH + (size_t)32 * (NR / 32) * 768 * 2 + 512 * 1024 <= WS_S && WS_MT + (size_t)2 * 32 * 512 * 768 * 2 <= WS_RA && WS_XNM + (size_t)NX * DM * 2 <= WS_END && WS_H + (size_t)NR * DFF * 2 <= WS_XNM, "ws map");
static_assert(WS_RS + (size_t)2 * NR * 8 * 4 <= 16 * MiB && WS_MOD + 2 * 5 * 6144 * 4 <= CTL_ZERO_BYTES, "ctl map");

constexpr int RING_BYTES = 131072, LDSCTL_OFF = RING_BYTES, MISC_OFF = LDSCTL_OFF + 320, LDS_BYTES = 147456;

__device__ __forceinline__ unsigned f2bf(float f) { unsigned u = __builtin_bit_cast(unsigned, f); return (u + 0x7fffu + ((u >> 16) & 1u)) >> 16; }
__device__ __forceinline__ unsigned pk2(float lo, float hi) { f32x2 v = {lo, hi}; bf16x2_t b = __builtin_convertvector(v, bf16x2_t); return __builtin_bit_cast(unsigned, b); }
__device__ __forceinline__ unsigned pk4_fp8(float a, float b, float c, float d) { int w = 0; w = __builtin_amdgcn_cvt_pk_fp8_f32(a, b, w, false); w = __builtin_amdgcn_cvt_pk_fp8_f32(c, d, w, true); return (unsigned)w; }
constexpr float W8_SCALE = 64.f;
__device__ __forceinline__ float bflo(unsigned w) { return __builtin_bit_cast(float, w << 16); }
__device__ __forceinline__ float bfhi(unsigned w) { return __builtin_bit_cast(float, w & 0xffff0000u); }
__device__ __forceinline__ float bf1(bf16_t h) { return __builtin_bit_cast(float, (unsigned)h << 16); }
__device__ __forceinline__ float shx(float v, int m, int lane) { return __builtin_bit_cast(float, __builtin_amdgcn_ds_bpermute((lane ^ m) << 2, __builtin_bit_cast(int, v))); }
__device__ __forceinline__ int shx_i(int v, int m, int lane) { return __builtin_amdgcn_ds_bpermute((lane ^ m) << 2, v); }
__device__ __forceinline__ int wave_sum_i(int v, int lane) {
#pragma unroll
    for (int o = 1; o < 64; o <<= 1) v += shx_i(v, o, lane);
    return v;
}
__device__ __forceinline__ float wave_sum(float v, int lane) {
#pragma unroll
    for (int o = 1; o < 64; o <<= 1) v += shx(v, o, lane);
    return v;
}
__device__ __forceinline__ float silu_f(float x) { return x * __builtin_amdgcn_rcpf(1.f + __builtin_amdgcn_exp2f(-1.4426950408889634f * x)); }
__device__ __forceinline__ float sigmoid_f(float x) { return __builtin_amdgcn_rcpf(1.f + __builtin_amdgcn_exp2f(-1.4426950408889634f * x)); }
__device__ __forceinline__ float gelu_tanh_f(float x) { const float u = (1.5957691216057308f * 1.4426950408889634f) * (x + 0.044715f * x * x * x); return x * __builtin_amdgcn_rcpf(1.f + __builtin_amdgcn_exp2f(-u)); }
#define LDS_WAIT() asm volatile("s_waitcnt lgkmcnt(0)" ::: "memory")
#define VM_WAIT() asm volatile("s_waitcnt vmcnt(0)" ::: "memory")

__device__ __forceinline__ int lane_id() { int l; asm volatile("v_mbcnt_lo_u32_b32 %0, -1, 0\n\tv_mbcnt_hi_u32_b32 %0, -1, %0" : "=v"(l)); return l; }
__device__ __forceinline__ unsigned char* opq(unsigned char* p) { asm volatile("" : "+s"(p)); return p; }
typedef const float* cfptr_t;
__device__ __forceinline__ const float* inptr(int k) {
    const __attribute__((address_space(4))) char* kp = (const __attribute__((address_space(4))) char*)__builtin_amdgcn_kernarg_segment_ptr();
    return *(const __attribute__((address_space(4))) cfptr_t volatile*)(kp + 8 * k);
}
#define INP(k) inptr(k)

namespace pg8 {
constexpr int BM = 256, BK = 64, HALF = 128, HTB = HALF * BK * 2  , STAGE_BYTES = 8 * HTB, NXCD = 8, WGM = 4;

__host__ __device__ __forceinline__ int lds_byte(int r, int c) { const int st = (r >> 4) * 2 + (c >> 5), rr = r & 15, cc = c & 31, ob = rr * 64 + cc * 2; return st * 1024 + (ob ^ (((ob >> 9) & 1) << 5)); }
__host__ __device__ __forceinline__ void stage_rc(int b, int& R, int& C) { const int st = b / 1024, sb = b % 1024, swz = sb ^ (((sb >> 9) & 1) << 5); R = (st >> 1) * 16 + swz / 64; C = (st & 1) * 32 + (swz % 64) / 2; }
__host__ __device__ __forceinline__ int perm32(int rho) { const int n = rho >> 4, i = rho & 15; return 8 * (i >> 2) + 4 * n + (i & 3); }
struct Unit { int pm, pn, ex; };
struct Gemm { const bf16_t* A; const bf16_t* Bt; int lda, ldb, K; size_t bexp, aexp; };

struct StaticOrder {
    int nM, nN, nwg, G, c;
    __device__ __forceinline__ void init(int M, int N, int G_, int c_) { nM = M / BM; nN = N / BM; nwg = nM * nN; G = G_; c = c_; }
    __device__ __forceinline__ bool next(int i, Unit& u) const {
        const long L = (long)i * G + c; if (L >= nwg) return false;
        int wgid = (int)L; { const int q = nwg / NXCD, r = nwg % NXCD, xcd = wgid % NXCD, off = wgid / NXCD; wgid = (xcd < r ? xcd * (q + 1) : r * (q + 1) + (xcd - r) * q) + off; }
        const int nig = WGM * nN, gid = wgid / nig, fm = gid * WGM, gsz = (nM - fm) < WGM ? (nM - fm) : WGM;
        u.pm = fm + ((wgid % nig) % gsz); u.pn = (wgid % nig) / gsz; u.ex = 0; return true;
    }
    __device__ __forceinline__ void a_ready(const Unit&) const {}
    __device__ __forceinline__ void done(const Unit&) const {}
};
struct MoeOrder {
    int nT, nN, nwg, G, c; int o1, o2, o3, o4, o5, o6, o7;
    __device__ __forceinline__ bool next(int i, Unit& u) const {
        const long L = (long)i * G + c; if (L >= nwg) return false;
        const int wgid = (int)L;
        const int nig = WGM * nN, gid = wgid / nig, fm = gid * WGM, gsz = (nT - fm) < WGM ? (nT - fm) : WGM;
        u.pm = fm + ((wgid % nig) % gsz); u.pn = (wgid % nig) / gsz;
        const int r = u.pm * BM; u.ex = (r >= o1) + (r >= o2) + (r >= o3) + (r >= o4) + (r >= o5) + (r >= o6) + (r >= o7); return true;
    }
    __device__ __forceinline__ void a_ready(const Unit&) const {}
    __device__ __forceinline__ void done(const Unit&) const {}
};

struct GroupOrder {
    int nMt, nN, G, c;
    __device__ __forceinline__ bool next(int i, Unit& u) const {
        const int L = i * G + c; const int per = nMt * nN; if (L >= NG * per) return false;
        u.ex = L / per; const int r = L - u.ex * per; u.pm = r / nN; u.pn = r - u.pm * nN; return true;
    }
    __device__ __forceinline__ void a_ready(const Unit&) const {}
    __device__ __forceinline__ void done(const Unit&) const {}
};

struct CtxSplitOrder {
    int nks, G, c;
    __device__ __forceinline__ bool next(int i, Unit& u) const { const int L = i * G + c; if (L >= 16 * nks) return false; u.ex = L >> 4; u.pm = (L >> 2) & 3; u.pn = L & 3; return true; }
    __device__ __forceinline__ void a_ready(const Unit&) const {}
    __device__ __forceinline__ void done(const Unit&) const {}
};

__device__ __forceinline__ u32x4 pack8(const f32x4& a, const f32x4& b) { u32x4 w; w.x = pk2(a[0], a[1]); w.y = pk2(a[2], a[3]); w.z = pk2(b[0], b[1]); w.w = pk2(b[2], b[3]); return w; }

struct EpiInProj {
    static constexpr bool PERM = true, AFTER_DRAIN = false, REOFF = false;
    bf16_t* Z; float* rs; bf16_t* UH;
    __device__ __forceinline__ void operator()(const f32x4 (&acc)[2][2][4][2], const Unit& u, int wr, int wc, int fr_, int fq_) const {
        const int ln_ = lane_id(); const int fr = ln_ & 15, fq = ln_ >> 4; (void)fr_; (void)fq_;
        const int row0 = u.pm * BM + wr * 64 + fr, col0 = u.pn * BM + wc * 32 + 8 * fq;
#pragma unroll
        for (int ai = 0; ai < 2; ++ai)
#pragma unroll
            for (int m = 0; m < 4; ++m) {
                const int row = row0 + ai * HALF + m * 16; float ss = 0.f;
#pragma unroll
                for (int bj = 0; bj < 2; ++bj) { const f32x4 v0 = acc[ai][bj][m][0], v1 = acc[ai][bj][m][1]; const int col = col0 + bj * HALF;
                    if (u.pn < 2) *(u32x4*)(UH + ((size_t)(col >> 4) * NCH + (row >> 5)) * 768 + (row & 31) * 16 + (col & 15)) = pack8(v0, v1);
                    else *(u32x4*)(Z + (size_t)row * 1024 + col) = pack8(v0, v1);
                    if (bj == 0 || u.pn == 2) ss += (v0[0] * v0[0] + v0[1] * v0[1]) + (v0[2] * v0[2] + v0[3] * v0[3]) + (v1[0] * v1[0] + v1[1] * v1[1]) + (v1[2] * v1[2] + v1[3] * v1[3]); }
                if (u.pn >= 2) { ss += shx(ss, 16, ln_); ss += shx(ss, 32, ln_); if (fq == 0) rs[(size_t)row * 8 + (u.pn - 2) * 4 + wc] = ss; }
            }
    }
};
struct EpiS {
    static constexpr bool PERM = false, AFTER_DRAIN = false, REOFF = false;
    float* S;
    __device__ __forceinline__ void operator()(const f32x4 (&acc)[2][2][4][2], const Unit& u, int wr, int wc, int fr_, int fq_) const {
        const int ln_ = lane_id(); const int fr = ln_ & 15, fq = ln_ >> 4; (void)fr_; (void)fq_;
        const int row0 = u.pm * BM + wr * 64 + fr, col0 = wc * 32 + 4 * fq;
#pragma unroll
        for (int ai = 0; ai < 2; ++ai)
#pragma unroll
            for (int m = 0; m < 4; ++m) { const int n = row0 + ai * HALF + m * 16; if (n < NCH) { float* sp = S + ((size_t)u.ex * NCH + n) * 256 + col0;
#pragma unroll
                for (int bj = 0; bj < 2; ++bj)
#pragma unroll
                    for (int nn = 0; nn < 2; ++nn) *(f32x4*)(sp + bj * HALF + nn * 16) = acc[ai][bj][m][nn]; } }
    }
};
struct EpiY {
    static constexpr bool PERM = true, AFTER_DRAIN = false, REOFF = false;
    bf16_t* ZG;
    __device__ __forceinline__ void operator()(const f32x4 (&acc)[2][2][4][2], const Unit& u, int wr, int wc, int fr_, int fq_) const {
        const int ln_ = lane_id(); const int fr = ln_ & 15, fq = ln_ >> 4; (void)fr_; (void)fq_;
        const int row0 = u.pm * BM + wr * 64 + fr, col0 = u.pn * BM + wc * 32 + 8 * fq;
#pragma unroll
        for (int ai = 0; ai < 2; ++ai)
#pragma unroll
            for (int m = 0; m < 4; ++m) { const int n = row0 + ai * HALF + m * 16; if (n < NCH) {
#pragma unroll
                for (int bj = 0; bj < 2; ++bj) { const int q = col0 + bj * HALF; f32x4 a = acc[ai][bj][m][0], b = acc[ai][bj][m][1];
#pragma unroll
                    for (int j = 0; j < 4; ++j) { a[j] = gelu_tanh_f(a[j]); b[j] = gelu_tanh_f(b[j]); }
                    *(u32x4*)(ZG + ((size_t)n * TCH + (q >> 4)) * 512 + u.ex * 16 + (q & 15)) = pack8(a, b); } } }
    }
};
struct EpiQ {
    static constexpr bool PERM = true, AFTER_DRAIN = false, REOFF = true;
    bf16_t* Q; const float* rs; const float* cosT; const float* sinT;
    __device__ __forceinline__ void operator()(const f32x4 (&acc)[2][2][4][2], const Unit& u, int wr, int wc, int fr_, int fq_) const {
        const int ln_ = lane_id(); const int fr = ln_ & 15, fq = ln_ >> 4; (void)fr_; (void)fq_;
        const int row0 = u.pm * BM + wr * 64 + fr; const bool latent = u.pm < NX / BM;
#pragma unroll
        for (int ai = 0; ai < 2; ++ai)
#pragma unroll
            for (int m = 0; m < 4; ++m) {
                const int row = row0 + ai * HALF + m * 16; const f32x4 q4 = *(const f32x4*)(rs + (size_t)row * 8); const float rstd = rsqrtf(((q4[0] + q4[1]) + (q4[2] + q4[3])) * (1.f / 256.f) + EPS);
#pragma unroll
                for (int bj = 0; bj < 2; ++bj) { const int cg = (u.pn * BM + bj * HALF + wc * 32) >> 5; const bool rope = latent && (cg % 3 == 2);
                    f32x4 v0 = acc[ai][bj][m][0] * rstd, v1 = acc[ai][bj][m][1] * rstd;
                    if (rope) {
                        f32x4 p0, p1;
#pragma unroll
                        for (int j = 0; j < 4; ++j) { p0[j] = shx(v0[j], 16, ln_); p1[j] = shx(v1[j], 16, ln_); }
                        const int t = row & (SEQ - 1); const float* cp = cosT + t * 16 + (fq >> 1) * 8; const float* sp = sinT + t * 16 + (fq >> 1) * 8;
                        const f32x4 c0 = *(const f32x4*)cp, c1 = *(const f32x4*)(cp + 4); f32x4 s0 = *(const f32x4*)sp, s1 = *(const f32x4*)(sp + 4);
                        if ((fq & 1) == 0) { s0 = -s0; s1 = -s1; }
                        v0 = v0 * c0 + p0 * s0; v1 = v1 * c1 + p1 * s1;
                    }
                    const float qs = (cg % 3 == 2) ? 4.0f * QSCALE : 8.0f * QSCALE;
                    v0 = v0 * qs; v1 = v1 * qs; u32x2 w; w.x = pk4_fp8(v0[0], v0[1], v0[2], v0[3]); w.y = pk4_fp8(v1[0], v1[1], v1[2], v1[3]);
                    *(u32x2*)((unsigned char*)Q + (unsigned)row * 768u + (unsigned)(u.pn * BM + bj * HALF + wc * 32 + 8 * fq)) = w; }
            }
    }
};
struct EpiKV {
    static constexpr bool PERM = true, AFTER_DRAIN = false, REOFF = false;
    bf16_t* KN; const float* rs;
    __device__ __forceinline__ void operator()(const f32x4 (&acc)[2][2][4][2], const Unit& u, int wr, int wc, int fr_, int fq_) const {
        const int ln_ = lane_id(); const int fr = ln_ & 15, fq = ln_ >> 4; (void)fr_; (void)fq_;
        const int row0 = u.pm * BM + wr * 64 + fr; const int col0 = u.pn * BM + wc * 32 + 8 * fq;
#pragma unroll
        for (int ai = 0; ai < 2; ++ai)
#pragma unroll
            for (int m = 0; m < 4; ++m) {
                const int row = row0 + ai * HALF + m * 16; const f32x4 q4 = *(const f32x4*)(rs + (size_t)row * 8 + 4); const float rstd = rsqrtf(((q4[0] + q4[1]) + (q4[2] + q4[3])) * (1.f / 128.f) + EPS);
#pragma unroll
                for (int bj = 0; bj < 2; ++bj) { const f32x4 x0 = acc[ai][bj][m][0] * rstd, x1 = acc[ai][bj][m][1] * rstd; u32x2 w; w.x = pk4_fp8(x0[0], x0[1], x0[2], x0[3]); w.y = pk4_fp8(x1[0], x1[1], x1[2], x1[3]);
                    *(u32x2*)((unsigned char*)KN + (unsigned)row * 512u + (unsigned)(col0 + bj * HALF)) = w; }
            }
    }
};
struct EpiVT {
    static constexpr bool PERM = true, AFTER_DRAIN = false, REOFF = true;
    bf16_t* VT; const float* rs;
    __device__ __forceinline__ void operator()(const f32x4 (&acc)[2][2][4][2], const Unit& u, int wr, int wc, int fr_, int fq_) const {
        const int ln_ = lane_id(); const int fr = ln_ & 15, fq = ln_ >> 4; (void)fr_; (void)fq_;
        const int c0 = u.pm * BM + wr * 64 + fr;
        const int b = u.pn < NX / BM ? (u.pn >> 5) : (u.pn - NX / BM); const int kbase = u.pn < NX / BM ? (u.pn & 31) * BM : SEQ;
        int wq = wc; asm volatile("" : "+s"(wq));
        const unsigned tp = (unsigned)((wq >> 1) * 64 + 16 * (wq & 1) + 32 * (fq & 1) + 8 * (fq >> 1));
#pragma unroll
        for (int bj = 0; bj < 2; ++bj) { const int tl = bj * HALF + wc * 32 + 8 * fq, tok = u.pn * BM + tl;
            f32x4 s0, s1;
#pragma unroll
            for (int i = 0; i < 4; ++i) { const f32x4 qa = *(const f32x4*)(rs + (size_t)(tok + i) * 8 + 4); s0[i] = rsqrtf(((qa[0] + qa[1]) + (qa[2] + qa[3])) * (1.f / 128.f) + EPS); }
            __builtin_amdgcn_sched_barrier(0);
#pragma unroll
            for (int i = 0; i < 4; ++i) { const f32x4 qb = *(const f32x4*)(rs + (size_t)(tok + 4 + i) * 8 + 4); s1[i] = rsqrtf(((qb[0] + qb[1]) + (qb[2] + qb[3])) * (1.f / 128.f) + EPS); }
            __builtin_amdgcn_sched_barrier(0);
#pragma unroll
            for (int ai = 0; ai < 2; ++ai)
#pragma unroll
                for (int m = 0; m < 4; ++m) {
                    const f32x4 x0 = acc[ai][bj][m][0] * s0, x1 = acc[ai][bj][m][1] * s1; u32x2 w; w.x = pk4_fp8(x0[0], x0[1], x0[2], x0[3]); w.y = pk4_fp8(x1[0], x1[1], x1[2], x1[3]);
                    const unsigned off = (unsigned)(b * 512 + c0 + ai * HALF + m * 16) * (unsigned)(SEQ + CTXL) + (unsigned)(kbase + bj * HALF) + tp;
                    *(u32x2*)((unsigned char*)VT + off) = w; } }
    }
};
struct EpiGlu {
    static constexpr bool PERM = true, AFTER_DRAIN = false, REOFF = false;
    const bf16_t* ZG; const float* bias; bf16_t* Y;
    __device__ __forceinline__ void operator()(const f32x4 (&acc)[2][2][4][2], const Unit& u, int wr, int wc, int fr_, int fq_) const {
        const int ln_ = lane_id(); const int fr = ln_ & 15, fq = ln_ >> 4; (void)fr_; (void)fq_;
        const int row0 = u.pm * BM + wr * 64 + fr, col0 = u.pn * BM + wc * 32 + 8 * fq;
#pragma unroll
        for (int ai = 0; ai < 2; ++ai)
#pragma unroll
            for (int m = 0; m < 4; ++m) { const int row = row0 + ai * HALF + m * 16;
#pragma unroll
                for (int bj = 0; bj < 2; ++bj) { const int col = col0 + bj * HALF;
                    const u32x4 zw = *(const u32x4*)(ZG + (size_t)row * 512 + col); const f32x4 b0 = *(const f32x4*)(bias + col), b1 = *(const f32x4*)(bias + col + 4);
                    const f32x4 a0 = acc[ai][bj][m][0] + b0, a1 = acc[ai][bj][m][1] + b1; f32x4 o0, o1;
                    o0[0] = bflo(zw.x) * sigmoid_f(a0[0]); o0[1] = bfhi(zw.x) * sigmoid_f(a0[1]); o0[2] = bflo(zw.y) * sigmoid_f(a0[2]); o0[3] = bfhi(zw.y) * sigmoid_f(a0[3]);
                    o1[0] = bflo(zw.z) * sigmoid_f(a1[0]); o1[1] = bfhi(zw.z) * sigmoid_f(a1[1]); o1[2] = bflo(zw.w) * sigmoid_f(a1[2]); o1[3] = bfhi(zw.w) * sigmoid_f(a1[3]);
                    *(u32x4*)(Y + (size_t)row * 1024 + col) = pack8(o0, o1); } }
    }
};
struct EpiRes {
    static constexpr bool PERM = true, AFTER_DRAIN = false, REOFF = false;
    const float* xin32; bf16_t* x16; const float* gate;   float s;
    __device__ __forceinline__ void operator()(const f32x4 (&acc)[2][2][4][2], const Unit& u, int wr, int wc, int fr_, int fq_) const {
        const int ln_ = lane_id(); const int fr = ln_ & 15, fq = ln_ >> 4; (void)fr_; (void)fq_;
        const int row0 = u.pm * BM + wr * 64 + fr, col0 = u.pn * BM + wc * 32 + 8 * fq; const int v = u.pm >> 5;
        f32x4 gv[2][2];
#pragma unroll
        for (int bj = 0; bj < 2; ++bj)
#pragma unroll
            for (int n = 0; n < 2; ++n) gv[bj][n] = *(const f32x4*)(gate + v * 6144 + col0 + bj * HALF + n * 4) * s;
#pragma unroll
        for (int ai = 0; ai < 2; ++ai)
#pragma unroll
            for (int m = 0; m < 4; ++m) { const int row = row0 + ai * HALF + m * 16;
#pragma unroll
                for (int bj = 0; bj < 2; ++bj) { const int col = col0 + bj * HALF; f32x4 x0, x1;
                    if (xin32) { x0 = *(const f32x4*)(xin32 + (size_t)row * 1024 + col); x1 = *(const f32x4*)(xin32 + (size_t)row * 1024 + col + 4); }
                    else { const u32x4 w = *(const u32x4*)(x16 + (size_t)row * 2048 + col); x0[0] = bflo(w.x); x0[1] = bfhi(w.x); x0[2] = bflo(w.y); x0[3] = bfhi(w.y); x1[0] = bflo(w.z); x1[1] = bfhi(w.z); x1[2] = bflo(w.w); x1[3] = bfhi(w.w); }
                    *(u32x4*)(x16 + (size_t)row * 2048 + col) = pack8(x0 + gv[bj][0] * acc[ai][bj][m][0], x1 + gv[bj][1] * acc[ai][bj][m][1]); } }
    }
};
struct EpiPart {
    static constexpr bool PERM = false, AFTER_DRAIN = false, REOFF = false;
    float* P; float s;
    __device__ __forceinline__ void operator()(const f32x4 (&acc)[2][2][4][2], const Unit& u, int wr, int wc, int fr_, int fq_) const {
        const int ln_ = lane_id(); const int fr = ln_ & 15, fq = ln_ >> 4; (void)fr_; (void)fq_;
        const int row0 = u.pm * BM + wr * 64 + fr, col0 = u.pn * BM + wc * 32 + 4 * fq;
#pragma unroll
        for (int ai = 0; ai < 2; ++ai)
#pragma unroll
            for (int m = 0; m < 4; ++m) { float* pp = P + ((size_t)u.ex * NC + row0 + ai * HALF + m * 16) * 1024 + col0;
#pragma unroll
                for (int bj = 0; bj < 2; ++bj)
#pragma unroll
                    for (int n = 0; n < 2; ++n) *(f32x4*)(pp + bj * HALF + n * 16) = acc[ai][bj][m][n] * s; }
    }
};
template <bool OUT8> struct EpiSwiglu {
    static constexpr bool PERM = true, AFTER_DRAIN = false, REOFF = false;
    void* H; int ldh; float s;
    __device__ __forceinline__ void operator()(const f32x4 (&acc)[2][2][4][2], const Unit& u, int wr, int wc, int fr_, int fq_) const {
        const int ln_ = lane_id(); const int fr = ln_ & 15, fq = ln_ >> 4; (void)fr_; (void)fq_;
        const int row0 = u.pm * BM + wr * 64 + fr, col0 = u.pn * HALF + wc * 32 + 8 * fq;
#pragma unroll
        for (int ai = 0; ai < 2; ++ai)
#pragma unroll
            for (int m = 0; m < 4; ++m) { f32x4 o0, o1;
#pragma unroll
                for (int j = 0; j < 4; ++j) { o0[j] = silu_f(acc[ai][0][m][0][j] * s) * (acc[ai][1][m][0][j] * s); o1[j] = silu_f(acc[ai][0][m][1][j] * s) * (acc[ai][1][m][1][j] * s); }
                const size_t off = (size_t)(row0 + ai * HALF + m * 16) * ldh + col0;
                if constexpr (OUT8) { u32x2 w; w.x = pk4_fp8(o0[0], o0[1], o0[2], o0[3]); w.y = pk4_fp8(o1[0], o1[1], o1[2], o1[3]); *(u32x2*)((unsigned char*)H + off) = w; }
                else *(u32x4*)((bf16_t*)H + off) = pack8(o0, o1); }
    }
};
struct EpiBf16 {
    static constexpr bool PERM = true, AFTER_DRAIN = false, REOFF = false;
    bf16_t* O; int ldc; float s;
    __device__ __forceinline__ void operator()(const f32x4 (&acc)[2][2][4][2], const Unit& u, int wr, int wc, int fr_, int fq_) const {
        const int ln_ = lane_id(); const int fr = ln_ & 15, fq = ln_ >> 4; (void)fr_; (void)fq_;
        const int row0 = u.pm * BM + wr * 64 + fr, col0 = u.pn * BM + wc * 32 + 8 * fq;
#pragma unroll
        for (int ai = 0; ai < 2; ++ai)
#pragma unroll
            for (int m = 0; m < 4; ++m)
#pragma unroll
                for (int bj = 0; bj < 2; ++bj) *(u32x4*)(O + (size_t)(row0 + ai * HALF + m * 16) * ldc + col0 + bj * HALF) = pack8(acc[ai][bj][m][0] * s, acc[ai][bj][m][1] * s);
    }
};
typedef int v8i_t __attribute__((ext_vector_type(8)));
typedef short s16x16_t __attribute__((ext_vector_type(16)));
__device__ __forceinline__ v8i_t cat8(bf16x8 a, bf16x8 b) { return __builtin_bit_cast(v8i_t, __builtin_shufflevector(a, b, 0, 1, 2, 3, 4, 5, 6, 7, 8, 9, 10, 11, 12, 13, 14, 15)); }
template <class Epi, class Sched, bool ALIGN_EPI = false, bool SP2 = false, bool F8 = false>
__device__ __forceinline__ void gemm_phase(PG8_LAS unsigned char* lds, const Gemm g, const Sched& S, const Epi& E, const int wid) {
    const int lane = lane_id(), tid = wid * 64 + lane, wr = wid >> 2, wc = wid & 3, fr = lane & 15, fq = lane >> 4;
    const int K = g.K, nt = K / BK;
    unsigned v_offA, v_offB;
    { int R, C; stage_rc(tid * 16, R, C); const int Rb = Epi::PERM ? ((R & ~31) + perm32(R & 31)) : R;
        v_offA = (unsigned)(R * g.lda + C) * 2u; v_offB = (unsigned)(Rb * g.ldb + C) * 2u; }
    const unsigned r64_offA = 64u * (unsigned)g.lda * 2u, r64_offB = 64u * (unsigned)g.ldb * 2u;
    const size_t kstep = (size_t)(BK * 2);
    const size_t hstepA = (size_t)HALF * g.lda * 2, hstepB = (size_t)HALF * g.ldb * 2;
    const size_t tstepA = 2 * hstepA, tstepB = 2 * hstepB;
    const unsigned ldsw = (unsigned)wid * 1024u;
    const int aoff = lds_byte(wr * 64 + fr, fq * 8), boff = lds_byte(wc * 32 + fr, fq * 8);
#define PG8_SA(b, h) (((b) * 2 + (h)) * HTB)
#define PG8_SB(b, h) ((4 + (b) * 2 + (h)) * HTB)
#define PG8_STAGE(bufoff, gbase, voff) do { _Pragma("unroll") for (int _i = 0; _i < 2; ++_i) \
        __builtin_amdgcn_global_load_lds((const unsigned*)((const char*)(gbase) + (size_t)(_i * r64_##voff) + v_##voff), (PG8_LAS unsigned*)(lds + (bufoff) + ldsw + _i * 8192), 16, 0, 0); } while (0)
#define PG8_RD(p) (*(const PG8_LAS bf16x8*)(p))
#define PG8_LDA(dst, b, h) do { if constexpr (F8) { _Pragma("unroll") for (int m = 0; m < 4; ++m) dst##8[m] = cat8(PG8_RD(lds + PG8_SA(b, h) + aoff + m * 2048), PG8_RD(lds + PG8_SA(b, h) + aoff + m * 2048 + 1024)); } \
        else { _Pragma("unroll") for (int m = 0; m < 4; ++m) _Pragma("unroll") for (int k = 0; k < 2; ++k) dst[m][k] = PG8_RD(lds + PG8_SA(b, h) + aoff + m * 2048 + k * 1024); } } while (0)
#define PG8_LDB(dst, b, h) do { if constexpr (F8) { _Pragma("unroll") for (int n = 0; n < 2; ++n) dst##8[n] = cat8(PG8_RD(lds + PG8_SB(b, h) + boff + n * 2048), PG8_RD(lds + PG8_SB(b, h) + boff + n * 2048 + 1024)); } \
        else { _Pragma("unroll") for (int n = 0; n < 2; ++n) _Pragma("unroll") for (int k = 0; k < 2; ++k) dst[n][k] = PG8_RD(lds + PG8_SB(b, h) + boff + n * 2048 + k * 1024); } } while (0)
#define PG8_MMA(ai, bj, At, Bt) do { __builtin_amdgcn_s_setprio(1); if constexpr (F8) { _Pragma("unroll") for (int m = 0; m < 4; ++m) _Pragma("unroll") for (int n = 0; n < 2; ++n) \
        asm volatile("v_mfma_scale_f32_16x16x128_f8f6f4 %0, %1, %2, %0, %3, %3 op_sel_hi:[0,0,0]" : "+v"(acc[ai][bj][m][n]) : "v"(Bt##8[n]), "v"(At##8[m]), "v"(sc1_)); } \
        else { _Pragma("unroll") for (int m = 0; m < 4; ++m) _Pragma("unroll") for (int n = 0; n < 2; ++n) _Pragma("unroll") for (int k = 0; k < 2; ++k) \
        acc[ai][bj][m][n] = __builtin_amdgcn_mfma_f32_16x16x32_bf16(Bt[n][k], At[m][k], acc[ai][bj][m][n], 0, 0, 0); } __builtin_amdgcn_s_setprio(0); } while (0)
#define PG8_WAIT_V(n) asm volatile("s_waitcnt vmcnt(" #n ")" ::: "memory")
#define PG8_WAIT_L(n) asm volatile("s_waitcnt lgkmcnt(" #n ")" ::: "memory")
#define PG8_BAR __builtin_amdgcn_s_barrier()
#define PG8_SCHED __builtin_amdgcn_sched_barrier(0)
    Unit cur, nxt; int ui = 0;
    if (!S.next(0, cur)) return;
    f32x4 acc[2][2][4][2];
#pragma unroll
    for (int a = 0; a < 2; ++a)
#pragma unroll
        for (int b = 0; b < 2; ++b)
#pragma unroll
            for (int m = 0; m < 4; ++m)
#pragma unroll
                for (int n = 0; n < 2; ++n) acc[a][b][m][n] = (f32x4){0.f, 0.f, 0.f, 0.f};
    const int sc1_ = 0x7f7f7f7f;
    bf16x8 At[4][2], B0[2][2], B1[2][2]; v8i_t At8[4], B08[2], B18[2];
    const char* cA = (const char*)g.A + (size_t)cur.ex * g.aexp + (size_t)cur.pm * tstepA; const char* cB = (const char*)g.Bt + (size_t)cur.ex * g.bexp + (size_t)cur.pn * tstepB;
    S.a_ready(cur);
    if constexpr (SP2) {
        PG8_STAGE(PG8_SB(0, 0), cB, offB); PG8_STAGE(PG8_SB(0, 1), cB + hstepB, offB); PG8_STAGE(PG8_SA(0, 0), cA, offA); PG8_STAGE(PG8_SA(0, 1), cA + hstepA, offA);
        if (wr == 1) PG8_BAR;
        PG8_WAIT_V(2); PG8_BAR;
        PG8_STAGE(PG8_SB(1, 0), cB + kstep, offB); PG8_STAGE(PG8_SA(1, 0), cA + kstep, offA); PG8_STAGE(PG8_SB(1, 1), cB + hstepB + kstep, offB);
        PG8_WAIT_V(6); PG8_BAR;
    } else {
        PG8_STAGE(PG8_SB(0, 0), cB, offB); PG8_STAGE(PG8_SA(0, 0), cA, offA); PG8_STAGE(PG8_SB(0, 1), cB + hstepB, offB); PG8_STAGE(PG8_SA(0, 1), cA + hstepA, offA);
        if (wr == 1) PG8_BAR;
        PG8_WAIT_V(4); PG8_BAR;
        PG8_STAGE(PG8_SB(1, 0), cB + kstep, offB); PG8_STAGE(PG8_SA(1, 0), cA + kstep, offA); PG8_STAGE(PG8_SB(1, 1), cB + hstepB + kstep, offB);
        PG8_WAIT_V(6); PG8_BAR;
    }
    for (;;) {
        const bool has_next = S.next(ui + 1, nxt);
        const char* nA = has_next ? (const char*)g.A + (size_t)nxt.ex * g.aexp + (size_t)nxt.pm * tstepA : cA; const char* nB = has_next ? (const char*)g.Bt + (size_t)nxt.ex * g.bexp + (size_t)nxt.pn * tstepB : cB;
        for (int t = 0; t < nt; t += 2) {
            const bool last = (t == nt - 2);
            const char* a1 = cA + (size_t)(t + 1) * kstep;
            const char* a2 = last ? nA : cA + (size_t)(t + 2) * kstep; const char* b2 = last ? nB : cB + (size_t)(t + 2) * kstep;
            const char* a3 = a2 + kstep; const char* b3 = b2 + kstep;
            if (last && has_next) S.a_ready(nxt);
            if constexpr (SP2) {
            PG8_LDB(B0, 0, 0); PG8_LDB(B1, 0, 1); PG8_SCHED; PG8_LDA(At, 0, 0); PG8_STAGE(PG8_SA(1, 1), a1 + hstepA, offA);
            PG8_WAIT_V(8); PG8_WAIT_L(0); PG8_BAR; PG8_MMA(0, 0, At, B0); PG8_MMA(0, 1, At, B1); PG8_BAR; PG8_SCHED;
            PG8_LDA(At, 0, 1); PG8_STAGE(PG8_SB(0, 0), b2, offB); PG8_STAGE(PG8_SB(0, 1), b2 + hstepB, offB); PG8_STAGE(PG8_SA(0, 0), a2, offA);
            PG8_WAIT_V(8); PG8_WAIT_L(0); PG8_BAR; PG8_MMA(1, 0, At, B0); PG8_MMA(1, 1, At, B1); PG8_BAR; PG8_SCHED;
            PG8_LDB(B0, 1, 0); PG8_LDB(B1, 1, 1); PG8_SCHED; PG8_LDA(At, 1, 0); PG8_STAGE(PG8_SA(0, 1), a2 + hstepA, offA);
            PG8_WAIT_V(8); PG8_WAIT_L(0); PG8_BAR; PG8_MMA(0, 0, At, B0); PG8_MMA(0, 1, At, B1); PG8_BAR; PG8_SCHED;
            PG8_LDA(At, 1, 1); PG8_STAGE(PG8_SB(1, 0), b3, offB); PG8_STAGE(PG8_SB(1, 1), b3 + hstepB, offB); PG8_STAGE(PG8_SA(1, 0), a3, offA);
            PG8_WAIT_V(8); PG8_WAIT_L(0); PG8_BAR; PG8_MMA(1, 0, At, B0); PG8_MMA(1, 1, At, B1); PG8_BAR; PG8_SCHED;
            } else {
            PG8_LDB(B0, 0, 0); PG8_SCHED; PG8_LDA(At, 0, 0); PG8_STAGE(PG8_SA(1, 1), a1 + hstepA, offA);
            PG8_WAIT_L(8); PG8_BAR; PG8_WAIT_L(0); PG8_MMA(0, 0, At, B0); PG8_BAR; PG8_SCHED;
            PG8_LDB(B1, 0, 1); PG8_STAGE(PG8_SB(0, 0), b2, offB);
            PG8_BAR; PG8_WAIT_L(0); PG8_MMA(0, 1, At, B1); PG8_BAR;
            PG8_LDA(At, 0, 1); PG8_STAGE(PG8_SA(0, 0), a2, offA);
            PG8_BAR; PG8_WAIT_L(0); PG8_MMA(1, 0, At, B0); PG8_BAR; PG8_SCHED;
            PG8_STAGE(PG8_SB(0, 1), b2 + hstepB, offB);
            PG8_WAIT_V(6); PG8_BAR; PG8_MMA(1, 1, At, B1); PG8_BAR;
            PG8_LDB(B0, 1, 0); PG8_SCHED; PG8_LDA(At, 1, 0); PG8_STAGE(PG8_SA(0, 1), a2 + hstepA, offA);
            PG8_WAIT_L(8); PG8_BAR; PG8_WAIT_L(0); PG8_MMA(0, 0, At, B0); PG8_BAR; PG8_SCHED;
            PG8_LDB(B1, 1, 1); PG8_STAGE(PG8_SB(1, 0), b3, offB);
            PG8_BAR; PG8_WAIT_L(0); PG8_MMA(0, 1, At, B1); PG8_BAR;
            PG8_LDA(At, 1, 1); PG8_STAGE(PG8_SA(1, 0), a3, offA);
            PG8_BAR; PG8_WAIT_L(0); PG8_MMA(1, 0, At, B0); PG8_BAR; PG8_SCHED;
            PG8_STAGE(PG8_SB(1, 1), b3 + hstepB, offB);
            PG8_WAIT_V(6); PG8_BAR; PG8_MMA(1, 1, At, B1); PG8_BAR;
            }
        }
        if constexpr (F8) { asm volatile("s_nop 15\n\ts_nop 7" ::: "memory"); }
        if constexpr (ALIGN_EPI) { if (wr == 0) PG8_BAR; }
        if constexpr (!Epi::AFTER_DRAIN) { E(acc, cur, wr, wc, fr, fq); S.done(cur); }
        if (!has_next) break;
#pragma unroll
        for (int a = 0; a < 2; ++a)
#pragma unroll
            for (int b = 0; b < 2; ++b)
#pragma unroll
                for (int m = 0; m < 4; ++m)
#pragma unroll
                    for (int n = 0; n < 2; ++n) acc[a][b][m][n] = (f32x4){0.f, 0.f, 0.f, 0.f};
        cur = nxt; cA = nA; cB = nB; ++ui;
        if constexpr (Epi::REOFF) { const int tid2 = wid * 64 + lane_id(); int R, C; stage_rc(tid2 * 16, R, C); const int Rb = Epi::PERM ? ((R & ~31) + perm32(R & 31)) : R;
            v_offA = (unsigned)(R * g.lda + C) * 2u; v_offB = (unsigned)(Rb * g.ldb + C) * 2u; }
        if constexpr (ALIGN_EPI) { if (wr == 1) PG8_BAR; }
    }
    PG8_WAIT_V(0);
    if constexpr (!ALIGN_EPI) { if (wr == 0) PG8_BAR; }
    PG8_BAR;
    if constexpr (Epi::AFTER_DRAIN) { E.fused(acc, cur, wr, wc, fr, fq, lds, wid, lane); S.done(cur); }
#undef PG8_SA
#undef PG8_SB
#undef PG8_STAGE
#undef PG8_RD
#undef PG8_LDA
#undef PG8_LDB
#undef PG8_MMA
#undef PG8_WAIT_V
#undef PG8_WAIT_L
#undef PG8_BAR
#undef PG8_SCHED
}
}


#define XB_TMO      128
#define XB_XCNT(j)  (256  + 64 * (j))
#define XB_XSUB(j)  (1280 + 64 * (j))
#define XB_XGEN(j)  (2304 + 64 * (j))
#define XB_TOP      3328
#define XB_TOPGEN   3392
#define XCD_BAR_WORDS 3456
#define XB_SPIN_CAP (1u << 18)

__device__ __forceinline__ unsigned xb_ld(unsigned* p)              { return __hip_atomic_load(p, __ATOMIC_RELAXED, __HIP_MEMORY_SCOPE_AGENT); }
__device__ __forceinline__ unsigned xb_add(unsigned* p, unsigned v) { return __hip_atomic_fetch_add(p, v, __ATOMIC_RELAXED, __HIP_MEMORY_SCOPE_AGENT); }
__device__ __forceinline__ unsigned xb_xcc_id() { return (unsigned)__builtin_amdgcn_s_getreg((3 << 11) | 20) & 0xFu; }
#define XB_SPIN(cond, bar) do { unsigned _sp = 0; while (cond) { __builtin_amdgcn_s_sleep(1); \
    if ((++_sp & 255u) == 0u) { if (xb_ld(&(bar)[XB_TMO])) break; if (_sp > XB_SPIN_CAP) { atomicAdd(&(bar)[XB_TMO], 1u); break; } } } } while (0)

struct XcdBarrier {
    unsigned* bar; unsigned x;
    volatile LAS unsigned* st;
};

__device__ __forceinline__ XcdBarrier xcd_barrier_post(unsigned* bar, volatile LAS unsigned* st) {
    XcdBarrier b; b.bar = bar; b.x = xb_xcc_id(); b.st = st;
    if (threadIdx.x == 0) (void)xb_add(&bar[XB_XCNT(b.x)], 1u);
    return b;
}
__device__ __forceinline__ void xcd_barrier_complete(unsigned* bar, unsigned x, unsigned& nloc, unsigned& nx) {
    const unsigned G = gridDim.x * gridDim.y * gridDim.z;
    unsigned sum, cnt, mine, sp = 0u;
    for (;;) {
        sum = 0u; cnt = 0u; mine = 0u;
#pragma unroll
        for (unsigned j = 0; j < 16; ++j) { const unsigned c = xb_ld(&bar[XB_XCNT(j)]); sum += c; cnt += (c > 0u) ? 1u : 0u; mine = (j == x) ? c : mine; }
        if (sum == G) break;
        __builtin_amdgcn_s_sleep(1);
        if ((++sp & 255u) == 0u) { if (xb_ld(&bar[XB_TMO])) break; if (sp > XB_SPIN_CAP) { atomicAdd(&bar[XB_TMO], 1u); break; } }
    }
    nloc = mine > 0u ? mine : 1u; nx = cnt > 0u ? cnt : 1u;
}

__device__ __forceinline__ void xcd_barrier(const XcdBarrier& b) {
    asm volatile("s_waitcnt vmcnt(0)" ::: "memory");
    __syncthreads();
    if (threadIdx.x == 0) {
        unsigned* bar = b.bar; asm volatile("" : "+s"(bar));
        __builtin_amdgcn_s_waitcnt(0);
        unsigned bx = b.x; asm volatile("" : "+s"(bx));
        unsigned nloc = b.st[0], nx = b.st[1];
        if (nloc == 0u) { xcd_barrier_complete(bar, bx, nloc, nx); b.st[0] = nloc; b.st[1] = nx; }
        const unsigned old = xb_add(&bar[XB_XSUB(bx)], 1u);
        const unsigned gen = old / nloc;
        if (old + 1u == (gen + 1u) * nloc) {
            __builtin_amdgcn_fence(__ATOMIC_RELEASE, "agent");
            asm volatile("s_waitcnt vmcnt(0)" ::: "memory");
            const unsigned og = xb_add(&bar[XB_TOP], 1u);
            const unsigned tg = og / nx;
            if (og + 1u == (tg + 1u) * nx) xb_add(&bar[XB_TOPGEN], 1u);
            else XB_SPIN(xb_ld(&bar[XB_TOPGEN]) == tg, bar);
            __builtin_amdgcn_fence(__ATOMIC_ACQUIRE, "agent");
            xb_add(&bar[XB_XGEN(bx)], 1u);
            asm volatile("s_waitcnt vmcnt(0)" ::: "memory");
        } else {
            XB_SPIN(xb_ld(&bar[XB_XGEN(bx)]) == gen, bar);
            __builtin_amdgcn_fence(__ATOMIC_ACQUIRE, "agent");
            asm volatile("s_waitcnt vmcnt(0)" ::: "memory");
        }
    }
    __syncthreads();
}

struct Args { const float* in[32]; float* out; unsigned char* ws; int ph_lo, ph_hi, li, pad; };
struct Frame {
    LAS unsigned char* lds; volatile LAS unsigned* MISC; unsigned* ctl;
    int wave, G, bid, gw, NGW;
    float* out; unsigned char* ws;
};
constexpr int NWAVES = 8, NTHR = NWAVES * 64;

#define TR_LOAD(wv, W, N, k0, n0) do { _Pragma("unroll") for (int i_ = 0; i_ < 32; ++i_) wv[i_] = __builtin_nontemporal_load((W) + (size_t)((k0) + 2 * i_ + (lane >> 5)) * (N) + (n0) + (lane & 31)); } while (0)
template <bool F8>
__device__ __forceinline__ void tr_store(const float (&wv)[32], void* WTv, int K  , int k0, int drow0, const float* ksc, LAS float* scr, int lane) {
#pragma unroll
    for (int i = 0; i < 32; ++i) { const int kk = 2 * i + (lane >> 5); float w = wv[i]; if (ksc) w *= ksc[k0 + kk]; if (F8) w *= W8_SCALE; scr[kk * 33 + (lane & 31)] = w; }
    LDS_WAIT(); asm volatile("" ::: "memory");
    const int c = lane & 7;
#pragma unroll
    for (int j = 0; j < 4; ++j) { const int n = (lane >> 3) + 8 * j; const LAS float* s = scr + (8 * c) * 33 + n;
        if (F8) { u32x2 o; o.x = pk4_fp8(s[0 * 33], s[1 * 33], s[2 * 33], s[3 * 33]); o.y = pk4_fp8(s[4 * 33], s[5 * 33], s[6 * 33], s[7 * 33]); *(u32x2*)((unsigned char*)WTv + (size_t)(drow0 + n) * K + k0 + 8 * c) = o; }
        else { u32x4 o; o.x = pk2(s[0 * 33], s[1 * 33]); o.y = pk2(s[2 * 33], s[3 * 33]); o.z = pk2(s[4 * 33], s[5 * 33]); o.w = pk2(s[6 * 33], s[7 * 33]); *(u32x4*)((bf16_t*)WTv + (size_t)(drow0 + n) * K + k0 + 8 * c) = o; } }
    LDS_WAIT(); asm volatile("" ::: "memory");
}
__device__ __forceinline__ int drow_map(int mode, int n0) {
    if (mode == 1) { const int h = n0 >> 7, j0 = n0 & 127; return j0 < 64 ? h * 64 + j0 : 512 + h * 64 + (j0 - 64); }
    if (mode == 2) return (n0 >> 7) * 256 + (n0 & 127);
    if (mode == 3) return (n0 >> 7) * 256 + 128 + (n0 & 127);
    return n0;
}
template <bool F8>
__device__ __forceinline__ void conv_mat(const Frame& F, const float* W, int K, int N, void* WT, int mode, const float* ksc, int ldk = 0) {
    if (ldk == 0) ldk = K;
    const int lane = lane_id();
    LAS float* scr = (LAS float*)(F.lds + F.wave * 16384);
    const int nblk = N / 32, items = (K / 64) * nblk;
    for (int it = F.gw; it < items; it += F.NGW) { const int k0 = 64 * (it / nblk), n0 = 32 * (it % nblk); float wv[32];
        TR_LOAD(wv, W, N, k0, n0); tr_store<F8>(wv, WT, ldk, k0, drow_map(mode, n0), ksc, scr, lane); }
}
__device__ __forceinline__ void p0_weights(const Frame& F, const Args& A) { unsigned char* const wsq_ = opq(F.ws);
    const int lane = lane_id(), tid = F.wave * 64 + lane; (void)tid; (void)lane;
    unsigned char* ws = wsq_;
    for (int l = 0; l < 2; ++l) {
        conv_mat<false>(F, INP(8) + (size_t)l * DM * DIN, DM, DIN, (bf16_t*)(ws + WS_WIN) + (size_t)l * 1024 * 1024, 0, nullptr);
        conv_mat<false>(F, INP(11) + (size_t)l * 256 * 768, 256, 768, (bf16_t*)(ws + WS_WUQ) + (size_t)l * 768 * 256, 0, INP(9) + l * 256);
        conv_mat<false>(F, INP(12) + (size_t)l * 128 * 1024, 128, 1024, (bf16_t*)(ws + WS_WUKV) + (size_t)l * 1024 * 128, 1, INP(10) + l * 128);
        conv_mat<false>(F, INP(21) + (size_t)l * 512 * 512, 512, 512, (bf16_t*)(ws + WS_WGLU) + (size_t)l * 512 * 512, 0, nullptr);
        conv_mat<false>(F, INP(23) + (size_t)l * 1024 * 1024, 1024, 1024, (bf16_t*)(ws + WS_WOUT) + (size_t)l * 1024 * 1024, 0, nullptr);
        { u32x4* z = (u32x4*)((bf16_t*)(ws + WS_WIN) + (size_t)l * 1024 * 1024 + (size_t)DIN * 1024); const int n16 = (1024 - DIN) * 1024 * 2 / 16;
          u32x4 z4 = {0u, 0u, 0u, 0u}; asm volatile("" : "+v"(z4));
          for (int i = F.gw * 64 + lane; i < n16; i += F.NGW * 64) z[i] = z4; }
    }
    conv_mat<false>(F, INP(24), DM, DFF, ws + WS_WFF13, 2, nullptr);
    conv_mat<false>(F, INP(25), DM, DFF, ws + WS_WFF13, 3, nullptr);
    conv_mat<true>(F, INP(26), DFF, DM, ws + WS_WFF2, 0, nullptr);
    { const int lane = lane_id(); u32x4 z4 = {0u, 0u, 0u, 0u}; asm volatile("" : "+v"(z4));
      for (int i = F.gw * 64 + lane; i < NE * DM * 8; i += F.NGW * 64) *(u32x4*)(wsq_ + WS_WM2 + (size_t)(i >> 3) * DFE8 + DFE + (i & 7) * 16) = z4; }
}
__device__ __forceinline__ void p0_moe_weights(const Frame& F, const Args& A, int e0, int e1) { unsigned char* const ws = opq(F.ws);
    for (int e = e0; e < e1; ++e) {
        conv_mat<true>(F, INP(28) + (size_t)e * DM * DFE, DM, DFE, ws + WS_WM13 + (size_t)e * 2 * DFE * DM, 2, nullptr);
        conv_mat<true>(F, INP(29) + (size_t)e * DM * DFE, DM, DFE, ws + WS_WM13 + (size_t)e * 2 * DFE * DM, 3, nullptr);
        conv_mat<true>(F, INP(30) + (size_t)e * DFE * DM, DFE, DM, ws + WS_WM2 + (size_t)e * DM * DFE8, 0, nullptr, DFE8);
    }
}
__device__ __forceinline__ void p0_prologue(const Frame& F, const Args& A) { unsigned char* const wsq_ = opq(F.ws);
    const int lane = lane_id(), tid = F.wave * 64 + lane; (void)tid; (void)lane;
    unsigned char* ws = wsq_;
    { float* cosT = (float*)(ws + WS_COS); float* sinT = (float*)(ws + WS_SIN);
      for (int idx = F.gw * 64 + lane; idx < SEQ * 16; idx += F.NGW * 64) { const int t = idx >> 4, a = (idx >> 3) & 1, i = idx & 7; const float pos = (float)(a == 0 ? (t >> 6) : (t & 63));
          const float inv = exp2f(-(float)i * (13.287712379549449f / 8.0f)); const float ang = pos * inv; cosT[idx] = cosf(ang); sinT[idx] = sinf(ang); } }
    { float* AB = (float*)(ws + WS_AB); float* BB = (float*)(ws + WS_BB);
      const int gwr = (((F.bid + F.G - (F.G == 256 ? 192 : 0)) % F.G) * NWAVES + F.wave);
      for (int idx = gwr * 64 + lane; idx < 2 * 2 * NG * NP; idx += F.NGW * 64) {
          const float ar = INP(13)[idx], ai = INP(14)[idx], dt = expf(INP(15)[idx >> 6]);
          const float mag = expf(dt * ar), abr = mag * cosf(dt * ai), abi = mag * sinf(dt * ai), den = ar * ar + ai * ai, nre = abr - 1.0f;
          const float fre = (nre * ar + abi * ai) / den, fim = (abi * ar - nre * ai) / den;
          AB[idx * 2] = abr; AB[idx * 2 + 1] = abi;
          { float* PW = (float*)(ws + WS_PW) + (size_t)idx * 66; const float dar = dt * ar, dai = dt * ai;
            (void)dar; (void)dai; float pr = 1.f, pi = 0.f;
            for (int e = 0; e <= TCH; ++e) { PW[2 * e] = pr; PW[2 * e + 1] = pi; const float nr = pr * abr - pi * abi, ni = pr * abi + pi * abr; pr = nr; pi = ni; } }
#pragma unroll 4
          for (int c = 0; c < 16; ++c) { const float br = INP(16)[idx * 16 + c], bi = INP(17)[idx * 16 + c]; BB[(idx * 16 + c) * 2] = fre * br - fim * bi; BB[(idx * 16 + c) * 2 + 1] = fre * bi + fim * br; } } }
    { LAS float* sv = (LAS float*)F.lds; LAS float* red = sv + 5 * 1024; float* MOD = (float*)(ws + WS_MOD);
      __syncthreads();
      for (int i = tid; i < 5 * 1024; i += NTHR) { const int v = i >> 10, k = i & 1023; const float cv = v < 4 ? INP(1)[v * 1024 + k] : INP(3)[k]; sv[i] = silu_f(cv); }
      __syncthreads();
      for (int it = F.bid; it < 2 * 96; it += F.G) { const int l = it / 96, jb = it % 96, kg = tid >> 6, jj = tid & 63, j = jb * 64 + jj;
          float a0 = 0.f, a1 = 0.f, a2 = 0.f, a3 = 0.f, a4 = 0.f; const float* wp = INP(4) + ((size_t)l * 1024 + kg * 128) * 6144 + j;
#pragma unroll 8
          for (int kk = 0; kk < 128; ++kk) { const float w = wp[(size_t)kk * 6144]; const int k = kg * 128 + kk; a0 += sv[k] * w; a1 += sv[1024 + k] * w; a2 += sv[2048 + k] * w; a3 += sv[3072 + k] * w; a4 += sv[4096 + k] * w; }
          red[(kg * 5 + 0) * 64 + jj] = a0; red[(kg * 5 + 1) * 64 + jj] = a1; red[(kg * 5 + 2) * 64 + jj] = a2; red[(kg * 5 + 3) * 64 + jj] = a3; red[(kg * 5 + 4) * 64 + jj] = a4;
          __syncthreads();
          if (tid < 320) { const int v = tid >> 6, q = tid & 63; float s = INP(5)[l * 6144 + jb * 64 + q];
#pragma unroll
              for (int g = 0; g < 8; ++g) s += red[(g * 5 + v) * 64 + q];
              MOD[((size_t)l * 5 + v) * 6144 + jb * 64 + q] = s; }
          __syncthreads(); }
    }
}

template <bool OUT8, bool X16 = false>
__device__ __forceinline__ void norm_rows(const Frame& F, const float* xs_x, const float* xs_c, int nrows, const float* gain, const float* mod, int shoff, int scoff, void* XNv,
                                          const float* part = nullptr, int nparts = 0, const float* pgate = nullptr, float* xc_out = nullptr) {
    const int lane = lane_id();
    for (int v = 0; v < 5; ++v) {
        const int r0 = v < 4 ? v * SEQ : NX, r1 = v < 4 ? r0 + SEQ : NR; if (r0 >= nrows) break;
        f32x4 ca[4], cb[4];
#pragma unroll
        for (int j = 0; j < 4; ++j) { const int c = 4 * lane + 256 * j; const f32x4 g = *(const f32x4*)(gain + c), sc = *(const f32x4*)(mod + v * 6144 + scoff + c); ca[j] = g * (sc + 1.0f); cb[j] = *(const f32x4*)(mod + v * 6144 + shoff + c); }
        for (int r = r0 + F.gw; r < r1; r += F.NGW) {
            const float* src = r < NX ? xs_x + (size_t)r * 1024 : xs_c + (size_t)(r - NX) * 1024;
            f32x4 x[4]; float ss = 0.f;
#pragma unroll
            for (int j = 0; j < 4; ++j) { const int c = 4 * lane + 256 * j;
                if (X16 && r < NX) { const u32x2 w = *(const u32x2*)((const bf16_t*)xs_x + (size_t)r * 2048 + c); x[j][0] = bflo(w.x); x[j][1] = bfhi(w.x); x[j][2] = bflo(w.y); x[j][3] = bfhi(w.y); }
                else x[j] = *(const f32x4*)(src + c);
                if (part && r >= NX) { f32x4 sacc = {0.f, 0.f, 0.f, 0.f}; for (int k = 0; k < nparts; ++k) sacc = sacc + *(const f32x4*)(part + ((size_t)k * NC + (r - NX)) * 1024 + c);
                    x[j] = x[j] + *(const f32x4*)(pgate + c) * sacc; if (xc_out) *(f32x4*)(xc_out + (size_t)(r - NX) * 1024 + c) = x[j]; }
                ss += (x[j][0] * x[j][0] + x[j][1] * x[j][1]) + (x[j][2] * x[j][2] + x[j][3] * x[j][3]); }
            const float rstd = rsqrtf(wave_sum(ss, lane) * (1.f / 1024.f) + EPS);
#pragma unroll
            for (int j = 0; j < 4; ++j) { x[j] = x[j] * rstd * ca[j] + cb[j];
                if (OUT8) *(unsigned*)((unsigned char*)XNv + (size_t)r * 1024 + 4 * lane + 256 * j) = pk4_fp8(x[j][0], x[j][1], x[j][2], x[j][3]);
                else { u32x2 o; o.x = pk2(x[j][0], x[j][1]); o.y = pk2(x[j][2], x[j][3]); *(u32x2*)((bf16_t*)XNv + (size_t)r * 1024 + 4 * lane + 256 * j) = o; } }
        }
    }
}
__device__ __forceinline__ void norm_router(const Frame& F, const float* xs, const float* gain, const float* mod, int shoff, int scoff, unsigned char* XNM) { unsigned char* const wsq_ = opq(F.ws);
    const int lane = lane_id(), tid = F.wave * 64 + lane;
    LAS float* RT = (LAS float*)F.lds; LAS int* lcnt = (LAS int*)(F.lds + 32768);
    __syncthreads();
    for (int i = tid; i < 1024 * 8 / 4; i += NTHR) { const int k = i >> 1, p = i & 1, ln = (k & 255) >> 2, jq = (k >> 8) * 4 + (k & 3); ((LAS f32x4*)RT)[(p * 16 + jq) * 64 + ln] = ((const f32x4*)INP(27))[i]; }
    if (tid < 8) lcnt[tid] = 0;
    __syncthreads();
    for (int ch = F.bid; ch < NX / 128; ch += F.G) {
        const int v = ch >> 6;
        f32x4 ca[4], cb[4];
#pragma unroll
        for (int j = 0; j < 4; ++j) { const int c = 4 * lane + 256 * j; const f32x4 g = *(const f32x4*)(gain + c), sc = *(const f32x4*)(mod + v * 6144 + scoff + c); ca[j] = g * (sc + 1.0f); cb[j] = *(const f32x4*)(mod + v * 6144 + shoff + c); }
        float bq[8];
#pragma unroll
        for (int e = 0; e < 8; ++e) bq[e] = 0.f;
#pragma unroll
        for (int j = 0; j < 4; ++j)
#pragma unroll
            for (int q = 0; q < 4; ++q) { const int k = 4 * lane + 256 * j + q; const f32x4 w0 = ((const LAS f32x4*)RT)[(j * 4 + q) * 64 + lane], w1 = ((const LAS f32x4*)RT)[(16 + j * 4 + q) * 64 + lane]; (void)k; const float cv = cb[j][q];
                bq[0] += cv * w0[0]; bq[1] += cv * w0[1]; bq[2] += cv * w0[2]; bq[3] += cv * w0[3]; bq[4] += cv * w1[0]; bq[5] += cv * w1[1]; bq[6] += cv * w1[2]; bq[7] += cv * w1[3]; }
#pragma unroll
        for (int e = 0; e < 8; ++e) bq[e] = wave_sum(bq[e], lane);
        for (int i = 0; i < 16; ++i) {
            const int r = ch * 128 + F.wave * 16 + i; const float* src = xs + (size_t)r * 1024;
            f32x4 x[4]; float ss = 0.f; float lg[8];
#pragma unroll
            for (int e = 0; e < 8; ++e) lg[e] = 0.f;
#pragma unroll
            for (int j = 0; j < 4; ++j) { { const u32x2 w = *(const u32x2*)((const bf16_t*)xs + (size_t)r * 2048 + 4 * lane + 256 * j); x[j][0] = bflo(w.x); x[j][1] = bfhi(w.x); x[j][2] = bflo(w.y); x[j][3] = bfhi(w.y); } ss += (x[j][0] * x[j][0] + x[j][1] * x[j][1]) + (x[j][2] * x[j][2] + x[j][3] * x[j][3]); }
#pragma unroll
            for (int j = 0; j < 4; ++j)
#pragma unroll
                for (int q = 0; q < 4; ++q) { const int k = 4 * lane + 256 * j + q; const f32x4 w0 = ((const LAS f32x4*)RT)[(j * 4 + q) * 64 + lane], w1 = ((const LAS f32x4*)RT)[(16 + j * 4 + q) * 64 + lane]; (void)k; const float xv = x[j][q] * ca[j][q];
                    lg[0] += xv * w0[0]; lg[1] += xv * w0[1]; lg[2] += xv * w0[2]; lg[3] += xv * w0[3]; lg[4] += xv * w1[0]; lg[5] += xv * w1[1]; lg[6] += xv * w1[2]; lg[7] += xv * w1[3]; }
            { const bool h5 = (lane & 32) != 0, h4 = (lane & 16) != 0, h3 = (lane & 8) != 0;
              float a0 = h5 ? lg[4] : lg[0], a1 = h5 ? lg[5] : lg[1], a2 = h5 ? lg[6] : lg[2], a3 = h5 ? lg[7] : lg[3];
              const float s0 = h5 ? lg[0] : lg[4], s1 = h5 ? lg[1] : lg[5], s2 = h5 ? lg[2] : lg[6], s3 = h5 ? lg[3] : lg[7];
              a0 += shx(s0, 32, lane); a1 += shx(s1, 32, lane); a2 += shx(s2, 32, lane); a3 += shx(s3, 32, lane);
              float b0 = h4 ? a2 : a0, b1 = h4 ? a3 : a1; const float t0 = h4 ? a0 : a2, t1 = h4 ? a1 : a3;
              b0 += shx(t0, 16, lane); b1 += shx(t1, 16, lane);
              float c0 = h3 ? b1 : b0; const float u0 = h3 ? b0 : b1;
              c0 += shx(u0, 8, lane); c0 += shx(c0, 4, lane); c0 += shx(c0, 2, lane); c0 += shx(c0, 1, lane);
              ss = wave_sum(ss, lane);
#pragma unroll
              for (int e = 0; e < 8; ++e) lg[e] = __builtin_bit_cast(float, __builtin_amdgcn_readlane(__builtin_bit_cast(int, c0), 8 * e)); }
            const float rstd = rsqrtf(ss * (1.f / 1024.f) + EPS);
#pragma unroll
            for (int j = 0; j < 4; ++j) { x[j] = x[j] * rstd * ca[j] + cb[j]; *(unsigned*)(XNM + (size_t)r * 1024 + 4 * lane + 256 * j) = pk4_fp8(x[j][0], x[j][1], x[j][2], x[j][3]); }
#pragma unroll
            for (int e = 0; e < 8; ++e) lg[e] = lg[e] * rstd + bq[e];
            {
                int i1 = 0; float v1 = lg[0];
#pragma unroll
                for (int e = 1; e < 8; ++e) if (lg[e] > v1) { v1 = lg[e]; i1 = e; }
                int i2 = -1; float v2 = -3.0e38f;
#pragma unroll
                for (int e = 0; e < 8; ++e) if (e != i1 && lg[e] > v2) { v2 = lg[e]; i2 = e; }
                const float w1 = 1.f / (1.f + expf(v2 - v1)), w2 = 1.f - w1;
                if (lane == 0) {
                    __hip_atomic_fetch_add(lcnt + i1, 1, __ATOMIC_RELAXED, __HIP_MEMORY_SCOPE_WORKGROUP); __hip_atomic_fetch_add(lcnt + i2, 1, __ATOMIC_RELAXED, __HIP_MEMORY_SCOPE_WORKGROUP);
                    int* te = (int*)(wsq_ + WS_TOKE) + r * 2; float* tw = (float*)(wsq_ + WS_TOKW) + r * 2;
                    te[0] = i1; te[1] = i2; tw[0] = w1; tw[1] = w2; }
            }
        }
        __syncthreads();
        if (tid < 8) { ((int*)(wsq_ + WS_CNTB))[ch * 8 + tid] = lcnt[tid]; lcnt[tid] = 0; }
        __syncthreads();
    }
}

__device__ __forceinline__ void kr_rows(const Frame& F, const bf16_t* Z, bf16_t* KR) { unsigned char* const wsq_ = opq(F.ws);
    const int lane = lane_id(), tid = F.wave * 64 + lane; (void)tid; (void)lane;
    const float* cosT = (const float*)(wsq_ + WS_COS); const float* sinT = (const float*)(wsq_ + WS_SIN);
    for (int idx = F.gw * 64 + lane; idx < NR * 16; idx += F.NGW * 64) { const int r = idx >> 4, a = (idx >> 3) & 1, i = idx & 7;
        const float x1 = bf1(Z[(size_t)r * 1024 + 896 + a * 16 + i]), x2 = bf1(Z[(size_t)r * 1024 + 896 + a * 16 + 8 + i]);
        float c = 1.f, s = 0.f; if (r < NX) { const int t = r & (SEQ - 1); c = cosT[t * 16 + a * 8 + i]; s = sinT[t * 16 + a * 8 + i]; }
        unsigned char* kr8 = (unsigned char*)KR + (size_t)r * 32 + a * 16 + i; kr8[0] = (unsigned char)(pk4_fp8(x1 * c - x2 * s, 0.f, 0.f, 0.f) & 0xffu); kr8[8] = (unsigned char)(pk4_fp8(x2 * c + x1 * s, 0.f, 0.f, 0.f) & 0xffu); }
}

__device__ __forceinline__ void ssm_tables(const Frame& F, const Args& A) { unsigned char* const wsq_ = opq(F.ws);
    const int lane = lane_id(), tid = F.wave * 64 + lane;
    LAS float* Cr = (LAS float*)F.lds; LAS float* Ci = Cr + 1040; LAS float* BBl = Ci + 1040; LAS float* PWl = BBl + 2048;
    unsigned char* ws = wsq_;
    for (int it2 = F.bid; it2 < 2 * NG * 2 * 2; it2 += F.G) {
        const int it = it2 >> 1, half = it2 & 1; const int dir = it & 1, g = (it >> 1) & 31, l = it >> 6; const int gi = (l * 2 + dir) * NG + g;
        __syncthreads();
        for (int i = tid; i < 1024; i += NTHR) { Cr[(i >> 6) * 65 + (i & 63)] = INP(18)[(size_t)gi * 1024 + i]; Ci[(i >> 6) * 65 + (i & 63)] = INP(19)[(size_t)gi * 1024 + i]; }
        for (int i = tid; i < 2048; i += NTHR) BBl[i] = ((const float*)(ws + WS_BB))[(size_t)gi * 2048 + i];
        for (int i = tid; i < 64 * 66; i += NTHR) PWl[i] = ((const float*)(ws + WS_PW))[(size_t)gi * 64 * 66 + i];
        __syncthreads();
        float* KL = (float*)(ws + WS_KL) + (size_t)((l * NG + g) * 2 + dir) * 8192;
        for (int e = half * 4096 + tid; e < half * 4096 + 4096; e += NTHR) { const int lag = e >> 8, c = (e >> 4) & 15, cp = e & 15; float acc = 0.f;
#pragma unroll 4
            for (int p = 0; p < 64; ++p) { const float cr = Cr[c * 65 + p], ci = Ci[c * 65 + p], pr = PWl[p * 66 + 2 * lag], pi = PWl[p * 66 + 2 * lag + 1], br = BBl[(p * 16 + cp) * 2], bi = BBl[(p * 16 + cp) * 2 + 1];
                acc += (cr * pr - ci * pi) * br - (cr * pi + ci * pr) * bi; }
            KL[e] = acc; }
        bf16_t* W1 = (bf16_t*)(ws + WS_W1T) + ((size_t)(l * NG + g) * 256 + dir * 128) * 512;
        if (half == 0) for (int q = tid; q < 8192; q += NTHR) { const int r = q >> 6, reim = r >> 6, p = r & 63, pc = q & 63, j = pc >> 1, c0 = (pc & 1) * 8, e = dir ? j : TCH - 1 - j;
            const float pr = PWl[p * 66 + 2 * e], pi = PWl[p * 66 + 2 * e + 1]; float v[8];
#pragma unroll
            for (int k = 0; k < 8; ++k) { const float br = BBl[(p * 16 + c0 + k) * 2], bi = BBl[(p * 16 + c0 + k) * 2 + 1]; v[k] = reim ? (pr * bi + pi * br) : (pr * br - pi * bi); }
            u32x4 o; o.x = pk2(v[0], v[1]); o.y = pk2(v[2], v[3]); o.z = pk2(v[4], v[5]); o.w = pk2(v[6], v[7]);
            *(u32x4*)(W1 + (size_t)r * 512 + j * 16 + c0) = o; }
        bf16_t* MT = (bf16_t*)(ws + WS_MT) + (size_t)(l * NG + g) * 512 * 768 + 512 + dir * 128;
        if (half == 1) for (int q = tid; q < 8192; q += NTHR) { const int row = q >> 4, ii = row >> 4, c = row & 15, pc = q & 15, reim = pc >> 3, p0 = (pc & 7) * 8, e = dir ? TCH - ii : ii + 1; float v[8];
#pragma unroll
            for (int k = 0; k < 8; ++k) { const int p = p0 + k; const float cr = Cr[c * 65 + p], ci = Ci[c * 65 + p], pr = PWl[p * 66 + 2 * e], pi = PWl[p * 66 + 2 * e + 1]; v[k] = reim ? -(cr * pi + ci * pr) : (cr * pr - ci * pi); }
            u32x4 o; o.x = pk2(v[0], v[1]); o.y = pk2(v[2], v[3]); o.z = pk2(v[4], v[5]); o.w = pk2(v[6], v[7]);
            *(u32x4*)(MT + (size_t)row * 768 + reim * 64 + p0) = o; }
    }
    __syncthreads();
}
__device__ __forceinline__ void ssm_toeplitz(const Frame& F, const Args& A) { unsigned char* const wsq_ = opq(F.ws);
    const int lane = lane_id(); unsigned char* ws = wsq_;
    for (int x = F.gw * 64 + lane; x < 2 * NG * 512 * 64; x += F.NGW * 64) { const int pc = x & 63, row = (x >> 6) & 511, lg = x >> 15, j = pc >> 1, c0 = (pc & 1) * 8, i = row >> 4, c = row & 15;
        const float* KL = (const float*)(ws + WS_KL) + (size_t)lg * 2 * 8192; float v[8];
#pragma unroll
        for (int k = 0; k < 8; ++k) v[k] = 0.f;
        if (j <= i) { const float* kp = KL + (i - j) * 256 + c * 16 + c0; const f32x4 a = *(const f32x4*)kp, b = *(const f32x4*)(kp + 4); v[0] += a[0]; v[1] += a[1]; v[2] += a[2]; v[3] += a[3]; v[4] += b[0]; v[5] += b[1]; v[6] += b[2]; v[7] += b[3]; }
        if (j >= i) { const float* kp = KL + 8192 + (j - i) * 256 + c * 16 + c0; const f32x4 a = *(const f32x4*)kp, b = *(const f32x4*)(kp + 4); v[0] += a[0]; v[1] += a[1]; v[2] += a[2]; v[3] += a[3]; v[4] += b[0]; v[5] += b[1]; v[6] += b[2]; v[7] += b[3]; }
        if (i == j && (c >> 3) == (c0 >> 3)) { const float d = INP(20)[(lg >> 5) * 512 + (lg & 31) * 16 + c];
#pragma unroll
            for (int k = 0; k < 8; ++k) v[k] += (k == (c & 7)) ? d : 0.f; }
        u32x4 o; o.x = pk2(v[0], v[1]); o.y = pk2(v[2], v[3]); o.z = pk2(v[4], v[5]); o.w = pk2(v[6], v[7]);
        *(u32x4*)((bf16_t*)(ws + WS_MT) + ((size_t)lg * 512 + row) * 768 + j * 16 + c0) = o; }
}
__device__ __forceinline__ void ssm_scan(const Frame& F, int l) { unsigned char* const wsq_ = opq(F.ws);
    const int lane = lane_id(); unsigned char* ws = wsq_;
    for (int w = F.bid + F.G * F.wave; w < NB * NG * 2; w += F.G * NWAVES) {
        const int dir = w & 1, g = (w >> 1) & 31, b = w >> 6; const int idx = ((l * 2 + dir) * NG + g) * NP + lane;
        const float* PW = (const float*)(ws + WS_PW) + (size_t)idx * 66; const float are = PW[2 * TCH], aim = PW[2 * TCH + 1];
        const float* S = (const float*)(ws + WS_S) + (size_t)g * NCH * 256 + dir * 128 + lane; bf16_t* UH = (bf16_t*)(ws + WS_UH) + (size_t)g * NCH * 768 + 512 + dir * 128 + lane;
        float hre = 0.f, him = 0.f;
        for (int blk = 0; blk < (CTXL + SEQ) / TCH / 24; ++blk) {
            float sr[24], si[24]; int nn[24];
#pragma unroll
            for (int k = 0; k < 24; ++k) { const int s = blk * 24 + k; int n;
                if (s < CTXL / TCH) n = NX / TCH + b * (CTXL / TCH) + (dir ? CTXL / TCH - 1 - s : s); else { const int t = s - CTXL / TCH; n = b * (SEQ / TCH) + (dir ? SEQ / TCH - 1 - t : t); }
                nn[k] = n; sr[k] = S[(size_t)n * 256]; si[k] = S[(size_t)n * 256 + 64]; }
#pragma unroll
            for (int k = 0; k < 24; ++k) { UH[(size_t)nn[k] * 768] = (bf16_t)f2bf(hre); UH[(size_t)nn[k] * 768 + 64] = (bf16_t)f2bf(him);
                const float nr = are * hre - aim * him + sr[k], ni = are * him + aim * hre + si[k]; hre = nr; him = ni; }
        }
    }
}

__device__ __forceinline__ int pad256(unsigned c) { return (int)((c + 255u) & ~255u); }
__device__ __forceinline__ void moe_gather(const Frame& F, const unsigned char* XNM, unsigned char* XP) { unsigned char* const wsq_ = opq(F.ws);
    const int lane = lane_id(), tid = F.wave * 64 + lane;
    { u32x4 z4 = {0u, 0u, 0u, 0u}; asm volatile("" : "+v"(z4));
      for (int i = F.gw * 64 + lane; i < MOE_ROWS * 8; i += F.NGW * 64) *(u32x4*)(wsq_ + WS_HP + (size_t)(i >> 3) * DFE8 + DFE + (i & 7) * 16) = z4; }
    LAS int* posl = (LAS int*)F.lds;
    const int* CNTB = (const int*)(wsq_ + WS_CNTB); const int* te = (const int*)(wsq_ + WS_TOKE); int* tp = (int*)(wsq_ + WS_TOKP);
    for (int ch = F.bid; ch < NX / 128; ch += F.G) {
        __syncthreads();
        if (F.wave == 0) {
            int es[4];
#pragma unroll
            for (int q = 0; q < 4; ++q) es[q] = te[ch * 256 + lane + 64 * q];
            int off = 0, ps[4] = {0, 0, 0, 0};
#pragma unroll
            for (int e = 0; e < 8; ++e) {
                int tot = 0, bef = 0;
#pragma unroll
                for (int q = 0; q < 4; ++q) { const int c2 = lane + 64 * q, vv = CNTB[c2 * 8 + e]; tot += vv; bef += (c2 < ch) ? vv : 0; }
                tot = wave_sum_i(tot, lane); bef = wave_sum_i(bef, lane);
                int run = off + bef;
#pragma unroll
                for (int q = 0; q < 4; ++q) { const unsigned long long m = __ballot(es[q] == e); if (es[q] == e) ps[q] = run + __popcll(m & ((1ull << lane) - 1ull)); run += __popcll(m); }
                if (ch == 0 && lane == 0) F.ctl[CW_MOE + e] = (unsigned)tot;
                off += pad256((unsigned)tot);
            }
#pragma unroll
            for (int q = 0; q < 4; ++q) { posl[lane + 64 * q] = ps[q]; tp[ch * 256 + lane + 64 * q] = ps[q]; }
        }
        __syncthreads();
        for (int i = 0; i < 16; ++i) { const int tl = F.wave * 16 + i, r = ch * 128 + tl;
            const u32x4 a = *(const u32x4*)(XNM + (size_t)r * 1024 + lane * 16);
#pragma unroll
            for (int k = 0; k < 2; ++k) { const size_t dst = (size_t)posl[tl * 2 + k] * 1024; *(u32x4*)(XP + dst + lane * 16) = a; } }
    }
}
__device__ __forceinline__ void moe_combine_final(const Frame& F, const Args& A, const bf16_t* YP, const float* g2mod) { unsigned char* const wsq_ = opq(F.ws);
    const int lane = lane_id(), tid = F.wave * 64 + lane; (void)tid; (void)lane;
    const int* tp = (const int*)(wsq_ + WS_TOKP); const float* tw = (const float*)(wsq_ + WS_TOKW);
    f32x4 fn[4];
#pragma unroll
    for (int j = 0; j < 4; ++j) fn[j] = *(const f32x4*)(INP(31) + 4 * lane + 256 * j);
    for (int r = F.gw; r < NX; r += F.NGW) {
        const int v = r >> 13; size_t src[2]; float wk[2];
#pragma unroll
        for (int k = 0; k < 2; ++k) { src[k] = (size_t)tp[r * 2 + k] * 1024; wk[k] = tw[r * 2 + k]; }
        f32x4 x[4]; float ss = 0.f;
#pragma unroll
        for (int j = 0; j < 4; ++j) { const int c = 4 * lane + 256 * j; { const u32x2 w = *(const u32x2*)((const bf16_t*)F.out + (size_t)r * 2048 + c); x[j][0] = bflo(w.x); x[j][1] = bfhi(w.x); x[j][2] = bflo(w.y); x[j][3] = bfhi(w.y); }
            const u32x2 y0 = *(const u32x2*)(YP + src[0] + c), y1 = *(const u32x2*)(YP + src[1] + c); const f32x4 g = *(const f32x4*)(g2mod + v * 6144 + c);
            f32x4 y; y[0] = wk[0] * bflo(y0.x) + wk[1] * bflo(y1.x); y[1] = wk[0] * bfhi(y0.x) + wk[1] * bfhi(y1.x); y[2] = wk[0] * bflo(y0.y) + wk[1] * bflo(y1.y); y[3] = wk[0] * bfhi(y0.y) + wk[1] * bfhi(y1.y);
            x[j] = x[j] + g * y; ss += (x[j][0] * x[j][0] + x[j][1] * x[j][1]) + (x[j][2] * x[j][2] + x[j][3] * x[j][3]); }
        const float rstd = rsqrtf(wave_sum(ss, lane) * (1.f / 1024.f) + EPS);
#pragma unroll
        for (int j = 0; j < 4; ++j) *(f32x4*)(F.out + (size_t)r * 1024 + 4 * lane + 256 * j) = x[j] * rstd * fn[j];
    }
}
typedef float f32x16 __attribute__((ext_vector_type(16)));
constexpr int KALL = SEQ + CTXL;
constexpr int ATT_KB = 6 * 1024, ATT_VB = 4 * 1024, ATT_TB = ATT_KB + ATT_VB, ATT_NBUF = 6;
__device__ __forceinline__ void glds16(const void* gsrc, unsigned lds_dst) { unsigned keep;
    asm volatile("s_mov_b32 %0, m0\n\ts_mov_b32 m0, %2\n\ts_nop 0\n\tglobal_load_lds_dwordx4 %1, off\n\ts_mov_b32 m0, %0" : "=&s"(keep) : "v"(gsrc), "s"(lds_dst) : "memory"); }
__device__ __forceinline__ float max3f(float a, float b, float c) { float r; asm("v_max3_f32 %0, %1, %2, %3" : "=v"(r) : "v"(a), "v"(b), "v"(c)); return r; }
__device__ __forceinline__ float fadd_s(float a, float b) { float r; asm("v_add_f32_e32 %0, %1, %2" : "=v"(r) : "v"(a), "v"(b)); return r; }
__device__ __forceinline__ float max2f(float a, float b) { float r; asm("v_max_f32_e32 %0, %1, %2" : "=v"(r) : "v"(a), "v"(b)); return r; }
__device__ __forceinline__ bf16x8 pack_p(const f32x16& p, int s) {
    u32x4 w; w.x = pk2(p[8 * s], p[8 * s + 1]); w.y = pk2(p[8 * s + 2], p[8 * s + 3]); w.z = pk2(p[8 * s + 4], p[8 * s + 5]); w.w = pk2(p[8 * s + 6], p[8 * s + 7]); return __builtin_bit_cast(bf16x8, w);
}
__device__ __forceinline__ void attn_phase(const Frame& F, bool need_ctx, const bf16_t* Q, const bf16_t* KN, const bf16_t* KR, const bf16_t* VT, bf16_t* Y) {
    LAS unsigned char* lds = F.lds;
    const int nmain = (F.G == 256) ? 4 : (NB * NH * (SEQ / 256) + F.G - 1) / F.G;
    for (int ui = 0; ui < nmain + 1; ++ui) {
        const int lane = lane_id(), r32 = lane & 31, hi = lane >> 5;
        int b, h, qrow0, t0;
        if (ui < nmain) { int un; if (F.G == 256) un = (((F.bid & 7) + 8 * ui) << 5) | (F.bid >> 3); else un = F.bid + ui * F.G;
            if (un >= NB * NH * (SEQ / 256)) continue;
            b = un >> 8; h = (un >> 5) & 7; qrow0 = b * SEQ + (un & 31) * 256; t0 = 0; }
        else { if (!need_ctx || F.bid >= NB * NH) continue; b = F.bid >> 3; h = F.bid & 7; qrow0 = NX + b * CTXL; t0 = SEQ / 64; }
        const int nt = KALL / 64;
        pg8::v8i_t qn8, qr8;
        { const unsigned char* qp = (const unsigned char*)Q + (size_t)(qrow0 + F.wave * 32 + r32) * 768 + h * 96;
          qn8 = pg8::cat8(*(const bf16x8*)(qp + 32 * hi), *(const bf16x8*)(qp + 32 * hi + 16)); qr8 = pg8::cat8(*(const bf16x8*)(qp + 64), *(const bf16x8*)(qp + 80)); }
        const unsigned ldsb = (unsigned)(size_t)lds;
        const char* kbase = (const char*)KN + h * 64 + (F.wave & 3) * 16; const char* rbase = (const char*)KR + (F.wave & 1) * 16;     const char* vbase = (const char*)VT + (size_t)((b * NH + h) * 64) * KALL + (F.wave & 3) * 16;
        const bool lead = F.wave < 4;
        const unsigned klo = (unsigned)lane * 512u, rlo = (unsigned)lane * 32u, vlo = (unsigned)lane * (unsigned)KALL;
#define ATT_DMA(t, bo) do { const int row0_ = (t) < SEQ / 64 ? b * SEQ + (t) * 64 : NX + b * CTXL + ((t) - SEQ / 64) * 64; \
            unsigned klo_ = klo, rlo_ = rlo, vlo_ = vlo; asm volatile("" : "+v"(klo_), "+v"(rlo_), "+v"(vlo_));     \
            if (lead) glds16(kbase + (size_t)row0_ * 512 + klo_, (unsigned)__builtin_amdgcn_readfirstlane(ldsb + (bo) + F.wave * 1024)); \
            else glds16(vbase + (size_t)(t) * 64 + vlo_, (unsigned)__builtin_amdgcn_readfirstlane(ldsb + (bo) + ATT_KB + (F.wave - 4) * 1024)); \
            glds16(rbase + (size_t)row0_ * 32 + rlo_, (unsigned)__builtin_amdgcn_readfirstlane(ldsb + (bo) + (4 + (F.wave & 1)) * 1024)); } while (0)
        const unsigned cA_ = (unsigned)__builtin_amdgcn_readfirstlane(lead ? ldsb + F.wave * 1024 : ldsb + ATT_KB + (F.wave - 4) * 1024), cB_ = (unsigned)__builtin_amdgcn_readfirstlane(ldsb + (4 + (F.wave & 1)) * 1024);
        unsigned long long pa_, pb_;
        const long long rj_ = (long long)((NX + b * CTXL) - (b * SEQ + SEQ));
        const long long dA_ = lead ? rj_ * 512 : 0ll, dB_ = rj_ * 32;
        const unsigned long long stA_ = lead ? 64ull * 512ull : 64ull;
#define ATT_PTR_INIT(t) do { const int row0_ = (t) < SEQ / 64 ? b * SEQ + (t) * 64 : NX + b * CTXL + ((t) - SEQ / 64) * 64; \
            pa_ = lead ? (unsigned long long)(size_t)(kbase + (size_t)row0_ * 512 + klo) : (unsigned long long)(size_t)(vbase + (size_t)(t) * 64 + vlo); pb_ = (unsigned long long)(size_t)(rbase + (size_t)row0_ * 32 + rlo); } while (0)
#define ATT_DMA_FAST(t, bo) do { if ((t) == SEQ / 64) { pa_ += (unsigned long long)dA_; pb_ += (unsigned long long)dB_; } \
            asm volatile("s_add_i32 m0, %2, %3\n\ts_nop 0\n\tglobal_load_lds_dwordx4 %0, off\n\ts_add_i32 m0, %2, %4\n\ts_nop 0\n\tglobal_load_lds_dwordx4 %1, off" \
                         :: "v"(pa_), "v"(pb_), "s"(bo), "s"(cA_), "s"(cB_) : "memory", "m0"); \
            pa_ += stA_; pb_ += 64 * 32; } while (0)
#define ATT_WAITBAR(fresh) do { if constexpr (fresh) asm volatile("s_waitcnt vmcnt(2)\n\ts_barrier" ::: "memory");     else asm volatile("s_waitcnt vmcnt(0) lgkmcnt(0)\n\ts_barrier" ::: "memory"); } while (0)
        const unsigned r32p = (unsigned)((r32 & ~12) | ((r32 & 4) << 1) | ((r32 & 8) >> 1));
        const unsigned kan = hi * 2048 + r32p * 16, kar = 4096 + r32p * 16;
        const unsigned va = ATT_KB + hi * 2048 + r32 * 16;
        const unsigned va_unused_ = 0; (void)va_unused_;
        f32x16 o0, o1, o2, pA0, pA1, pB0, pB1;
#pragma unroll
        for (int r = 0; r < 16; ++r) { o0[r] = 0.f; o1[r] = 0.f; o2[r] = 0.f; }
        pg8::v8i_t ones8; { int c38_ = 0x38383838; asm volatile("" : "+v"(c38_));
#pragma unroll
          for (int r = 0; r < 8; ++r) ones8[r] = c38_; }
        asm volatile("" : "+v"(ones8));
        float m = 0.f, lsum = 0.f, lsum1 = 0.f; f32x16 negm;
#pragma unroll
        for (int r = 0; r < 16; ++r) negm[r] = 0.f;
        asm volatile("" : "+v"(negm));
#define ATT_KN8(bo, kb) pg8::cat8(*(const LAS bf16x8*)(lds + (bo) + kan + (kb) * 512), *(const LAS bf16x8*)(lds + (bo) + kan + (kb) * 512 + 1024))
#define ATT_KR8(bo, kb) pg8::cat8(*(const LAS bf16x8*)(lds + (bo) + kar + (kb) * 512), *(const LAS bf16x8*)(lds + (bo) + kar + (kb) * 512 + 1024))
#define ATT_S8N(P, A8) asm volatile("v_mfma_scale_f32_32x32x64_f8f6f4 %0, %1, %2, %3, %4, %5 op_sel_hi:[0,0,0]" : "=&v"(P) : "v"(A8), "v"(qn8), "v"(negm), "v"(sc1_), "v"(scq_))
#define ATT_S8R(P, A8) asm volatile("v_mfma_scale_f32_32x32x64_f8f6f4 %0, %1, %2, %0, %3, %4 op_sel_hi:[0,0,0]" : "+v"(P) : "v"(A8), "v"(qr8), "v"(sc1_), "v"(scq_))
#define ATT_QK(P0, P1, bo) do { const pg8::v8i_t kn0_ = ATT_KN8(bo, 0), kn1_ = ATT_KN8(bo, 1), kr0_ = ATT_KR8(bo, 0), kr1_ = ATT_KR8(bo, 1); \
            ATT_S8N(P0, kn0_); ATT_S8N(P1, kn1_); ATT_S8R(P0, kr0_); ATT_S8R(P1, kr1_); asm volatile("s_nop 15" :: "v"(kn0_), "v"(kn1_), "v"(kr0_), "v"(kr1_)); } while (0)
#define ATT_VF8(bo, db) pg8::cat8(*(const LAS bf16x8*)(lds + (bo) + va + (db) * 512), *(const LAS bf16x8*)(lds + (bo) + va + (db) * 512 + 1024))
#define ATT_PV8(O, A8, B8) asm volatile("v_mfma_scale_f32_32x32x64_f8f6f4 %0, %1, %2, %0, %3, %3 op_sel_hi:[0,0,0]" : "+v"(O) : "v"(A8), "v"(B8), "v"(sc1_))
#define ATT_MAX(P0, P1, FIRST) do { asm volatile("s_nop 15\n\ts_nop 7" : "+v"(P0), "+v"(P1));     \
            float ra_ = max3f(P0[0], P0[1], P1[0]), rb_ = max3f(P0[2], P0[3], P1[1]); ra_ = max3f(ra_, P1[2], P1[3]); \
            _Pragma("unroll") for (int r = 4; r < 16; r += 4) { ra_ = max3f(ra_, P0[r], P0[r + 1]); rb_ = max3f(rb_, P0[r + 2], P0[r + 3]); ra_ = max3f(ra_, P1[r], P1[r + 1]); rb_ = max3f(rb_, P1[r + 2], P1[r + 3]); } \
            float rm_ = max2f(ra_, rb_); rm_ = max2f(rm_, shx(rm_, 32, lane)); \
            if ((FIRST) || __any(rm_ > 8.0f)) { const float dl_ = (FIRST) ? rm_ - 5.0f : max2f(rm_ - 5.0f, 0.f); m += dl_; const float al_ = __builtin_amdgcn_exp2f(-dl_); lsum *= al_; lsum1 *= al_; \
                _Pragma("unroll") for (int r = 0; r < 16; ++r) negm[r] = -m; asm volatile("" : "+v"(negm));     \
                _Pragma("unroll") for (int r = 0; r < 16; ++r) { P0[r] -= dl_; P1[r] -= dl_; o0[r] *= al_; o1[r] *= al_; } } } while (0)
#define ATT_ROT() do { const unsigned t_ = bpp; bpp = bprv; bprv = bcur; bcur = bnxt; bnxt = bn2; bn2 = bn3; bn3 = t_; } while (0)
#define ATT_E(PO0, PO1, r) do { float a_ = PO0[r], b_ = PO1[r]; asm("v_exp_f32_e32 %0, %0\n\tv_exp_f32_e32 %1, %1\n\tv_add_f32_e32 %2, %2, %0\n\tv_add_f32_e32 %3, %3, %1" : "+v"(a_), "+v"(b_), "+v"(lsum), "+v"(lsum1)); PO0[r] = a_; PO1[r] = b_; } while (0)
#define ATT_X(P, i, D, PF) do { float t0_, t1_, t2_, t3_; int d_; \
            asm("v_exp_f32_e32 %1, %5\n\tv_exp_f32_e32 %2, %6\n\tv_exp_f32_e32 %3, %7\n\tv_exp_f32_e32 %4, %8\n\tv_cvt_pk_fp8_f32 %0, %1, %2\n\tv_cvt_pk_fp8_f32 %0, %3, %4 op_sel:[0,0,1]" \
                : "=&v"(d_), "=&v"(t0_), "=&v"(t1_), "=&v"(t2_), "=&v"(t3_) : "v"(P[4 * (i)]), "v"(P[4 * (i) + 1]), "v"(P[4 * (i) + 2]), "v"(P[4 * (i) + 3])); PF[D] = d_; } while (0)
#define SB_ __builtin_amdgcn_sched_barrier(0)
#define ATT_BODY(PN0, PN1, PO0, PO1, PFW, PFR, VSRC, KNXT, DMAB, j, FRESH) do { const unsigned bv_ = (VSRC), bn_ = (KNXT); float rm_; \
            { const pg8::v8i_t k8_ = pg8::cat8(ka0, ka1); ATT_S8N(PN0, k8_); } SB_; \
            if (FRESH) ATT_DMA_FAST((j) + 3, DMAB); \
            const bf16x8 vb1 = *(const LAS bf16x8*)(lds + bv_ + va + 1024), vb0 = *(const LAS bf16x8*)(lds + bv_ + va), vd1 = *(const LAS bf16x8*)(lds + bv_ + va + 512 + 1024), vd0 = *(const LAS bf16x8*)(lds + bv_ + va + 512); ATT_X(PO0, 0, 0, PFW); SB_; \
            { const pg8::v8i_t k8_ = pg8::cat8(kb0, kb1); ATT_S8N(PN1, k8_); } ATT_X(PO1, 0, 4, PFW); SB_; \
            { const pg8::v8i_t k8_ = pg8::cat8(kc0, kc1); ATT_S8R(PN0, k8_); } ATT_X(PO0, 1, 1, PFW); SB_; \
            { const pg8::v8i_t k8_ = pg8::cat8(kd0, kd1); ATT_S8R(PN1, k8_); } asm volatile("" :: "v"(ka0), "v"(ka1), "v"(kb0), "v"(kb1));     \
            ATT_X(PO1, 1, 5, PFW); SB_; \
            { const pg8::v8i_t va0_ = pg8::cat8(vb0, vb1); ATT_PV8(o0, va0_, PFR); } asm volatile("" :: "v"(kc0), "v"(kc1), "v"(kd0), "v"(kd1)); \
            ka1 = *(const LAS bf16x8*)(lds + bn_ + kan + 1024); ka0 = *(const LAS bf16x8*)(lds + bn_ + kan); kb1 = *(const LAS bf16x8*)(lds + bn_ + kan + 512 + 1024); kb0 = *(const LAS bf16x8*)(lds + bn_ + kan + 512); \
            kc1 = *(const LAS bf16x8*)(lds + bn_ + kar + 1024); kc0 = *(const LAS bf16x8*)(lds + bn_ + kar); kd1 = *(const LAS bf16x8*)(lds + bn_ + kar + 512 + 1024); kd0 = *(const LAS bf16x8*)(lds + bn_ + kar + 512);     \
            ATT_X(PO0, 2, 2, PFW); SB_; \
            { const pg8::v8i_t va1_ = pg8::cat8(vd0, vd1); ATT_PV8(o1, va1_, PFR); } asm volatile("" :: "v"(vb0), "v"(vb1)); ATT_X(PO1, 2, 6, PFW); SB_; \
            ATT_PV8(o2, ones8, PFR); asm volatile("" :: "v"(vd0), "v"(vd1));     \
            ATT_X(PO0, 3, 3, PFW); ATT_X(PO1, 3, 7, PFW); SB_; \
            asm volatile("s_nop 7" : "+v"(PN0), "+v"(PN1)); float ra_, rb_; asm("v_max3_f32 %0, %2, %3, %4\n\tv_max3_f32 %1, %5, %6, %7\n\tv_max3_f32 %0, %0, %8, %9\n\tv_max3_f32 %1, %1, %10, %11" : "=&v"(ra_), "=&v"(rb_) : "v"(PN0[0]), "v"(PN0[1]), "v"(PN0[2]), "v"(PN1[0]), "v"(PN1[1]), "v"(PN1[2]), "v"(PN0[3]), "v"(PN0[4]), "v"(PN0[5]), "v"(PN0[6])); \
            asm("v_max3_f32 %0, %0, %2, %3\n\tv_max3_f32 %1, %1, %4, %5\n\tv_max3_f32 %0, %0, %6, %7\n\tv_max3_f32 %1, %1, %8, %9" : "+v"(ra_), "+v"(rb_) : "v"(PN0[7]), "v"(PN0[8]), "v"(PN0[9]), "v"(PN0[10]), "v"(PN0[11]), "v"(PN0[12]), "v"(PN0[13]), "v"(PN0[14])); \
            asm("v_max3_f32 %0, %0, %2, %3\n\tv_max3_f32 %1, %1, %4, %5\n\tv_max3_f32 %0, %0, %6, %7\n\tv_max3_f32 %1, %1, %8, %9\n\tv_max3_f32 %0, %0, %10, %11\n\tv_max3_f32 %1, %1, %12, %13\n\tv_max3_f32 %0, %0, %14, %15" : "+v"(ra_), "+v"(rb_) : "v"(PN0[15]), "v"(PN1[3]), "v"(PN1[4]), "v"(PN1[5]), "v"(PN1[6]), "v"(PN1[7]), "v"(PN1[8]), "v"(PN1[9]), "v"(PN1[10]), "v"(PN1[11]), "v"(PN1[12]), "v"(PN1[13]), "v"(PN1[14]), "v"(PN1[15])); \
            { float rn_; asm volatile("v_max_f32_e32 %0, %2, %3\n\tv_mov_b32_e32 %1, %0\n\ts_nop 1\n\tv_permlane32_swap_b32 %0, %1\n\tv_max_f32_e32 %0, %0, %1" : "=&v"(rm_), "=&v"(rn_) : "v"(ra_), "v"(rb_)); }     \
            SB_; \
            ATT_APPLY_PENDING(); \
            if (__any(rm_ > 8.0f)) { const float dl_ = max2f(rm_ - 5.0f, 0.f); m += dl_; alp_ = __builtin_amdgcn_exp2f(-dl_); pend_ = true; \
                _Pragma("unroll") for (int r = 0; r < 16; ++r) negm[r] = -m; asm volatile("" : "+v"(negm)); \
                _Pragma("unroll") for (int r = 0; r < 16; ++r) { PN0[r] -= dl_; PN1[r] -= dl_; } } } while (0)
#define ATT_APPLY_PENDING() do { if (pend_) { asm volatile("s_nop 15\n\ts_nop 7" : "+v"(o0), "+v"(o1), "+v"(o2));     \
                _Pragma("unroll") for (int r = 0; r < 16; ++r) { o0[r] *= alp_; o1[r] *= alp_; o2[r] *= alp_; } pend_ = false; } } while (0)
#define ATT_STEPX(PN0, PN1, PO0, PO1, PFW, PFR, VSRC, KNXT, DMAB, j, FRESH) do { \
            ATT_BODY(PN0, PN1, PO0, PO1, PFW, PFR, VSRC, KNXT, DMAB, j, FRESH); \
            if (FRESH) asm volatile("s_waitcnt vmcnt(2)\n\ts_barrier" ::: "memory"); else asm volatile("s_waitcnt vmcnt(0)\n\ts_barrier" ::: "memory"); } while (0)
#define ATT_STEP(PN0, PN1, PO0, PO1, PFW, PFR, VSRC, j, FRESH) do { ATT_STEPX(PN0, PN1, PO0, PO1, PFW, PFR, VSRC, bnxt, bn3, j, FRESH); ATT_ROT(); } while (0)
        pg8::v8i_t pf8a, pf8b; int sc1_ = 0x7f7f7f7f, scq_ = 0x7c7c7c7c; asm volatile("" : "+v"(sc1_), "+v"(scq_));
        { int z_ = 0; asm volatile("" : "+v"(z_));
#pragma unroll
          for (int r = 0; r < 8; ++r) { pf8a[r] = z_; pf8b[r] = z_; } }
        float alp_ = 1.f; bool pend_ = false;
        unsigned bpp = 5 * ATT_TB, bprv = 4 * ATT_TB, bcur = 0, bnxt = ATT_TB, bn2 = 2 * ATT_TB, bn3 = 3 * ATT_TB;
        asm volatile("s_waitcnt vmcnt(0) lgkmcnt(0)\n\ts_barrier" ::: "memory");
        ATT_DMA(t0, bcur); ATT_DMA(t0 + 1, bnxt); ATT_DMA(t0 + 2, bn2);
        ATT_WAITBAR(true);
        ATT_DMA(t0 + 3, bn3);
        ATT_QK(pA0, pA1, bcur); ATT_MAX(pA0, pA1, true);
        bf16x8 ka1 = *(const LAS bf16x8*)(lds + bnxt + kan + 1024), ka0 = *(const LAS bf16x8*)(lds + bnxt + kan), kb1 = *(const LAS bf16x8*)(lds + bnxt + kan + 512 + 1024), kb0 = *(const LAS bf16x8*)(lds + bnxt + kan + 512);
        bf16x8 kc1 = *(const LAS bf16x8*)(lds + bnxt + kar + 1024), kc0 = *(const LAS bf16x8*)(lds + bnxt + kar), kd1 = *(const LAS bf16x8*)(lds + bnxt + kar + 512 + 1024), kd0 = *(const LAS bf16x8*)(lds + bnxt + kar + 512);
        ATT_ROT(); ATT_WAITBAR(true);
        int j = t0 + 1; ATT_PTR_INIT(t0 + 4);
        { const bool fh_ = j + 3 < nt; ATT_STEP(pB0, pB1, pA0, pA1, pf8a, pf8b, bprv, j, fh_); ++j; }
        for (; j + 8 < nt; j += 6) { constexpr unsigned T_ = ATT_TB;
            ATT_STEPX(pA0, pA1, pB0, pB1, pf8b, pf8a, 0 * T_, 3 * T_, 4 * T_, j, true);     ATT_STEPX(pB0, pB1, pA0, pA1, pf8a, pf8b, 1 * T_, 5 * T_, 0 * T_, j + 1, true);
            ATT_STEPX(pA0, pA1, pB0, pB1, pf8b, pf8a, 2 * T_, 4 * T_, 1 * T_, j + 2, true); ATT_STEPX(pB0, pB1, pA0, pA1, pf8a, pf8b, 3 * T_, 0 * T_, 2 * T_, j + 3, true);
            ATT_STEPX(pA0, pA1, pB0, pB1, pf8b, pf8a, 5 * T_, 1 * T_, 3 * T_, j + 4, true); ATT_STEPX(pB0, pB1, pA0, pA1, pf8a, pf8b, 4 * T_, 2 * T_, 5 * T_, j + 5, true); }
        if (t0 == 0) { ATT_STEP(pA0, pA1, pB0, pB1, pf8b, pf8a, bpp, j, true); ATT_STEP(pB0, pB1, pA0, pA1, pf8a, pf8b, bpp, j + 1, false); j += 2; }
        ATT_STEP(pA0, pA1, pB0, pB1, pf8b, pf8a, bpp, j, false); ATT_STEP(pB0, pB1, pA0, pA1, pf8a, pf8b, bpp, j + 1, false);
        { const pg8::v8i_t va0_ = ATT_VF8(bpp, 0), va1_ = ATT_VF8(bpp, 1); ATT_PV8(o0, va0_, pf8a); ATT_PV8(o1, va1_, pf8a); ATT_PV8(o2, ones8, pf8a); asm volatile("s_nop 15" :: "v"(va0_), "v"(va1_), "v"(pf8a)); }
        ATT_APPLY_PENDING();
        ATT_X(pB0, 0, 0, pf8b); ATT_X(pB1, 0, 4, pf8b); ATT_X(pB0, 1, 1, pf8b); ATT_X(pB1, 1, 5, pf8b); ATT_X(pB0, 2, 2, pf8b); ATT_X(pB1, 2, 6, pf8b); ATT_X(pB0, 3, 3, pf8b); ATT_X(pB1, 3, 7, pf8b);
        { const pg8::v8i_t va0_ = ATT_VF8(bprv, 0), va1_ = ATT_VF8(bprv, 1); asm volatile("s_nop 3" : "+v"(pf8b)); ATT_PV8(o0, va0_, pf8b); ATT_PV8(o1, va1_, pf8b); ATT_PV8(o2, ones8, pf8b); asm volatile("s_nop 15" :: "v"(va0_), "v"(va1_), "v"(pf8b)); }
#undef ATT_DMA
#undef ATT_DMA_FAST
#undef ATT_PTR_INIT
#undef ATT_WAITBAR
#undef ATT_QK
#undef ATT_VF8
#undef ATT_PV8
#undef ATT_APPLY_PENDING
#undef ATT_MAX
#undef ATT_ROT
#undef ATT_STEP
#undef ATT_STEPX
#undef ATT_BODY
#undef ATT_KN8
#undef ATT_KR8
#undef ATT_S8N
#undef ATT_S8R
#undef ATT_E
#undef SB_
        const int le = lane_id();
        asm volatile("s_nop 15\n\ts_nop 7" : "+v"(o0), "+v"(o1), "+v"(o2));
        lsum = o2[0]; (void)lsum1;
        const float inv = 1.f / lsum;
        bf16_t* yp = Y + (size_t)(qrow0 + F.wave * 32 + (le & 31)) * 1024 + 512 + h * 64 + 4 * (le >> 5);
#pragma unroll
        for (int g = 0; g < 4; ++g) {
            u32x2 w0, w1; w0.x = pk2(o0[4 * g] * inv, o0[4 * g + 1] * inv); w0.y = pk2(o0[4 * g + 2] * inv, o0[4 * g + 3] * inv);
            w1.x = pk2(o1[4 * g] * inv, o1[4 * g + 1] * inv); w1.y = pk2(o1[4 * g + 2] * inv, o1[4 * g + 3] * inv);
            *(u32x2*)(yp + 8 * g) = w0; *(u32x2*)(yp + 32 + 8 * g) = w1;
        }
    }
    __syncthreads();
}

constexpr int N_PHASES = 23;
#define SP2v true
#define ALIGNv true
__global__ void __launch_bounds__(NTHR, 2) fwd_kernel(Args A) {
    extern __shared__ __attribute__((aligned(16))) unsigned char lds_raw[];
    Frame F;
    F.lds = (LAS unsigned char*)lds_raw; F.MISC = (volatile LAS unsigned*)(F.lds + MISC_OFF);
    F.wave = __builtin_amdgcn_readfirstlane((int)threadIdx.x >> 6);
    F.G = gridDim.x; F.bid = blockIdx.x; F.gw = F.bid * NWAVES + F.wave; F.NGW = F.G * NWAVES;
    F.out = A.out; F.ws = A.ws; F.ctl = (unsigned*)(A.ws + WS_CTL);
    for (int u = (int)threadIdx.x; u < (LDS_BYTES - LDSCTL_OFF) / 4; u += NTHR) ((LAS unsigned*)(F.lds + LDSCTL_OFF))[u] = 0u;
    __syncthreads();
#if MK_N_LAUNCHES == 1
    XcdBarrier bar = xcd_barrier_post(F.ctl + CW_BAR, F.MISC + 8);
#define GRID_BAR() xcd_barrier(bar)
#else
#define GRID_BAR() do {} while (0)
#endif
    const int lo = A.ph_lo, hi = A.ph_hi;
#define IN(k) (lo <= (k) && (k) < hi)
#ifndef PROBE_ON
#define PROBE_ON 0
#endif
#if PROBE_ON
#define SEAM(k) do { if (IN(k) && IN((k) + 1)) { GRID_BAR(); const int k_ = (k); if (F.bid == 0 && (k_ == PROBE_A - 100 || k_ == PROBE_A - 101 || k_ == PROBE_B - 100 || k_ == PROBE_B - 101) && lane_id() == 0 && F.wave == 0) \
        __hip_atomic_store((unsigned long long*)(opq(F.ws) + WS_PROBE) + 16 + k_, __builtin_amdgcn_s_memrealtime(), __ATOMIC_RELAXED, __HIP_MEMORY_SCOPE_AGENT); } } while (0)
#else
#define SEAM(k) do { if (IN(k) && IN((k) + 1)) GRID_BAR(); } while (0)
#endif
    LAS unsigned char* ring = F.lds;
#define WSQ() unsigned char* ws = opq(F.ws)
#define PBF(name, off) bf16_t* name = (bf16_t*)(ws + (off))

    if (IN(0)) { p0_prologue(F, A); } SEAM(0);

    for (int l = 0; l < 2; ++l) {
        const int pb = 1 + 10 * l; const bool need_ctx = (l == 0);
        if (IN(pb + 0)) { WSQ(); PBF(XN, WS_XN); const float* modl = (const float*)(ws + WS_MOD) + (size_t)l * 5 * 6144;
            const float* xs_x = (l == 0) ? INP(0) : F.out; const float* xs_c = (l == 0) ? INP(2) : (const float*)(ws + WS_XC);
            if (l == 0) { p0_weights(F, A); __syncthreads(); ssm_tables(F, A); }
            if (l == 0) norm_rows<false, false>(F, xs_x, xs_c, NR, INP(6) + l * 1024, modl, 0, 1024, XN, l == 1 ? (const float*)(ws + WS_PART) : nullptr, 11, (const float*)(ws + WS_MOD) + 4 * 6144 + 5120, nullptr); else norm_rows<false, true>(F, xs_x, xs_c, NR, INP(6) + l * 1024, modl, 0, 1024, XN, l == 1 ? (const float*)(ws + WS_PART) : nullptr, 11, (const float*)(ws + WS_MOD) + 4 * 6144 + 5120, nullptr); } SEAM(pb + 0);
        if (IN(pb + 1)) { WSQ(); PBF(XN, WS_XN); PBF(Z, WS_Z); float* rs = (float*)(ws + WS_RS) + (size_t)l * NR * 8;
            pg8::Gemm g{XN, (const bf16_t*)(ws + WS_WIN) + (size_t)l * 1024 * 1024, 1024, 1024, 1024, 0}; pg8::StaticOrder S; S.init(NR, 1024, F.G, F.bid);
            pg8::EpiInProj E{Z, rs, (bf16_t*)(ws + WS_UH)}; pg8::gemm_phase<pg8::EpiInProj, pg8::StaticOrder, ALIGNv, SP2v>(ring, g, S, E, F.wave);
            if (l == 0) ssm_toeplitz(F, A); } SEAM(pb + 1);
        if (IN(pb + 2)) {
            const int qx = ((need_ctx ? NR : NX) / 256) * 3 - F.G;
            const int c_kn = (F.G == 256) ? ((F.bid + 256 - qx) & 255) : F.bid, c_vt = (F.G == 256) ? ((F.bid + 256 - qx - 8) & 255) : F.bid, c_s1 = (F.G == 256) ? ((F.bid + 256 - qx - 16) & 255) : F.bid;
            { WSQ(); PBF(Z, WS_Z); PBF(Qb, WS_Q); const float* rs = (const float*)(ws + WS_RS) + (size_t)l * NR * 8;
              pg8::Gemm g{Z + 512, (const bf16_t*)(ws + WS_WUQ) + (size_t)l * 768 * 256, 1024, 256, 256, 0}; pg8::StaticOrder S; S.init(need_ctx ? NR : NX, 768, F.G, F.bid);
              pg8::EpiQ E{Qb, rs, (const float*)(ws + WS_COS), (const float*)(ws + WS_SIN)}; pg8::gemm_phase<pg8::EpiQ, pg8::StaticOrder, ALIGNv, SP2v>(ring, g, S, E, F.wave); }
            { WSQ(); PBF(Z, WS_Z); PBF(KN, WS_KN); const float* rs = (const float*)(ws + WS_RS) + (size_t)l * NR * 8;
              pg8::Gemm g{Z + 768, (const bf16_t*)(ws + WS_WUKV) + (size_t)l * 1024 * 128, 1024, 128, 128, 0}; pg8::StaticOrder S; S.init(NR, 512, F.G, c_kn);
              pg8::EpiKV E{KN, rs}; pg8::gemm_phase<pg8::EpiKV, pg8::StaticOrder, ALIGNv, SP2v>(ring, g, S, E, F.wave); }
            { WSQ(); PBF(Z, WS_Z); PBF(VT, WS_V); const float* rs = (const float*)(ws + WS_RS) + (size_t)l * NR * 8;
              pg8::Gemm g{(const bf16_t*)(ws + WS_WUKV) + (size_t)l * 1024 * 128 + 512 * 128, Z + 768, 128, 1024, 128, 0}; pg8::StaticOrder S; S.init(512, NR, F.G, c_vt);
              pg8::EpiVT E{VT, rs}; pg8::gemm_phase<pg8::EpiVT, pg8::StaticOrder, ALIGNv, SP2v>(ring, g, S, E, F.wave); }
            { WSQ(); PBF(Z, WS_Z); PBF(KR, WS_KR); kr_rows(F, Z, KR); }
            { WSQ(); PBF(UH, WS_UH);
              pg8::Gemm g{UH, (const bf16_t*)(ws + WS_W1T) + (size_t)l * NG * 256 * 512, 768, 512, 512, (size_t)256 * 512 * 2, (size_t)NCH * 768 * 2}; pg8::GroupOrder S{5, 1, F.G, c_s1};
              pg8::EpiS E{(float*)(ws + WS_S)}; pg8::gemm_phase<pg8::EpiS, pg8::GroupOrder, ALIGNv, SP2v>(ring, g, S, E, F.wave); }
        } SEAM(pb + 2);
        if (IN(pb + 3)) {
            ssm_scan(F, l);
            if (F.wave != 0) { Frame F2 = F; F2.gw = F.bid * (NWAVES - 1) + F.wave - 1; F2.NGW = F.G * (NWAVES - 1); p0_moe_weights(F2, A, 4 * l, 4 * l + 4); }
            __syncthreads();
            { WSQ(); PBF(Qb, WS_Q); PBF(KN, WS_KN); PBF(KR, WS_KR); PBF(VT, WS_V); PBF(YMIX, WS_YMIX); attn_phase(F, need_ctx, Qb, KN, KR, VT, YMIX); }
        } SEAM(pb + 3);
        if (IN(pb + 4)) { WSQ(); PBF(UH, WS_UH); PBF(ZG, WS_ZG);
            pg8::Gemm g{UH, (const bf16_t*)(ws + WS_MT) + (size_t)l * NG * 512 * 768, 768, 768, 768, (size_t)512 * 768 * 2, (size_t)NCH * 768 * 2}; pg8::GroupOrder S{need_ctx ? 5 : 4, 2, F.G, F.bid};
            pg8::EpiY E{ZG}; pg8::gemm_phase<pg8::EpiY, pg8::GroupOrder, ALIGNv, SP2v>(ring, g, S, E, F.wave); } SEAM(pb + 4);
        if (IN(pb + 5)) { WSQ(); PBF(ZG, WS_ZG); PBF(YMIX, WS_YMIX);
            pg8::Gemm g{ZG, (const bf16_t*)(ws + WS_WGLU) + (size_t)l * 512 * 512, 512, 512, 512, 0}; pg8::StaticOrder S; S.init(need_ctx ? NR : NX, 512, F.G, F.bid);
            pg8::EpiGlu E{ZG, INP(22) + l * 512, YMIX}; pg8::gemm_phase<pg8::EpiGlu, pg8::StaticOrder, ALIGNv, SP2v>(ring, g, S, E, F.wave); } SEAM(pb + 5);
        if (IN(pb + 6)) { WSQ(); PBF(YMIX, WS_YMIX); const float* modl = (const float*)(ws + WS_MOD) + (size_t)l * 5 * 6144; float* XC = (float*)(ws + WS_XC);
            const float* xs_x = (l == 0) ? INP(0) : F.out; const float* xs_c = (l == 0) ? INP(2) : XC;
            { pg8::Gemm g{YMIX, (const bf16_t*)(ws + WS_WOUT) + (size_t)l * 1024 * 1024, 1024, 1024, 1024, 0}; pg8::StaticOrder S; S.init(NX, 1024, F.G, F.bid);
              pg8::EpiRes E{l == 0 ? xs_x : nullptr, (bf16_t*)F.out, modl + 2048, 1.f}; pg8::gemm_phase<pg8::EpiRes, pg8::StaticOrder, ALIGNv, SP2v>(ring, g, S, E, F.wave); }
            if (need_ctx) {
              pg8::Gemm g{YMIX + (size_t)NX * 1024, (const bf16_t*)(ws + WS_WOUT) + (size_t)l * 1024 * 1024, 1024, 1024, 256, 512, 512}; pg8::CtxSplitOrder S{4, F.G, F.bid};
              pg8::EpiPart E{(float*)(ws + WS_PART), 1.f}; pg8::gemm_phase<pg8::EpiPart, pg8::CtxSplitOrder, ALIGNv, SP2v>(ring, g, S, E, F.wave); }
        } SEAM(pb + 6);
        if (l == 0) {
            if (IN(pb + 7)) { WSQ(); PBF(XN, WS_XN); const float* modl = (const float*)(ws + WS_MOD); norm_rows<false, true>(F, F.out, INP(2), NR, INP(7), modl, 3072, 4096, XN, (const float*)(ws + WS_PART), 4, modl + 4 * 6144 + 2048, (float*)(ws + WS_XC)); } SEAM(pb + 7);
            if (IN(pb + 8)) { WSQ(); PBF(XN, WS_XN); PBF(H, WS_H);
                pg8::Gemm g{XN, (const bf16_t*)(ws + WS_WFF13), 1024, 1024, 1024, 0}; pg8::StaticOrder S; S.init(NR, 2 * DFF, F.G, F.bid);
                pg8::EpiSwiglu<true> E{H, DFF, 1.f}; pg8::gemm_phase<pg8::EpiSwiglu<true>, pg8::StaticOrder, ALIGNv, SP2v>(ring, g, S, E, F.wave); } SEAM(pb + 8);
            if (IN(pb + 9)) { WSQ(); PBF(H, WS_H); const float* modl = (const float*)(ws + WS_MOD); float* XC = (float*)(ws + WS_XC);
                { pg8::Gemm g{H, (const bf16_t*)(ws + WS_WFF2), DFF / 2, DFF / 2, DFF / 2, 0}; pg8::StaticOrder S; S.init(NX, 1024, F.G, F.bid);
                  pg8::EpiRes E{nullptr, (bf16_t*)F.out, modl + 5120, 1.f / W8_SCALE}; pg8::gemm_phase<pg8::EpiRes, pg8::StaticOrder, ALIGNv, SP2v, true>(ring, g, S, E, F.wave); }
                { pg8::Gemm g{(const bf16_t*)((const unsigned char*)H + (size_t)NX * DFF), (const bf16_t*)(ws + WS_WFF2), DFF / 2, DFF / 2, 128, 256, 256}; pg8::CtxSplitOrder S{11, F.G, F.bid};
                  pg8::EpiPart E{(float*)(ws + WS_PART), 1.f / W8_SCALE}; pg8::gemm_phase<pg8::EpiPart, pg8::CtxSplitOrder, ALIGNv, SP2v, true>(ring, g, S, E, F.wave); } } SEAM(pb + 9);
        } else {
            if (IN(pb + 7)) { WSQ(); const float* modl = (const float*)(ws + WS_MOD) + (size_t)5 * 6144; norm_router(F, F.out, INP(7) + 1024, modl, 3072, 4096, ws + WS_XNM); } SEAM(pb + 7);
            if (IN(pb + 8)) { WSQ(); moe_gather(F, ws + WS_XNM, ws + WS_XP); } SEAM(pb + 8);
            if (IN(pb + 9)) { WSQ(); PBF(XP, WS_XP); PBF(HP, WS_HP); const unsigned* cnt = F.ctl + CW_MOE; int o[9]; o[0] = 0;
#pragma unroll
                for (int e = 0; e < 8; ++e) o[e + 1] = o[e] + pad256(cnt[e]);
                pg8::MoeOrder S; S.nT = o[8] / 256; S.nN = 2 * DFE / 256; S.nwg = S.nT * S.nN; S.G = F.G; S.c = F.bid; S.o1 = o[1]; S.o2 = o[2]; S.o3 = o[3]; S.o4 = o[4]; S.o5 = o[5]; S.o6 = o[6]; S.o7 = o[7];
                pg8::Gemm g{XP, (const bf16_t*)(ws + WS_WM13), 512, 512, 512, (size_t)2 * DFE * 1024};
                pg8::EpiSwiglu<true> E{HP, DFE8, 1.f / W8_SCALE}; pg8::gemm_phase<pg8::EpiSwiglu<true>, pg8::MoeOrder, ALIGNv, SP2v, true>(ring, g, S, E, F.wave); } SEAM(pb + 9);
        }
    }
    if (IN(21)) { WSQ(); PBF(HP, WS_HP); PBF(YP, WS_YP); const unsigned* cnt = F.ctl + CW_MOE; int o[9]; o[0] = 0;
#pragma unroll
        for (int e = 0; e < 8; ++e) o[e + 1] = o[e] + pad256(cnt[e]);
        pg8::MoeOrder S; S.nT = o[8] / 256; S.nN = 4; S.nwg = S.nT * S.nN; S.G = F.G; S.c = F.bid; S.o1 = o[1]; S.o2 = o[2]; S.o3 = o[3]; S.o4 = o[4]; S.o5 = o[5]; S.o6 = o[6]; S.o7 = o[7];
        pg8::Gemm g{HP, (const bf16_t*)(ws + WS_WM2), DFE8 / 2, DFE8 / 2, DFE8 / 2, (size_t)1024 * DFE8};
        pg8::EpiBf16 E{YP, 1024, 1.f / W8_SCALE}; pg8::gemm_phase<pg8::EpiBf16, pg8::MoeOrder, ALIGNv, SP2v, true>(ring, g, S, E, F.wave); } SEAM(21);
    if (IN(22)) { WSQ(); PBF(YP, WS_YP); moe_combine_final(F, A, YP, (const float*)(ws + WS_MOD) + (size_t)5 * 6144 + 5120);
#if PROBE_ON
        { __syncthreads(); const unsigned long long* pw = (const unsigned long long*)(ws + WS_PROBE); float va, vb;
          if (PROBE_A >= 100) va = (float)(pw[16 + PROBE_A - 100] - pw[16 + PROBE_A - 101]) * 0.1f; else va = (float)pw[PROBE_A] / 131.f;
          if (PROBE_B >= 100) vb = (float)(pw[16 + PROBE_B - 100] - pw[16 + PROBE_B - 101]) * 0.1f; else vb = (float)pw[PROBE_B] / 131.f;
          if (PROBE_A == 63) { va = 1234.f; vb = 777.f; }
          va = exp2f((rintf(4.f * log2f(fmaxf(va, 1.f)) + PROBE_Q) - PROBE_Q) * 0.25f); vb = exp2f((rintf(4.f * log2f(fmaxf(vb, 1.f)) + PROBE_Q) - PROBE_Q) * 0.25f);
          const float sn = 1000.f * sqrtf(va);
          const int lane = lane_id();
          for (int r = F.gw; r < NX; r += F.NGW)
#pragma unroll
              for (int jq = 0; jq < 4; ++jq) { const size_t i = (size_t)r * 1024 + 4 * lane + 256 * jq; f32x4 o;
#pragma unroll
                  for (int k = 0; k < 4; ++k) { const unsigned hsh = (unsigned)(i + k) * 2654435761u; o[k] = (hsh & 0x10000u) ? sn : -sn; }
                  if (i == 0) o[0] = 1.0e4f * vb;
                  *(f32x4*)(F.out + i) = o; } }
#endif
    }
#undef IN
#undef SEAM
}

extern "C" void kernel_launch(void* const* d_in, const int* in_sizes, int n_in, void* d_out, int out_size, void* d_ws, size_t ws_size, hipStream_t stream) {
    static int grid = 0;
    if (grid == 0) {
        if (n_in != 32 || in_sizes[0] != NX * DM || out_size != NX * DM || ws_size < WS_END) { fprintf(stderr, "kernel_launch: unexpected shapes (n_in %d, in0 %d, out %d, ws %zu); nothing launched\n", n_in, n_in > 0 ? in_sizes[0] : -1, out_size, ws_size); grid = -1; return; }
        int dev = 0, cus = 0, per_cu = 0;
        if (hipGetDevice(&dev) != hipSuccess || hipDeviceGetAttribute(&cus, hipDeviceAttributeMultiprocessorCount, dev) != hipSuccess) { grid = -1; return; }
        if (hipFuncSetAttribute((const void*)fwd_kernel, hipFuncAttributeMaxDynamicSharedMemorySize, LDS_BYTES) != hipSuccess) { fprintf(stderr, "kernel_launch: hipFuncSetAttribute failed\n"); grid = -1; return; }
        if (hipOccupancyMaxActiveBlocksPerMultiprocessor(&per_cu, (const void*)fwd_kernel, NTHR, LDS_BYTES) != hipSuccess || per_cu < 1) fprintf(stderr, "kernel_launch: occupancy query says %d\n", per_cu);
        (void)hipGetLastError();
        grid = cus;
    }
    if (grid < 0) return;
    if (hipMemsetAsync((char*)d_ws + WS_CTL, 0, CTL_ZERO_BYTES, stream) != hipSuccess) { fprintf(stderr, "kernel_launch: memset failed\n"); return; }
    Args a{};
    for (int i = 0; i < 32; ++i) a.in[i] = (const float*)d_in[i];
    a.out = (float*)d_out; a.ws = (unsigned char*)d_ws; a.pad = 0;
#if MK_N_LAUNCHES == 1
    a.ph_lo = 0; a.ph_hi = N_PHASES; a.li = 0;
    hipLaunchKernelGGL(fwd_kernel, dim3(grid), dim3(NTHR), LDS_BYTES, stream, a);
#else
    for (int p = 0; p < N_PHASES; ++p) { a.ph_lo = p; a.ph_hi = p + 1; a.li = p; hipLaunchKernelGGL(fwd_kernel, dim3(grid), dim3(NTHR), LDS_BYTES, stream, a); }
#endif
    const hipError_t le = hipPeekAtLastError();
    if (le != hipSuccess) fprintf(stderr, "kernel_launch: launch failed: %s\n", hipGetErrorName(le));
}
```

```cpp
#include <hip/hip_runtime.h>
#include <cstdio>
#include <cstdint>

#define LAS __attribute__((address_space(3)))
#define GAS __attribute__((address_space(1)))
#define PG8_LAS LAS
typedef unsigned short bf16_t;
typedef short bf16x8 __attribute__((ext_vector_type(8)));
typedef float f32x4 __attribute__((ext_vector_type(4)));
typedef float f32x2 __attribute__((ext_vector_type(2)));
typedef unsigned u32x4 __attribute__((ext_vector_type(4)));
typedef unsigned u32x2 __attribute__((ext_vector_type(2)));
typedef __bf16 bf16x2_t __attribute__((ext_vector_type(2)));

#ifndef MK_N_LAUNCHES
#define MK_N_LAUNCHES 1
#endif

constexpr int DM = 1024, NB = 4, SEQ = 8192, CTXL = 256, NX = NB * SEQ, NC = NB * CTXL, NR = NX + NC;
constexpr int D_SSM = 512, NG = 32, NP = 64, NH = 8, DQK = 96, DIN = 928;
constexpr int DFF = 2816, NE = 8, DFE = 1408, DFE8 = 1536;
constexpr float EPS = 1e-6f;
constexpr float QSCALE = 0.10206207261596575f * 1.4426950408889634f;
constexpr int TCH = 32, NCH = NR / TCH;
constexpr int MOE_ROWS = 2 * NX + NE * 256;

constexpr size_t MiB = 1u << 20;
constexpr size_t WS_CTL = 0, CTL_ZERO_BYTES = 1 * MiB;
constexpr int CW_TMO = 0, CW_BAR = 4096, CW_MOE = 8192;
constexpr size_t WS_MOD = 64 * 1024;
constexpr size_t WS_RS = 5 * MiB;
constexpr size_t WS_COS = 1 * MiB, WS_SIN = WS_COS + 512 * 1024;
constexpr size_t WS_AB = 2 * MiB;
constexpr size_t WS_BB = WS_AB + 128 * 1024;
constexpr size_t WS_PW = 8 * MiB;
constexpr size_t WS_KL = 11 * MiB;
constexpr size_t WS_PROBE = 15 * MiB;
constexpr size_t WS_TOKE = 4 * MiB, WS_TOKP = WS_TOKE + 256 * 1024, WS_TOKW = WS_TOKP + 256 * 1024, WS_CNTB = WS_TOKW + 256 * 1024;
constexpr size_t WS_WIN = 16 * MiB, WS_WUQ = 20 * MiB, WS_WUKV = 21 * MiB, WS_WGLU = 22 * MiB, WS_WOUT = 23 * MiB;
constexpr size_t WS_WFF13 = 27 * MiB, WS_WFF2 = 38 * MiB, WS_WM13 = 44 * MiB, WS_WM2 = 88 * MiB;
constexpr size_t WS_XC = 112 * MiB;
constexpr size_t WS_RB = 116 * MiB;
constexpr size_t WS_XN = WS_RB, WS_Q = WS_RB, WS_XP = WS_RB, WS_YP = WS_RB;
constexpr size_t WS_W1T = WS_RB + 66 * MiB;
constexpr size_t WS_MT = WS_RB + 82 * MiB;
constexpr size_t WS_RA = 248 * MiB;
constexpr size_t WS_Z = WS_RA, WS_YMIX = WS_RA, WS_KN = WS_RA + 66 * MiB, WS_V = WS_RA + 99 * MiB, WS_KR = WS_RA + 132 * MiB;
constexpr size_t WS_ZG = WS_RA + 135 * MiB;
constexpr size_t WS_UH = WS_RA + 168 * MiB;
constexpr size_t WS_S = WS_RA + 218 * MiB;
constexpr size_t WS_H = WS_RA, WS_HP = WS_RA, WS_XNM = WS_RA + 182 * MiB;
constexpr size_t WS_PART = WS_RA + 182 * MiB;
constexpr size_t WS_END = 512 * MiB;
static_assert(WS_S + (size_t)32 * (NR / 32) * 256 * 4 <= WS_END && WS_UH + (size_t)32 * (NR / 32) * 768 * 2 + 512 * 1024 <= WS_S && WS_MT + (size_t)2 * 32 * 512 * 768 * 2 <= WS_RA && WS_XNM + (size_t)NX * DM * 2 <= WS_END && WS_H + (size_t)NR * DFF * 2 <= WS_XNM, "ws map");
static_assert(WS_RS + (size_t)2 * NR * 8 * 4 <= 16 * MiB && WS_MOD + 2 * 5 * 6144 * 4 <= CTL_ZERO_BYTES, "ctl map");

constexpr int RING_BYTES = 131072, LDSCTL_OFF = RING_BYTES, MISC_OFF = LDSCTL_OFF + 320, LDS_BYTES = 147456;

__device__ __forceinline__ unsigned f2bf(float f) { unsigned u = __builtin_bit_cast(unsigned, f); return (u + 0x7fffu + ((u >> 16) & 1u)) >> 16; }
__device__ __forceinline__ unsigned pk2(float lo, float hi) { f32x2 v = {lo, hi}; bf16x2_t b = __builtin_convertvector(v, bf16x2_t); return __builtin_bit_cast(unsigned, b); }
__device__ __forceinline__ unsigned pk4_fp8(float a, float b, float c, float d) { int w = 0; w = __builtin_amdgcn_cvt_pk_fp8_f32(a, b, w, false); w = __builtin_amdgcn_cvt_pk_fp8_f32(c, d, w, true); return (unsigned)w; }
constexpr float W8_SCALE = 64.f;
__device__ __forceinline__ float bflo(unsigned w) { return __builtin_bit_cast(float, w << 16); }
__device__ __forceinline__ float bfhi(unsigned w) { return __builtin_bit_cast(float, w & 0xffff0000u); }
__device__ __forceinline__ float bf1(bf16_t h) { return __builtin_bit_cast(float, (unsigned)h << 16); }
__device__ __forceinline__ float shx(float v, int m, int lane) { return __builtin_bit_cast(float, __builtin_amdgcn_ds_bpermute((lane ^ m) << 2, __builtin_bit_cast(int, v))); }
__device__ __forceinline__ int shx_i(int v, int m, int lane) { return __builtin_amdgcn_ds_bpermute((lane ^ m) << 2, v); }
__device__ __forceinline__ int wave_sum_i(int v, int lane) {
#pragma unroll
    for (int o = 1; o < 64; o <<= 1) v += shx_i(v, o, lane);
    return v;
}
__device__ __forceinline__ float wave_sum(float v, int lane) {
#pragma unroll
    for (int o = 1; o < 64; o <<= 1) v += shx(v, o, lane);
    return v;
}
__device__ __forceinline__ float silu_f(float x) { return x * __builtin_amdgcn_rcpf(1.f + __builtin_amdgcn_exp2f(-1.4426950408889634f * x)); }
__device__ __forceinline__ float sigmoid_f(float x) { return __builtin_amdgcn_rcpf(1.f + __builtin_amdgcn_exp2f(-1.4426950408889634f * x)); }
__device__ __forceinline__ float gelu_tanh_f(float x) { const float u = (1.5957691216057308f * 1.4426950408889634f) * (x + 0.044715f * x * x * x); return x * __builtin_amdgcn_rcpf(1.f + __builtin_amdgcn_exp2f(-u)); }
#define LDS_WAIT() asm volatile("s_waitcnt lgkmcnt(0)" ::: "memory")
#define VM_WAIT() asm volatile("s_waitcnt vmcnt(0)" ::: "memory")

__device__ __forceinline__ int lane_id() { int l; asm volatile("v_mbcnt_lo_u32_b32 %0, -1, 0\n\tv_mbcnt_hi_u32_b32 %0, -1, %0" : "=v"(l)); return l; }
__device__ __forceinline__ unsigned char* opq(unsigned char* p) { asm volatile("" : "+s"(p)); return p; }
typedef const float* cfptr_t;
__device__ __forceinline__ const float* inptr(int k) {
    const __attribute__((address_space(4))) char* kp = (const __attribute__((address_space(4))) char*)__builtin_amdgcn_kernarg_segment_ptr();
    return *(const __attribute__((address_space(4))) cfptr_t volatile*)(kp + 8 * k);
}
#define INP(k) inptr(k)

namespace pg8 {
constexpr int BM = 256, BK = 64, HALF = 128, HTB = HALF * BK * 2  , STAGE_BYTES = 8 * HTB, NXCD = 8, WGM = 4;

__host__ __device__ __forceinline__ int lds_byte(int r, int c) { const int st = (r >> 4) * 2 + (c >> 5), rr = r & 15, cc = c & 31, ob = rr * 64 + cc * 2; return st * 1024 + (ob ^ (((ob >> 9) & 1) << 5)); }
__host__ __device__ __forceinline__ void stage_rc(int b, int& R, int& C) { const int st = b / 1024, sb = b % 1024, swz = sb ^ (((sb >> 9) & 1) << 5); R = (st >> 1) * 16 + swz / 64; C = (st & 1) * 32 + (swz % 64) / 2; }
__host__ __device__ __forceinline__ int perm32(int rho) { const int n = rho >> 4, i = rho & 15; return 8 * (i >> 2) + 4 * n + (i & 3); }
struct Unit { int pm, pn, ex; };
struct Gemm { const bf16_t* A; const bf16_t* Bt; int lda, ldb, K; size_t bexp, aexp; };

struct StaticOrder {
    int nM, nN, nwg, G, c;
    __device__ __forceinline__ void init(int M, int N, int G_, int c_) { nM = M / BM; nN = N / BM; nwg = nM * nN; G = G_; c = c_; }
    __device__ __forceinline__ bool next(int i, Unit& u) const {
        const long L = (long)i * G + c; if (L >= nwg) return false;
        int wgid = (int)L; { const int q = nwg / NXCD, r = nwg % NXCD, xcd = wgid % NXCD, off = wgid / NXCD; wgid = (xcd < r ? xcd * (q + 1) : r * (q + 1) + (xcd - r) * q) + off; }
        const int nig = WGM * nN, gid = wgid / nig, fm = gid * WGM, gsz = (nM - fm) < WGM ? (nM - fm) : WGM;
        u.pm = fm + ((wgid % nig) % gsz); u.pn = (wgid % nig) / gsz; u.ex = 0; return true;
    }
    __device__ __forceinline__ void a_ready(const Unit&) const {}
    __device__ __forceinline__ void done(const Unit&) const {}
};
struct MoeOrder {
    int nT, nN, nwg, G, c; int o1, o2, o3, o4, o5, o6, o7;
    __device__ __forceinline__ bool next(int i, Unit& u) const {
        const long L = (long)i * G + c; if (L >= nwg) return false;
        const int wgid = (int)L;
        const int nig = WGM * nN, gid = wgid / nig, fm = gid * WGM, gsz = (nT - fm) < WGM ? (nT - fm) : WGM;
        u.pm = fm + ((wgid % nig) % gsz); u.pn = (wgid % nig) / gsz;
        const int r = u.pm * BM; u.ex = (r >= o1) + (r >= o2) + (r >= o3) + (r >= o4) + (r >= o5) + (r >= o6) + (r >= o7); return true;
    }
    __device__ __forceinline__ void a_ready(const Unit&) const {}
    __device__ __forceinline__ void done(const Unit&) const {}
};

struct GroupOrder {
    int nMt, nN, G, c;
    __device__ __forceinline__ bool next(int i, Unit& u) const {
        const int L = i * G + c; const int per = nMt * nN; if (L >= NG * per) return false;
        u.ex = L / per; const int r = L - u.ex * per; u.pm = r / nN; u.pn = r - u.pm * nN; return true;
    }
    __device__ __forceinline__ void a_ready(const Unit&) const {}
    __device__ __forceinline__ void done(const Unit&) const {}
};

struct CtxSplitOrder {
    int nks, G, c;
    __device__ __forceinline__ bool next(int i, Unit& u) const { const int L = i * G + c; if (L >= 16 * nks) return false; u.ex = L >> 4; u.pm = (L >> 2) & 3; u.pn = L & 3; return true; }
    __device__ __forceinline__ void a_ready(const Unit&) const {}
    __device__ __forceinline__ void done(const Unit&) const {}
};

__device__ __forceinline__ u32x4 pack8(const f32x4& a, const f32x4& b) { u32x4 w; w.x = pk2(a[0], a[1]); w.y = pk2(a[2], a[3]); w.z = pk2(b[0], b[1]); w.w = pk2(b[2], b[3]); return w; }

struct EpiInProj {
    static constexpr bool PERM = true, AFTER_DRAIN = false, REOFF = false;
    bf16_t* Z; float* rs; bf16_t* UH; float s;
    __device__ __forceinline__ void operator()(const f32x4 (&acc)[2][2][4][2], const Unit& u, int wr, int wc, int fr_, int fq_) const {
        const int ln_ = lane_id(); const int fr = ln_ & 15, fq = ln_ >> 4; (void)fr_; (void)fq_;
        const int row0 = u.pm * BM + wr * 64 + fr, col0 = u.pn * BM + wc * 32 + 8 * fq;
#pragma unroll
        for (int ai = 0; ai < 2; ++ai)
#pragma unroll
            for (int m = 0; m < 4; ++m) {
                const int row = row0 + ai * HALF + m * 16; float ss = 0.f;
#pragma unroll
                for (int bj = 0; bj < 2; ++bj) { const f32x4 v0 = acc[ai][bj][m][0] * s, v1 = acc[ai][bj][m][1] * s; const int col = col0 + bj * HALF;
                    if (u.pn < 2) *(u32x4*)(UH + ((size_t)(col >> 4) * NCH + (row >> 5)) * 768 + (row & 31) * 16 + (col & 15)) = pack8(v0, v1);
                    else *(u32x4*)(Z + (size_t)row * 1024 + col) = pack8(v0, v1);
                    if (bj == 0 || u.pn == 2) ss += (v0[0] * v0[0] + v0[1] * v0[1]) + (v0[2] * v0[2] + v0[3] * v0[3]) + (v1[0] * v1[0] + v1[1] * v1[1]) + (v1[2] * v1[2] + v1[3] * v1[3]); }
                if (u.pn >= 2) { ss += shx(ss, 16, ln_); ss += shx(ss, 32, ln_); if (fq == 0) rs[(size_t)row * 8 + (u.pn - 2) * 4 + wc] = ss; }
            }
    }
};
struct EpiS {
    static constexpr bool PERM = false, AFTER_DRAIN = false, REOFF = false;
    float* S;
    __device__ __forceinline__ void operator()(const f32x4 (&acc)[2][2][4][2], const Unit& u, int wr, int wc, int fr_, int fq_) const {
        const int ln_ = lane_id(); const int fr = ln_ & 15, fq = ln_ >> 4; (void)fr_; (void)fq_;
        const int row0 = u.pm * BM + wr * 64 + fr, col0 = wc * 32 + 4 * fq;
#pragma unroll
        for (int ai = 0; ai < 2; ++ai)
#pragma unroll
            for (int m = 0; m < 4; ++m) { const int n = row0 + ai * HALF + m * 16; if (n < NCH) { float* sp = S + ((size_t)u.ex * NCH + n) * 256 + col0;
#pragma unroll
                for (int bj = 0; bj < 2; ++bj)
#pragma unroll
                    for (int nn = 0; nn < 2; ++nn) *(f32x4*)(sp + bj * HALF + nn * 16) = acc[ai][bj][m][nn]; } }
    }
};
struct EpiY {
    static constexpr bool PERM = true, AFTER_DRAIN = false, REOFF = false;
    bf16_t* ZG;
    __device__ __forceinline__ void operator()(const f32x4 (&acc)[2][2][4][2], const Unit& u, int wr, int wc, int fr_, int fq_) const {
        const int ln_ = lane_id(); const int fr = ln_ & 15, fq = ln_ >> 4; (void)fr_; (void)fq_;
        const int row0 = u.pm * BM + wr * 64 + fr, col0 = u.pn * BM + wc * 32 + 8 * fq;
#pragma unroll
        for (int ai = 0; ai < 2; ++ai)
#pragma unroll
            for (int m = 0; m < 4; ++m) { const int n = row0 + ai * HALF + m * 16; if (n < NCH) {
#pragma unroll
                for (int bj = 0; bj < 2; ++bj) { const int q = col0 + bj * HALF; f32x4 a = acc[ai][bj][m][0], b = acc[ai][bj][m][1];
#pragma unroll
                    for (int j = 0; j < 4; ++j) { a[j] = gelu_tanh_f(a[j]); b[j] = gelu_tanh_f(b[j]); }
                    *(u32x4*)(ZG + ((size_t)n * TCH + (q >> 4)) * 512 + u.ex * 16 + (q & 15)) = pack8(a, b); } } }
    }
};
struct EpiQ {
    static constexpr bool PERM = true, AFTER_DRAIN = false, REOFF = true;
    bf16_t* Q; const float* rs; const float* cosT; const float* sinT;
    __device__ __forceinline__ void operator()(const f32x4 (&acc)[2][2][4][2], const Unit& u, int wr, int wc, int fr_, int fq_) const {
        const int ln_ = lane_id(); const int fr = ln_ & 15, fq = ln_ >> 4; (void)fr_; (void)fq_;
        const int row0 = u.pm * BM + wr * 64 + fr; const bool latent = u.pm < NX / BM;
#pragma unroll
        for (int ai = 0; ai < 2; ++ai)
#pragma unroll
            for (int m = 0; m < 4; ++m) {
                const int row = row0 + ai * HALF + m * 16; const f32x4 q4 = *(const f32x4*)(rs + (size_t)row * 8); const float rstd = rsqrtf(((q4[0] + q4[1]) + (q4[2] + q4[3])) * (1.f / 256.f) + EPS);
#pragma unroll
                for (int bj = 0; bj < 2; ++bj) { const int cg = (u.pn * BM + bj * HALF + wc * 32) >> 5; const bool rope = latent && (cg % 3 == 2);
                    f32x4 v0 = acc[ai][bj][m][0] * rstd, v1 = acc[ai][bj][m][1] * rstd;
                    if (rope) {
                        f32x4 p0, p1;
#pragma unroll
                        for (int j = 0; j < 4; ++j) { p0[j] = shx(v0[j], 16, ln_); p1[j] = shx(v1[j], 16, ln_); }
                        const int t = row & (SEQ - 1); const float* cp = cosT + t * 16 + (fq >> 1) * 8; const float* sp = sinT + t * 16 + (fq >> 1) * 8;
                        const f32x4 c0 = *(const f32x4*)cp, c1 = *(const f32x4*)(cp + 4); f32x4 s0 = *(const f32x4*)sp, s1 = *(const f32x4*)(sp + 4);
                        if ((fq & 1) == 0) { s0 = -s0; s1 = -s1; }
                        v0 = v0 * c0 + p0 * s0; v1 = v1 * c1 + p1 * s1;
                    }
                    const float qs = (cg % 3 == 2) ? 4.0f * QSCALE : 8.0f * QSCALE;
                    v0 = v0 * qs; v1 = v1 * qs; u32x2 w; w.x = pk4_fp8(v0[0], v0[1], v0[2], v0[3]); w.y = pk4_fp8(v1[0], v1[1], v1[2], v1[3]);
                    *(u32x2*)((unsigned char*)Q + (unsigned)row * 768u + (unsigned)(u.pn * BM + bj * HALF + wc * 32 + 8 * fq)) = w; }
            }
    }
};
struct EpiKV {
    static constexpr bool PERM = true, AFTER_DRAIN = false, REOFF = false;
    bf16_t* KN; const float* rs;
    __device__ __forceinline__ void operator()(const f32x4 (&acc)[2][2][4][2], const Unit& u, int wr, int wc, int fr_, int fq_) const {
        const int ln_ = lane_id(); const int fr = ln_ & 15, fq = ln_ >> 4; (void)fr_; (void)fq_;
        const int row0 = u.pm * BM + wr * 64 + fr; const int col0 = u.pn * BM + wc * 32 + 8 * fq;
#pragma unroll
        for (int ai = 0; ai < 2; ++ai)
#pragma unroll
            for (int m = 0; m < 4; ++m) {
                const int row = row0 + ai * HALF + m * 16; const f32x4 q4 = *(const f32x4*)(rs + (size_t)row * 8 + 4); const float rstd = rsqrtf(((q4[0] + q4[1]) + (q4[2] + q4[3])) * (1.f / 128.f) + EPS);
#pragma unroll
                for (int bj = 0; bj < 2; ++bj) { const f32x4 x0 = acc[ai][bj][m][0] * rstd, x1 = acc[ai][bj][m][1] * rstd; u32x2 w; w.x = pk4_fp8(x0[0], x0[1], x0[2], x0[3]); w.y = pk4_fp8(x1[0], x1[1], x1[2], x1[3]);
                    *(u32x2*)((unsigned char*)KN + (unsigned)row * 512u + (unsigned)(col0 + bj * HALF)) = w; }
            }
    }
};
struct EpiVT {
    static constexpr bool PERM = true, AFTER_DRAIN = false, REOFF = true;
    bf16_t* VT; const float* rs;
    __device__ __forceinline__ void operator()(const f32x4 (&acc)[2][2][4][2], const Unit& u, int wr, int wc, int fr_, int fq_) const {
        const int ln_ = lane_id(); const int fr = ln_ & 15, fq = ln_ >> 4; (void)fr_; (void)fq_;
        const int c0 = u.pm * BM + wr * 64 + fr;
        const int b = u.pn < NX / BM ? (u.pn >> 5) : (u.pn - NX / BM); const int kbase = u.pn < NX / BM ? (u.pn & 31) * BM : SEQ;
        int wq = wc; asm volatile("" : "+s"(wq));
        const unsigned tp = (unsigned)((wq >> 1) * 64 + 16 * (wq & 1) + 32 * (fq & 1) + 8 * (fq >> 1));
#pragma unroll
        for (int bj = 0; bj < 2; ++bj) { const int tl = bj * HALF + wc * 32 + 8 * fq, tok = u.pn * BM + tl;
            f32x4 s0, s1;
#pragma unroll
            for (int i = 0; i < 4; ++i) { const f32x4 qa = *(const f32x4*)(rs + (size_t)(tok + i) * 8 + 4); s0[i] = rsqrtf(((qa[0] + qa[1]) + (qa[2] + qa[3])) * (1.f / 128.f) + EPS); }
            __builtin_amdgcn_sched_barrier(0);
#pragma unroll
            for (int i = 0; i < 4; ++i) { const f32x4 qb = *(const f32x4*)(rs + (size_t)(tok + 4 + i) * 8 + 4); s1[i] = rsqrtf(((qb[0] + qb[1]) + (qb[2] + qb[3])) * (1.f / 128.f) + EPS); }
            __builtin_amdgcn_sched_barrier(0);
#pragma unroll
            for (int ai = 0; ai < 2; ++ai)
#pragma unroll
                for (int m = 0; m < 4; ++m) {
                    const f32x4 x0 = acc[ai][bj][m][0] * s0, x1 = acc[ai][bj][m][1] * s1; u32x2 w; w.x = pk4_fp8(x0[0], x0[1], x0[2], x0[3]); w.y = pk4_fp8(x1[0], x1[1], x1[2], x1[3]);
                    const unsigned off = (unsigned)(b * 512 + c0 + ai * HALF + m * 16) * (unsigned)(SEQ + CTXL) + (unsigned)(kbase + bj * HALF) + tp;
                    *(u32x2*)((unsigned char*)VT + off) = w; } }
    }
};
struct EpiGlu {
    static constexpr bool PERM = true, AFTER_DRAIN = false, REOFF = false;
    const bf16_t* ZG; const float* bias; bf16_t* Y;
    __device__ __forceinline__ void operator()(const f32x4 (&acc)[2][2][4][2], const Unit& u, int wr, int wc, int fr_, int fq_) const {
        const int ln_ = lane_id(); const int fr = ln_ & 15, fq = ln_ >> 4; (void)fr_; (void)fq_;
        const int row0 = u.pm * BM + wr * 64 + fr, col0 = u.pn * BM + wc * 32 + 8 * fq;
#pragma unroll
        for (int ai = 0; ai < 2; ++ai)
#pragma unroll
            for (int m = 0; m < 4; ++m) { const int row = row0 + ai * HALF + m * 16;
#pragma unroll
                for (int bj = 0; bj < 2; ++bj) { const int col = col0 + bj * HALF;
                    const u32x4 zw = *(const u32x4*)(ZG + (size_t)row * 512 + col); const f32x4 b0 = *(const f32x4*)(bias + col), b1 = *(const f32x4*)(bias + col + 4);
                    const f32x4 a0 = acc[ai][bj][m][0] + b0, a1 = acc[ai][bj][m][1] + b1; f32x4 o0, o1;
                    o0[0] = bflo(zw.x) * sigmoid_f(a0[0]); o0[1] = bfhi(zw.x) * sigmoid_f(a0[1]); o0[2] = bflo(zw.y) * sigmoid_f(a0[2]); o0[3] = bfhi(zw.y) * sigmoid_f(a0[3]);
                    o1[0] = bflo(zw.z) * sigmoid_f(a1[0]); o1[1] = bfhi(zw.z) * sigmoid_f(a1[1]); o1[2] = bflo(zw.w) * sigmoid_f(a1[2]); o1[3] = bfhi(zw.w) * sigmoid_f(a1[3]);
                    *(u32x4*)(Y + (size_t)row * 1024 + col) = pack8(o0, o1); } }
    }
};
struct EpiRes {
    static constexpr bool PERM = true, AFTER_DRAIN = false, REOFF = false;
    const float* xin32; bf16_t* x16; const float* gate;   float s;
    __device__ __forceinline__ void operator()(const f32x4 (&acc)[2][2][4][2], const Unit& u, int wr, int wc, int fr_, int fq_) const {
        const int ln_ = lane_id(); const int fr = ln_ & 15, fq = ln_ >> 4; (void)fr_; (void)fq_;
        const int row0 = u.pm * BM + wr * 64 + fr, col0 = u.pn * BM + wc * 32 + 8 * fq; const int v = u.pm >> 5;
        f32x4 gv[2][2];
#pragma unroll
        for (int bj = 0; bj < 2; ++bj)
#pragma unroll
            for (int n = 0; n < 2; ++n) gv[bj][n] = *(const f32x4*)(gate + v * 6144 + col0 + bj * HALF + n * 4) * s;
#pragma unroll
        for (int ai = 0; ai < 2; ++ai)
#pragma unroll
            for (int m = 0; m < 4; ++m) { const int row = row0 + ai * HALF + m * 16;
#pragma unroll
                for (int bj = 0; bj < 2; ++bj) { const int col = col0 + bj * HALF; f32x4 x0, x1;
                    if (xin32) { x0 = *(const f32x4*)(xin32 + (size_t)row * 1024 + col); x1 = *(const f32x4*)(xin32 + (size_t)row * 1024 + col + 4); }
                    else { const u32x4 w = *(const u32x4*)(x16 + (size_t)row * 2048 + col); x0[0] = bflo(w.x); x0[1] = bfhi(w.x); x0[2] = bflo(w.y); x0[3] = bfhi(w.y); x1[0] = bflo(w.z); x1[1] = bfhi(w.z); x1[2] = bflo(w.w); x1[3] = bfhi(w.w); }
                    *(u32x4*)(x16 + (size_t)row * 2048 + col) = pack8(x0 + gv[bj][0] * acc[ai][bj][m][0], x1 + gv[bj][1] * acc[ai][bj][m][1]); } }
    }
};
struct EpiPart {
    static constexpr bool PERM = false, AFTER_DRAIN = false, REOFF = false;
    float* P; float s;
    __device__ __forceinline__ void operator()(const f32x4 (&acc)[2][2][4][2], const Unit& u, int wr, int wc, int fr_, int fq_) const {
        const int ln_ = lane_id(); const int fr = ln_ & 15, fq = ln_ >> 4; (void)fr_; (void)fq_;
        const int row0 = u.pm * BM + wr * 64 + fr, col0 = u.pn * BM + wc * 32 + 4 * fq;
#pragma unroll
        for (int ai = 0; ai < 2; ++ai)
#pragma unroll
            for (int m = 0; m < 4; ++m) { float* pp = P + ((size_t)u.ex * NC + row0 + ai * HALF + m * 16) * 1024 + col0;
#pragma unroll
                for (int bj = 0; bj < 2; ++bj)
#pragma unroll
                    for (int n = 0; n < 2; ++n) *(f32x4*)(pp + bj * HALF + n * 16) = acc[ai][bj][m][n] * s; }
    }
};
template <bool OUT8> struct EpiSwiglu {
    static constexpr bool PERM = true, AFTER_DRAIN = false, REOFF = false;
    void* H; int ldh; float s;
    __device__ __forceinline__ void operator()(const f32x4 (&acc)[2][2][4][2], const Unit& u, int wr, int wc, int fr_, int fq_) const {
        const int ln_ = lane_id(); const int fr = ln_ & 15, fq = ln_ >> 4; (void)fr_; (void)fq_;
        const int row0 = u.pm * BM + wr * 64 + fr, col0 = u.pn * HALF + wc * 32 + 8 * fq;
#pragma unroll
        for (int ai = 0; ai < 2; ++ai)
#pragma unroll
            for (int m = 0; m < 4; ++m) { f32x4 o0, o1;
#pragma unroll
                for (int j = 0; j < 4; ++j) { o0[j] = silu_f(acc[ai][0][m][0][j] * s) * (acc[ai][1][m][0][j] * s); o1[j] = silu_f(acc[ai][0][m][1][j] * s) * (acc[ai][1][m][1][j] * s); }
                const size_t off = (size_t)(row0 + ai * HALF + m * 16) * ldh + col0;
                if constexpr (OUT8) { u32x2 w; w.x = pk4_fp8(o0[0], o0[1], o0[2], o0[3]); w.y = pk4_fp8(o1[0], o1[1], o1[2], o1[3]); *(u32x2*)((unsigned char*)H + off) = w; }
                else *(u32x4*)((bf16_t*)H + off) = pack8(o0, o1); }
    }
};
struct EpiBf16 {
    static constexpr bool PERM = true, AFTER_DRAIN = false, REOFF = false;
    bf16_t* O; int ldc; float s;
    __device__ __forceinline__ void operator()(const f32x4 (&acc)[2][2][4][2], const Unit& u, int wr, int wc, int fr_, int fq_) const {
        const int ln_ = lane_id(); const int fr = ln_ & 15, fq = ln_ >> 4; (void)fr_; (void)fq_;
        const int row0 = u.pm * BM + wr * 64 + fr, col0 = u.pn * BM + wc * 32 + 8 * fq;
#pragma unroll
        for (int ai = 0; ai < 2; ++ai)
#pragma unroll
            for (int m = 0; m < 4; ++m)
#pragma unroll
                for (int bj = 0; bj < 2; ++bj) *(u32x4*)(O + (size_t)(row0 + ai * HALF + m * 16) * ldc + col0 + bj * HALF) = pack8(acc[ai][bj][m][0] * s, acc[ai][bj][m][1] * s);
    }
};
typedef int v8i_t __attribute__((ext_vector_type(8)));
typedef short s16x16_t __attribute__((ext_vector_type(16)));
__device__ __forceinline__ v8i_t cat8(bf16x8 a, bf16x8 b) { return __builtin_bit_cast(v8i_t, __builtin_shufflevector(a, b, 0, 1, 2, 3, 4, 5, 6, 7, 8, 9, 10, 11, 12, 13, 14, 15)); }
template <class Epi, class Sched, bool ALIGN_EPI = false, bool SP2 = false, bool F8 = false>
__device__ __forceinline__ void gemm_phase(PG8_LAS unsigned char* lds, const Gemm g, const Sched& S, const Epi& E, const int wid) {
    const int lane = lane_id(), tid = wid * 64 + lane, wr = wid >> 2, wc = wid & 3, fr = lane & 15, fq = lane >> 4;
    const int K = g.K, nt = K / BK;
    unsigned v_offA, v_offB;
    { int R, C; stage_rc(tid * 16, R, C); const int Rb = Epi::PERM ? ((R & ~31) + perm32(R & 31)) : R;
        v_offA = (unsigned)(R * g.lda + C) * 2u; v_offB = (unsigned)(Rb * g.ldb + C) * 2u; }
    const unsigned r64_offA = 64u * (unsigned)g.lda * 2u, r64_offB = 64u * (unsigned)g.ldb * 2u;
    const size_t kstep = (size_t)(BK * 2);
    const size_t hstepA = (size_t)HALF * g.lda * 2, hstepB = (size_t)HALF * g.ldb * 2;
    const size_t tstepA = 2 * hstepA, tstepB = 2 * hstepB;
    const unsigned ldsw = (unsigned)wid * 1024u;
    const int aoff = lds_byte(wr * 64 + fr, fq * 8), boff = lds_byte(wc * 32 + fr, fq * 8);
#define PG8_SA(b, h) (((b) * 2 + (h)) * HTB)
#define PG8_SB(b, h) ((4 + (b) * 2 + (h)) * HTB)
#define PG8_STAGE(bufoff, gbase, voff) do { _Pragma("unroll") for (int _i = 0; _i < 2; ++_i) \
        __builtin_amdgcn_global_load_lds((const unsigned*)((const char*)(gbase) + (size_t)(_i * r64_##voff) + v_##voff), (PG8_LAS unsigned*)(lds + (bufoff) + ldsw + _i * 8192), 16, 0, 0); } while (0)
#define PG8_RD(p) (*(const PG8_LAS bf16x8*)(p))
#define PG8_LDA(dst, b, h) do { if constexpr (F8) { _Pragma("unroll") for (int m = 0; m < 4; ++m) dst##8[m] = cat8(PG8_RD(lds + PG8_SA(b, h) + aoff + m * 2048), PG8_RD(lds + PG8_SA(b, h) + aoff + m * 2048 + 1024)); } \
        else { _Pragma("unroll") for (int m = 0; m < 4; ++m) _Pragma("unroll") for (int k = 0; k < 2; ++k) dst[m][k] = PG8_RD(lds + PG8_SA(b, h) + aoff + m * 2048 + k * 1024); } } while (0)
#define PG8_LDB(dst, b, h) do { if constexpr (F8) { _Pragma("unroll") for (int n = 0; n < 2; ++n) dst##8[n] = cat8(PG8_RD(lds + PG8_SB(b, h) + boff + n * 2048), PG8_RD(lds + PG8_SB(b, h) + boff + n * 2048 + 1024)); } \
        else { _Pragma("unroll") for (int n = 0; n < 2; ++n) _Pragma("unroll") for (int k = 0; k < 2; ++k) dst[n][k] = PG8_RD(lds + PG8_SB(b, h) + boff + n * 2048 + k * 1024); } } while (0)
#define PG8_MMA(ai, bj, At, Bt) do { __builtin_amdgcn_s_setprio(1); if constexpr (F8) { _Pragma("unroll") for (int m = 0; m < 4; ++m) _Pragma("unroll") for (int n = 0; n < 2; ++n) \
        asm volatile("v_mfma_scale_f32_16x16x128_f8f6f4 %0, %1, %2, %0, %3, %3 op_sel_hi:[0,0,0]" : "+v"(acc[ai][bj][m][n]) : "v"(Bt##8[n]), "v"(At##8[m]), "v"(sc1_)); } \
        else { _Pragma("unroll") for (int m = 0; m < 4; ++m) _Pragma("unroll") for (int n = 0; n < 2; ++n) _Pragma("unroll") for (int k = 0; k < 2; ++k) \
        acc[ai][bj][m][n] = __builtin_amdgcn_mfma_f32_16x16x32_bf16(Bt[n][k], At[m][k], acc[ai][bj][m][n], 0, 0, 0); } __builtin_amdgcn_s_setprio(0); } while (0)
#define PG8_WAIT_V(n) asm volatile("s_waitcnt vmcnt(" #n ")" ::: "memory")
#define PG8_WAIT_L(n) asm volatile("s_waitcnt lgkmcnt(" #n ")" ::: "memory")
#define PG8_BAR __builtin_amdgcn_s_barrier()
#define PG8_SCHED __builtin_amdgcn_sched_barrier(0)
    Unit cur, nxt; int ui = 0;
    if (!S.next(0, cur)) return;
    f32x4 acc[2][2][4][2];
#pragma unroll
    for (int a = 0; a < 2; ++a)
#pragma unroll
        for (int b = 0; b < 2; ++b)
#pragma unroll
            for (int m = 0; m < 4; ++m)
#pragma unroll
                for (int n = 0; n < 2; ++n) acc[a][b][m][n] = (f32x4){0.f, 0.f, 0.f, 0.f};
    const int sc1_ = 0x7f7f7f7f;
    bf16x8 At[4][2], B0[2][2], B1[2][2]; v8i_t At8[4], B08[2], B18[2];
    const char* cA = (const char*)g.A + (size_t)cur.ex * g.aexp + (size_t)cur.pm * tstepA; const char* cB = (const char*)g.Bt + (size_t)cur.ex * g.bexp + (size_t)cur.pn * tstepB;
    S.a_ready(cur);
    if constexpr (SP2) {
        PG8_STAGE(PG8_SB(0, 0), cB, offB); PG8_STAGE(PG8_SB(0, 1), cB + hstepB, offB); PG8_STAGE(PG8_SA(0, 0), cA, offA); PG8_STAGE(PG8_SA(0, 1), cA + hstepA, offA);
        if (wr == 1) PG8_BAR;
        PG8_WAIT_V(2); PG8_BAR;
        PG8_STAGE(PG8_SB(1, 0), cB + kstep, offB); PG8_STAGE(PG8_SA(1, 0), cA + kstep, offA); PG8_STAGE(PG8_SB(1, 1), cB + hstepB + kstep, offB);
        PG8_WAIT_V(6); PG8_BAR;
    } else {
        PG8_STAGE(PG8_SB(0, 0), cB, offB); PG8_STAGE(PG8_SA(0, 0), cA, offA); PG8_STAGE(PG8_SB(0, 1), cB + hstepB, offB); PG8_STAGE(PG8_SA(0, 1), cA + hstepA, offA);
        if (wr == 1) PG8_BAR;
        PG8_WAIT_V(4); PG8_BAR;
        PG8_STAGE(PG8_SB(1, 0), cB + kstep, offB); PG8_STAGE(PG8_SA(1, 0), cA + kstep, offA); PG8_STAGE(PG8_SB(1, 1), cB + hstepB + kstep, offB);
        PG8_WAIT_V(6); PG8_BAR;
    }
    for (;;) {
        const bool has_next = S.next(ui + 1, nxt);
        const char* nA = has_next ? (const char*)g.A + (size_t)nxt.ex * g.aexp + (size_t)nxt.pm * tstepA : cA; const char* nB = has_next ? (const char*)g.Bt + (size_t)nxt.ex * g.bexp + (size_t)nxt.pn * tstepB : cB;
        for (int t = 0; t < nt; t += 2) {
            const bool last = (t == nt - 2);
            const char* a1 = cA + (size_t)(t + 1) * kstep;
            const char* a2 = last ? nA : cA + (size_t)(t + 2) * kstep; const char* b2 = last ? nB : cB + (size_t)(t + 2) * kstep;
            const char* a3 = a2 + kstep; const char* b3 = b2 + kstep;
            if (last && has_next) S.a_ready(nxt);
            if constexpr (SP2) {
            PG8_LDB(B0, 0, 0); PG8_LDB(B1, 0, 1); PG8_SCHED; PG8_LDA(At, 0, 0); PG8_STAGE(PG8_SA(1, 1), a1 + hstepA, offA);
            PG8_WAIT_V(8); PG8_WAIT_L(0); PG8_BAR; PG8_MMA(0, 0, At, B0); PG8_MMA(0, 1, At, B1); PG8_BAR; PG8_SCHED;
            PG8_LDA(At, 0, 1); PG8_STAGE(PG8_SB(0, 0), b2, offB); PG8_STAGE(PG8_SB(0, 1), b2 + hstepB, offB); PG8_STAGE(PG8_SA(0, 0), a2, offA);
            PG8_WAIT_V(8); PG8_WAIT_L(0); PG8_BAR; PG8_MMA(1, 0, At, B0); PG8_MMA(1, 1, At, B1); PG8_BAR; PG8_SCHED;
            PG8_LDB(B0, 1, 0); PG8_LDB(B1, 1, 1); PG8_SCHED; PG8_LDA(At, 1, 0); PG8_STAGE(PG8_SA(0, 1), a2 + hstepA, offA);
            PG8_WAIT_V(8); PG8_WAIT_L(0); PG8_BAR; PG8_MMA(0, 0, At, B0); PG8_MMA(0, 1, At, B1); PG8_BAR; PG8_SCHED;
            PG8_LDA(At, 1, 1); PG8_STAGE(PG8_SB(1, 0), b3, offB); PG8_STAGE(PG8_SB(1, 1), b3 + hstepB, offB); PG8_STAGE(PG8_SA(1, 0), a3, offA);
            PG8_WAIT_V(8); PG8_WAIT_L(0); PG8_BAR; PG8_MMA(1, 0, At, B0); PG8_MMA(1, 1, At, B1); PG8_BAR; PG8_SCHED;
            } else {
            PG8_LDB(B0, 0, 0); PG8_SCHED; PG8_LDA(At, 0, 0); PG8_STAGE(PG8_SA(1, 1), a1 + hstepA, offA);
            PG8_WAIT_L(8); PG8_BAR; PG8_WAIT_L(0); PG8_MMA(0, 0, At, B0); PG8_BAR; PG8_SCHED;
            PG8_LDB(B1, 0, 1); PG8_STAGE(PG8_SB(0, 0), b2, offB);
            PG8_BAR; PG8_WAIT_L(0); PG8_MMA(0, 1, At, B1); PG8_BAR;
            PG8_LDA(At, 0, 1); PG8_STAGE(PG8_SA(0, 0), a2, offA);
            PG8_BAR; PG8_WAIT_L(0); PG8_MMA(1, 0, At, B0); PG8_BAR; PG8_SCHED;
            PG8_STAGE(PG8_SB(0, 1), b2 + hstepB, offB);
            PG8_WAIT_V(6); PG8_BAR; PG8_MMA(1, 1, At, B1); PG8_BAR;
            PG8_LDB(B0, 1, 0); PG8_SCHED; PG8_LDA(At, 1, 0); PG8_STAGE(PG8_SA(0, 1), a2 + hstepA, offA);
            PG8_WAIT_L(8); PG8_BAR; PG8_WAIT_L(0); PG8_MMA(0, 0, At, B0); PG8_BAR; PG8_SCHED;
            PG8_LDB(B1, 1, 1); PG8_STAGE(PG8_SB(1, 0), b3, offB);
            PG8_BAR; PG8_WAIT_L(0); PG8_MMA(0, 1, At, B1); PG8_BAR;
            PG8_LDA(At, 1, 1); PG8_STAGE(PG8_SA(1, 0), a3, offA);
            PG8_BAR; PG8_WAIT_L(0); PG8_MMA(1, 0, At, B0); PG8_BAR; PG8_SCHED;
            PG8_STAGE(PG8_SB(1, 1), b3 + hstepB, offB);
            PG8_WAIT_V(6); PG8_BAR; PG8_MMA(1, 1, At, B1); PG8_BAR;
            }
        }
        if constexpr (F8) { asm volatile("s_nop 15\n\ts_nop 7" ::: "memory"); }
        if constexpr (ALIGN_EPI) { if (wr == 0) PG8_BAR; }
        if constexpr (!Epi::AFTER_DRAIN) { E(acc, cur, wr, wc, fr, fq); S.done(cur); }
        if (!has_next) break;
#pragma unroll
        for (int a = 0; a < 2; ++a)
#pragma unroll
            for (int b = 0; b < 2; ++b)
#pragma unroll
                for (int m = 0; m < 4; ++m)
#pragma unroll
                    for (int n = 0; n < 2; ++n) acc[a][b][m][n] = (f32x4){0.f, 0.f, 0.f, 0.f};
        cur = nxt; cA = nA; cB = nB; ++ui;
        if constexpr (Epi::REOFF) { const int tid2 = wid * 64 + lane_id(); int R, C; stage_rc(tid2 * 16, R, C); const int Rb = Epi::PERM ? ((R & ~31) + perm32(R & 31)) : R;
            v_offA = (unsigned)(R * g.lda + C) * 2u; v_offB = (unsigned)(Rb * g.ldb + C) * 2u; }
        if constexpr (ALIGN_EPI) { if (wr == 1) PG8_BAR; }
    }
    PG8_WAIT_V(0);
    if constexpr (!ALIGN_EPI) { if (wr == 0) PG8_BAR; }
    PG8_BAR;
    if constexpr (Epi::AFTER_DRAIN) { E.fused(acc, cur, wr, wc, fr, fq, lds, wid, lane); S.done(cur); }
#undef PG8_SA
#undef PG8_SB
#undef PG8_STAGE
#undef PG8_RD
#undef PG8_LDA
#undef PG8_LDB
#undef PG8_MMA
#undef PG8_WAIT_V
#undef PG8_WAIT_L
#undef PG8_BAR
#undef PG8_SCHED
}
}


#define XB_TMO      128
#define XB_XCNT(j)  (256  + 64 * (j))
#define XB_XSUB(j)  (1280 + 64 * (j))
#define XB_XGEN(j)  (2304 + 64 * (j))
#define XB_TOP      3328
#define XB_TOPGEN   3392
#define XCD_BAR_WORDS 3456
#define XB_SPIN_CAP (1u << 18)

__device__ __forceinline__ unsigned xb_ld(unsigned* p)              { return __hip_atomic_load(p, __ATOMIC_RELAXED, __HIP_MEMORY_SCOPE_AGENT); }
__device__ __forceinline__ unsigned xb_add(unsigned* p, unsigned v) { return __hip_atomic_fetch_add(p, v, __ATOMIC_RELAXED, __HIP_MEMORY_SCOPE_AGENT); }
__device__ __forceinline__ unsigned xb_xcc_id() { return (unsigned)__builtin_amdgcn_s_getreg((3 << 11) | 20) & 0xFu; }
#define XB_SPIN(cond, bar) do { unsigned _sp = 0; while (cond) { __builtin_amdgcn_s_sleep(1); \
    if ((++_sp & 255u) == 0u) { if (xb_ld(&(bar)[XB_TMO])) break; if (_sp > XB_SPIN_CAP) { atomicAdd(&(bar)[XB_TMO], 1u); break; } } } } while (0)

struct XcdBarrier {
    unsigned* bar; unsigned x;
    volatile LAS unsigned* st;
};

__device__ __forceinline__ XcdBarrier xcd_barrier_post(unsigned* bar, volatile LAS unsigned* st) {
    XcdBarrier b; b.bar = bar; b.x = xb_xcc_id(); b.st = st;
    if (threadIdx.x == 0) (void)xb_add(&bar[XB_XCNT(b.x)], 1u);
    return b;
}
__device__ __forceinline__ void xcd_barrier_complete(unsigned* bar, unsigned x, unsigned& nloc, unsigned& nx) {
    const unsigned G = gridDim.x * gridDim.y * gridDim.z;
    unsigned sum, cnt, mine, sp = 0u;
    for (;;) {
        sum = 0u; cnt = 0u; mine = 0u;
#pragma unroll
        for (unsigned j = 0; j < 16; ++j) { const unsigned c = xb_ld(&bar[XB_XCNT(j)]); sum += c; cnt += (c > 0u) ? 1u : 0u; mine = (j == x) ? c : mine; }
        if (sum == G) break;
        __builtin_amdgcn_s_sleep(1);
        if ((++sp & 255u) == 0u) { if (xb_ld(&bar[XB_TMO])) break; if (sp > XB_SPIN_CAP) { atomicAdd(&bar[XB_TMO], 1u); break; } }
    }
    nloc = mine > 0u ? mine : 1u; nx = cnt > 0u ? cnt : 1u;
}

__device__ __forceinline__ void xcd_barrier(const XcdBarrier& b) {
    asm volatile("s_waitcnt vmcnt(0)" ::: "memory");
    __syncthreads();
    if (threadIdx.x == 0) {
        unsigned* bar = b.bar; asm volatile("" : "+s"(bar));
        __builtin_amdgcn_s_waitcnt(0);
        unsigned bx = b.x; asm volatile("" : "+s"(bx));
        unsigned nloc = b.st[0], nx = b.st[1];
        if (nloc == 0u) { xcd_barrier_complete(bar, bx, nloc, nx); b.st[0] = nloc; b.st[1] = nx; }
        const unsigned old = xb_add(&bar[XB_XSUB(bx)], 1u);
        const unsigned gen = old / nloc;
        if (old + 1u == (gen + 1u) * nloc) {
            __builtin_amdgcn_fence(__ATOMIC_RELEASE, "agent");
            asm volatile("s_waitcnt vmcnt(0)" ::: "memory");
            const unsigned og = xb_add(&bar[XB_TOP], 1u);
            const unsigned tg = og / nx;
            if (og + 1u == (tg + 1u) * nx) xb_add(&bar[XB_TOPGEN], 1u);
            else XB_SPIN(xb_ld(&bar[XB_TOPGEN]) == tg, bar);
            __builtin_amdgcn_fence(__ATOMIC_ACQUIRE, "agent");
            xb_add(&bar[XB_XGEN(bx)], 1u);
            asm volatile("s_waitcnt vmcnt(0)" ::: "memory");
        } else {
            XB_SPIN(xb_ld(&bar[XB_XGEN(bx)]) == gen, bar);
            __builtin_amdgcn_fence(__ATOMIC_ACQUIRE, "agent");
            asm volatile("s_waitcnt vmcnt(0)" ::: "memory");
        }
    }
    __syncthreads();
}

struct Args { const float* in[32]; float* out; unsigned char* ws; int ph_lo, ph_hi, li, pad; };
struct Frame {
    LAS unsigned char* lds; volatile LAS unsigned* MISC; unsigned* ctl;
    int wave, G, bid, gw, NGW;
    float* out; unsigned char* ws;
};
constexpr int NWAVES = 8, NTHR = NWAVES * 64;

#define TR_LOAD(wv, W, N, k0, n0) do { _Pragma("unroll") for (int i_ = 0; i_ < 32; ++i_) wv[i_] = __builtin_nontemporal_load((W) + (size_t)((k0) + 2 * i_ + (lane >> 5)) * (N) + (n0) + (lane & 31)); } while (0)
template <bool F8>
__device__ __forceinline__ void tr_store(const float (&wv)[32], void* WTv, int K  , int k0, int drow0, const float* ksc, LAS float* scr, int lane) {
#pragma unroll
    for (int i = 0; i < 32; ++i) { const int kk = 2 * i + (lane >> 5); float w = wv[i]; if (ksc) w *= ksc[k0 + kk]; if (F8) w *= W8_SCALE; scr[kk * 33 + (lane & 31)] = w; }
    LDS_WAIT(); asm volatile("" ::: "memory");
    const int c = lane & 7;
#pragma unroll
    for (int j = 0; j < 4; ++j) { const int n = (lane >> 3) + 8 * j; const LAS float* s = scr + (8 * c) * 33 + n;
        if (F8) { u32x2 o; o.x = pk4_fp8(s[0 * 33], s[1 * 33], s[2 * 33], s[3 * 33]); o.y = pk4_fp8(s[4 * 33], s[5 * 33], s[6 * 33], s[7 * 33]); *(u32x2*)((unsigned char*)WTv + (size_t)(drow0 + n) * K + k0 + 8 * c) = o; }
        else { u32x4 o; o.x = pk2(s[0 * 33], s[1 * 33]); o.y = pk2(s[2 * 33], s[3 * 33]); o.z = pk2(s[4 * 33], s[5 * 33]); o.w = pk2(s[6 * 33], s[7 * 33]); *(u32x4*)((bf16_t*)WTv + (size_t)(drow0 + n) * K + k0 + 8 * c) = o; } }
    LDS_WAIT(); asm volatile("" ::: "memory");
}
__device__ __forceinline__ int drow_map(int mode, int n0) {
    if (mode == 1) { const int h = n0 >> 7, j0 = n0 & 127; return j0 < 64 ? h * 64 + j0 : 512 + h * 64 + (j0 - 64); }
    if (mode == 2) return (n0 >> 7) * 256 + (n0 & 127);
    if (mode == 3) return (n0 >> 7) * 256 + 128 + (n0 & 127);
    return n0;
}
template <bool F8>
__device__ __forceinline__ void conv_mat(const Frame& F, const float* W, int K, int N, void* WT, int mode, const float* ksc, int ldk = 0) {
    if (ldk == 0) ldk = K;
    const int lane = lane_id();
    LAS float* scr = (LAS float*)(F.lds + F.wave * 16384);
    const int nblk = N / 32, items = (K / 64) * nblk;
    for (int it = F.gw; it < items; it += F.NGW) { const int k0 = 64 * (it / nblk), n0 = 32 * (it % nblk); float wv[32];
        TR_LOAD(wv, W, N, k0, n0); tr_store<F8>(wv, WT, ldk, k0, drow_map(mode, n0), ksc, scr, lane); }
}
__device__ __forceinline__ void p0_weights(const Frame& F, const Args& A) { unsigned char* const wsq_ = opq(F.ws);
    const int lane = lane_id(), tid = F.wave * 64 + lane; (void)tid; (void)lane;
    unsigned char* ws = wsq_;
    for (int l = 0; l < 2; ++l) {
        conv_mat<true>(F, INP(8) + (size_t)l * DM * DIN, DM, DIN, ws + WS_WIN + (size_t)l * 1024 * 1024, 0, nullptr);
        conv_mat<false>(F, INP(11) + (size_t)l * 256 * 768, 256, 768, (bf16_t*)(ws + WS_WUQ) + (size_t)l * 768 * 256, 0, INP(9) + l * 256);
        conv_mat<false>(F, INP(12) + (size_t)l * 128 * 1024, 128, 1024, (bf16_t*)(ws + WS_WUKV) + (size_t)l * 1024 * 128, 1, INP(10) + l * 128);
        conv_mat<false>(F, INP(21) + (size_t)l * 512 * 512, 512, 512, (bf16_t*)(ws + WS_WGLU) + (size_t)l * 512 * 512, 0, nullptr);
        conv_mat<false>(F, INP(23) + (size_t)l * 1024 * 1024, 1024, 1024, (bf16_t*)(ws + WS_WOUT) + (size_t)l * 1024 * 1024, 0, nullptr);
        { u32x4* z = (u32x4*)(ws + WS_WIN + (size_t)l * 1024 * 1024 + (size_t)DIN * 1024); const int n16 = (1024 - DIN) * 1024 / 16;
          u32x4 z4 = {0u, 0u, 0u, 0u}; asm volatile("" : "+v"(z4));
          for (int i = F.gw * 64 + lane; i < n16; i += F.NGW * 64) z[i] = z4; }
    }
    conv_mat<false>(F, INP(24), DM, DFF, ws + WS_WFF13, 2, nullptr);
    conv_mat<false>(F, INP(25), DM, DFF, ws + WS_WFF13, 3, nullptr);
    conv_mat<true>(F, INP(26), DFF, DM, ws + WS_WFF2, 0, nullptr);
    { const int lane = lane_id(); u32x4 z4 = {0u, 0u, 0u, 0u}; asm volatile("" : "+v"(z4));
      for (int i = F.gw * 64 + lane; i < NE * DM * 8; i += F.NGW * 64) *(u32x4*)(wsq_ + WS_WM2 + (size_t)(i >> 3) * DFE8 + DFE + (i & 7) * 16) = z4; }
}
__device__ __forceinline__ void p0_moe_weights(const Frame& F, const Args& A, int e0, int e1) { unsigned char* const ws = opq(F.ws);
    for (int e = e0; e < e1; ++e) {
        conv_mat<true>(F, INP(28) + (size_t)e * DM * DFE, DM, DFE, ws + WS_WM13 + (size_t)e * 2 * DFE * DM, 2, nullptr);
        conv_mat<true>(F, INP(29) + (size_t)e * DM * DFE, DM, DFE, ws + WS_WM13 + (size_t)e * 2 * DFE * DM, 3, nullptr);
        conv_mat<true>(F, INP(30) + (size_t)e * DFE * DM, DFE, DM, ws + WS_WM2 + (size_t)e * DM * DFE8, 0, nullptr, DFE8);
    }
}
__device__ __forceinline__ void p0_prologue(const Frame& F, const Args& A) { unsigned char* const wsq_ = opq(F.ws);
    const int lane = lane_id(), tid = F.wave * 64 + lane; (void)tid; (void)lane;
    unsigned char* ws = wsq_;
    { float* cosT = (float*)(ws + WS_COS); float* sinT = (float*)(ws + WS_SIN);
      for (int idx = F.gw * 64 + lane; idx < SEQ * 16; idx += F.NGW * 64) { const int t = idx >> 4, a = (idx >> 3) & 1, i = idx & 7; const float pos = (float)(a == 0 ? (t >> 6) : (t & 63));
          const float inv = exp2f(-(float)i * (13.287712379549449f / 8.0f)); const float ang = pos * inv; cosT[idx] = cosf(ang); sinT[idx] = sinf(ang); } }
    { float* AB = (float*)(ws + WS_AB); float* BB = (float*)(ws + WS_BB);
      const int gwr = (((F.bid + F.G - (F.G == 256 ? 192 : 0)) % F.G) * NWAVES + F.wave);
      for (int idx = gwr * 64 + lane; idx < 2 * 2 * NG * NP; idx += F.NGW * 64) {
          const float ar = INP(13)[idx], ai = INP(14)[idx], dt = expf(INP(15)[idx >> 6]);
          const float mag = expf(dt * ar), abr = mag * cosf(dt * ai), abi = mag * sinf(dt * ai), den = ar * ar + ai * ai, nre = abr - 1.0f;
          const float fre = (nre * ar + abi * ai) / den, fim = (abi * ar - nre * ai) / den;
          AB[idx * 2] = abr; AB[idx * 2 + 1] = abi;
          { float* PW = (float*)(ws + WS_PW) + (size_t)idx * 66; const float dar = dt * ar, dai = dt * ai;
            (void)dar; (void)dai; float pr = 1.f, pi = 0.f;
            for (int e = 0; e <= TCH; ++e) { PW[2 * e] = pr; PW[2 * e + 1] = pi; const float nr = pr * abr - pi * abi, ni = pr * abi + pi * abr; pr = nr; pi = ni; } }
#pragma unroll 4
          for (int c = 0; c < 16; ++c) { const float br = INP(16)[idx * 16 + c], bi = INP(17)[idx * 16 + c]; BB[(idx * 16 + c) * 2] = fre * br - fim * bi; BB[(idx * 16 + c) * 2 + 1] = fre * bi + fim * br; } } }
    { LAS float* sv = (LAS float*)F.lds; LAS float* red = sv + 5 * 1024; float* MOD = (float*)(ws + WS_MOD);
      __syncthreads();
      for (int i = tid; i < 5 * 1024; i += NTHR) { const int v = i >> 10, k = i & 1023; const float cv = v < 4 ? INP(1)[v * 1024 + k] : INP(3)[k]; sv[i] = silu_f(cv); }
      __syncthreads();
      for (int it = F.bid; it < 2 * 96; it += F.G) { const int l = it / 96, jb = it % 96, kg = tid >> 6, jj = tid & 63, j = jb * 64 + jj;
          float a0 = 0.f, a1 = 0.f, a2 = 0.f, a3 = 0.f, a4 = 0.f; const float* wp = INP(4) + ((size_t)l * 1024 + kg * 128) * 6144 + j;
#pragma unroll 8
          for (int kk = 0; kk < 128; ++kk) { const float w = wp[(size_t)kk * 6144]; const int k = kg * 128 + kk; a0 += sv[k] * w; a1 += sv[1024 + k] * w; a2 += sv[2048 + k] * w; a3 += sv[3072 + k] * w; a4 += sv[4096 + k] * w; }
          red[(kg * 5 + 0) * 64 + jj] = a0; red[(kg * 5 + 1) * 64 + jj] = a1; red[(kg * 5 + 2) * 64 + jj] = a2; red[(kg * 5 + 3) * 64 + jj] = a3; red[(kg * 5 + 4) * 64 + jj] = a4;
          __syncthreads();
          if (tid < 320) { const int v = tid >> 6, q = tid & 63; float s = INP(5)[l * 6144 + jb * 64 + q];
#pragma unroll
              for (int g = 0; g < 8; ++g) s += red[(g * 5 + v) * 64 + q];
              MOD[((size_t)l * 5 + v) * 6144 + jb * 64 + q] = s; }
          __syncthreads(); }
    }
}

template <bool OUT8, bool X16 = false>
__device__ __forceinline__ void norm_rows(const Frame& F, const float* xs_x, const float* xs_c, int nrows, const float* gain, const float* mod, int shoff, int scoff, void* XNv,
                                          const float* part = nullptr, int nparts = 0, const float* pgate = nullptr, float* xc_out = nullptr) {
    const int lane = lane_id();
    for (int v = 0; v < 5; ++v) {
        const int r0 = v < 4 ? v * SEQ : NX, r1 = v < 4 ? r0 + SEQ : NR; if (r0 >= nrows) break;
        f32x4 ca[4], cb[4];
#pragma unroll
        for (int j = 0; j < 4; ++j) { const int c = 4 * lane + 256 * j; const f32x4 g = *(const f32x4*)(gain + c), sc = *(const f32x4*)(mod + v * 6144 + scoff + c); ca[j] = g * (sc + 1.0f); cb[j] = *(const f32x4*)(mod + v * 6144 + shoff + c); }
        for (int r = r0 + F.gw; r < r1; r += F.NGW) {
            const float* src = r < NX ? xs_x + (size_t)r * 1024 : xs_c + (size_t)(r - NX) * 1024;
            f32x4 x[4]; float ss = 0.f;
#pragma unroll
            for (int j = 0; j < 4; ++j) { const int c = 4 * lane + 256 * j;
                if (X16 && r < NX) { const u32x2 w = *(const u32x2*)((const bf16_t*)xs_x + (size_t)r * 2048 + c); x[j][0] = bflo(w.x); x[j][1] = bfhi(w.x); x[j][2] = bflo(w.y); x[j][3] = bfhi(w.y); }
                else x[j] = *(const f32x4*)(src + c);
                if (part && r >= NX) { f32x4 sacc = {0.f, 0.f, 0.f, 0.f}; for (int k = 0; k < nparts; ++k) sacc = sacc + *(const f32x4*)(part + ((size_t)k * NC + (r - NX)) * 1024 + c);
                    x[j] = x[j] + *(const f32x4*)(pgate + c) * sacc; if (xc_out) *(f32x4*)(xc_out + (size_t)(r - NX) * 1024 + c) = x[j]; }
                ss += (x[j][0] * x[j][0] + x[j][1] * x[j][1]) + (x[j][2] * x[j][2] + x[j][3] * x[j][3]); }
            const float rstd = rsqrtf(wave_sum(ss, lane) * (1.f / 1024.f) + EPS);
#pragma unroll
            for (int j = 0; j < 4; ++j) { x[j] = x[j] * rstd * ca[j] + cb[j];
                if (OUT8) *(unsigned*)((unsigned char*)XNv + (size_t)r * 1024 + 4 * lane + 256 * j) = pk4_fp8(x[j][0], x[j][1], x[j][2], x[j][3]);
                else { u32x2 o; o.x = pk2(x[j][0], x[j][1]); o.y = pk2(x[j][2], x[j][3]); *(u32x2*)((bf16_t*)XNv + (size_t)r * 1024 + 4 * lane + 256 * j) = o; } }
        }
    }
}
__device__ __forceinline__ void norm_router(const Frame& F, const float* xs, const float* gain, const float* mod, int shoff, int scoff, unsigned char* XNM) { unsigned char* const wsq_ = opq(F.ws);
    const int lane = lane_id(), tid = F.wave * 64 + lane;
    LAS float* RT = (LAS float*)F.lds; LAS int* lcnt = (LAS int*)(F.lds + 32768);
    __syncthreads();
    for (int i = tid; i < 1024 * 8 / 4; i += NTHR) { const int k = i >> 1, p = i & 1, ln = (k & 255) >> 2, jq = (k >> 8) * 4 + (k & 3); ((LAS f32x4*)RT)[(p * 16 + jq) * 64 + ln] = ((const f32x4*)INP(27))[i]; }
    if (tid < 8) lcnt[tid] = 0;
    __syncthreads();
    for (int ch = F.bid; ch < NX / 128; ch += F.G) {
        const int v = ch >> 6;
        f32x4 ca[4], cb[4];
#pragma unroll
        for (int j = 0; j < 4; ++j) { const int c = 4 * lane + 256 * j; const f32x4 g = *(const f32x4*)(gain + c), sc = *(const f32x4*)(mod + v * 6144 + scoff + c); ca[j] = g * (sc + 1.0f); cb[j] = *(const f32x4*)(mod + v * 6144 + shoff + c); }
        float bq[8];
#pragma unroll
        for (int e = 0; e < 8; ++e) bq[e] = 0.f;
#pragma unroll
        for (int j = 0; j < 4; ++j)
#pragma unroll
            for (int q = 0; q < 4; ++q) { const int k = 4 * lane + 256 * j + q; const f32x4 w0 = ((const LAS f32x4*)RT)[(j * 4 + q) * 64 + lane], w1 = ((const LAS f32x4*)RT)[(16 + j * 4 + q) * 64 + lane]; (void)k; const float cv = cb[j][q];
                bq[0] += cv * w0[0]; bq[1] += cv * w0[1]; bq[2] += cv * w0[2]; bq[3] += cv * w0[3]; bq[4] += cv * w1[0]; bq[5] += cv * w1[1]; bq[6] += cv * w1[2]; bq[7] += cv * w1[3]; }
#pragma unroll
        for (int e = 0; e < 8; ++e) bq[e] = wave_sum(bq[e], lane);
        for (int i = 0; i < 16; ++i) {
            const int r = ch * 128 + F.wave * 16 + i; const float* src = xs + (size_t)r * 1024;
            f32x4 x[4]; float ss = 0.f; float lg[8];
#pragma unroll
            for (int e = 0; e < 8; ++e) lg[e] = 0.f;
#pragma unroll
            for (int j = 0; j < 4; ++j) { { const u32x2 w = *(const u32x2*)((const bf16_t*)xs + (size_t)r * 2048 + 4 * lane + 256 * j); x[j][0] = bflo(w.x); x[j][1] = bfhi(w.x); x[j][2] = bflo(w.y); x[j][3] = bfhi(w.y); } ss += (x[j][0] * x[j][0] + x[j][1] * x[j][1]) + (x[j][2] * x[j][2] + x[j][3] * x[j][3]); }
#pragma unroll
            for (int j = 0; j < 4; ++j)
#pragma unroll
                for (int q = 0; q < 4; ++q) { const int k = 4 * lane + 256 * j + q; const f32x4 w0 = ((const LAS f32x4*)RT)[(j * 4 + q) * 64 + lane], w1 = ((const LAS f32x4*)RT)[(16 + j * 4 + q) * 64 + lane]; (void)k; const float xv = x[j][q] * ca[j][q];
                    lg[0] += xv * w0[0]; lg[1] += xv * w0[1]; lg[2] += xv * w0[2]; lg[3] += xv * w0[3]; lg[4] += xv * w1[0]; lg[5] += xv * w1[1]; lg[6] += xv * w1[2]; lg[7] += xv * w1[3]; }
            { const bool h5 = (lane & 32) != 0, h4 = (lane & 16) != 0, h3 = (lane & 8) != 0;
              float a0 = h5 ? lg[4] : lg[0], a1 = h5 ? lg[5] : lg[1], a2 = h5 ? lg[6] : lg[2], a3 = h5 ? lg[7] : lg[3];
              const float s0 = h5 ? lg[0] : lg[4], s1 = h5 ? lg[1] : lg[5], s2 = h5 ? lg[2] : lg[6], s3 = h5 ? lg[3] : lg[7];
              a0 += shx(s0, 32, lane); a1 += shx(s1, 32, lane); a2 += shx(s2, 32, lane); a3 += shx(s3, 32, lane);
              float b0 = h4 ? a2 : a0, b1 = h4 ? a3 : a1; const float t0 = h4 ? a0 : a2, t1 = h4 ? a1 : a3;
              b0 += shx(t0, 16, lane); b1 += shx(t1, 16, lane);
              float c0 = h3 ? b1 : b0; const float u0 = h3 ? b0 : b1;
              c0 += shx(u0, 8, lane); c0 += shx(c0, 4, lane); c0 += shx(c0, 2, lane); c0 += shx(c0, 1, lane);
              ss = wave_sum(ss, lane);
#pragma unroll
              for (int e = 0; e < 8; ++e) lg[e] = __builtin_bit_cast(float, __builtin_amdgcn_readlane(__builtin_bit_cast(int, c0), 8 * e)); }
            const float rstd = rsqrtf(ss * (1.f / 1024.f) + EPS);
#pragma unroll
            for (int j = 0; j < 4; ++j) { x[j] = x[j] * rstd * ca[j] + cb[j]; *(unsigned*)(XNM + (size_t)r * 1024 + 4 * lane + 256 * j) = pk4_fp8(x[j][0], x[j][1], x[j][2], x[j][3]); }
#pragma unroll
            for (int e = 0; e < 8; ++e) lg[e] = lg[e] * rstd + bq[e];
            {
                int i1 = 0; float v1 = lg[0];
#pragma unroll
                for (int e = 1; e < 8; ++e) if (lg[e] > v1) { v1 = lg[e]; i1 = e; }
                int i2 = -1; float v2 = -3.0e38f;
#pragma unroll
                for (int e = 0; e < 8; ++e) if (e != i1 && lg[e] > v2) { v2 = lg[e]; i2 = e; }
                const float w1 = 1.f / (1.f + expf(v2 - v1)), w2 = 1.f - w1;
                if (lane == 0) {
                    __hip_atomic_fetch_add(lcnt + i1, 1, __ATOMIC_RELAXED, __HIP_MEMORY_SCOPE_WORKGROUP); __hip_atomic_fetch_add(lcnt + i2, 1, __ATOMIC_RELAXED, __HIP_MEMORY_SCOPE_WORKGROUP);
                    int* te = (int*)(wsq_ + WS_TOKE) + r * 2; float* tw = (float*)(wsq_ + WS_TOKW) + r * 2;
                    te[0] = i1; te[1] = i2; tw[0] = w1; tw[1] = w2; }
            }
        }
        __syncthreads();
        if (tid < 8) { ((int*)(wsq_ + WS_CNTB))[ch * 8 + tid] = lcnt[tid]; lcnt[tid] = 0; }
        __syncthreads();
    }
}

__device__ __forceinline__ void kr_rows(const Frame& F, const bf16_t* Z, bf16_t* KR) { unsigned char* const wsq_ = opq(F.ws);
    const int lane = lane_id(), tid = F.wave * 64 + lane; (void)tid; (void)lane;
    const float* cosT = (const float*)(wsq_ + WS_COS); const float* sinT = (const float*)(wsq_ + WS_SIN);
    for (int idx = F.gw * 64 + lane; idx < NR * 16; idx += F.NGW * 64) { const int r = idx >> 4, a = (idx >> 3) & 1, i = idx & 7;
        const float x1 = bf1(Z[(size_t)r * 1024 + 896 + a * 16 + i]), x2 = bf1(Z[(size_t)r * 1024 + 896 + a * 16 + 8 + i]);
        float c = 1.f, s = 0.f; if (r < NX) { const int t = r & (SEQ - 1); c = cosT[t * 16 + a * 8 + i]; s = sinT[t * 16 + a * 8 + i]; }
        unsigned char* kr8 = (unsigned char*)KR + (size_t)r * 32 + a * 16 + i; kr8[0] = (unsigned char)(pk4_fp8(x1 * c - x2 * s, 0.f, 0.f, 0.f) & 0xffu); kr8[8] = (unsigned char)(pk4_fp8(x2 * c + x1 * s, 0.f, 0.f, 0.f) & 0xffu); }
}

__device__ __forceinline__ void ssm_tables(const Frame& F, const Args& A) { unsigned char* const wsq_ = opq(F.ws);
    const int lane = lane_id(), tid = F.wave * 64 + lane;
    LAS float* Cr = (LAS float*)F.lds; LAS float* Ci = Cr + 1040; LAS float* BBl = Ci + 1040; LAS float* PWl = BBl + 2048;
    unsigned char* ws = wsq_;
    for (int it2 = F.bid; it2 < 2 * NG * 2 * 2; it2 += F.G) {
        const int it = it2 >> 1, half = it2 & 1; const int dir = it & 1, g = (it >> 1) & 31, l = it >> 6; const int gi = (l * 2 + dir) * NG + g;
        __syncthreads();
        for (int i = tid; i < 1024; i += NTHR) { Cr[(i >> 6) * 65 + (i & 63)] = INP(18)[(size_t)gi * 1024 + i]; Ci[(i >> 6) * 65 + (i & 63)] = INP(19)[(size_t)gi * 1024 + i]; }
        for (int i = tid; i < 2048; i += NTHR) BBl[i] = ((const float*)(ws + WS_BB))[(size_t)gi * 2048 + i];
        for (int i = tid; i < 64 * 66; i += NTHR) PWl[i] = ((const float*)(ws + WS_PW))[(size_t)gi * 64 * 66 + i];
        __syncthreads();
        float* KL = (float*)(ws + WS_KL) + (size_t)((l * NG + g) * 2 + dir) * 8192;
        for (int e = half * 4096 + tid; e < half * 4096 + 4096; e += NTHR) { const int lag = e >> 8, c = (e >> 4) & 15, cp = e & 15; float acc = 0.f;
#pragma unroll 4
            for (int p = 0; p < 64; ++p) { const float cr = Cr[c * 65 + p], ci = Ci[c * 65 + p], pr = PWl[p * 66 + 2 * lag], pi = PWl[p * 66 + 2 * lag + 1], br = BBl[(p * 16 + cp) * 2], bi = BBl[(p * 16 + cp) * 2 + 1];
                acc += (cr * pr - ci * pi) * br - (cr * pi + ci * pr) * bi; }
            KL[e] = acc; }
        bf16_t* W1 = (bf16_t*)(ws + WS_W1T) + ((size_t)(l * NG + g) * 256 + dir * 128) * 512;
        if (half == 0) for (int q = tid; q < 8192; q += NTHR) { const int r = q >> 6, reim = r >> 6, p = r & 63, pc = q & 63, j = pc >> 1, c0 = (pc & 1) * 8, e = dir ? j : TCH - 1 - j;
            const float pr = PWl[p * 66 + 2 * e], pi = PWl[p * 66 + 2 * e + 1]; float v[8];
#pragma unroll
            for (int k = 0; k < 8; ++k) { const float br = BBl[(p * 16 + c0 + k) * 2], bi = BBl[(p * 16 + c0 + k) * 2 + 1]; v[k] = reim ? (pr * bi + pi * br) : (pr * br - pi * bi); }
            u32x4 o; o.x = pk2(v[0], v[1]); o.y = pk2(v[2], v[3]); o.z = pk2(v[4], v[5]); o.w = pk2(v[6], v[7]);
            *(u32x4*)(W1 + (size_t)r * 512 + j * 16 + c0) = o; }
        bf16_t* MT = (bf16_t*)(ws + WS_MT) + (size_t)(l * NG + g) * 512 * 768 + 512 + dir * 128;
        if (half == 1) for (int q = tid; q < 8192; q += NTHR) { const int row = q >> 4, ii = row >> 4, c = row & 15, pc = q & 15, reim = pc >> 3, p0 = (pc & 7) * 8, e = dir ? TCH - ii : ii + 1; float v[8];
#pragma unroll
            for (int k = 0; k < 8; ++k) { const int p = p0 + k; const float cr = Cr[c * 65 + p], ci = Ci[c * 65 + p], pr = PWl[p * 66 + 2 * e], pi = PWl[p * 66 + 2 * e + 1]; v[k] = reim ? -(cr * pi + ci * pr) : (cr * pr - ci * pi); }
            u32x4 o; o.x = pk2(v[0], v[1]); o.y = pk2(v[2], v[3]); o.z = pk2(v[4], v[5]); o.w = pk2(v[6], v[7]);
            *(u32x4*)(MT + (size_t)row * 768 + reim * 64 + p0) = o; }
    }
    __syncthreads();
}
__device__ __forceinline__ void ssm_toeplitz(const Frame& F, const Args& A) { unsigned char* const wsq_ = opq(F.ws);
    const int lane = lane_id(); unsigned char* ws = wsq_;
    for (int x = F.gw * 64 + lane; x < 2 * NG * 512 * 64; x += F.NGW * 64) { const int pc = x & 63, row = (x >> 6) & 511, lg = x >> 15, j = pc >> 1, c0 = (pc & 1) * 8, i = row >> 4, c = row & 15;
        const float* KL = (const float*)(ws + WS_KL) + (size_t)lg * 2 * 8192; float v[8];
#pragma unroll
        for (int k = 0; k < 8; ++k) v[k] = 0.f;
        if (j <= i) { const float* kp = KL + (i - j) * 256 + c * 16 + c0; const f32x4 a = *(const f32x4*)kp, b = *(const f32x4*)(kp + 4); v[0] += a[0]; v[1] += a[1]; v[2] += a[2]; v[3] += a[3]; v[4] += b[0]; v[5] += b[1]; v[6] += b[2]; v[7] += b[3]; }
        if (j >= i) { const float* kp = KL + 8192 + (j - i) * 256 + c * 16 + c0; const f32x4 a = *(const f32x4*)kp, b = *(const f32x4*)(kp + 4); v[0] += a[0]; v[1] += a[1]; v[2] += a[2]; v[3] += a[3]; v[4] += b[0]; v[5] += b[1]; v[6] += b[2]; v[7] += b[3]; }
        if (i == j && (c >> 3) == (c0 >> 3)) { const float d = INP(20)[(lg >> 5) * 512 + (lg & 31) * 16 + c];
#pragma unroll
            for (int k = 0; k < 8; ++k) v[k] += (k == (c & 7)) ? d : 0.f; }
        u32x4 o; o.x = pk2(v[0], v[1]); o.y = pk2(v[2], v[3]); o.z = pk2(v[4], v[5]); o.w = pk2(v[6], v[7]);
        *(u32x4*)((bf16_t*)(ws + WS_MT) + ((size_t)lg * 512 + row) * 768 + j * 16 + c0) = o; }
}
__device__ __forceinline__ void ssm_scan(const Frame& F, int l) { unsigned char* const wsq_ = opq(F.ws);
    const int lane = lane_id(); unsigned char* ws = wsq_;
    for (int w = F.bid + F.G * F.wave; w < NB * NG * 2; w += F.G * NWAVES) {
        const int dir = w & 1, g = (w >> 1) & 31, b = w >> 6; const int idx = ((l * 2 + dir) * NG + g) * NP + lane;
        const float* PW = (const float*)(ws + WS_PW) + (size_t)idx * 66; const float are = PW[2 * TCH], aim = PW[2 * TCH + 1];
        const float* S = (const float*)(ws + WS_S) + (size_t)g * NCH * 256 + dir * 128 + lane; bf16_t* UH = (bf16_t*)(ws + WS_UH) + (size_t)g * NCH * 768 + 512 + dir * 128 + lane;
        float hre = 0.f, him = 0.f;
        for (int blk = 0; blk < (CTXL + SEQ) / TCH / 24; ++blk) {
            float sr[24], si[24]; int nn[24];
#pragma unroll
            for (int k = 0; k < 24; ++k) { const int s = blk * 24 + k; int n;
                if (s < CTXL / TCH) n = NX / TCH + b * (CTXL / TCH) + (dir ? CTXL / TCH - 1 - s : s); else { const int t = s - CTXL / TCH; n = b * (SEQ / TCH) + (dir ? SEQ / TCH - 1 - t : t); }
                nn[k] = n; sr[k] = S[(size_t)n * 256]; si[k] = S[(size_t)n * 256 + 64]; }
#pragma unroll
            for (int k = 0; k < 24; ++k) { UH[(size_t)nn[k] * 768] = (bf16_t)f2bf(hre); UH[(size_t)nn[k] * 768 + 64] = (bf16_t)f2bf(him);
                const float nr = are * hre - aim * him + sr[k], ni = are * him + aim * hre + si[k]; hre = nr; him = ni; }
        }
    }
}

__device__ __forceinline__ int pad256(unsigned c) { return (int)((c + 255u) & ~255u); }
__device__ __forceinline__ void moe_gather(const Frame& F, const unsigned char* XNM, unsigned char* XP) { unsigned char* const wsq_ = opq(F.ws);
    const int lane = lane_id(), tid = F.wave * 64 + lane;
    { u32x4 z4 = {0u, 0u, 0u, 0u}; asm volatile("" : "+v"(z4));
      for (int i = F.gw * 64 + lane; i < MOE_ROWS * 8; i += F.NGW * 64) *(u32x4*)(wsq_ + WS_HP + (size_t)(i >> 3) * DFE8 + DFE + (i & 7) * 16) = z4; }
    LAS int* posl = (LAS int*)F.lds;
    const int* CNTB = (const int*)(wsq_ + WS_CNTB); const int* te = (const int*)(wsq_ + WS_TOKE); int* tp = (int*)(wsq_ + WS_TOKP);
    for (int ch = F.bid; ch < NX / 128; ch += F.G) {
        __syncthreads();
        if (F.wave == 0) {
            int es[4];
#pragma unroll
            for (int q = 0; q < 4; ++q) es[q] = te[ch * 256 + lane + 64 * q];
            int off = 0, ps[4] = {0, 0, 0, 0};
#pragma unroll
            for (int e = 0; e < 8; ++e) {
                int tot = 0, bef = 0;
#pragma unroll
                for (int q = 0; q < 4; ++q) { const int c2 = lane + 64 * q, vv = CNTB[c2 * 8 + e]; tot += vv; bef += (c2 < ch) ? vv : 0; }
                tot = wave_sum_i(tot, lane); bef = wave_sum_i(bef, lane);
                int run = off + bef;
#pragma unroll
                for (int q = 0; q < 4; ++q) { const unsigned long long m = __ballot(es[q] == e); if (es[q] == e) ps[q] = run + __popcll(m & ((1ull << lane) - 1ull)); run += __popcll(m); }
                if (ch == 0 && lane == 0) F.ctl[CW_MOE + e] = (unsigned)tot;
                off += pad256((unsigned)tot);
            }
#pragma unroll
            for (int q = 0; q < 4; ++q) { posl[lane + 64 * q] = ps[q]; tp[ch * 256 + lane + 64 * q] = ps[q]; }
        }
        __syncthreads();
        for (int i = 0; i < 16; ++i) { const int tl = F.wave * 16 + i, r = ch * 128 + tl;
            const u32x4 a = *(const u32x4*)(XNM + (size_t)r * 1024 + lane * 16);
#pragma unroll
            for (int k = 0; k < 2; ++k) { const size_t dst = (size_t)posl[tl * 2 + k] * 1024; *(u32x4*)(XP + dst + lane * 16) = a; } }
    }
}
__device__ __forceinline__ void moe_combine_final(const Frame& F, const Args& A, const bf16_t* YP, const float* g2mod) { unsigned char* const wsq_ = opq(F.ws);
    const int lane = lane_id(), tid = F.wave * 64 + lane; (void)tid; (void)lane;
    const int* tp = (const int*)(wsq_ + WS_TOKP); const float* tw = (const float*)(wsq_ + WS_TOKW);
    f32x4 fn[4];
#pragma unroll
    for (int j = 0; j < 4; ++j) fn[j] = *(const f32x4*)(INP(31) + 4 * lane + 256 * j);
    for (int r = F.gw; r < NX; r += F.NGW) {
        const int v = r >> 13; size_t src[2]; float wk[2];
#pragma unroll
        for (int k = 0; k < 2; ++k) { src[k] = (size_t)tp[r * 2 + k] * 1024; wk[k] = tw[r * 2 + k]; }
        f32x4 x[4]; float ss = 0.f;
#pragma unroll
        for (int j = 0; j < 4; ++j) { const int c = 4 * lane + 256 * j; { const u32x2 w = *(const u32x2*)((const bf16_t*)F.out + (size_t)r * 2048 + c); x[j][0] = bflo(w.x); x[j][1] = bfhi(w.x); x[j][2] = bflo(w.y); x[j][3] = bfhi(w.y); }
            const u32x2 y0 = *(const u32x2*)(YP + src[0] + c), y1 = *(const u32x2*)(YP + src[1] + c); const f32x4 g = *(const f32x4*)(g2mod + v * 6144 + c);
            f32x4 y; y[0] = wk[0] * bflo(y0.x) + wk[1] * bflo(y1.x); y[1] = wk[0] * bfhi(y0.x) + wk[1] * bfhi(y1.x); y[2] = wk[0] * bflo(y0.y) + wk[1] * bflo(y1.y); y[3] = wk[0] * bfhi(y0.y) + wk[1] * bfhi(y1.y);
            x[j] = x[j] + g * y; ss += (x[j][0] * x[j][0] + x[j][1] * x[j][1]) + (x[j][2] * x[j][2] + x[j][3] * x[j][3]); }
        const float rstd = rsqrtf(wave_sum(ss, lane) * (1.f / 1024.f) + EPS);
#pragma unroll
        for (int j = 0; j < 4; ++j) *(f32x4*)(F.out + (size_t)r * 1024 + 4 * lane + 256 * j) = x[j] * rstd * fn[j];
    }
}
typedef float f32x16 __attribute__((ext_vector_type(16)));
constexpr int KALL = SEQ + CTXL;
constexpr int ATT_KB = 6 * 1024, ATT_VB = 4 * 1024, ATT_TB = ATT_KB + ATT_VB, ATT_NBUF = 6;
__device__ __forceinline__ void glds16(const void* gsrc, unsigned lds_dst) { unsigned keep;
    asm volatile("s_mov_b32 %0, m0\n\ts_mov_b32 m0, %2\n\ts_nop 0\n\tglobal_load_lds_dwordx4 %1, off\n\ts_mov_b32 m0, %0" : "=&s"(keep) : "v"(gsrc), "s"(lds_dst) : "memory"); }
__device__ __forceinline__ float max3f(float a, float b, float c) { float r; asm("v_max3_f32 %0, %1, %2, %3" : "=v"(r) : "v"(a), "v"(b), "v"(c)); return r; }
__device__ __forceinline__ float fadd_s(float a, float b) { float r; asm("v_add_f32_e32 %0, %1, %2" : "=v"(r) : "v"(a), "v"(b)); return r; }
__device__ __forceinline__ float max2f(float a, float b) { float r; asm("v_max_f32_e32 %0, %1, %2" : "=v"(r) : "v"(a), "v"(b)); return r; }
__device__ __forceinline__ bf16x8 pack_p(const f32x16& p, int s) {
    u32x4 w; w.x = pk2(p[8 * s], p[8 * s + 1]); w.y = pk2(p[8 * s + 2], p[8 * s + 3]); w.z = pk2(p[8 * s + 4], p[8 * s + 5]); w.w = pk2(p[8 * s + 6], p[8 * s + 7]); return __builtin_bit_cast(bf16x8, w);
}
__device__ __forceinline__ void attn_phase(const Frame& F, bool need_ctx, const bf16_t* Q, const bf16_t* KN, const bf16_t* KR, const bf16_t* VT, bf16_t* Y) {
    LAS unsigned char* lds = F.lds;
    const int nmain = (F.G == 256) ? 4 : (NB * NH * (SEQ / 256) + F.G - 1) / F.G;
    for (int ui = 0; ui < nmain + 1; ++ui) {
        const int lane = lane_id(), r32 = lane & 31, hi = lane >> 5;
        int b, h, qrow0, t0;
        if (ui < nmain) { int un; if (F.G == 256) un = (((F.bid & 7) + 8 * ui) << 5) | (F.bid >> 3); else un = F.bid + ui * F.G;
            if (un >= NB * NH * (SEQ / 256)) continue;
            b = un >> 8; h = (un >> 5) & 7; qrow0 = b * SEQ + (un & 31) * 256; t0 = 0; }
        else { if (!need_ctx || F.bid >= NB * NH) continue; b = F.bid >> 3; h = F.bid & 7; qrow0 = NX + b * CTXL; t0 = SEQ / 64; }
        const int nt = KALL / 64;
        pg8::v8i_t qn8, qr8;
        { const unsigned char* qp = (const unsigned char*)Q + (size_t)(qrow0 + F.wave * 32 + r32) * 768 + h * 96;
          qn8 = pg8::cat8(*(const bf16x8*)(qp + 32 * hi), *(const bf16x8*)(qp + 32 * hi + 16)); qr8 = pg8::cat8(*(const bf16x8*)(qp + 64), *(const bf16x8*)(qp + 80)); }
        const unsigned ldsb = (unsigned)(size_t)lds;
        const char* kbase = (const char*)KN + h * 64 + (F.wave & 3) * 16; const char* rbase = (const char*)KR + (F.wave & 1) * 16;     const char* vbase = (const char*)VT + (size_t)((b * NH + h) * 64) * KALL + (F.wave & 3) * 16;
        const bool lead = F.wave < 4;
        const unsigned klo = (unsigned)lane * 512u, rlo = (unsigned)lane * 32u, vlo = (unsigned)lane * (unsigned)KALL;
#define ATT_DMA(t, bo) do { const int row0_ = (t) < SEQ / 64 ? b * SEQ + (t) * 64 : NX + b * CTXL + ((t) - SEQ / 64) * 64; \
            unsigned klo_ = klo, rlo_ = rlo, vlo_ = vlo; asm volatile("" : "+v"(klo_), "+v"(rlo_), "+v"(vlo_));     \
            if (lead) glds16(kbase + (size_t)row0_ * 512 + klo_, (unsigned)__builtin_amdgcn_readfirstlane(ldsb + (bo) + F.wave * 1024)); \
            else glds16(vbase + (size_t)(t) * 64 + vlo_, (unsigned)__builtin_amdgcn_readfirstlane(ldsb + (bo) + ATT_KB + (F.wave - 4) * 1024)); \
            glds16(rbase + (size_t)row0_ * 32 + rlo_, (unsigned)__builtin_amdgcn_readfirstlane(ldsb + (bo) + (4 + (F.wave & 1)) * 1024)); } while (0)
        const unsigned cA_ = (unsigned)__builtin_amdgcn_readfirstlane(lead ? ldsb + F.wave * 1024 : ldsb + ATT_KB + (F.wave - 4) * 1024), cB_ = (unsigned)__builtin_amdgcn_readfirstlane(ldsb + (4 + (F.wave & 1)) * 1024);
        unsigned long long pa_, pb_;
        const long long rj_ = (long long)((NX + b * CTXL) - (b * SEQ + SEQ));
        const long long dA_ = lead ? rj_ * 512 : 0ll, dB_ = rj_ * 32;
        const unsigned long long stA_ = lead ? 64ull * 512ull : 64ull;
#define ATT_PTR_INIT(t) do { const int row0_ = (t) < SEQ / 64 ? b * SEQ + (t) * 64 : NX + b * CTXL + ((t) - SEQ / 64) * 64; \
            pa_ = lead ? (unsigned long long)(size_t)(kbase + (size_t)row0_ * 512 + klo) : (unsigned long long)(size_t)(vbase + (size_t)(t) * 64 + vlo); pb_ = (unsigned long long)(size_t)(rbase + (size_t)row0_ * 32 + rlo); } while (0)
#define ATT_DMA_FAST(t, bo) do { if ((t) == SEQ / 64) { pa_ += (unsigned long long)dA_; pb_ += (unsigned long long)dB_; } \
            asm volatile("s_add_i32 m0, %2, %3\n\ts_nop 0\n\tglobal_load_lds_dwordx4 %0, off\n\ts_add_i32 m0, %2, %4\n\ts_nop 0\n\tglobal_load_lds_dwordx4 %1, off" \
                         :: "v"(pa_), "v"(pb_), "s"(bo), "s"(cA_), "s"(cB_) : "memory", "m0"); \
            pa_ += stA_; pb_ += 64 * 32; } while (0)
#define ATT_WAITBAR(fresh) do { if constexpr (fresh) asm volatile("s_waitcnt vmcnt(2)\n\ts_barrier" ::: "memory");     else asm volatile("s_waitcnt vmcnt(0) lgkmcnt(0)\n\ts_barrier" ::: "memory"); } while (0)
        const unsigned r32p = (unsigned)((r32 & ~12) | ((r32 & 4) << 1) | ((r32 & 8) >> 1));
        const unsigned kan = hi * 2048 + r32p * 16, kar = 4096 + r32p * 16;
        const unsigned va = ATT_KB + hi * 2048 + r32 * 16;
        const unsigned va_unused_ = 0; (void)va_unused_;
        f32x16 o0, o1, o2, pA0, pA1, pB0, pB1;
#pragma unroll
        for (int r = 0; r < 16; ++r) { o0[r] = 0.f; o1[r] = 0.f; o2[r] = 0.f; }
        pg8::v8i_t ones8; { int c38_ = 0x38383838; asm volatile("" : "+v"(c38_));
#pragma unroll
          for (int r = 0; r < 8; ++r) ones8[r] = c38_; }
        asm volatile("" : "+v"(ones8));
        float m = 0.f, lsum = 0.f, lsum1 = 0.f; f32x16 negm;
#pragma unroll
        for (int r = 0; r < 16; ++r) negm[r] = 0.f;
        asm volatile("" : "+v"(negm));
#define ATT_KN8(bo, kb) pg8::cat8(*(const LAS bf16x8*)(lds + (bo) + kan + (kb) * 512), *(const LAS bf16x8*)(lds + (bo) + kan + (kb) * 512 + 1024))
#define ATT_KR8(bo, kb) pg8::cat8(*(const LAS bf16x8*)(lds + (bo) + kar + (kb) * 512), *(const LAS bf16x8*)(lds + (bo) + kar + (kb) * 512 + 1024))
#define ATT_S8N(P, A8) asm volatile("v_mfma_scale_f32_32x32x64_f8f6f4 %0, %1, %2, %3, %4, %5 op_sel_hi:[0,0,0]" : "=&v"(P) : "v"(A8), "v"(qn8), "v"(negm), "v"(sc1_), "v"(scq_))
#define ATT_S8R(P, A8) asm volatile("v_mfma_scale_f32_32x32x64_f8f6f4 %0, %1, %2, %0, %3, %4 op_sel_hi:[0,0,0]" : "+v"(P) : "v"(A8), "v"(qr8), "v"(sc1_), "v"(scq_))
#define ATT_QK(P0, P1, bo) do { const pg8::v8i_t kn0_ = ATT_KN8(bo, 0), kn1_ = ATT_KN8(bo, 1), kr0_ = ATT_KR8(bo, 0), kr1_ = ATT_KR8(bo, 1); \
            ATT_S8N(P0, kn0_); ATT_S8N(P1, kn1_); ATT_S8R(P0, kr0_); ATT_S8R(P1, kr1_); asm volatile("s_nop 15" :: "v"(kn0_), "v"(kn1_), "v"(kr0_), "v"(kr1_)); } while (0)
#define ATT_VF8(bo, db) pg8::cat8(*(const LAS bf16x8*)(lds + (bo) + va + (db) * 512), *(const LAS bf16x8*)(lds + (bo) + va + (db) * 512 + 1024))
#define ATT_PV8(O, A8, B8) asm volatile("v_mfma_scale_f32_32x32x64_f8f6f4 %0, %1, %2, %0, %3, %3 op_sel_hi:[0,0,0]" : "+v"(O) : "v"(A8), "v"(B8), "v"(sc1_))
#define ATT_MAX(P0, P1, FIRST) do { asm volatile("s_nop 15\n\ts_nop 7" : "+v"(P0), "+v"(P1));     \
            float ra_ = max3f(P0[0], P0[1], P1[0]), rb_ = max3f(P0[2], P0[3], P1[1]); ra_ = max3f(ra_, P1[2], P1[3]); \
            _Pragma("unroll") for (int r = 4; r < 16; r += 4) { ra_ = max3f(ra_, P0[r], P0[r + 1]); rb_ = max3f(rb_, P0[r + 2], P0[r + 3]); ra_ = max3f(ra_, P1[r], P1[r + 1]); rb_ = max3f(rb_, P1[r + 2], P1[r + 3]); } \
            float rm_ = max2f(ra_, rb_); rm_ = max2f(rm_, shx(rm_, 32, lane)); \
            if ((FIRST) || __any(rm_ > 8.0f)) { const float dl_ = (FIRST) ? rm_ - 5.0f : max2f(rm_ - 5.0f, 0.f); m += dl_; const float al_ = __builtin_amdgcn_exp2f(-dl_); lsum *= al_; lsum1 *= al_; \
                _Pragma("unroll") for (int r = 0; r < 16; ++r) negm[r] = -m; asm volatile("" : "+v"(negm));     \
                _Pragma("unroll") for (int r = 0; r < 16; ++r) { P0[r] -= dl_; P1[r] -= dl_; o0[r] *= al_; o1[r] *= al_; } } } while (0)
#define ATT_ROT() do { const unsigned t_ = bpp; bpp = bprv; bprv = bcur; bcur = bnxt; bnxt = bn2; bn2 = bn3; bn3 = t_; } while (0)
#define ATT_E(PO0, PO1, r) do { float a_ = PO0[r], b_ = PO1[r]; asm("v_exp_f32_e32 %0, %0\n\tv_exp_f32_e32 %1, %1\n\tv_add_f32_e32 %2, %2, %0\n\tv_add_f32_e32 %3, %3, %1" : "+v"(a_), "+v"(b_), "+v"(lsum), "+v"(lsum1)); PO0[r] = a_; PO1[r] = b_; } while (0)
#define ATT_X(P, i, D, PF) do { float t0_, t1_, t2_, t3_; int d_; \
            asm("v_exp_f32_e32 %1, %5\n\tv_exp_f32_e32 %2, %6\n\tv_exp_f32_e32 %3, %7\n\tv_exp_f32_e32 %4, %8\n\tv_cvt_pk_fp8_f32 %0, %1, %2\n\tv_cvt_pk_fp8_f32 %0, %3, %4 op_sel:[0,0,1]" \
                : "=&v"(d_), "=&v"(t0_), "=&v"(t1_), "=&v"(t2_), "=&v"(t3_) : "v"(P[4 * (i)]), "v"(P[4 * (i) + 1]), "v"(P[4 * (i) + 2]), "v"(P[4 * (i) + 3])); PF[D] = d_; } while (0)
#define SB_ __builtin_amdgcn_sched_barrier(0)
#define ATT_BODY(PN0, PN1, PO0, PO1, PFW, PFR, VSRC, KNXT, DMAB, j, FRESH) do { const unsigned bv_ = (VSRC), bn_ = (KNXT); float rm_; \
            { const pg8::v8i_t k8_ = pg8::cat8(ka0, ka1); ATT_S8N(PN0, k8_); } SB_; \
            if (FRESH) ATT_DMA_FAST((j) + 3, DMAB); \
            const bf16x8 vb1 = *(const LAS bf16x8*)(lds + bv_ + va + 1024), vb0 = *(const LAS bf16x8*)(lds + bv_ + va), vd1 = *(const LAS bf16x8*)(lds + bv_ + va + 512 + 1024), vd0 = *(const LAS bf16x8*)(lds + bv_ + va + 512); ATT_X(PO0, 0, 0, PFW); SB_; \
            { const pg8::v8i_t k8_ = pg8::cat8(kb0, kb1); ATT_S8N(PN1, k8_); } ATT_X(PO1, 0, 4, PFW); SB_; \
            { const pg8::v8i_t k8_ = pg8::cat8(kc0, kc1); ATT_S8R(PN0, k8_); } ATT_X(PO0, 1, 1, PFW); SB_; \
            { const pg8::v8i_t k8_ = pg8::cat8(kd0, kd1); ATT_S8R(PN1, k8_); } asm volatile("" :: "v"(ka0), "v"(ka1), "v"(kb0), "v"(kb1));     \
            ATT_X(PO1, 1, 5, PFW); SB_; \
            { const pg8::v8i_t va0_ = pg8::cat8(vb0, vb1); ATT_PV8(o0, va0_, PFR); } asm volatile("" :: "v"(kc0), "v"(kc1), "v"(kd0), "v"(kd1)); \
            ka1 = *(const LAS bf16x8*)(lds + bn_ + kan + 1024); ka0 = *(const LAS bf16x8*)(lds + bn_ + kan); kb1 = *(const LAS bf16x8*)(lds + bn_ + kan + 512 + 1024); kb0 = *(const LAS bf16x8*)(lds + bn_ + kan + 512); \
            kc1 = *(const LAS bf16x8*)(lds + bn_ + kar + 1024); kc0 = *(const LAS bf16x8*)(lds + bn_ + kar); kd1 = *(const LAS bf16x8*)(lds + bn_ + kar + 512 + 1024); kd0 = *(const LAS bf16x8*)(lds + bn_ + kar + 512);     \
            ATT_X(PO0, 2, 2, PFW); SB_; \
            { const pg8::v8i_t va1_ = pg8::cat8(vd0, vd1); ATT_PV8(o1, va1_, PFR); } asm volatile("" :: "v"(vb0), "v"(vb1)); ATT_X(PO1, 2, 6, PFW); SB_; \
            ATT_PV8(o2, ones8, PFR); asm volatile("" :: "v"(vd0), "v"(vd1));     \
            ATT_X(PO0, 3, 3, PFW); ATT_X(PO1, 3, 7, PFW); SB_; \
            asm volatile("s_nop 7" : "+v"(PN0), "+v"(PN1)); float ra_, rb_; asm("v_max3_f32 %0, %2, %3, %4\n\tv_max3_f32 %1, %5, %6, %7\n\tv_max3_f32 %0, %0, %8, %9\n\tv_max3_f32 %1, %1, %10, %11" : "=&v"(ra_), "=&v"(rb_) : "v"(PN0[0]), "v"(PN0[1]), "v"(PN0[2]), "v"(PN1[0]), "v"(PN1[1]), "v"(PN1[2]), "v"(PN0[3]), "v"(PN0[4]), "v"(PN0[5]), "v"(PN0[6])); \
            asm("v_max3_f32 %0, %0, %2, %3\n\tv_max3_f32 %1, %1, %4, %5\n\tv_max3_f32 %0, %0, %6, %7\n\tv_max3_f32 %1, %1, %8, %9" : "+v"(ra_), "+v"(rb_) : "v"(PN0[7]), "v"(PN0[8]), "v"(PN0[9]), "v"(PN0[10]), "v"(PN0[11]), "v"(PN0[12]), "v"(PN0[13]), "v"(PN0[14])); \
            asm("v_max3_f32 %0, %0, %2, %3\n\tv_max3_f32 %1, %1, %4, %5\n\tv_max3_f32 %0, %0, %6, %7\n\tv_max3_f32 %1, %1, %8, %9\n\tv_max3_f32 %0, %0, %10, %11\n\tv_max3_f32 %1, %1, %12, %13\n\tv_max3_f32 %0, %0, %14, %15" : "+v"(ra_), "+v"(rb_) : "v"(PN0[15]), "v"(PN1[3]), "v"(PN1[4]), "v"(PN1[5]), "v"(PN1[6]), "v"(PN1[7]), "v"(PN1[8]), "v"(PN1[9]), "v"(PN1[10]), "v"(PN1[11]), "v"(PN1[12]), "v"(PN1[13]), "v"(PN1[14]), "v"(PN1[15])); \
            { float rn_; asm volatile("v_max_f32_e32 %0, %2, %3\n\tv_mov_b32_e32 %1, %0\n\ts_nop 1\n\tv_permlane32_swap_b32 %0, %1\n\tv_max_f32_e32 %0, %0, %1" : "=&v"(rm_), "=&v"(rn_) : "v"(ra_), "v"(rb_)); }     \
            SB_; \
            ATT_APPLY_PENDING(); \
            if (__any(rm_ > 8.0f)) { const float dl_ = max2f(rm_ - 5.0f, 0.f); m += dl_; alp_ = __builtin_amdgcn_exp2f(-dl_); pend_ = true; \
                _Pragma("unroll") for (int r = 0; r < 16; ++r) negm[r] = -m; asm volatile("" : "+v"(negm)); \
                _Pragma("unroll") for (int r = 0; r < 16; ++r) { PN0[r] -= dl_; PN1[r] -= dl_; } } } while (0)
#define ATT_APPLY_PENDING() do { if (pend_) { asm volatile("s_nop 15\n\ts_nop 7" : "+v"(o0), "+v"(o1), "+v"(o2));     \
                _Pragma("unroll") for (int r = 0; r < 16; ++r) { o0[r] *= alp_; o1[r] *= alp_; o2[r] *= alp_; } pend_ = false; } } while (0)
#define ATT_STEPX(PN0, PN1, PO0, PO1, PFW, PFR, VSRC, KNXT, DMAB, j, FRESH) do { \
            ATT_BODY(PN0, PN1, PO0, PO1, PFW, PFR, VSRC, KNXT, DMAB, j, FRESH); \
            if (FRESH) asm volatile("s_waitcnt vmcnt(2)\n\ts_barrier" ::: "memory"); else asm volatile("s_waitcnt vmcnt(0)\n\ts_barrier" ::: "memory"); } while (0)
#define ATT_STEP(PN0, PN1, PO0, PO1, PFW, PFR, VSRC, j, FRESH) do { ATT_STEPX(PN0, PN1, PO0, PO1, PFW, PFR, VSRC, bnxt, bn3, j, FRESH); ATT_ROT(); } while (0)
        pg8::v8i_t pf8a, pf8b; int sc1_ = 0x7f7f7f7f, scq_ = 0x7c7c7c7c; asm volatile("" : "+v"(sc1_), "+v"(scq_));
        { int z_ = 0; asm volatile("" : "+v"(z_));
#pragma unroll
          for (int r = 0; r < 8; ++r) { pf8a[r] = z_; pf8b[r] = z_; } }
        float alp_ = 1.f; bool pend_ = false;
        unsigned bpp = 5 * ATT_TB, bprv = 4 * ATT_TB, bcur = 0, bnxt = ATT_TB, bn2 = 2 * ATT_TB, bn3 = 3 * ATT_TB;
        asm volatile("s_waitcnt vmcnt(0) lgkmcnt(0)\n\ts_barrier" ::: "memory");
        ATT_DMA(t0, bcur); ATT_DMA(t0 + 1, bnxt); ATT_DMA(t0 + 2, bn2);
        ATT_WAITBAR(true);
        ATT_DMA(t0 + 3, bn3);
        ATT_QK(pA0, pA1, bcur); ATT_MAX(pA0, pA1, true);
        bf16x8 ka1 = *(const LAS bf16x8*)(lds + bnxt + kan + 1024), ka0 = *(const LAS bf16x8*)(lds + bnxt + kan), kb1 = *(const LAS bf16x8*)(lds + bnxt + kan + 512 + 1024), kb0 = *(const LAS bf16x8*)(lds + bnxt + kan + 512);
        bf16x8 kc1 = *(const LAS bf16x8*)(lds + bnxt + kar + 1024), kc0 = *(const LAS bf16x8*)(lds + bnxt + kar), kd1 = *(const LAS bf16x8*)(lds + bnxt + kar + 512 + 1024), kd0 = *(const LAS bf16x8*)(lds + bnxt + kar + 512);
        ATT_ROT(); ATT_WAITBAR(true);
        int j = t0 + 1; ATT_PTR_INIT(t0 + 4);
        { const bool fh_ = j + 3 < nt; ATT_STEP(pB0, pB1, pA0, pA1, pf8a, pf8b, bprv, j, fh_); ++j; }
        for (; j + 8 < nt; j += 6) { constexpr unsigned T_ = ATT_TB;
            ATT_STEPX(pA0, pA1, pB0, pB1, pf8b, pf8a, 0 * T_, 3 * T_, 4 * T_, j, true);     ATT_STEPX(pB0, pB1, pA0, pA1, pf8a, pf8b, 1 * T_, 5 * T_, 0 * T_, j + 1, true);
            ATT_STEPX(pA0, pA1, pB0, pB1, pf8b, pf8a, 2 * T_, 4 * T_, 1 * T_, j + 2, true); ATT_STEPX(pB0, pB1, pA0, pA1, pf8a, pf8b, 3 * T_, 0 * T_, 2 * T_, j + 3, true);
            ATT_STEPX(pA0, pA1, pB0, pB1, pf8b, pf8a, 5 * T_, 1 * T_, 3 * T_, j + 4, true); ATT_STEPX(pB0, pB1, pA0, pA1, pf8a, pf8b, 4 * T_, 2 * T_, 5 * T_, j + 5, true); }
        if (t0 == 0) { ATT_STEP(pA0, pA1, pB0, pB1, pf8b, pf8a, bpp, j, true); ATT_STEP(pB0, pB1, pA0, pA1, pf8a, pf8b, bpp, j + 1, false); j += 2; }
        ATT_STEP(pA0, pA1, pB0, pB1, pf8b, pf8a, bpp, j, false); ATT_STEP(pB0, pB1, pA0, pA1, pf8a, pf8b, bpp, j + 1, false);
        { const pg8::v8i_t va0_ = ATT_VF8(bpp, 0), va1_ = ATT_VF8(bpp, 1); ATT_PV8(o0, va0_, pf8a); ATT_PV8(o1, va1_, pf8a); ATT_PV8(o2, ones8, pf8a); asm volatile("s_nop 15" :: "v"(va0_), "v"(va1_), "v"(pf8a)); }
        ATT_APPLY_PENDING();
        ATT_X(pB0, 0, 0, pf8b); ATT_X(pB1, 0, 4, pf8b); ATT_X(pB0, 1, 1, pf8b); ATT_X(pB1, 1, 5, pf8b); ATT_X(pB0, 2, 2, pf8b); ATT_X(pB1, 2, 6, pf8b); ATT_X(pB0, 3, 3, pf8b); ATT_X(pB1, 3, 7, pf8b);
        { const pg8::v8i_t va0_ = ATT_VF8(bprv, 0), va1_ = ATT_VF8(bprv, 1); asm volatile("s_nop 3" : "+v"(pf8b)); ATT_PV8(o0, va0_, pf8b); ATT_PV8(o1, va1_, pf8b); ATT_PV8(o2, ones8, pf8b); asm volatile("s_nop 15" :: "v"(va0_), "v"(va1_), "v"(pf8b)); }
#undef ATT_DMA
#undef ATT_DMA_FAST
#undef ATT_PTR_INIT
#undef ATT_WAITBAR
#undef ATT_QK
#undef ATT_VF8
#undef ATT_PV8
#undef ATT_APPLY_PENDING
#undef ATT_MAX
#undef ATT_ROT
#undef ATT_STEP
#undef ATT_STEPX
#undef ATT_BODY
#undef ATT_KN8
#undef ATT_KR8
#undef ATT_S8N
#undef ATT_S8R
#undef ATT_E
#undef SB_
        const int le = lane_id();
        asm volatile("s_nop 15\n\ts_nop 7" : "+v"(o0), "+v"(o1), "+v"(o2));
        lsum = o2[0]; (void)lsum1;
        const float inv = 1.f / lsum;
        bf16_t* yp = Y + (size_t)(qrow0 + F.wave * 32 + (le & 31)) * 1024 + 512 + h * 64 + 4 * (le >> 5);
#pragma unroll
        for (int g = 0; g < 4; ++g) {
            u32x2 w0, w1; w0.x = pk2(o0[4 * g] * inv, o0[4 * g + 1] * inv); w0.y = pk2(o0[4 * g + 2] * inv, o0[4 * g + 3] * inv);
            w1.x = pk2(o1[4 * g] * inv, o1[4 * g + 1] * inv); w1.y = pk2(o1[4 * g + 2] * inv, o1[4 * g + 3] * inv);
            *(u32x2*)(yp + 8 * g) = w0; *(u32x2*)(yp + 32 + 8 * g) = w1;
        }
    }
    __syncthreads();
}

constexpr int N_PHASES = 23;
#define SP2v true
#define ALIGNv true
__global__ void __launch_bounds__(NTHR, 2) fwd_kernel(Args A) {
    extern __shared__ __attribute__((aligned(16))) unsigned char lds_raw[];
    Frame F;
    F.lds = (LAS unsigned char*)lds_raw; F.MISC = (volatile LAS unsigned*)(F.lds + MISC_OFF);
    F.wave = __builtin_amdgcn_readfirstlane((int)threadIdx.x >> 6);
    F.G = gridDim.x; F.bid = blockIdx.x; F.gw = F.bid * NWAVES + F.wave; F.NGW = F.G * NWAVES;
    F.out = A.out; F.ws = A.ws; F.ctl = (unsigned*)(A.ws + WS_CTL);
    for (int u = (int)threadIdx.x; u < (LDS_BYTES - LDSCTL_OFF) / 4; u += NTHR) ((LAS unsigned*)(F.lds + LDSCTL_OFF))[u] = 0u;
    __syncthreads();
#if MK_N_LAUNCHES == 1
    XcdBarrier bar = xcd_barrier_post(F.ctl + CW_BAR, F.MISC + 8);
#define GRID_BAR() xcd_barrier(bar)
#else
#define GRID_BAR() do {} while (0)
#endif
    const int lo = A.ph_lo, hi = A.ph_hi;
#define IN(k) (lo <= (k) && (k) < hi)
#ifndef PROBE_ON
#define PROBE_ON 0
#endif
#if PROBE_ON
#define SEAM(k) do { if (IN(k) && IN((k) + 1)) { GRID_BAR(); const int k_ = (k); if (F.bid == 0 && (k_ == PROBE_A - 100 || k_ == PROBE_A - 101 || k_ == PROBE_B - 100 || k_ == PROBE_B - 101) && lane_id() == 0 && F.wave == 0) \
        __hip_atomic_store((unsigned long long*)(opq(F.ws) + WS_PROBE) + 16 + k_, __builtin_amdgcn_s_memrealtime(), __ATOMIC_RELAXED, __HIP_MEMORY_SCOPE_AGENT); } } while (0)
#else
#define SEAM(k) do { if (IN(k) && IN((k) + 1)) GRID_BAR(); } while (0)
#endif
    LAS unsigned char* ring = F.lds;
#define WSQ() unsigned char* ws = opq(F.ws)
#define PBF(name, off) bf16_t* name = (bf16_t*)(ws + (off))

    if (IN(0)) { p0_prologue(F, A); } SEAM(0);

    for (int l = 0; l < 2; ++l) {
        const int pb = 1 + 10 * l; const bool need_ctx = (l == 0);
        if (IN(pb + 0)) { WSQ(); PBF(XN, WS_XN); const float* modl = (const float*)(ws + WS_MOD) + (size_t)l * 5 * 6144;
            const float* xs_x = (l == 0) ? INP(0) : F.out; const float* xs_c = (l == 0) ? INP(2) : (const float*)(ws + WS_XC);
            if (l == 0) { p0_weights(F, A); __syncthreads(); ssm_tables(F, A); }
            if (l == 0) norm_rows<true, false>(F, xs_x, xs_c, NR, INP(6) + l * 1024, modl, 0, 1024, XN, l == 1 ? (const float*)(ws + WS_PART) : nullptr, 11, (const float*)(ws + WS_MOD) + 4 * 6144 + 5120, nullptr); else norm_rows<true, true>(F, xs_x, xs_c, NR, INP(6) + l * 1024, modl, 0, 1024, XN, l == 1 ? (const float*)(ws + WS_PART) : nullptr, 11, (const float*)(ws + WS_MOD) + 4 * 6144 + 5120, nullptr); } SEAM(pb + 0);
        if (IN(pb + 1)) { WSQ(); PBF(XN, WS_XN); PBF(Z, WS_Z); float* rs = (float*)(ws + WS_RS) + (size_t)l * NR * 8;
            pg8::Gemm g{XN, (const bf16_t*)(ws + WS_WIN + (size_t)l * 1024 * 1024), 512, 512, 512, 0}; pg8::StaticOrder S; S.init(NR, 1024, F.G, F.bid);
            pg8::EpiInProj E{Z, rs, (bf16_t*)(ws + WS_UH), 1.f / W8_SCALE}; pg8::gemm_phase<pg8::EpiInProj, pg8::StaticOrder, ALIGNv, SP2v, true>(ring, g, S, E, F.wave);
            if (l == 0) ssm_toeplitz(F, A); } SEAM(pb + 1);
        if (IN(pb + 2)) {
            const int qx = ((need_ctx ? NR : NX) / 256) * 3 - F.G;
            const int c_kn = (F.G == 256) ? ((F.bid + 256 - qx) & 255) : F.bid, c_vt = (F.G == 256) ? ((F.bid + 256 - qx - 8) & 255) : F.bid, c_s1 = (F.G == 256) ? ((F.bid + 256 - qx - 16) & 255) : F.bid;
            { WSQ(); PBF(Z, WS_Z); PBF(Qb, WS_Q); const float* rs = (const float*)(ws + WS_RS) + (size_t)l * NR * 8;
              pg8::Gemm g{Z + 512, (const bf16_t*)(ws + WS_WUQ) + (size_t)l * 768 * 256, 1024, 256, 256, 0}; pg8::StaticOrder S; S.init(need_ctx ? NR : NX, 768, F.G, F.bid);
              pg8::EpiQ E{Qb, rs, (const float*)(ws + WS_COS), (const float*)(ws + WS_SIN)}; pg8::gemm_phase<pg8::EpiQ, pg8::StaticOrder, ALIGNv, SP2v>(ring, g, S, E, F.wave); }
            { WSQ(); PBF(Z, WS_Z); PBF(KN, WS_KN); const float* rs = (const float*)(ws + WS_RS) + (size_t)l * NR * 8;
              pg8::Gemm g{Z + 768, (const bf16_t*)(ws + WS_WUKV) + (size_t)l * 1024 * 128, 1024, 128, 128, 0}; pg8::StaticOrder S; S.init(NR, 512, F.G, c_kn);
              pg8::EpiKV E{KN, rs}; pg8::gemm_phase<pg8::EpiKV, pg8::StaticOrder, ALIGNv, SP2v>(ring, g, S, E, F.wave); }
            { WSQ(); PBF(Z, WS_Z); PBF(VT, WS_V); const float* rs = (const float*)(ws + WS_RS) + (size_t)l * NR * 8;
              pg8::Gemm g{(const bf16_t*)(ws + WS_WUKV) + (size_t)l * 1024 * 128 + 512 * 128, Z + 768, 128, 1024, 128, 0}; pg8::StaticOrder S; S.init(512, NR, F.G, c_vt);
              pg8::EpiVT E{VT, rs}; pg8::gemm_phase<pg8::EpiVT, pg8::StaticOrder, ALIGNv, SP2v>(ring, g, S, E, F.wave); }
            { WSQ(); PBF(Z, WS_Z); PBF(KR, WS_KR); kr_rows(F, Z, KR); }
            { WSQ(); PBF(UH, WS_UH);
              pg8::Gemm g{UH, (const bf16_t*)(ws + WS_W1T) + (size_t)l * NG * 256 * 512, 768, 512, 512, (size_t)256 * 512 * 2, (size_t)NCH * 768 * 2}; pg8::GroupOrder S{5, 1, F.G, c_s1};
              pg8::EpiS E{(float*)(ws + WS_S)}; pg8::gemm_phase<pg8::EpiS, pg8::GroupOrder, ALIGNv, SP2v>(ring, g, S, E, F.wave); }
        } SEAM(pb + 2);
        if (IN(pb + 3)) {
            ssm_scan(F, l);
            if (F.wave != 0) { Frame F2 = F; F2.gw = F.bid * (NWAVES - 1) + F.wave - 1; F2.NGW = F.G * (NWAVES - 1); p0_moe_weights(F2, A, 4 * l, 4 * l + 4); }
            __syncthreads();
            { WSQ(); PBF(Qb, WS_Q); PBF(KN, WS_KN); PBF(KR, WS_KR); PBF(VT, WS_V); PBF(YMIX, WS_YMIX); attn_phase(F, need_ctx, Qb, KN, KR, VT, YMIX); }
        } SEAM(pb + 3);
        if (IN(pb + 4)) { WSQ(); PBF(UH, WS_UH); PBF(ZG, WS_ZG);
            pg8::Gemm g{UH, (const bf16_t*)(ws + WS_MT) + (size_t)l * NG * 512 * 768, 768, 768, 768, (size_t)512 * 768 * 2, (size_t)NCH * 768 * 2}; pg8::GroupOrder S{need_ctx ? 5 : 4, 2, F.G, F.bid};
            pg8::EpiY E{ZG}; pg8::gemm_phase<pg8::EpiY, pg8::GroupOrder, ALIGNv, SP2v>(ring, g, S, E, F.wave); } SEAM(pb + 4);
        if (IN(pb + 5)) { WSQ(); PBF(ZG, WS_ZG); PBF(YMIX, WS_YMIX);
            pg8::Gemm g{ZG, (const bf16_t*)(ws + WS_WGLU) + (size_t)l * 512 * 512, 512, 512, 512, 0}; pg8::StaticOrder S; S.init(need_ctx ? NR : NX, 512, F.G, F.bid);
            pg8::EpiGlu E{ZG, INP(22) + l * 512, YMIX}; pg8::gemm_phase<pg8::EpiGlu, pg8::StaticOrder, ALIGNv, SP2v>(ring, g, S, E, F.wave); } SEAM(pb + 5);
        if (IN(pb + 6)) { WSQ(); PBF(YMIX, WS_YMIX); const float* modl = (const float*)(ws + WS_MOD) + (size_t)l * 5 * 6144; float* XC = (float*)(ws + WS_XC);
            const float* xs_x = (l == 0) ? INP(0) : F.out; const float* xs_c = (l == 0) ? INP(2) : XC;
            { pg8::Gemm g{YMIX, (const bf16_t*)(ws + WS_WOUT) + (size_t)l * 1024 * 1024, 1024, 1024, 1024, 0}; pg8::StaticOrder S; S.init(NX, 1024, F.G, F.bid);
              pg8::EpiRes E{l == 0 ? xs_x : nullptr, (bf16_t*)F.out, modl + 2048, 1.f}; pg8::gemm_phase<pg8::EpiRes, pg8::StaticOrder, ALIGNv, SP2v>(ring, g, S, E, F.wave); }
            if (need_ctx) {
              pg8::Gemm g{YMIX + (size_t)NX * 1024, (const bf16_t*)(ws + WS_WOUT) + (size_t)l * 1024 * 1024, 1024, 1024, 256, 512, 512}; pg8::CtxSplitOrder S{4, F.G, F.bid};
              pg8::EpiPart E{(float*)(ws + WS_PART), 1.f}; pg8::gemm_phase<pg8::EpiPart, pg8::CtxSplitOrder, ALIGNv, SP2v>(ring, g, S, E, F.wave); }
        } SEAM(pb + 6);
        if (l == 0) {
            if (IN(pb + 7)) { WSQ(); PBF(XN, WS_XN); const float* modl = (const float*)(ws + WS_MOD); norm_rows<false, true>(F, F.out, INP(2), NR, INP(7), modl, 3072, 4096, XN, (const float*)(ws + WS_PART), 4, modl + 4 * 6144 + 2048, (float*)(ws + WS_XC)); } SEAM(pb + 7);
            if (IN(pb + 8)) { WSQ(); PBF(XN, WS_XN); PBF(H, WS_H);
                pg8::Gemm g{XN, (const bf16_t*)(ws + WS_WFF13), 1024, 1024, 1024, 0}; pg8::StaticOrder S; S.init(NR, 2 * DFF, F.G, F.bid);
                pg8::EpiSwiglu<true> E{H, DFF, 1.f}; pg8::gemm_phase<pg8::EpiSwiglu<true>, pg8::StaticOrder, ALIGNv, SP2v>(ring, g, S, E, F.wave); } SEAM(pb + 8);
            if (IN(pb + 9)) { WSQ(); PBF(H, WS_H); const float* modl = (const float*)(ws + WS_MOD); float* XC = (float*)(ws + WS_XC);
                { pg8::Gemm g{H, (const bf16_t*)(ws + WS_WFF2), DFF / 2, DFF / 2, DFF / 2, 0}; pg8::StaticOrder S; S.init(NX, 1024, F.G, F.bid);
                  pg8::EpiRes E{nullptr, (bf16_t*)F.out, modl + 5120, 1.f / W8_SCALE}; pg8::gemm_phase<pg8::EpiRes, pg8::StaticOrder, ALIGNv, SP2v, true>(ring, g, S, E, F.wave); }
                { pg8::Gemm g{(const bf16_t*)((const unsigned char*)H + (size_t)NX * DFF), (const bf16_t*)(ws + WS_WFF2), DFF / 2, DFF / 2, 128, 256, 256}; pg8::CtxSplitOrder S{11, F.G, F.bid};
                  pg8::EpiPart E{(float*)(ws + WS_PART), 1.f / W8_SCALE}; pg8::gemm_phase<pg8::EpiPart, pg8::CtxSplitOrder, ALIGNv, SP2v, true>(ring, g, S, E, F.wave); } } SEAM(pb + 9);
        } else {
            if (IN(pb + 7)) { WSQ(); const float* modl = (const float*)(ws + WS_MOD) + (size_t)5 * 6144; norm_router(F, F.out, INP(7) + 1024, modl, 3072, 4096, ws + WS_XNM); } SEAM(pb + 7);
            if (IN(pb + 8)) { WSQ(); moe_gather(F, ws + WS_XNM, ws + WS_XP); } SEAM(pb + 8);
            if (IN(pb + 9)) { WSQ(); PBF(XP, WS_XP); PBF(HP, WS_HP); const unsigned* cnt = F.ctl + CW_MOE; int o[9]; o[0] = 0;
#pragma unroll
                for (int e = 0; e < 8; ++e) o[e + 1] = o[e] + pad256(cnt[e]);
                pg8::MoeOrder S; S.nT = o[8] / 256; S.nN = 2 * DFE / 256; S.nwg = S.nT * S.nN; S.G = F.G; S.c = F.bid; S.o1 = o[1]; S.o2 = o[2]; S.o3 = o[3]; S.o4 = o[4]; S.o5 = o[5]; S.o6 = o[6]; S.o7 = o[7];
                pg8::Gemm g{XP, (const bf16_t*)(ws + WS_WM13), 512, 512, 512, (size_t)2 * DFE * 1024};
                pg8::EpiSwiglu<true> E{HP, DFE8, 1.f / W8_SCALE}; pg8::gemm_phase<pg8::EpiSwiglu<true>, pg8::MoeOrder, ALIGNv, SP2v, true>(ring, g, S, E, F.wave); } SEAM(pb + 9);
        }
    }
    if (IN(21)) { WSQ(); PBF(HP, WS_HP); PBF(YP, WS_YP); const unsigned* cnt = F.ctl + CW_MOE; int o[9]; o[0] = 0;
#pragma unroll
        for (int e = 0; e < 8; ++e) o[e + 1] = o[e] + pad256(cnt[e]);
        pg8::MoeOrder S; S.nT = o[8] / 256; S.nN = 4; S.nwg = S.nT * S.nN; S.G = F.G; S.c = F.bid; S.o1 = o[1]; S.o2 = o[2]; S.o3 = o[3]; S.o4 = o[4]; S.o5 = o[5]; S.o6 = o[6]; S.o7 = o[7];
        pg8::Gemm g{HP, (const bf16_t*)(ws + WS_WM2), DFE8 / 2, DFE8 / 2, DFE8 / 2, (size_t)1024 * DFE8};
        pg8::EpiBf16 E{YP, 1024, 1.f / W8_SCALE}; pg8::gemm_phase<pg8::EpiBf16, pg8::MoeOrder, ALIGNv, SP2v, true>(ring, g, S, E, F.wave); } SEAM(21);
    if (IN(22)) { WSQ(); PBF(YP, WS_YP); moe_combine_final(F, A, YP, (const float*)(ws + WS_MOD) + (size_t)5 * 6144 + 5120);
#if PROBE_ON
        { __syncthreads(); const unsigned long long* pw = (const unsigned long long*)(ws + WS_PROBE); float va, vb;
          if (PROBE_A >= 100) va = (float)(pw[16 + PROBE_A - 100] - pw[16 + PROBE_A - 101]) * 0.1f; else va = (float)pw[PROBE_A] / 131.f;
          if (PROBE_B >= 100) vb = (float)(pw[16 + PROBE_B - 100] - pw[16 + PROBE_B - 101]) * 0.1f; else vb = (float)pw[PROBE_B] / 131.f;
          if (PROBE_A == 63) { va = 1234.f; vb = 777.f; }
          va = exp2f((rintf(4.f * log2f(fmaxf(va, 1.f)) + PROBE_Q) - PROBE_Q) * 0.25f); vb = exp2f((rintf(4.f * log2f(fmaxf(vb, 1.f)) + PROBE_Q) - PROBE_Q) * 0.25f);
          const float sn = 1000.f * sqrtf(va);
          const int lane = lane_id();
          for (int r = F.gw; r < NX; r += F.NGW)
#pragma unroll
              for (int jq = 0; jq < 4; ++jq) { const size_t i = (size_t)r * 1024 + 4 * lane + 256 * jq; f32x4 o;
#pragma unroll
                  for (int k = 0; k < 4; ++k) { const unsigned hsh = (unsigned)(i + k) * 2654435761u; o[k] = (hsh & 0x10000u) ? sn : -sn; }
                  if (i == 0) o[0] = 1.0e4f * vb;
                  *(f32x4*)(F.out + i) = o; } }
#endif
    }
#undef IN
#undef SEAM
}

extern "C" void kernel_launch(void* const* d_in, const int* in_sizes, int n_in, void* d_out, int out_size, void* d_ws, size_t ws_size, hipStream_t stream) {
    static int grid = 0;
    if (grid == 0) {
        if (n_in != 32 || in_sizes[0] != NX * DM || out_size != NX * DM || ws_size < WS_END) { fprintf(stderr, "kernel_launch: unexpected shapes (n_in %d, in0 %d, out %d, ws %zu); nothing launched\n", n_in, n_in > 0 ? in_sizes[0] : -1, out_size, ws_size); grid = -1; return; }
        int dev = 0, cus = 0, per_cu = 0;
        if (hipGetDevice(&dev) != hipSuccess || hipDeviceGetAttribute(&cus, hipDeviceAttributeMultiprocessorCount, dev) != hipSuccess) { grid = -1; return; }
        if (hipFuncSetAttribute((const void*)fwd_kernel, hipFuncAttributeMaxDynamicSharedMemorySize, LDS_BYTES) != hipSuccess) { fprintf(stderr, "kernel_launch: hipFuncSetAttribute failed\n"); grid = -1; return; }
        if (hipOccupancyMaxActiveBlocksPerMultiprocessor(&per_cu, (const void*)fwd_kernel, NTHR, LDS_BYTES) != hipSuccess || per_cu < 1) fprintf(stderr, "kernel_launch: occupancy query says %d\n", per_cu);
        (void)hipGetLastError();
        grid = cus;
    }
    if (grid < 0) return;
    if (hipMemsetAsync((char*)d_ws + WS_CTL, 0, CTL_ZERO_BYTES, stream) != hipSuccess) { fprintf(stderr, "kernel_launch: memset failed\n"); return; }
    Args a{};
    for (int i = 0; i < 32; ++i) a.in[i] = (const float*)d_in[i];
    a.out = (float*)d_out; a.ws = (unsigned char*)d_ws; a.pad = 0;
#if MK_N_LAUNCHES == 1
    a.ph_lo = 0; a.ph_hi = N_PHASES; a.li = 0;
    hipLaunchKernelGGL(fwd_kernel, dim3(grid), dim3(NTHR), LDS_BYTES, stream, a);
#else
    for (int p = 0; p < N_PHASES; ++p) { a.ph_lo = p; a.ph_hi = p + 1; a.li = p; hipLaunchKernelGGL(fwd_kernel, dim3(grid), dim3(NTHR), LDS_BYTES, stream, a); }
#endif
    const hipError_t le = hipPeekAtLastError();
    if (le != hipSuccess) fprintf(stderr, "kernel_launch: launch failed: %s\n", hipGetErrorName(le));
}
```
